# Optimizing an MI355X kernel written in HIP

```python
import math
import jax, jax.numpy as jnp
from jax import lax
import numpy as np

D_MODEL = 1024
BATCH = 8
SEQ = 2048
DEPTH = 2

N_MEM = 256
EPS = 1e-6
CHUNK = 128
N_BRANCH = 4

S5_WIDTH = 512
S5_GROUP = 16
S5_GROUPS = S5_WIDTH // S5_GROUP
S5_STATE = 64
S5_DT_MIN = 1e-3
S5_DT_MAX = 1e-1

SSD_HEADS = 8
SSD_HEAD_DIM = 64
SSD_WIDTH = SSD_HEADS * SSD_HEAD_DIM
SSD_GROUPS = 2
SSD_HEADS_PER_GROUP = SSD_HEADS // SSD_GROUPS
SSD_STATE = 64
SSD_CONV = 4
SSD_CONV_DIM = SSD_WIDTH + 2 * SSD_GROUPS * SSD_STATE

RET_HEADS = 8
RET_HEAD_DIM = 64
RET_WIDTH = RET_HEADS * RET_HEAD_DIM
ROPE_BASE = 10000.0

LRU_WIDTH = 512
LRU_BLOCKS = 8
LRU_BLOCK = LRU_WIDTH // LRU_BLOCKS
LRU_CONV = 4
LRU_C = 8.0

SECTION_WIDTHS = (S5_WIDTH, SSD_WIDTH, SSD_CONV_DIM, SSD_HEADS,
                  RET_WIDTH, RET_WIDTH, RET_WIDTH, RET_WIDTH,
                  LRU_WIDTH, LRU_WIDTH, N_BRANCH * D_MODEL)
IN_TOTAL = sum(SECTION_WIDTHS)
BRANCH_WIDTH = 512

XA_HEADS = 4
XA_HEAD_DIM = D_MODEL // XA_HEADS

D_FF = 2816
N_EXPERTS = 8
TOP_K = 2
D_FF_EXPERT = 3584
N_DENSE = (DEPTH + 1) // 2
N_MOE = DEPTH // 2

kernel_name = 'hybrid_gated_s5_ssd_retention_rglru_moe'


def rmsnorm(x, w):
    xf = x.astype(jnp.float32)
    xf = xf * lax.rsqrt(jnp.mean(xf * xf, axis=-1, keepdims=True) + EPS)
    return (xf * w.astype(jnp.float32)).astype(x.dtype)


def causal_dwconv(x, w, b):
    k = w.shape[0]
    y = lax.conv_general_dilated(x, w[:, None, :].astype(x.dtype), window_strides=(1,),
                                 padding=[(k - 1, 0)], dimension_numbers=('NWC', 'WIO', 'NWC'),
                                 feature_group_count=x.shape[-1])
    return y + b.astype(x.dtype)


def apply_rope(x, cos, sin):
    x1, x2 = jnp.split(x, 2, axis=-1)
    return jnp.concatenate([x1 * cos - x2 * sin, x2 * cos + x1 * sin], axis=-1)


def _combine_complex(e1, e2):
    a1r, a1i, b1r, b1i = e1
    a2r, a2i, b2r, b2i = e2
    return (a2r * a1r - a2i * a1i, a2r * a1i + a2i * a1r,
            a2r * b1r - a2i * b1i + b2r, a2r * b1i + a2i * b1r + b2i)


def _combine_real(e1, e2):
    a1, b1 = e1
    a2, b2 = e2
    return (a1 * a2, a2 * b1 + b2)


def s5_mixer(u, lam_re, lam_im, b_re, b_im, c_re, c_im, d_skip, log_dt, w_glu):
    bsz, seq, _ = u.shape
    f32 = jnp.float32
    ug = u.astype(f32).reshape(bsz, seq, S5_GROUPS, S5_GROUP)
    lr = lam_re.astype(f32)
    li = lam_im.astype(f32)
    step = jnp.exp(log_dt.astype(f32))[:, None]
    mag = jnp.exp(lr * step)
    ar = mag * jnp.cos(li * step)
    ai = mag * jnp.sin(li * step)
    inv = 1.0 / (lr * lr + li * li)
    cr = ((ar - 1.0) * lr + ai * li) * inv
    ci = (ai * lr - (ar - 1.0) * li) * inv
    br = b_re.astype(f32)
    bi = b_im.astype(f32)
    bb_r = cr[..., None] * br - ci[..., None] * bi
    bb_i = cr[..., None] * bi + ci[..., None] * br
    bu_r = jnp.einsum('blgh,gnh->blgn', ug, bb_r)
    bu_i = jnp.einsum('blgh,gnh->blgn', ug, bb_i)
    a_r = jnp.broadcast_to(ar, bu_r.shape)
    a_i = jnp.broadcast_to(ai, bu_r.shape)
    _, _, s_r, s_i = lax.associative_scan(_combine_complex, (a_r, a_i, bu_r, bu_i), axis=1)
    y = (jnp.einsum('blgn,ghn->blgh', s_r, c_re.astype(f32))
         - jnp.einsum('blgn,ghn->blgh', s_i, c_im.astype(f32))
         + d_skip.astype(f32) * ug)
    y = jax.nn.gelu(y).reshape(bsz, seq, S5_WIDTH).astype(u.dtype)
    return y * jax.nn.sigmoid(y @ w_glu)


def ssd_mixer(z, xbc, dt_raw, conv_w, conv_b, dt_bias, a_log, d_skip, norm_w):
    bsz, seq, _ = z.shape
    nc = seq // CHUNK
    f32 = jnp.float32
    xbc = jax.nn.silu(causal_dwconv(xbc, conv_w, conv_b)).astype(f32)
    xs = xbc[..., :SSD_WIDTH]
    bs = xbc[..., SSD_WIDTH:SSD_WIDTH + SSD_GROUPS * SSD_STATE]
    cs = xbc[..., SSD_WIDTH + SSD_GROUPS * SSD_STATE:]
    G, R, P, N = SSD_GROUPS, SSD_HEADS_PER_GROUP, SSD_HEAD_DIM, SSD_STATE
    x = xs.reshape(bsz, nc, CHUNK, G, R, P)
    bm = bs.reshape(bsz, nc, CHUNK, G, N)
    cm = cs.reshape(bsz, nc, CHUNK, G, N)
    dt = jax.nn.softplus(dt_raw.astype(f32) + dt_bias.astype(f32)).reshape(bsz, nc, CHUNK, G, R)
    a = -jnp.exp(a_log.astype(f32)).reshape(G, R)
    acum = jnp.cumsum(dt * a, axis=2)
    xdt = x * dt[..., None]
    seg = acum[:, :, :, None] - acum[:, :, None, :]
    causal = jnp.tril(jnp.ones((CHUNK, CHUNK), dtype=bool))[:, :, None, None]
    lmat = jnp.exp(jnp.where(causal, seg, -jnp.inf))
    cb = jnp.einsum('bclgn,bcsgn->bclsg', cm, bm)
    y_diag = jnp.einsum('bclsgr,bcsgrp->bclgrp', cb[..., None] * lmat, xdt)
    decay_end = jnp.exp(acum[:, :, -1:] - acum)
    chunk_states = jnp.einsum('bcsgn,bcsgr,bcsgrp->bcgrpn', bm, decay_end, xdt)
    chunk_decay = jnp.exp(acum[:, :, -1])

    def step(state, inp):
        cst, dec = inp
        return state * dec[..., None, None] + cst, state

    init = jnp.zeros((bsz, G, R, P, N), f32)
    _, prev = lax.scan(step, init, (jnp.moveaxis(chunk_states, 1, 0), jnp.moveaxis(chunk_decay, 1, 0)))
    prev = jnp.moveaxis(prev, 0, 1)
    y_off = jnp.einsum('bclgn,bcgrpn->bclgrp', cm, prev) * jnp.exp(acum)[..., None]
    y = y_diag + y_off + d_skip.astype(f32).reshape(G, R)[:, :, None] * x
    y = y.reshape(bsz, seq, SSD_WIDTH) * jax.nn.silu(z.astype(f32))
    return rmsnorm(y, norm_w).astype(z.dtype)


def retention_mixer(q, k, v, g, cos, sin, gn_w):
    bsz, seq, _ = q.shape
    nc = seq // CHUNK
    f32 = jnp.float32
    H, Dh = RET_HEADS, RET_HEAD_DIM
    q = apply_rope(q.reshape(bsz, seq, H, Dh), cos.astype(q.dtype), sin.astype(q.dtype))
    k = apply_rope(k.reshape(bsz, seq, H, Dh), cos.astype(k.dtype), sin.astype(k.dtype)) * (Dh ** -0.5)
    q = q.astype(f32).reshape(bsz, nc, CHUNK, H, Dh)
    k = k.astype(f32).reshape(bsz, nc, CHUNK, H, Dh)
    v = v.astype(f32).reshape(bsz, nc, CHUNK, H, Dh)
    log_gamma = jnp.log1p(-jnp.exp2(-5.0 - jnp.arange(H, dtype=f32)))
    idx = jnp.arange(CHUNK, dtype=f32)
    diff = idx[:, None] - idx[None, :]
    causal = diff >= 0
    dmat = jnp.where(causal[None], jnp.exp(jnp.where(causal, diff, 0.0)[None] * log_gamma[:, None, None]), 0.0)
    scores = jnp.einsum('bclhd,bcshd->bchls', q, k) * dmat
    inner = jnp.einsum('bchls,bcshe->bclhe', scores, v)
    k_decay = jnp.exp((CHUNK - 1.0 - idx)[:, None] * log_gamma)
    chunk_kv = jnp.einsum('bcshd,bcshe->bchde', k * k_decay[:, :, None], v)
    chunk_decay = jnp.exp(CHUNK * log_gamma)

    def step(state, kv):
        return state * chunk_decay[:, None, None] + kv, state

    _, prev = lax.scan(step, jnp.zeros((bsz, H, Dh, Dh), f32), jnp.moveaxis(chunk_kv, 1, 0))
    prev = jnp.moveaxis(prev, 0, 1)
    q_decay = jnp.exp((idx + 1.0)[:, None] * log_gamma)
    cross = jnp.einsum('bclhd,bchde->bclhe', q, prev) * q_decay[:, :, None]
    y = (inner + cross).reshape(bsz, seq, H, Dh)
    mu = jnp.mean(y, axis=-1, keepdims=True)
    var = jnp.mean(jnp.square(y - mu), axis=-1, keepdims=True)
    y = (y - mu) * lax.rsqrt(var + EPS) * gn_w.astype(f32).reshape(H, Dh)
    y = y.reshape(bsz, seq, RET_WIDTH)
    return (jax.nn.silu(g.astype(f32)) * y).astype(g.dtype)


def rglru_mixer(x, gate, conv_w, conv_b, wa, ba, wx, bx, lam):
    bsz, seq, _ = x.shape
    f32 = jnp.float32
    xc = causal_dwconv(x, conv_w, conv_b)
    xb = xc.reshape(bsz, seq, LRU_BLOCKS, LRU_BLOCK)
    r = jax.nn.sigmoid((jnp.einsum('blhi,hij->blhj', xb, wa).reshape(bsz, seq, LRU_WIDTH) + ba).astype(f32))
    i = jax.nn.sigmoid((jnp.einsum('blhi,hij->blhj', xb, wx).reshape(bsz, seq, LRU_WIDTH) + bx).astype(f32))
    log_a = -LRU_C * r * jax.nn.softplus(-lam.astype(f32))
    a = jnp.exp(log_a)
    mult = jnp.sqrt(jnp.maximum(-jnp.expm1(2.0 * log_a), 0.0))
    b = mult * i * xc.astype(f32)
    _, hs = lax.associative_scan(_combine_real, (a, b), axis=1)
    return (hs * jax.nn.gelu(gate.astype(f32))).astype(x.dtype)


def mixing_block(h, cos, sin, norm_w, w_in, b_gate,
                 s5_lam_re, s5_lam_im, s5_b_re, s5_b_im, s5_c_re, s5_c_im, s5_d, s5_log_dt, s5_w_glu,
                 ssd_conv_w, ssd_conv_b, ssd_dt_bias, ssd_a_log, ssd_d, ssd_norm,
                 ret_norm,
                 lru_conv_w, lru_conv_b, lru_wa, lru_ba, lru_wx, lru_bx, lru_lam,
                 w_branch, w_out):
    bsz, seq, _ = h.shape
    hn = rmsnorm(h, norm_w)
    proj = hn @ w_in
    split_points = tuple(int(v) for v in np.cumsum(SECTION_WIDTHS)[:-1])
    (u_s5, z_ssd, xbc_ssd, dt_ssd, q_ret, k_ret, v_ret, g_ret,
     x_lru, gate_lru, gate_logits) = jnp.split(proj, split_points, axis=-1)
    branches = (
        s5_mixer(u_s5, s5_lam_re, s5_lam_im, s5_b_re, s5_b_im, s5_c_re, s5_c_im, s5_d, s5_log_dt, s5_w_glu),
        ssd_mixer(z_ssd, xbc_ssd, dt_ssd, ssd_conv_w, ssd_conv_b, ssd_dt_bias, ssd_a_log, ssd_d, ssd_norm),
        retention_mixer(q_ret, k_ret, v_ret, g_ret, cos, sin, ret_norm),
        rglru_mixer(x_lru, gate_lru, lru_conv_w, lru_conv_b, lru_wa, lru_ba, lru_wx, lru_bx, lru_lam),
    )
    gates = jax.nn.sigmoid((gate_logits + b_gate).astype(jnp.float32)).astype(h.dtype)
    gates = gates.reshape(bsz, seq, N_BRANCH, D_MODEL)
    merged = gates[:, :, 0] * (branches[0] @ w_branch[0])
    for bi in range(1, N_BRANCH):
        merged = merged + gates[:, :, bi] * (branches[bi] @ w_branch[bi])
    return merged @ w_out


def cross_attention(h, mem, norm_w, mem_norm_w, wq, wk, wv, wo):
    bsz, seq, _ = h.shape
    hn = rmsnorm(h, norm_w)
    mn = rmsnorm(mem, mem_norm_w)
    q = (hn @ wq).reshape(bsz, seq, XA_HEADS, XA_HEAD_DIM)
    k = (mn @ wk).reshape(bsz, mem.shape[1], XA_HEADS, XA_HEAD_DIM)
    v = (mn @ wv).reshape(bsz, mem.shape[1], XA_HEADS, XA_HEAD_DIM)
    s = jnp.einsum('blhd,bmhd->bhlm', q, k).astype(jnp.float32) * (XA_HEAD_DIM ** -0.5)
    p = jax.nn.softmax(s, axis=-1).astype(v.dtype)
    o = jnp.einsum('bhlm,bmhd->blhd', p, v).reshape(bsz, seq, D_MODEL)
    return o @ wo


def swiglu(x, w1, w3, w2):
    return (jax.nn.silu(x @ w1) * (x @ w3)) @ w2


def moe_swiglu(x, w_router, w1, w3, w2):
    bsz, seq, _ = x.shape
    t = x.reshape(-1, D_MODEL)
    logits = (t @ w_router).astype(jnp.float32)
    top_v, top_i = lax.top_k(logits, TOP_K)
    top_w = jax.nn.softmax(top_v, axis=-1)
    combine = jnp.einsum('tk,tke->te', top_w, jax.nn.one_hot(top_i, N_EXPERTS, dtype=jnp.float32)).astype(x.dtype)
    out = combine[:, 0:1] * swiglu(t, w1[0], w3[0], w2[0])
    for e in range(1, N_EXPERTS):
        out = out + combine[:, e:e + 1] * swiglu(t, w1[e], w3[e], w2[e])
    return out.reshape(bsz, seq, D_MODEL)


def setup_inputs(seed: int = 0) -> dict:
    key = jax.random.key(seed)
    keys = iter(jax.random.split(key, 64))
    f32 = jnp.float32

    def nrm(shape, scale):
        return jax.random.normal(next(keys), shape, f32) * scale

    def gain(shape):
        return 1.0 + nrm(shape, 0.02)

    x = nrm((BATCH, SEQ, D_MODEL), 1.0)
    mem = nrm((BATCH, N_MEM, D_MODEL), 1.0)
    offsets = jax.random.randint(next(keys), (BATCH, 1), 0, 4096, dtype=jnp.int32)
    positions = (jnp.arange(SEQ, dtype=jnp.int32)[None, :] + offsets).astype(jnp.int32)

    s5_lam_re = -0.5 + nrm((DEPTH, S5_GROUPS, S5_STATE), 0.01)
    s5_lam_im = math.pi * jnp.arange(S5_STATE, dtype=f32)[None, None, :] + nrm((DEPTH, S5_GROUPS, S5_STATE), 0.01)
    s5_log_dt = jax.random.uniform(next(keys), (DEPTH, S5_GROUPS), f32, math.log(S5_DT_MIN), math.log(S5_DT_MAX))
    ssd_dt = jnp.exp(jax.random.uniform(next(keys), (DEPTH, SSD_HEADS), f32, math.log(1e-3), math.log(1e-1)))
    ssd_dt_bias = ssd_dt + jnp.log(-jnp.expm1(-ssd_dt))
    ssd_a_log = jnp.log(jax.random.uniform(next(keys), (DEPTH, SSD_HEADS), f32, 1.0, 16.0))
    lru_u = jax.random.uniform(next(keys), (DEPTH, LRU_WIDTH), f32, 0.9, 0.999)
    lru_a0 = lru_u ** (1.0 / LRU_C)
    lru_lam = jnp.log(lru_a0) - jnp.log1p(-lru_a0)

    return {
        'x': x, 'mem': mem, 'positions': positions,
        'norm_mix': gain((DEPTH, D_MODEL)),
        'w_in': nrm((DEPTH, D_MODEL, IN_TOTAL), D_MODEL ** -0.5),
        'b_gate': nrm((DEPTH, N_BRANCH * D_MODEL), 0.02),
        's5_lam_re': s5_lam_re, 's5_lam_im': s5_lam_im,
        's5_b_re': nrm((DEPTH, S5_GROUPS, S5_STATE, S5_GROUP), (2 * S5_GROUP) ** -0.5),
        's5_b_im': nrm((DEPTH, S5_GROUPS, S5_STATE, S5_GROUP), (2 * S5_GROUP) ** -0.5),
        's5_c_re': nrm((DEPTH, S5_GROUPS, S5_GROUP, S5_STATE), S5_STATE ** -0.5),
        's5_c_im': nrm((DEPTH, S5_GROUPS, S5_GROUP, S5_STATE), S5_STATE ** -0.5),
        's5_d': nrm((DEPTH, S5_GROUPS, S5_GROUP), 1.0),
        's5_log_dt': s5_log_dt,
        's5_w_glu': nrm((DEPTH, S5_WIDTH, S5_WIDTH), S5_WIDTH ** -0.5),
        'ssd_conv_w': nrm((DEPTH, SSD_CONV, SSD_CONV_DIM), SSD_CONV ** -0.5),
        'ssd_conv_b': nrm((DEPTH, SSD_CONV_DIM), 0.02),
        'ssd_dt_bias': ssd_dt_bias, 'ssd_a_log': ssd_a_log,
        'ssd_d': 1.0 + nrm((DEPTH, SSD_HEADS), 0.1),
        'ssd_norm': gain((DEPTH, SSD_WIDTH)),
        'ret_norm': gain((DEPTH, RET_WIDTH)),
        'lru_conv_w': nrm((DEPTH, LRU_CONV, LRU_WIDTH), LRU_CONV ** -0.5),
        'lru_conv_b': nrm((DEPTH, LRU_WIDTH), 0.02),
        'lru_wa': nrm((DEPTH, LRU_BLOCKS, LRU_BLOCK, LRU_BLOCK), LRU_BLOCK ** -0.5),
        'lru_ba': nrm((DEPTH, LRU_WIDTH), 0.02),
        'lru_wx': nrm((DEPTH, LRU_BLOCKS, LRU_BLOCK, LRU_BLOCK), LRU_BLOCK ** -0.5),
        'lru_bx': nrm((DEPTH, LRU_WIDTH), 0.02),
        'lru_lam': lru_lam,
        'w_branch': nrm((DEPTH, N_BRANCH, BRANCH_WIDTH, D_MODEL), BRANCH_WIDTH ** -0.5),
        'w_out': nrm((DEPTH, D_MODEL, D_MODEL), D_MODEL ** -0.5),
        'norm_xa': gain((DEPTH, D_MODEL)),
        'norm_mem': gain((DEPTH, D_MODEL)),
        'xa_wq': nrm((DEPTH, D_MODEL, D_MODEL), D_MODEL ** -0.5),
        'xa_wk': nrm((DEPTH, D_MODEL, D_MODEL), D_MODEL ** -0.5),
        'xa_wv': nrm((DEPTH, D_MODEL, D_MODEL), D_MODEL ** -0.5),
        'xa_wo': nrm((DEPTH, D_MODEL, D_MODEL), D_MODEL ** -0.5),
        'norm_ffn': gain((DEPTH, D_MODEL)),
        'ffn_w1': nrm((N_DENSE, D_MODEL, D_FF), D_MODEL ** -0.5),
        'ffn_w3': nrm((N_DENSE, D_MODEL, D_FF), D_MODEL ** -0.5),
        'ffn_w2': nrm((N_DENSE, D_FF, D_MODEL), D_FF ** -0.5),
        'moe_router': nrm((N_MOE, D_MODEL, N_EXPERTS), D_MODEL ** -0.5),
        'moe_w1': nrm((N_MOE, N_EXPERTS, D_MODEL, D_FF_EXPERT), D_MODEL ** -0.5),
        'moe_w3': nrm((N_MOE, N_EXPERTS, D_MODEL, D_FF_EXPERT), D_MODEL ** -0.5),
        'moe_w2': nrm((N_MOE, N_EXPERTS, D_FF_EXPERT, D_MODEL), D_FF_EXPERT ** -0.5),
        'norm_final': gain((D_MODEL,)),
    }


def reference(x, mem, positions, norm_mix, w_in, b_gate,
              s5_lam_re, s5_lam_im, s5_b_re, s5_b_im, s5_c_re, s5_c_im, s5_d, s5_log_dt, s5_w_glu,
              ssd_conv_w, ssd_conv_b, ssd_dt_bias, ssd_a_log, ssd_d, ssd_norm,
              ret_norm,
              lru_conv_w, lru_conv_b, lru_wa, lru_ba, lru_wx, lru_bx, lru_lam,
              w_branch, w_out,
              norm_xa, norm_mem, xa_wq, xa_wk, xa_wv, xa_wo,
              norm_ffn, ffn_w1, ffn_w3, ffn_w2,
              moe_router, moe_w1, moe_w3, moe_w2,
              norm_final):
    half = RET_HEAD_DIM // 2
    inv_freq = ROPE_BASE ** (-jnp.arange(half, dtype=jnp.float32) / half)
    ang = positions.astype(jnp.float32)[..., None] * inv_freq
    cos = jnp.cos(ang)[:, :, None, :]
    sin = jnp.sin(ang)[:, :, None, :]
    h = x
    for i in range(DEPTH):
        h = h + mixing_block(h, cos, sin, norm_mix[i], w_in[i], b_gate[i],
                             s5_lam_re[i], s5_lam_im[i], s5_b_re[i], s5_b_im[i], s5_c_re[i], s5_c_im[i],
                             s5_d[i], s5_log_dt[i], s5_w_glu[i],
                             ssd_conv_w[i], ssd_conv_b[i], ssd_dt_bias[i], ssd_a_log[i], ssd_d[i], ssd_norm[i],
                             ret_norm[i],
                             lru_conv_w[i], lru_conv_b[i], lru_wa[i], lru_ba[i], lru_wx[i], lru_bx[i], lru_lam[i],
                             w_branch[i], w_out[i])
        h = h + cross_attention(h, mem, norm_xa[i], norm_mem[i], xa_wq[i], xa_wk[i], xa_wv[i], xa_wo[i])
        hn = rmsnorm(h, norm_ffn[i])
        if i % 2 == 0:
            h = h + swiglu(hn, ffn_w1[i // 2], ffn_w3[i // 2], ffn_w2[i // 2])
        else:
            h = h + moe_swiglu(hn, moe_router[i // 2], moe_w1[i // 2], moe_w3[i // 2], moe_w2[i // 2])
    return rmsnorm(h, norm_final)
```

```cpp
#include <hip/hip_runtime.h>
#include <stdint.h>
#include <math.h>

namespace cfg {
constexpr int D = 1024, NB = 8, L = 2048, T = NB * L, NMEM = 256, TM = NB * NMEM;
constexpr int IN_TOTAL = 8968;
constexpr int OFF_U = 0, OFF_Z = 512, OFF_XBC = 1024, OFF_DT = 1792, OFF_Q = 1800, OFF_K = 2312, OFF_V = 2824, OFF_G = 3336, OFF_XL = 3848, OFF_GL = 4360, OFF_GATE = 4872;
constexpr int PW = 4872;
constexpr int DFF = 2816, DFE = 3584, NE = 8;
constexpr int HB = 4;
constexpr int HR = HB * L;
}
using namespace cfg;

__device__ __forceinline__ float wave_sum(float v) {
#pragma unroll
    for (int o = 1; o < 64; o <<= 1) v += __shfl_xor(v, o);
    return v;
}
__device__ __forceinline__ float wave_max(float v) {
#pragma unroll
    for (int o = 1; o < 64; o <<= 1) v = fmaxf(v, __shfl_xor(v, o));
    return v;
}
__device__ __forceinline__ float sigmoidf_(float x) { return 1.0f / (1.0f + expf(-x)); }
__device__ __forceinline__ float siluf_(float x) { return x / (1.0f + expf(-x)); }
__device__ __forceinline__ float gelu_tanh(float x) { return 0.5f * x * (1.0f + tanhf(0.7978845608028654f * (x + 0.044715f * x * x * x))); }
__device__ __forceinline__ float softplusf_(float x) { return x > 20.f ? x : log1pf(expf(x)); }

__global__ void k_rmsnorm(const float* __restrict__ in, const float* __restrict__ w, float* __restrict__ out, int rows) {
    const int row = blockIdx.x * 4 + (threadIdx.x >> 6), lane = threadIdx.x & 63;
    if (row >= rows) return;
    const float4* p = (const float4*)(in + (size_t)row * D);
    float4 v[4]; float ss = 0.f;
#pragma unroll
    for (int i = 0; i < 4; ++i) { v[i] = p[lane + 64 * i]; ss += v[i].x * v[i].x + v[i].y * v[i].y + v[i].z * v[i].z + v[i].w * v[i].w; }
    ss = wave_sum(ss);
    const float r = 1.0f / sqrtf(ss * (1.0f / D) + 1e-6f);
    const float4* wp = (const float4*)w; float4* o = (float4*)(out + (size_t)row * D);
#pragma unroll
    for (int i = 0; i < 4; ++i) { const float4 ww = wp[lane + 64 * i]; float4 y; y.x = v[i].x * r * ww.x; y.y = v[i].y * r * ww.y; y.z = v[i].z * r * ww.z; y.w = v[i].w * r * ww.w; o[lane + 64 * i] = y; }
}

template <int ACC>
__global__ void __launch_bounds__(256) k_sgemm(const float* __restrict__ A, int lda, const float* __restrict__ B, int ldb, float* __restrict__ C, int ldc,
                                               int M, int N, int K, const int* __restrict__ mptr, int mbase, int mcap) {
    if (mptr) { int m = *mptr - mbase; m = m < 0 ? 0 : m; M = m < mcap ? m : mcap; }
    const int row0 = blockIdx.y * 128, col0 = blockIdx.x * 128;
    if (row0 >= M) return;
    __shared__ float As[8][128 + 4];
    __shared__ float Bs[8][128 + 4];
    const int tid = threadIdx.x, ty = tid >> 4, tx = tid & 15;
    float acc[8][8];
#pragma unroll
    for (int i = 0; i < 8; ++i)
#pragma unroll
        for (int j = 0; j < 8; ++j) acc[i][j] = 0.f;
    const int ar = tid >> 1, ak = (tid & 1) * 4;
    const int bk = tid >> 5, bc = (tid & 31) * 4;
    for (int k0 = 0; k0 < K; k0 += 8) {
        float4 av = make_float4(0.f, 0.f, 0.f, 0.f), bv = make_float4(0.f, 0.f, 0.f, 0.f);
        if (row0 + ar < M) av = *(const float4*)(A + (size_t)(row0 + ar) * lda + k0 + ak);
        {
            const float* bp = B + (size_t)(k0 + bk) * ldb + col0 + bc;
            if (col0 + bc + 3 < N) bv = *(const float4*)bp;
            else { if (col0 + bc < N) bv.x = bp[0]; if (col0 + bc + 1 < N) bv.y = bp[1]; if (col0 + bc + 2 < N) bv.z = bp[2]; }
        }
        __syncthreads();
        As[ak + 0][ar] = av.x; As[ak + 1][ar] = av.y; As[ak + 2][ar] = av.z; As[ak + 3][ar] = av.w;
        *(float4*)&Bs[bk][bc] = bv;
        __syncthreads();
#pragma unroll
        for (int kk = 0; kk < 8; ++kk) {
            float a[8], b[8];
            *(float4*)&a[0] = *(const float4*)&As[kk][ty * 4]; *(float4*)&a[4] = *(const float4*)&As[kk][64 + ty * 4];
            *(float4*)&b[0] = *(const float4*)&Bs[kk][tx * 4]; *(float4*)&b[4] = *(const float4*)&Bs[kk][64 + tx * 4];
#pragma unroll
            for (int i = 0; i < 8; ++i)
#pragma unroll
                for (int j = 0; j < 8; ++j) acc[i][j] += a[i] * b[j];
        }
    }
#pragma unroll
    for (int i = 0; i < 8; ++i) {
        const int r = row0 + (i < 4 ? ty * 4 + i : 64 + ty * 4 + (i - 4));
        if (r >= M) continue;
#pragma unroll
        for (int j = 0; j < 8; ++j) {
            const int c = col0 + (j < 4 ? tx * 4 + j : 64 + tx * 4 + (j - 4));
            if (c < N) { float* cp = C + (size_t)r * ldc + c; if (ACC) *cp += acc[i][j]; else *cp = acc[i][j]; }
        }
    }
}

__global__ void k_conv_inplace(float* buf, int pitch, int coff, int C, const float* __restrict__ w, const float* __restrict__ bias, int act, int nb) {
    const int idx = blockIdx.x * blockDim.x + threadIdx.x;
    if (idx >= nb * C) return;
    const int b = idx / C, c = idx % C;
    const float w0 = w[c], w1 = w[C + c], w2 = w[2 * C + c], w3 = w[3 * C + c], bb = bias[c];
    float x0 = 0.f, x1 = 0.f, x2 = 0.f;
    float* p = buf + (size_t)b * L * pitch + coff + c;
    for (int t = 0; t < L; ++t) {
        const float x3 = p[(size_t)t * pitch];
        float y = w0 * x0 + w1 * x1 + w2 * x2 + w3 * x3 + bb;
        if (act) y = siluf_(y);
        p[(size_t)t * pitch] = y;
        x0 = x1; x1 = x2; x2 = x3;
    }
}

__global__ void __launch_bounds__(64) k_s5_scan(const float* __restrict__ proj, float* __restrict__ br,
                                                const float* __restrict__ lam_re, const float* __restrict__ lam_im, const float* __restrict__ b_re, const float* __restrict__ b_im,
                                                const float* __restrict__ c_re, const float* __restrict__ c_im, const float* __restrict__ dsk, const float* __restrict__ log_dt) {
    const int b = blockIdx.x / 32, g = blockIdx.x % 32, n = threadIdx.x;
    const float lr = lam_re[g * 64 + n], li = lam_im[g * 64 + n], step = expf(log_dt[g]);
    const float mag = expf(lr * step), ar = mag * cosf(li * step), ai = mag * sinf(li * step);
    const float inv = 1.0f / (lr * lr + li * li);
    const float cr = ((ar - 1.0f) * lr + ai * li) * inv, ci = (ai * lr - (ar - 1.0f) * li) * inv;
    float bbr[16], bbi[16], cre[16], cim[16], dd[16];
#pragma unroll
    for (int h = 0; h < 16; ++h) {
        const float br_ = b_re[(g * 64 + n) * 16 + h], bi_ = b_im[(g * 64 + n) * 16 + h];
        bbr[h] = cr * br_ - ci * bi_; bbi[h] = cr * bi_ + ci * br_;
        cre[h] = c_re[(g * 16 + h) * 64 + n]; cim[h] = c_im[(g * 16 + h) * 64 + n];
        dd[h] = dsk[g * 16 + h];
    }
    float sr = 0.f, si = 0.f;
    for (int t = 0; t < L; ++t) {
        const size_t row = (size_t)b * L + t;
        const float* up = proj + row * PW + OFF_U + g * 16;
        float u[16];
#pragma unroll
        for (int h = 0; h < 16; ++h) u[h] = up[h];
        float bur = 0.f, bui = 0.f;
#pragma unroll
        for (int h = 0; h < 16; ++h) { bur += u[h] * bbr[h]; bui += u[h] * bbi[h]; }
        const float nr = ar * sr - ai * si + bur, ni = ar * si + ai * sr + bui;
        sr = nr; si = ni;
        float mine = 0.f;
#pragma unroll
        for (int h = 0; h < 16; ++h) {
            float y = wave_sum(sr * cre[h] - si * cim[h]) + dd[h] * u[h];
            if (n == h) mine = y;
        }
        if (n < 16) br[row * 2048 + g * 16 + n] = gelu_tanh(mine);
    }
}
__global__ void k_s5_gate(float* br, const float* __restrict__ tmp, int rows) {
    const int idx = blockIdx.x * blockDim.x + threadIdx.x;
    if (idx >= rows * 512) return;
    const int r = idx / 512, c = idx % 512;
    float* p = br + (size_t)r * 2048 + c;
    *p = *p * sigmoidf_(tmp[idx]);
}

__global__ void __launch_bounds__(256) k_ssd_scan(const float* __restrict__ proj, float* __restrict__ br, const float* __restrict__ dt_bias, const float* __restrict__ a_log, const float* __restrict__ dsk) {
    const int b = blockIdx.x / 8, hh = blockIdx.x % 8, g = hh / 4, p = threadIdx.x >> 2, nq = threadIdx.x & 3;
    const float Aa = -expf(a_log[hh]), Dk = dsk[hh], dtb = dt_bias[hh];
    float S[16];
#pragma unroll
    for (int j = 0; j < 16; ++j) S[j] = 0.f;
    for (int t = 0; t < L; ++t) {
        const size_t row = (size_t)b * L + t;
        const float* pr = proj + row * PW;
        const float dtv = softplusf_(pr[OFF_DT + hh] + dtb);
        const float x = pr[OFF_XBC + hh * 64 + p];
        const float* Bp = pr + OFF_XBC + 512 + g * 64 + nq * 16;
        const float* Cp = pr + OFF_XBC + 640 + g * 64 + nq * 16;
        const float da = expf(dtv * Aa), xdt = x * dtv;
        float acc = 0.f;
#pragma unroll
        for (int j = 0; j < 16; ++j) { S[j] = da * S[j] + xdt * Bp[j]; acc += Cp[j] * S[j]; }
        acc += __shfl_xor(acc, 1); acc += __shfl_xor(acc, 2);
        if (nq == 0) br[row * 2048 + 512 + hh * 64 + p] = acc + Dk * x;
    }
}
__global__ void k_ssd_post(float* br, const float* __restrict__ proj, const float* __restrict__ nw, int rows) {
    const int row = blockIdx.x * 4 + (threadIdx.x >> 6), lane = threadIdx.x & 63;
    if (row >= rows) return;
    float* y = br + (size_t)row * 2048 + 512; const float* z = proj + (size_t)row * PW + OFF_Z;
    float v[8]; float ss = 0.f;
#pragma unroll
    for (int i = 0; i < 8; ++i) { const int c = lane + 64 * i; v[i] = y[c] * siluf_(z[c]); ss += v[i] * v[i]; }
    ss = wave_sum(ss);
    const float r = 1.0f / sqrtf(ss * (1.0f / 512.0f) + 1e-6f);
#pragma unroll
    for (int i = 0; i < 8; ++i) { const int c = lane + 64 * i; y[c] = v[i] * r * nw[c]; }
}

__global__ void k_rope_tab(const int* __restrict__ pos, float* __restrict__ ct, float* __restrict__ st) {
    const int idx = blockIdx.x * blockDim.x + threadIdx.x;
    if (idx >= T * 32) return;
    const int row = idx / 32, i = idx % 32;
    const float inv_freq = (float)exp(-(double)i / 32.0 * log(10000.0));
    const float ang = (float)pos[row] * inv_freq;
    ct[idx] = (float)cos((double)ang); st[idx] = (float)sin((double)ang);
}
__global__ void k_rope(float* proj, const float* __restrict__ ct, const float* __restrict__ st, int row_base, int rows) {
    const int idx = blockIdx.x * blockDim.x + threadIdx.x;
    if (idx >= rows * 256) return;
    const int r = idx / 256, h = (idx % 256) / 32, i = idx % 32;
    const float c = ct[(size_t)(row_base + r) * 32 + i], s = st[(size_t)(row_base + r) * 32 + i];
    float* q = proj + (size_t)r * PW + OFF_Q + h * 64; float* k = proj + (size_t)r * PW + OFF_K + h * 64;
    const float q1 = q[i], q2 = q[i + 32], k1 = k[i], k2 = k[i + 32];
    q[i] = q1 * c - q2 * s; q[i + 32] = q2 * c + q1 * s;
    k[i] = (k1 * c - k2 * s) * 0.125f; k[i + 32] = (k2 * c + k1 * s) * 0.125f;
}
__global__ void __launch_bounds__(256) k_ret_scan(const float* __restrict__ proj, float* __restrict__ br) {
    const int b = blockIdx.x / 8, hh = blockIdx.x % 8, e = threadIdx.x >> 2, dq = threadIdx.x & 3;
    const float gamma = 1.0f - exp2f(-5.0f - (float)hh);
    float S[16];
#pragma unroll
    for (int j = 0; j < 16; ++j) S[j] = 0.f;
    for (int t = 0; t < L; ++t) {
        const size_t row = (size_t)b * L + t;
        const float* pr = proj + row * PW;
        const float v = pr[OFF_V + hh * 64 + e];
        const float* kp = pr + OFF_K + hh * 64 + dq * 16;
        const float* qp = pr + OFF_Q + hh * 64 + dq * 16;
        float acc = 0.f;
#pragma unroll
        for (int j = 0; j < 16; ++j) { S[j] = gamma * S[j] + kp[j] * v; acc += qp[j] * S[j]; }
        acc += __shfl_xor(acc, 1); acc += __shfl_xor(acc, 2);
        if (dq == 0) br[row * 2048 + 1024 + hh * 64 + e] = acc;
    }
}
__global__ void k_ret_post(float* br, const float* __restrict__ proj, const float* __restrict__ gw, int rows) {
    const int row = blockIdx.x * 4 + (threadIdx.x >> 6), lane = threadIdx.x & 63;
    if (row >= rows) return;
    float* y = br + (size_t)row * 2048 + 1024; const float* g = proj + (size_t)row * PW + OFF_G;
    for (int h = 0; h < 8; ++h) {
        const float v = y[h * 64 + lane];
        const float mu = wave_sum(v) * (1.0f / 64.0f);
        const float d = v - mu;
        const float var = wave_sum(d * d) * (1.0f / 64.0f);
        y[h * 64 + lane] = siluf_(g[h * 64 + lane]) * (d * (1.0f / sqrtf(var + 1e-6f)) * gw[h * 64 + lane]);
    }
}

__global__ void __launch_bounds__(64) k_lru_scan(const float* __restrict__ proj, float* __restrict__ br, const float* __restrict__ wa, const float* __restrict__ ba, const float* __restrict__ wx, const float* __restrict__ bx, const float* __restrict__ lam) {
    const int b = blockIdx.x / 8, blk = blockIdx.x % 8, j = threadIdx.x;
    float wA[64], wX[64];
#pragma unroll
    for (int i = 0; i < 64; ++i) { wA[i] = wa[(blk * 64 + i) * 64 + j]; wX[i] = wx[(blk * 64 + i) * 64 + j]; }
    const float bA = ba[blk * 64 + j], bX = bx[blk * 64 + j], sp = softplusf_(-lam[blk * 64 + j]);
    float hs = 0.f;
    for (int t = 0; t < L; ++t) {
        const size_t row = (size_t)b * L + t;
        const float xc = proj[row * PW + OFF_XL + blk * 64 + j];
        float ra = bA, ri = bX;
#pragma unroll
        for (int i = 0; i < 64; ++i) { const float xi = __shfl(xc, i); ra += xi * wA[i]; ri += xi * wX[i]; }
        const float r = sigmoidf_(ra), ig = sigmoidf_(ri);
        const float log_a = -8.0f * r * sp, a = expf(log_a);
        const float mult = sqrtf(fmaxf(-expm1f(2.0f * log_a), 0.f));
        hs = a * hs + mult * ig * xc;
        br[row * 2048 + 1536 + blk * 64 + j] = hs * gelu_tanh(proj[row * PW + OFF_GL + blk * 64 + j]);
    }
}

__global__ void k_gate_acc(float* merged, const float* __restrict__ tmp, const float* __restrict__ gl, const float* __restrict__ bg, int first, int rows) {
    const int idx = blockIdx.x * blockDim.x + threadIdx.x;
    if (idx >= rows * 1024) return;
    const float v = sigmoidf_(gl[idx] + bg[idx % 1024]) * tmp[idx];
    if (first) merged[idx] = v; else merged[idx] += v;
}

__global__ void __launch_bounds__(256) k_xattn(const float* __restrict__ q, const float* __restrict__ kx, const float* __restrict__ vx, float* __restrict__ o) {
    __shared__ float qs[16][256];
    __shared__ float ps[16][256];
    const int h = blockIdx.x % 4, rb = blockIdx.x / 4;
    const int row0 = rb * 16, b = row0 / L, tid = threadIdx.x;
    for (int i = tid; i < 16 * 256; i += 256) qs[i / 256][i % 256] = q[(size_t)(row0 + i / 256) * D + h * 256 + (i % 256)];
    __syncthreads();
    {
        const float* kr = kx + (size_t)(b * NMEM + tid) * D + h * 256;
        float s[16];
#pragma unroll
        for (int r = 0; r < 16; ++r) s[r] = 0.f;
        for (int d = 0; d < 256; d += 4) {
            const float4 kv = *(const float4*)(kr + d);
#pragma unroll
            for (int r = 0; r < 16; ++r) s[r] += qs[r][d] * kv.x + qs[r][d + 1] * kv.y + qs[r][d + 2] * kv.z + qs[r][d + 3] * kv.w;
        }
#pragma unroll
        for (int r = 0; r < 16; ++r) ps[r][tid] = s[r] * 0.0625f;
    }
    __syncthreads();
    {
        const int w = tid >> 6, lane = tid & 63;
        for (int r = 4 * w; r < 4 * w + 4; ++r) {
            float v[4]; float mx = -1e30f;
#pragma unroll
            for (int i = 0; i < 4; ++i) { v[i] = ps[r][lane + 64 * i]; mx = fmaxf(mx, v[i]); }
            mx = wave_max(mx);
            float sum = 0.f;
#pragma unroll
            for (int i = 0; i < 4; ++i) { v[i] = expf(v[i] - mx); sum += v[i]; }
            sum = wave_sum(sum);
            const float inv = 1.0f / sum;
#pragma unroll
            for (int i = 0; i < 4; ++i) ps[r][lane + 64 * i] = v[i] * inv;
        }
    }
    __syncthreads();
    {
        float acc[16];
#pragma unroll
        for (int r = 0; r < 16; ++r) acc[r] = 0.f;
        const float* vp = vx + (size_t)(b * NMEM) * D + h * 256 + tid;
        for (int m = 0; m < 256; ++m) {
            const float vv = vp[(size_t)m * D];
#pragma unroll
            for (int r = 0; r < 16; ++r) acc[r] += ps[r][m] * vv;
        }
#pragma unroll
        for (int r = 0; r < 16; ++r) o[(size_t)(row0 + r) * D + h * 256 + tid] = acc[r];
    }
}

__global__ void k_swiglu(float* g1, const float* __restrict__ g3, size_t n, const int* mptr, int mbase, int mcap, int width) {
    size_t lim = n;
    if (mptr) { int m = *mptr - mbase; m = m < 0 ? 0 : m; m = m < mcap ? m : mcap; lim = (size_t)m * width; }
    for (size_t i = (size_t)blockIdx.x * blockDim.x + threadIdx.x; i < lim; i += (size_t)gridDim.x * blockDim.x) g1[i] = siluf_(g1[i]) * g3[i];
}

__global__ void k_router(const float* __restrict__ hn, const float* __restrict__ wr, int* cnt, int* lists, float* wl) {
    const int row = blockIdx.x * 4 + (threadIdx.x >> 6), lane = threadIdx.x & 63;
    if (row >= T) return;
    float lg[8];
#pragma unroll
    for (int e = 0; e < 8; ++e) lg[e] = 0.f;
    for (int i = lane; i < D; i += 64) {
        const float x = hn[(size_t)row * D + i];
#pragma unroll
        for (int e = 0; e < 8; ++e) lg[e] += x * wr[i * 8 + e];
    }
#pragma unroll
    for (int e = 0; e < 8; ++e) lg[e] = wave_sum(lg[e]);
    if (lane == 0) {
        int i1 = 0; float v1 = lg[0];
#pragma unroll
        for (int e = 1; e < 8; ++e) if (lg[e] > v1) { v1 = lg[e]; i1 = e; }
        int i2 = -1; float v2 = -3.0e38f;
#pragma unroll
        for (int e = 0; e < 8; ++e) if (e != i1 && lg[e] > v2) { v2 = lg[e]; i2 = e; }
        const float w1 = 1.0f / (1.0f + expf(v2 - v1)), w2 = 1.0f - w1;
        const int r1 = atomicAdd(&cnt[i1], 1); lists[i1 * T + r1] = row; wl[i1 * T + r1] = w1;
        const int r2 = atomicAdd(&cnt[i2], 1); lists[i2 * T + r2] = row; wl[i2 * T + r2] = w2;
    }
}
__global__ void k_gather(const float* __restrict__ hn, const int* __restrict__ list, const int* cnt, int mbase, float* xs) {
    const int r = blockIdx.x; if (mbase + r >= *cnt) return;
    const int tok = list[mbase + r];
    ((float4*)(xs + (size_t)r * D))[threadIdx.x] = ((const float4*)(hn + (size_t)tok * D))[threadIdx.x];
}
__global__ void k_combine(float* h, const float* __restrict__ y, const int* __restrict__ list, const float* __restrict__ wl, const int* cnt, int mbase) {
    const int r = blockIdx.x; if (mbase + r >= *cnt) return;
    const int tok = list[mbase + r]; const float w = wl[mbase + r];
    float4* hp = (float4*)(h + (size_t)tok * D) + threadIdx.x; const float4 yv = ((const float4*)(y + (size_t)r * D))[threadIdx.x];
    float4 hv = *hp; hv.x += w * yv.x; hv.y += w * yv.y; hv.z += w * yv.z; hv.w += w * yv.w; *hp = hv;
}

static void sgemm(hipStream_t s, bool acc, const float* A, int lda, const float* B, int ldb, float* C, int ldc, int M, int N, int K, const int* mptr = nullptr, int mbase = 0, int mcap = 0) {
    dim3 grid((N + 127) / 128, (M + 127) / 128);
    if (acc) hipLaunchKernelGGL(k_sgemm<1>, grid, dim3(256), 0, s, A, lda, B, ldb, C, ldc, M, N, K, mptr, mbase, mcap);
    else hipLaunchKernelGGL(k_sgemm<0>, grid, dim3(256), 0, s, A, lda, B, ldb, C, ldc, M, N, K, mptr, mbase, mcap);
}

extern "C" void kernel_launch(void* const* d_in, const int* in_sizes, int n_in, void* d_out, int out_size, void* d_ws, size_t ws_size, hipStream_t stream) {
    (void)in_sizes; (void)n_in; (void)out_size; (void)ws_size;
    const float* x = (const float*)d_in[0]; const float* mem = (const float*)d_in[1]; const int* positions = (const int*)d_in[2];
    const float* norm_mix = (const float*)d_in[3]; const float* w_in = (const float*)d_in[4]; const float* b_gate = (const float*)d_in[5];
    const float* s5_lam_re = (const float*)d_in[6]; const float* s5_lam_im = (const float*)d_in[7]; const float* s5_b_re = (const float*)d_in[8]; const float* s5_b_im = (const float*)d_in[9];
    const float* s5_c_re = (const float*)d_in[10]; const float* s5_c_im = (const float*)d_in[11]; const float* s5_d = (const float*)d_in[12]; const float* s5_log_dt = (const float*)d_in[13];
    const float* s5_w_glu = (const float*)d_in[14];
    const float* ssd_conv_w = (const float*)d_in[15]; const float* ssd_conv_b = (const float*)d_in[16]; const float* ssd_dt_bias = (const float*)d_in[17]; const float* ssd_a_log = (const float*)d_in[18];
    const float* ssd_d = (const float*)d_in[19]; const float* ssd_norm = (const float*)d_in[20]; const float* ret_norm = (const float*)d_in[21];
    const float* lru_conv_w = (const float*)d_in[22]; const float* lru_conv_b = (const float*)d_in[23]; const float* lru_wa = (const float*)d_in[24]; const float* lru_ba = (const float*)d_in[25];
    const float* lru_wx = (const float*)d_in[26]; const float* lru_bx = (const float*)d_in[27]; const float* lru_lam = (const float*)d_in[28];
    const float* w_branch = (const float*)d_in[29]; const float* w_out = (const float*)d_in[30];
    const float* norm_xa = (const float*)d_in[31]; const float* norm_mem = (const float*)d_in[32];
    const float* xa_wq = (const float*)d_in[33]; const float* xa_wk = (const float*)d_in[34]; const float* xa_wv = (const float*)d_in[35]; const float* xa_wo = (const float*)d_in[36];
    const float* norm_ffn = (const float*)d_in[37]; const float* ffn_w1 = (const float*)d_in[38]; const float* ffn_w3 = (const float*)d_in[39]; const float* ffn_w2 = (const float*)d_in[40];
    const float* moe_router = (const float*)d_in[41]; const float* moe_w1 = (const float*)d_in[42]; const float* moe_w3 = (const float*)d_in[43]; const float* moe_w2 = (const float*)d_in[44];
    const float* norm_final = (const float*)d_in[45];
    float* out = (float*)d_out;

    char* ws = (char*)d_ws; size_t off = 0;
    auto alloc = [&](size_t bytes) { char* p = ws + off; off += (bytes + 255) & ~(size_t)255; return p; };
    float* h = (float*)alloc((size_t)T * D * 4);
    float* hn = (float*)alloc((size_t)T * D * 4);
    int* cnt = (int*)alloc(256);
    int* lists = (int*)alloc((size_t)NE * T * 4);
    float* wl = (float*)alloc((size_t)NE * T * 4);
    float* ct = (float*)alloc((size_t)T * 32 * 4);
    float* st = (float*)alloc((size_t)T * 32 * 4);
    char* R = alloc(0);
    float* PROJ = (float*)R;
    float* BR = PROJ + (size_t)HR * PW;
    float* TMP = BR + (size_t)HR * 2048;
    float* GLG = TMP + (size_t)HR * 1024;
    float* MERGED = GLG + (size_t)HR * 1024;
    float* MN = (float*)R;
    float* KX = MN + (size_t)TM * D; float* VX = KX + (size_t)TM * D;
    float* XQ = VX + (size_t)TM * D;
    float* XO = XQ + (size_t)T * D;
    float* G1 = (float*)R; float* G3 = G1 + (size_t)T * DFF;
    constexpr int MC = 4096;
    float* XS = (float*)R; float* A1 = XS + (size_t)MC * D; float* A3 = A1 + (size_t)MC * DFE; float* YE = A3 + (size_t)MC * DFE;

    hipMemcpyAsync(h, x, (size_t)T * D * 4, hipMemcpyDeviceToDevice, stream);
    hipLaunchKernelGGL(k_rope_tab, dim3((T * 32 + 255) / 256), dim3(256), 0, stream, positions, ct, st);

    for (int layer = 0; layer < 2; ++layer) {
        hipLaunchKernelGGL(k_rmsnorm, dim3(T / 4), dim3(256), 0, stream, h, norm_mix + layer * D, hn, T);
        const float* Win = w_in + (size_t)layer * D * IN_TOTAL;
        for (int half = 0; half < NB / HB; ++half) {
            const int r0 = half * HR;
            const float* hnh = hn + (size_t)r0 * D;
            sgemm(stream, false, hnh, D, Win, IN_TOTAL, PROJ, PW, HR, PW, D);
            hipLaunchKernelGGL(k_s5_scan, dim3(HB * 32), dim3(64), 0, stream, PROJ, BR, s5_lam_re + layer * 2048, s5_lam_im + layer * 2048, s5_b_re + layer * 32768, s5_b_im + layer * 32768,
                               s5_c_re + layer * 32768, s5_c_im + layer * 32768, s5_d + layer * 512, s5_log_dt + layer * 32);
            sgemm(stream, false, BR, 2048, s5_w_glu + (size_t)layer * 512 * 512, 512, TMP, 512, HR, 512, 512);
            hipLaunchKernelGGL(k_s5_gate, dim3((HR * 512 + 255) / 256), dim3(256), 0, stream, BR, TMP, HR);
            hipLaunchKernelGGL(k_conv_inplace, dim3((HB * 768 + 255) / 256), dim3(256), 0, stream, PROJ, PW, OFF_XBC, 768, ssd_conv_w + layer * 4 * 768, ssd_conv_b + layer * 768, 1, HB);
            hipLaunchKernelGGL(k_ssd_scan, dim3(HB * 8), dim3(256), 0, stream, PROJ, BR, ssd_dt_bias + layer * 8, ssd_a_log + layer * 8, ssd_d + layer * 8);
            hipLaunchKernelGGL(k_ssd_post, dim3(HR / 4), dim3(256), 0, stream, BR, PROJ, ssd_norm + layer * 512, HR);
            hipLaunchKernelGGL(k_rope, dim3((HR * 256 + 255) / 256), dim3(256), 0, stream, PROJ, ct, st, r0, HR);
            hipLaunchKernelGGL(k_ret_scan, dim3(HB * 8), dim3(256), 0, stream, PROJ, BR);
            hipLaunchKernelGGL(k_ret_post, dim3(HR / 4), dim3(256), 0, stream, BR, PROJ, ret_norm + layer * 512, HR);
            hipLaunchKernelGGL(k_conv_inplace, dim3((HB * 512 + 255) / 256), dim3(256), 0, stream, PROJ, PW, OFF_XL, 512, lru_conv_w + layer * 4 * 512, lru_conv_b + layer * 512, 0, HB);
            hipLaunchKernelGGL(k_lru_scan, dim3(HB * 8), dim3(64), 0, stream, PROJ, BR, lru_wa + layer * 32768, lru_ba + layer * 512, lru_wx + layer * 32768, lru_bx + layer * 512, lru_lam + layer * 512);
            for (int k = 0; k < 4; ++k) {
                sgemm(stream, false, BR + k * 512, 2048, w_branch + ((size_t)layer * 4 + k) * 512 * 1024, 1024, TMP, 1024, HR, 1024, 512);
                sgemm(stream, false, hnh, D, Win + OFF_GATE + k * 1024, IN_TOTAL, GLG, 1024, HR, 1024, D);
                hipLaunchKernelGGL(k_gate_acc, dim3((HR * 1024 + 255) / 256), dim3(256), 0, stream, MERGED, TMP, GLG, b_gate + layer * 4096 + k * 1024, k == 0 ? 1 : 0, HR);
            }
            sgemm(stream, true, MERGED, 1024, w_out + (size_t)layer * D * D, D, h + (size_t)r0 * D, D, HR, D, D);
        }
        hipLaunchKernelGGL(k_rmsnorm, dim3(T / 4), dim3(256), 0, stream, h, norm_xa + layer * D, hn, T);
        hipLaunchKernelGGL(k_rmsnorm, dim3(TM / 4), dim3(256), 0, stream, mem, norm_mem + layer * D, MN, TM);
        sgemm(stream, false, hn, D, xa_wq + (size_t)layer * D * D, D, XQ, D, T, D, D);
        sgemm(stream, false, MN, D, xa_wk + (size_t)layer * D * D, D, KX, D, TM, D, D);
        sgemm(stream, false, MN, D, xa_wv + (size_t)layer * D * D, D, VX, D, TM, D, D);
        hipLaunchKernelGGL(k_xattn, dim3(T / 16 * 4), dim3(256), 0, stream, XQ, KX, VX, XO);
        sgemm(stream, true, XO, D, xa_wo + (size_t)layer * D * D, D, h, D, T, D, D);
        hipLaunchKernelGGL(k_rmsnorm, dim3(T / 4), dim3(256), 0, stream, h, norm_ffn + layer * D, hn, T);
        if (layer == 0) {
            sgemm(stream, false, hn, D, ffn_w1, DFF, G1, DFF, T, DFF, D);
            sgemm(stream, false, hn, D, ffn_w3, DFF, G3, DFF, T, DFF, D);
            hipLaunchKernelGGL(k_swiglu, dim3(4096), dim3(256), 0, stream, G1, G3, (size_t)T * DFF, (const int*)nullptr, 0, 0, DFF);
            sgemm(stream, true, G1, DFF, ffn_w2, D, h, D, T, D, DFF);
        } else {
            hipMemsetAsync(cnt, 0, 256, stream);
            hipLaunchKernelGGL(k_router, dim3(T / 4), dim3(256), 0, stream, hn, moe_router, cnt, lists, wl);
            for (int e = 0; e < NE; ++e) {
                const float* W1 = moe_w1 + (size_t)e * D * DFE; const float* W3 = moe_w3 + (size_t)e * D * DFE; const float* W2 = moe_w2 + (size_t)e * DFE * D;
                for (int c = 0; c < T / MC; ++c) {
                    const int mb = c * MC;
                    hipLaunchKernelGGL(k_gather, dim3(MC), dim3(256), 0, stream, hn, lists + e * T, cnt + e, mb, XS);
                    sgemm(stream, false, XS, D, W1, DFE, A1, DFE, MC, DFE, D, cnt + e, mb, MC);
                    sgemm(stream, false, XS, D, W3, DFE, A3, DFE, MC, DFE, D, cnt + e, mb, MC);
                    hipLaunchKernelGGL(k_swiglu, dim3(2048), dim3(256), 0, stream, A1, A3, (size_t)MC * DFE, cnt + e, mb, MC, DFE);
                    sgemm(stream, false, A1, DFE, W2, D, YE, D, MC, D, DFE, cnt + e, mb, MC);
                    hipLaunchKernelGGL(k_combine, dim3(MC), dim3(256), 0, stream, h, YE, lists + e * T, wl + e * T, cnt + e, mb);
                }
            }
        }
    }
    hipLaunchKernelGGL(k_rmsnorm, dim3(T / 4), dim3(256), 0, stream, h, norm_final, out, T);
}
```

```cpp
#include <hip/hip_runtime.h>
#include <cstdio>
#include <cstdint>
__device__ __forceinline__ int lane_id_fresh() { int l; asm volatile("v_mbcnt_lo_u32_b32 %0, -1, 0\n\tv_mbcnt_hi_u32_b32 %0, -1, %0" : "=v"(l)); return l; }
namespace pg8 {
#define PG8_LAS __attribute__((address_space(3)))
typedef unsigned short bf16_t;
typedef short bf16x8 __attribute__((ext_vector_type(8)));
typedef float f32x4 __attribute__((ext_vector_type(4)));
typedef float f32x2 __attribute__((ext_vector_type(2)));
typedef unsigned u32x4 __attribute__((ext_vector_type(4)));
typedef unsigned u32x2 __attribute__((ext_vector_type(2)));
constexpr int BM = 256, BK = 64, HALF = 128, HTB = HALF * BK * 2  , STAGE_BYTES = 8 * HTB, NXCD = 8, WGM = 8;
__host__ __device__ __forceinline__ int lds_byte(int r, int c) { const int st = (r >> 4) * 2 + (c >> 5), rr = r & 15, cc = c & 31, ob = rr * 64 + cc * 2; return st * 1024 + (ob ^ (((ob >> 9) & 1) << 5)); }
__host__ __device__ __forceinline__ void stage_rc(int b, int& R, int& C) { const int st = b / 1024, sb = b % 1024, swz = sb ^ (((sb >> 9) & 1) << 5); R = (st >> 1) * 16 + swz / 64; C = (st & 1) * 32 + (swz % 64) / 2; }
__host__ __device__ __forceinline__ int perm32(int rho) { const int n = rho >> 4, i = rho & 15; return 8 * (i >> 2) + 4 * n + (i & 3); }

struct Unit { int pm, pn, z; const char* a; const char* b; };
struct Gemm { int lda, ldb, K; };

__device__ __forceinline__ void tile_map(int L, int nM, int nN, int& pm, int& pn) {
    const int nwg = nM * nN; int wgid = L;
    { const int q = nwg / NXCD, r = nwg % NXCD, xcd = wgid % NXCD, off = wgid / NXCD; wgid = (xcd < r ? xcd * (q + 1) : r * (q + 1) + (xcd - r) * q) + off; }
    const int nig = WGM * nN, gid = wgid / nig, fm = gid * WGM, gsz = (nM - fm) < WGM ? (nM - fm) : WGM;
    pm = fm + ((wgid % nig) % gsz); pn = (wgid % nig) / gsz;
}
typedef __bf16 bf16x2_t __attribute__((ext_vector_type(2)));
__device__ __forceinline__ unsigned cvt_pk_bf16(float lo, float hi) { const f32x2 v = {lo, hi}; return __builtin_bit_cast(unsigned, __builtin_convertvector(v, bf16x2_t)); }
__device__ __forceinline__ float bf_lo(unsigned w) { return __uint_as_float(w << 16); }
__device__ __forceinline__ float bf_hi(unsigned w) { return __uint_as_float(w & 0xffff0000u); }
__device__ __forceinline__ float fast_sigmoid(float x) { return __builtin_amdgcn_rcpf(1.0f + __builtin_amdgcn_exp2f(-1.4426950408889634f * x)); }

struct NoHooks { __device__ __forceinline__ void a_ready(const Unit&) const {} __device__ __forceinline__ void done(const Unit&) const {} };

typedef f32x4 AccT[2][2][4][2];
__device__ __forceinline__ u32x4 pack8(const f32x4 v0, const f32x4 v1) { u32x4 w; w.x = cvt_pk_bf16(v0[0], v0[1]); w.y = cvt_pk_bf16(v0[2], v0[3]); w.z = cvt_pk_bf16(v1[0], v1[1]); w.w = cvt_pk_bf16(v1[2], v1[3]); return w; }

struct EpiStore {
    static constexpr bool PERM = true, AFTER_DRAIN = false, KEEPS = false;
    bf16_t* O; int ldc;
    __device__ __forceinline__ void operator()(AccT& acc, const Unit& u, int wr, int wc, int fr, int fq) const {
        const int row0 = u.pm * BM + wr * 64 + fr, col0 = u.pn * BM + wc * 32 + 8 * fq;
#pragma unroll
        for (int ai = 0; ai < 2; ++ai)
#pragma unroll
            for (int m = 0; m < 4; ++m) { bf16_t* rowp = O + (size_t)(row0 + ai * HALF + m * 16) * ldc + col0;
#pragma unroll
                for (int bj = 0; bj < 2; ++bj) *(u32x4*)(rowp + bj * HALF) = pack8(acc[ai][bj][m][0], acc[ai][bj][m][1]); }
    }
};
struct EpiKV {
    static constexpr bool PERM = true, AFTER_DRAIN = false, KEEPS = false;
    bf16_t* kvb;
    __device__ __forceinline__ void operator()(AccT& acc, const Unit& u, int wr, int wc, int fr, int fq) const {
        const int l = u.z >> 1, isv = u.z & 1;
        bf16_t* base = kvb + (size_t)l * 4194304 + (isv ? 2097152 : 0);
        const int ldc = isv ? 256 : 1024;
        const int row0 = (isv ? (u.pn * 1024 + u.pm * 256) : u.pm * 256) + wr * 64 + fr, col0 = (isv ? 0 : u.pn * 256) + wc * 32 + 8 * fq;
#pragma unroll
        for (int ai = 0; ai < 2; ++ai)
#pragma unroll
            for (int m = 0; m < 4; ++m) { bf16_t* rowp = base + (size_t)(row0 + ai * HALF + m * 16) * ldc + col0;
#pragma unroll
                for (int bj = 0; bj < 2; ++bj) *(u32x4*)(rowp + bj * HALF) = pack8(acc[ai][bj][m][0], acc[ai][bj][m][1]); }
    }
};
#ifdef MK_GATE_LOGIT
#define GATE_ACT(x) (x)
#else
#define GATE_ACT(x) fast_sigmoid(x)
#endif
struct EpiProj {
    static constexpr bool PERM = true, AFTER_DRAIN = false, KEEPS = false;
    bf16_t* projb; bf16_t* gate; const float* bgate;
    __device__ __forceinline__ void operator()(AccT& acc, const Unit& u, int wr, int wc, int fr, int fq) const {
        const int row0 = u.pm * BM + wr * 64 + fr;
        if (u.pn < 19) {
            const int col0 = u.pn * BM + wc * 32 + 8 * fq;
#pragma unroll
            for (int ai = 0; ai < 2; ++ai)
#pragma unroll
                for (int m = 0; m < 4; ++m) { bf16_t* rowp = projb + (size_t)(row0 + ai * HALF + m * 16) * 4864 + col0;
#pragma unroll
                    for (int bj = 0; bj < 2; ++bj) *(u32x4*)(rowp + bj * HALF) = pack8(acc[ai][bj][m][0], acc[ai][bj][m][1]); }
        } else {
            const int col0 = (u.pn - 19) * BM + wc * 32 + 8 * fq;
            f32x4 bv[2][2];
#pragma unroll
            for (int bj = 0; bj < 2; ++bj)
#pragma unroll
                for (int n = 0; n < 2; ++n) bv[bj][n] = *(const f32x4*)(bgate + col0 + bj * HALF + 4 * n);
#pragma unroll
            for (int ai = 0; ai < 2; ++ai)
#pragma unroll
                for (int m = 0; m < 4; ++m) { bf16_t* rowp = gate + (size_t)(row0 + ai * HALF + m * 16) * 4096 + col0;
#pragma unroll
                    for (int bj = 0; bj < 2; ++bj) { f32x4 v0 = acc[ai][bj][m][0] + bv[bj][0], v1 = acc[ai][bj][m][1] + bv[bj][1];
#pragma unroll
                        for (int j = 0; j < 4; ++j) { v0[j] = GATE_ACT(v0[j]); v1[j] = GATE_ACT(v1[j]); }
                        *(u32x4*)(rowp + bj * HALF) = pack8(v0, v1); } }
        }
    }
};
struct EpiGlu {
    static constexpr bool PERM = true, AFTER_DRAIN = false, KEEPS = false;
    const bf16_t* ys; bf16_t* br;
    __device__ __forceinline__ void operator()(AccT& acc, const Unit& u, int wr, int wc, int fr, int fq) const {
        const int row0 = u.pm * BM + wr * 64 + fr, col0 = u.pn * BM + wc * 32 + 8 * fq;
#pragma unroll
        for (int ai = 0; ai < 2; ++ai)
#pragma unroll
            for (int m = 0; m < 4; ++m) { const size_t row = (size_t)(row0 + ai * HALF + m * 16);
#pragma unroll
                for (int bj = 0; bj < 2; ++bj) { const u32x4 yw = *(const u32x4*)(ys + row * 512 + col0 + bj * HALF);
                    f32x4 v0 = acc[ai][bj][m][0], v1 = acc[ai][bj][m][1];
                    v0[0] = bf_lo(yw.x) * fast_sigmoid(v0[0]); v0[1] = bf_hi(yw.x) * fast_sigmoid(v0[1]); v0[2] = bf_lo(yw.y) * fast_sigmoid(v0[2]); v0[3] = bf_hi(yw.y) * fast_sigmoid(v0[3]);
                    v1[0] = bf_lo(yw.z) * fast_sigmoid(v1[0]); v1[1] = bf_hi(yw.z) * fast_sigmoid(v1[1]); v1[2] = bf_lo(yw.w) * fast_sigmoid(v1[2]); v1[3] = bf_hi(yw.w) * fast_sigmoid(v1[3]);
                    *(u32x4*)(br + row * 2048 + col0 + bj * HALF) = pack8(v0, v1); } }
    }
};
struct EpiMerge {
    static constexpr bool PERM = true, AFTER_DRAIN = false, KEEPS = true;
    const bf16_t* gate; bf16_t* merged;
    __device__ __forceinline__ bool keep(const Unit& u) const { return u.z < 3; }
    __device__ __forceinline__ void operator()(AccT& acc, const Unit& u, int wr, int wc, int fr, int fq) const {
        const int row0 = u.pm * BM + wr * 64 + fr, col0 = u.pn * BM + wc * 32 + 8 * fq, k = u.z;
#pragma unroll
        for (int ai = 0; ai < 2; ++ai)
#pragma unroll
            for (int m = 0; m < 4; ++m) { const size_t row = (size_t)(row0 + ai * HALF + m * 16);
#pragma unroll
#ifdef MK_EXP_B
                for (int bj = 0; bj < 2; ++bj) { if (k == 3) *(u32x4*)(merged + row * 1024 + col0 + bj * HALF) = pack8(acc[ai][bj][m][0], acc[ai][bj][m][1]); continue;
                    const bf16_t* gp = gate + row * 4096 + k * 1024 + col0 + bj * HALF; const u32x4 gw = *(const u32x4*)gp;
#else
                for (int bj = 0; bj < 2; ++bj) { const bf16_t* gp = gate + row * 4096 + k * 1024 + col0 + bj * HALF; const u32x4 gw = *(const u32x4*)gp;
#endif
                    f32x4 g0 = (f32x4){bf_lo(gw.x), bf_hi(gw.x), bf_lo(gw.y), bf_hi(gw.y)}, g1 = (f32x4){bf_lo(gw.z), bf_hi(gw.z), bf_lo(gw.w), bf_hi(gw.w)};
#pragma unroll
                    for (int j = 0; j < 4; ++j) { g0[j] = fmaxf(g0[j], 1e-20f); g1[j] = fmaxf(g1[j], 1e-20f); }
                    if (k < 3) { const u32x4 nw = *(const u32x4*)(gp + 1024);
                        const f32x4 n0 = (f32x4){bf_lo(nw.x), bf_hi(nw.x), bf_lo(nw.y), bf_hi(nw.y)}, n1 = (f32x4){bf_lo(nw.z), bf_hi(nw.z), bf_lo(nw.w), bf_hi(nw.w)};
#pragma unroll
                        for (int j = 0; j < 4; ++j) { g0[j] *= __builtin_amdgcn_rcpf(fmaxf(n0[j], 1e-20f)); g1[j] *= __builtin_amdgcn_rcpf(fmaxf(n1[j], 1e-20f)); }
                        acc[ai][bj][m][0] *= g0; acc[ai][bj][m][1] *= g1; }
                    else *(u32x4*)(merged + row * 1024 + col0 + bj * HALF) = pack8(acc[ai][bj][m][0] * g0, acc[ai][bj][m][1] * g1); }
                if (m & 1) asm volatile("" ::: "memory"); }
    }
};
struct EpiRes {
    static constexpr bool PERM = false, AFTER_DRAIN = false, KEEPS = false;
    const float* in; float* out;
    __device__ __forceinline__ void operator()(AccT& acc, const Unit& u, int wr, int wc, int fr, int fq) const {
        const int row0 = u.pm * BM + wr * 64 + fr, col0 = u.pn * BM + wc * 32 + 4 * fq;
#pragma unroll
        for (int ai = 0; ai < 2; ++ai)
#pragma unroll
            for (int m = 0; m < 4; ++m) { const size_t off = (size_t)(row0 + ai * HALF + m * 16) * 1024 + col0;
#pragma unroll
                for (int bj = 0; bj < 2; ++bj)
#pragma unroll
                    for (int n = 0; n < 2; ++n) { const f32x4 bs = *(const f32x4*)(in + off + bj * HALF + n * 16); *(f32x4*)(out + off + bj * HALF + n * 16) = bs + acc[ai][bj][m][n]; }
                if (m & 1) asm volatile("" ::: "memory"); }
    }
};
struct EpiSoftmax {
    static constexpr bool PERM = true, AFTER_DRAIN = true, KEEPS = false;
    bf16_t* P; PG8_LAS float* xch;
    __device__ __forceinline__ void fused(AccT& acc, const Unit& u, int wr, int wc, int fr, int fq, PG8_LAS unsigned char*, int, int) const {
        PG8_LAS float* RM = xch; PG8_LAS float* RS = xch + 1024;
#pragma unroll
        for (int ai = 0; ai < 2; ++ai)
#pragma unroll
            for (int m = 0; m < 4; ++m) { float mx = -3.0e38f;
#pragma unroll
                for (int bj = 0; bj < 2; ++bj)
#pragma unroll
                    for (int n = 0; n < 2; ++n) { const f32x4 x = acc[ai][bj][m][n]; mx = fmaxf(mx, fmaxf(fmaxf(x[0], x[1]), fmaxf(x[2], x[3]))); }
                mx = fmaxf(mx, __shfl_xor(mx, 16)); mx = fmaxf(mx, __shfl_xor(mx, 32));
                if (fq == 0) RM[(ai * HALF + wr * 64 + m * 16 + fr) * 4 + wc] = mx; }
        asm volatile("s_waitcnt lgkmcnt(0)" ::: "memory"); __builtin_amdgcn_s_barrier(); asm volatile("" ::: "memory");
#pragma unroll
        for (int ai = 0; ai < 2; ++ai)
#pragma unroll
            for (int m = 0; m < 4; ++m) { const int r = ai * HALF + wr * 64 + m * 16 + fr; const f32x4 q = *(const PG8_LAS f32x4*)(RM + r * 4);
                const float mx = fmaxf(fmaxf(q[0], q[1]), fmaxf(q[2], q[3])) * 1.4426950408889634f; float s = 0.f;
#pragma unroll
                for (int bj = 0; bj < 2; ++bj)
#pragma unroll
                    for (int n = 0; n < 2; ++n) { f32x4 x = acc[ai][bj][m][n];
#pragma unroll
                        for (int j = 0; j < 4; ++j) { x[j] = __builtin_amdgcn_exp2f(x[j] * 1.4426950408889634f - mx); s += x[j]; }
                        acc[ai][bj][m][n] = x; }
                s += __shfl_xor(s, 16); s += __shfl_xor(s, 32);
                if (fq == 0) RS[r * 4 + wc] = s; }
        asm volatile("s_waitcnt lgkmcnt(0)" ::: "memory"); __builtin_amdgcn_s_barrier(); asm volatile("" ::: "memory");
        const int row0 = u.pm * BM + wr * 64 + fr, col0 = u.pn * BM + wc * 32 + 8 * fq;
#pragma unroll
        for (int ai = 0; ai < 2; ++ai)
#pragma unroll
            for (int m = 0; m < 4; ++m) { const int r = ai * HALF + wr * 64 + m * 16 + fr; const f32x4 q = *(const PG8_LAS f32x4*)(RS + r * 4);
                const float inv = __builtin_amdgcn_rcpf((q[0] + q[1]) + (q[2] + q[3]));
                bf16_t* rowp = P + (size_t)(row0 + ai * HALF + m * 16) * 1024 + col0;
#pragma unroll
                for (int bj = 0; bj < 2; ++bj) *(u32x4*)(rowp + bj * HALF) = pack8(acc[ai][bj][m][0] * inv, acc[ai][bj][m][1] * inv); }
    }
};
struct EpiSwiglu {
    static constexpr bool PERM = true, AFTER_DRAIN = false, KEEPS = false;
    bf16_t* act; int ldc;
    __device__ __forceinline__ void operator()(AccT& acc, const Unit& u, int wr, int wc, int fr, int fq) const {
        const int row0 = u.pm * BM + wr * 64 + fr, col0 = u.pn * 128 + wc * 16 + 4 * fq;
#pragma unroll
        for (int ai = 0; ai < 2; ++ai)
#pragma unroll
            for (int m = 0; m < 4; ++m) { bf16_t* rowp = act + (size_t)(row0 + ai * HALF + m * 16) * ldc + col0;
#pragma unroll
                for (int bj = 0; bj < 2; ++bj) { const f32x4 a = acc[ai][bj][m][0], b = acc[ai][bj][m][1]; f32x4 o;
#pragma unroll
                    for (int j = 0; j < 4; ++j) o[j] = a[j] * fast_sigmoid(a[j]) * b[j];
                    u32x2 w; w.x = cvt_pk_bf16(o[0], o[1]); w.y = cvt_pk_bf16(o[2], o[3]); *(u32x2*)(rowp + bj * 64) = w; } }
    }
};

struct PlainOrder : NoHooks {
    const char* A; const char* B; int nM, nN, lda, ldb, G, c;
    __device__ __forceinline__ bool next(int i, Unit& u) const { const int L = i * G + c; if (L >= nM * nN) return false; tile_map(L, nM, nN, u.pm, u.pn); u.z = 0;
        u.a = A + (size_t)u.pm * 256 * lda * 2; u.b = B + (size_t)u.pn * 256 * ldb * 2; return true; }
};
struct MergeOrder : NoHooks {
    const char* br_; const char* wb_; int G, c;
    __device__ __forceinline__ bool next(int i, Unit& u) const { const int t = c + (i >> 2) * G; if (t >= 256) return false; const int k = i & 3; tile_map(t, 64, 4, u.pm, u.pn); u.z = k;
        u.a = br_ + ((size_t)u.pm * 256 * 2048 + k * 512) * 2; u.b = wb_ + ((size_t)u.pn * 256 * 2048 + k * 512) * 2; return true; }
};
struct KVOrder : NoHooks {
    const char* mnr_; const char* WKV0; const char* WKV1; int G, c;
    __device__ __forceinline__ bool next(int i, Unit& u) const { const int L = i * G + c; if (L >= 128) return false; const int kind = L >> 5, t = L & 31, isv = kind & 1;
        const char* W = (kind >> 1) ? WKV1 : WKV0; u.z = kind;
        if (!isv) { u.pm = t & 7; u.pn = t >> 3; u.a = mnr_ + (size_t)u.pm * 256 * 1024 * 2; u.b = W + (size_t)u.pn * 256 * 1024 * 2; }
        else { u.pm = t & 3; u.pn = t >> 2; u.a = W + (size_t)(1024 + u.pm * 256) * 1024 * 2; u.b = mnr_ + (size_t)u.pn * 256 * 1024 * 2; }
        return true; }
};
struct QKOrder : NoHooks {
    const char* xq_; const char* kx_; int G, c, base;
    __device__ __forceinline__ bool next(int i, Unit& u) const { const int L = base + c; if (i > 0 || L >= 256) return false; tile_map(L, 64, 4, u.pm, u.pn); u.z = 0;
        u.a = xq_ + ((size_t)u.pm * 256 * 1024 + u.pn * 256) * 2; u.b = kx_ + ((size_t)(u.pm >> 3) * 256 * 1024 + u.pn * 256) * 2; return true; }
};
struct PVOrder : NoHooks {
    const char* p_; const char* vt_; int G, c;
    __device__ __forceinline__ bool next(int i, Unit& u) const { const int L = i * G + c; if (L >= 256) return false; tile_map(L, 64, 4, u.pm, u.pn); u.z = 0;
        u.a = p_ + ((size_t)u.pm * 256 * 1024 + u.pn * 256) * 2; u.b = vt_ + ((size_t)(u.pm >> 3) * 1024 + u.pn * 256) * 256 * 2; return true; }
};
struct MoeOrder : NoHooks {
    const char* A; const char* B; size_t estride; int lda, ldb, ntiles, nN, G, c; int t1, t2, t3, t4, t5, t6, t7;
    __device__ __forceinline__ bool next(int i, Unit& u) const { const int L = i * G + c; if (L >= ntiles * nN) return false; tile_map(L, ntiles, nN, u.pm, u.pn);
        const int rt = u.pm; const int e = (rt >= t1) + (rt >= t2) + (rt >= t3) + (rt >= t4) + (rt >= t5) + (rt >= t6) + (rt >= t7); u.z = e;
        u.a = A + (size_t)rt * 256 * lda * 2; u.b = B + (size_t)e * estride + (size_t)u.pn * 256 * ldb * 2; return true; }
};

template <class Epi, class Sched, bool ALIGN_EPI = false, bool SP2 = false>
__device__ __forceinline__ void gemm_phase(PG8_LAS unsigned char* lds, const Gemm g, const Sched& S, const Epi& E, const int wave_s) {
    int tid_ = wave_s * 64 + lane_id_fresh(); asm volatile("" : "+v"(tid_));
    const int tid = tid_, wid = __builtin_amdgcn_readfirstlane(tid >> 6), lane = tid & 63, wr = wid >> 2, wc = wid & 3, fr = lane & 15, fq = lane >> 4;
    const int K = g.K, nt = K / BK;
    unsigned voffA[2], voffB[2];
#pragma unroll
    for (int i = 0; i < 2; ++i) { int R, C; stage_rc(tid * 16 + i * 8192, R, C); const int Rb = Epi::PERM ? ((R & ~31) + perm32(R & 31)) : R;
        voffA[i] = (unsigned)(R * g.lda + C) * 2u; voffB[i] = (unsigned)(Rb * g.ldb + C) * 2u; }
    const size_t kstep = (size_t)(BK * 2);
    const size_t hstepA = (size_t)HALF * g.lda * 2, hstepB = (size_t)HALF * g.ldb * 2;
    const unsigned ldsw = (unsigned)wid * 1024u;
    const int aoff = lds_byte(wr * 64 + fr, fq * 8), boff = lds_byte(wc * 32 + fr, fq * 8);
#define PG8_SA(b, h) (((b) * 2 + (h)) * HTB)
#define PG8_SB(b, h) ((4 + (b) * 2 + (h)) * HTB)
#define PG8_STAGE(bufoff, gbase, voff) do { _Pragma("unroll") for (int _i = 0; _i < 2; ++_i) \
        __builtin_amdgcn_global_load_lds((const unsigned*)((const char*)(gbase) + (voff)[_i]), (PG8_LAS unsigned*)(lds + (bufoff) + ldsw + _i * 8192), 16, 0, 0); } while (0)
#define PG8_LDA(dst, b, h) do { _Pragma("unroll") for (int m = 0; m < 4; ++m) _Pragma("unroll") for (int k = 0; k < 2; ++k) dst[m][k] = *(const PG8_LAS bf16x8*)(lds + PG8_SA(b, h) + aoff + m * 2048 + k * 1024); } while (0)
#define PG8_LDB(dst, b, h) do { _Pragma("unroll") for (int n = 0; n < 2; ++n) _Pragma("unroll") for (int k = 0; k < 2; ++k) dst[n][k] = *(const PG8_LAS bf16x8*)(lds + PG8_SB(b, h) + boff + n * 2048 + k * 1024); } while (0)
#define PG8_MMA(ai, bj, At, Bt) do { __builtin_amdgcn_s_setprio(1); _Pragma("unroll") for (int m = 0; m < 4; ++m) _Pragma("unroll") for (int n = 0; n < 2; ++n) _Pragma("unroll") for (int k = 0; k < 2; ++k) \
        acc[ai][bj][m][n] = __builtin_amdgcn_mfma_f32_16x16x32_bf16(Bt[n][k], At[m][k], acc[ai][bj][m][n], 0, 0, 0); __builtin_amdgcn_s_setprio(0); } while (0)
#define PG8_WAIT_V(n) asm volatile("s_waitcnt vmcnt(" #n ")" ::: "memory")
#define PG8_WAIT_L(n) asm volatile("s_waitcnt lgkmcnt(" #n ")" ::: "memory")
#define PG8_BAR __builtin_amdgcn_s_barrier()
#define PG8_SCHED __builtin_amdgcn_sched_barrier(0)
    Unit cur, nxt; int ui = 0;
    if (!S.next(0, cur)) return;
    f32x4 acc[2][2][4][2];
#pragma unroll
    for (int a = 0; a < 2; ++a)
#pragma unroll
        for (int b = 0; b < 2; ++b)
#pragma unroll
            for (int m = 0; m < 4; ++m)
#pragma unroll
                for (int n = 0; n < 2; ++n) acc[a][b][m][n] = (f32x4){0.f, 0.f, 0.f, 0.f};
    bf16x8 At[4][2], B0[2][2], B1[2][2];
    const char* cA = cur.a; const char* cB = cur.b;
    S.a_ready(cur);
    if constexpr (SP2) {
        PG8_STAGE(PG8_SB(0, 0), cB, voffB); PG8_STAGE(PG8_SB(0, 1), cB + hstepB, voffB); PG8_STAGE(PG8_SA(0, 0), cA, voffA); PG8_STAGE(PG8_SA(0, 1), cA + hstepA, voffA);
        if (wr == 1) PG8_BAR;
        PG8_WAIT_V(2); PG8_BAR;
        PG8_STAGE(PG8_SB(1, 0), cB + kstep, voffB); PG8_STAGE(PG8_SA(1, 0), cA + kstep, voffA); PG8_STAGE(PG8_SB(1, 1), cB + hstepB + kstep, voffB);
        PG8_WAIT_V(6); PG8_BAR;
    } else {
        PG8_STAGE(PG8_SB(0, 0), cB, voffB); PG8_STAGE(PG8_SA(0, 0), cA, voffA); PG8_STAGE(PG8_SB(0, 1), cB + hstepB, voffB); PG8_STAGE(PG8_SA(0, 1), cA + hstepA, voffA);
        if (wr == 1) PG8_BAR;
        PG8_WAIT_V(4); PG8_BAR;
        PG8_STAGE(PG8_SB(1, 0), cB + kstep, voffB); PG8_STAGE(PG8_SA(1, 0), cA + kstep, voffA); PG8_STAGE(PG8_SB(1, 1), cB + hstepB + kstep, voffB);
        PG8_WAIT_V(6); PG8_BAR;
    }
    for (;;) {
        const bool has_next = S.next(ui + 1, nxt);
        const char* nA = has_next ? nxt.a : cA; const char* nB = has_next ? nxt.b : cB;
        for (int t = 0; t < nt; t += 2) {
            const bool last = (t == nt - 2);
            const char* a1 = cA + (size_t)(t + 1) * kstep;
            const char* a2 = last ? nA : cA + (size_t)(t + 2) * kstep; const char* b2 = last ? nB : cB + (size_t)(t + 2) * kstep;
            const char* a3 = a2 + kstep; const char* b3 = b2 + kstep;
            if (last && has_next) S.a_ready(nxt);
            if constexpr (SP2) {
            PG8_LDB(B0, 0, 0); PG8_LDB(B1, 0, 1); PG8_SCHED; PG8_LDA(At, 0, 0); PG8_STAGE(PG8_SA(1, 1), a1 + hstepA, voffA);
            PG8_WAIT_V(8); PG8_WAIT_L(0); PG8_BAR; PG8_MMA(0, 0, At, B0); PG8_MMA(0, 1, At, B1); PG8_BAR; PG8_SCHED;
            PG8_LDA(At, 0, 1); PG8_STAGE(PG8_SB(0, 0), b2, voffB); PG8_STAGE(PG8_SB(0, 1), b2 + hstepB, voffB); PG8_STAGE(PG8_SA(0, 0), a2, voffA);
            PG8_WAIT_V(8); PG8_WAIT_L(0); PG8_BAR; PG8_MMA(1, 0, At, B0); PG8_MMA(1, 1, At, B1); PG8_BAR; PG8_SCHED;
            PG8_LDB(B0, 1, 0); PG8_LDB(B1, 1, 1); PG8_SCHED; PG8_LDA(At, 1, 0); PG8_STAGE(PG8_SA(0, 1), a2 + hstepA, voffA);
            PG8_WAIT_V(8); PG8_WAIT_L(0); PG8_BAR; PG8_MMA(0, 0, At, B0); PG8_MMA(0, 1, At, B1); PG8_BAR; PG8_SCHED;
            PG8_LDA(At, 1, 1); PG8_STAGE(PG8_SB(1, 0), b3, voffB); PG8_STAGE(PG8_SB(1, 1), b3 + hstepB, voffB); PG8_STAGE(PG8_SA(1, 0), a3, voffA);
            PG8_WAIT_V(8); PG8_WAIT_L(0); PG8_BAR; PG8_MMA(1, 0, At, B0); PG8_MMA(1, 1, At, B1); PG8_BAR; PG8_SCHED;
            } else {
            PG8_LDB(B0, 0, 0); PG8_SCHED; PG8_LDA(At, 0, 0); PG8_STAGE(PG8_SA(1, 1), a1 + hstepA, voffA);
            PG8_WAIT_L(8); PG8_BAR; PG8_WAIT_L(0); PG8_MMA(0, 0, At, B0); PG8_BAR; PG8_SCHED;
            PG8_LDB(B1, 0, 1); PG8_STAGE(PG8_SB(0, 0), b2, voffB);
            PG8_BAR; PG8_WAIT_L(0); PG8_MMA(0, 1, At, B1); PG8_BAR;
            PG8_LDA(At, 0, 1); PG8_STAGE(PG8_SA(0, 0), a2, voffA);
            PG8_BAR; PG8_WAIT_L(0); PG8_MMA(1, 0, At, B0); PG8_BAR; PG8_SCHED;
            PG8_STAGE(PG8_SB(0, 1), b2 + hstepB, voffB);
            PG8_WAIT_V(6); PG8_BAR; PG8_MMA(1, 1, At, B1); PG8_BAR;
            PG8_LDB(B0, 1, 0); PG8_SCHED; PG8_LDA(At, 1, 0); PG8_STAGE(PG8_SA(0, 1), a2 + hstepA, voffA);
            PG8_WAIT_L(8); PG8_BAR; PG8_WAIT_L(0); PG8_MMA(0, 0, At, B0); PG8_BAR; PG8_SCHED;
            PG8_LDB(B1, 1, 1); PG8_STAGE(PG8_SB(1, 0), b3, voffB);
            PG8_BAR; PG8_WAIT_L(0); PG8_MMA(0, 1, At, B1); PG8_BAR;
            PG8_LDA(At, 1, 1); PG8_STAGE(PG8_SA(1, 0), a3, voffA);
            PG8_BAR; PG8_WAIT_L(0); PG8_MMA(1, 0, At, B0); PG8_BAR; PG8_SCHED;
            PG8_STAGE(PG8_SB(1, 1), b3 + hstepB, voffB);
            PG8_WAIT_V(6); PG8_BAR; PG8_MMA(1, 1, At, B1); PG8_BAR;
            }
        }
        if constexpr (ALIGN_EPI) { if (wr == 0) PG8_BAR; }
        if constexpr (!Epi::AFTER_DRAIN) { const int l2_ = lane_id_fresh(); E(acc, cur, wr, wc, l2_ & 15, l2_ >> 4); S.done(cur); }
        if (!has_next) break;
        bool zero_acc = true; if constexpr (Epi::KEEPS) zero_acc = !E.keep(cur);
        if (zero_acc) {
#pragma unroll
        for (int a = 0; a < 2; ++a)
#pragma unroll
            for (int b = 0; b < 2; ++b)
#pragma unroll
                for (int m = 0; m < 4; ++m)
#pragma unroll
                    for (int n = 0; n < 2; ++n) acc[a][b][m][n] = (f32x4){0.f, 0.f, 0.f, 0.f};
        }
        cur = nxt; cA = nA; cB = nB; ++ui;
        if constexpr (ALIGN_EPI) { if (wr == 1) PG8_BAR; }
    }
    PG8_WAIT_V(0);
    if constexpr (!ALIGN_EPI) { if (wr == 0) PG8_BAR; }
    PG8_BAR;
    if constexpr (Epi::AFTER_DRAIN) { const int l3_ = lane_id_fresh(); E.fused(acc, cur, wr, wc, l3_ & 15, l3_ >> 4, lds, wid, l3_); S.done(cur); }
#undef PG8_SA
#undef PG8_SB
#undef PG8_STAGE
#undef PG8_LDA
#undef PG8_LDB
#undef PG8_MMA
#undef PG8_WAIT_V
#undef PG8_WAIT_L
#undef PG8_BAR
#undef PG8_SCHED
}
}

#define GAS __attribute__((address_space(1)))
#define LAS __attribute__((address_space(3)))
typedef unsigned short bf16;
typedef unsigned v4u __attribute__((ext_vector_type(4)));
typedef unsigned v2u __attribute__((ext_vector_type(2)));
typedef float f32x4 __attribute__((ext_vector_type(4)));
typedef float f32x2 __attribute__((ext_vector_type(2)));
typedef int i32x4 __attribute__((ext_vector_type(4)));
typedef int i32x2 __attribute__((ext_vector_type(2)));
#define RLX_AGENT __ATOMIC_RELAXED, __HIP_MEMORY_SCOPE_AGENT
#define LDS_WAIT() asm volatile("s_waitcnt lgkmcnt(0)" ::: "memory")
#define VM_WAIT() asm volatile("s_waitcnt vmcnt(0)" ::: "memory")
__device__ __forceinline__ unsigned f2bf(float f) { unsigned u = __builtin_bit_cast(unsigned, f); return (u + 0x7fffu + ((u >> 16) & 1u)) >> 16; }
__device__ __forceinline__ unsigned pk2(float lo, float hi) { return f2bf(lo) | (f2bf(hi) << 16); }
__device__ __forceinline__ float bflo(unsigned w) { return __uint_as_float(w << 16); }
__device__ __forceinline__ float bfhi(unsigned w) { return __uint_as_float(w & 0xffff0000u); }
__device__ __forceinline__ float bf1(bf16 v) { return __uint_as_float((unsigned)v << 16); }

#define XB_TMO      128
#define XB_XCNT(j)  (256  + 64 * (j))
#define XB_XSUB(j)  (1280 + 64 * (j))
#define XB_XGEN(j)  (2304 + 64 * (j))
#define XB_TOP      3328
#define XB_TOPGEN   3392
#define XCD_BAR_WORDS 3456
#define XB_SPIN_CAP (1u << 18)

__device__ __forceinline__ unsigned xb_ld(unsigned* p)              { return __hip_atomic_load(p, __ATOMIC_RELAXED, __HIP_MEMORY_SCOPE_AGENT); }
__device__ __forceinline__ unsigned xb_add(unsigned* p, unsigned v) { return __hip_atomic_fetch_add(p, v, __ATOMIC_RELAXED, __HIP_MEMORY_SCOPE_AGENT); }
__device__ __forceinline__ unsigned xb_xcc_id() { return (unsigned)__builtin_amdgcn_s_getreg((3 << 11) | 20) & 0xFu; }
#define XB_SPIN(cond, bar) do { unsigned _sp = 0; while (cond) { __builtin_amdgcn_s_sleep(1); \
    if ((++_sp & 255u) == 0u) { if (xb_ld(&(bar)[XB_TMO])) break; if (_sp > XB_SPIN_CAP) { atomicAdd(&(bar)[XB_TMO], 1u); break; } } } } while (0)

struct XcdBarrier {
    unsigned* bar; unsigned x;
    volatile LAS unsigned* st;
};

__device__ __forceinline__ XcdBarrier xcd_barrier_post(unsigned* bar, volatile LAS unsigned* st, const int wave_s) {
    XcdBarrier b; b.bar = bar; b.x = xb_xcc_id(); b.st = st;
    if (wave_s == 0 && lane_id_fresh() == 0) (void)xb_add(&bar[XB_XCNT(b.x)], 1u);
    return b;
}
__device__ __forceinline__ void xcd_barrier_complete(unsigned* bar, unsigned x, unsigned& nloc, unsigned& nx) {
    const unsigned G = gridDim.x * gridDim.y * gridDim.z;
    unsigned sum, cnt, mine, sp = 0u;
    for (;;) {
        sum = 0u; cnt = 0u; mine = 0u;
#pragma unroll
        for (unsigned j = 0; j < 16; ++j) { const unsigned c = xb_ld(&bar[XB_XCNT(j)]); sum += c; cnt += (c > 0u) ? 1u : 0u; mine = (j == x) ? c : mine; }
        if (sum == G) break;
        __builtin_amdgcn_s_sleep(1);
        if ((++sp & 255u) == 0u) { if (xb_ld(&bar[XB_TMO])) break; if (sp > XB_SPIN_CAP) { atomicAdd(&bar[XB_TMO], 1u); break; } }
    }
    nloc = mine > 0u ? mine : 1u; nx = cnt > 0u ? cnt : 1u;
}

__device__ __forceinline__ void xcd_barrier(const XcdBarrier& b, const int wave_s) {
    asm volatile("s_waitcnt vmcnt(0)" ::: "memory");
    __syncthreads();
    if (wave_s == 0 && lane_id_fresh() == 0) {
        unsigned* bar = b.bar;
        __builtin_amdgcn_s_waitcnt(0);
        unsigned nloc = b.st[0], nx = b.st[1];
        if (nloc == 0u) { xcd_barrier_complete(bar, b.x, nloc, nx); b.st[0] = nloc; b.st[1] = nx; }
        const unsigned old = xb_add(&bar[XB_XSUB(b.x)], 1u);
        const unsigned gen = old / nloc;
        if (old + 1u == (gen + 1u) * nloc) {
            __builtin_amdgcn_fence(__ATOMIC_RELEASE, "agent");
            asm volatile("s_waitcnt vmcnt(0)" ::: "memory");
            const unsigned og = xb_add(&bar[XB_TOP], 1u);
            const unsigned tg = og / nx;
            if (og + 1u == (tg + 1u) * nx) xb_add(&bar[XB_TOPGEN], 1u);
            else XB_SPIN(xb_ld(&bar[XB_TOPGEN]) == tg, bar);
            __builtin_amdgcn_fence(__ATOMIC_ACQUIRE, "agent");
            xb_add(&bar[XB_XGEN(b.x)], 1u);
            asm volatile("s_waitcnt vmcnt(0)" ::: "memory");
        } else {
            XB_SPIN(xb_ld(&bar[XB_XGEN(b.x)]) == gen, bar);
            __builtin_amdgcn_fence(__ATOMIC_ACQUIRE, "agent");
            asm volatile("s_waitcnt vmcnt(0)" ::: "memory");
        }
    }
    __syncthreads();
}

constexpr int NWAVES = 8;
namespace cf {
constexpr int D = 1024, NB = 8, L = 2048, T = NB * L, NMEM = 256, TM = NB * NMEM, IN_TOTAL = 8968, DFF = 2816, DFE = 3584, NE = 8;
constexpr int PJ = 4864;
constexpr int C_U = 0, C_Z = 512, C_XBC = 1024, C_Q = 1792, C_K = 2304, C_V = 2816, C_G = 3328, C_XL = 3840, C_GL = 4352;
constexpr int O_DT = 1792, O_GATE = 4872;
constexpr int MAXSLOT = 34816;
}
constexpr size_t MiB = 1u << 20;
constexpr size_t WS_CTL = 0, CTL_ZERO_BYTES = 1 * MiB;
constexpr size_t WS_TOPI = 1 * MiB, WS_TOPW = WS_TOPI + 256 * 1024, WS_SLOT = WS_TOPW + 128 * 1024;
constexpr size_t WS_HN = 2 * MiB, WS_KV = 34 * MiB, WS_TAB = 50 * MiB, WS_DT = 54 * MiB, WS_MNR = 55 * MiB, WS_W = 59 * MiB;
constexpr size_t WL_STRIDE = 32 * MiB, WL_WIN = 0, WL_GLU = 17 * MiB + 512 * 1024, WL_WB = 18 * MiB, WL_WOUT = 22 * MiB, WL_WQ = 24 * MiB, WL_WKV = 26 * MiB, WL_WO = 30 * MiB;
constexpr size_t WS_W13 = 123 * MiB, WS_W2 = 134 * MiB, WS_R = 140 * MiB;
constexpr size_t R_PROJB = WS_R, R_GATE = WS_R + 152 * MiB, R_BR = WS_R + 280 * MiB, R_XBCC = WS_R + 344 * MiB, R_XLC = WS_R + 368 * MiB, R_END = WS_R + 384 * MiB;
constexpr size_t R_MP = WS_R, R_MERGED = WS_R + 64 * MiB;
constexpr size_t R_XQ = WS_R, R_P = WS_R + 32 * MiB, R_XO = WS_R + 64 * MiB;
constexpr size_t R_ACT = WS_R;
constexpr size_t M_W13E = 34 * MiB, M_W2E = 146 * MiB, M_XS = 202 * MiB, M_ACTE = 270 * MiB, M_END = 508 * MiB;
constexpr size_t WS_NEED = R_END > M_END ? R_END : M_END;
constexpr int CW_TMO = 0, CW_CODE = 1, CW_BAR = 4096, CW_CNT = 8192;
constexpr int RING_BYTES = 131072, LDSCTL_OFF = RING_BYTES, XCH_OFF = LDSCTL_OFF + 1024, LDS_BYTES = 147456;

struct Params { const float* in[46]; float* out; unsigned char* ws; int ph_lo, ph_hi; };

__device__ __forceinline__ int opq(int v) { asm volatile("" : "+s"(v)); return v; }
template <class Tp> __device__ __forceinline__ Tp* opqp(Tp* q) { return q + opq(0); }
__device__ __forceinline__ float wave_sum(float v) {
#pragma unroll
    for (int o = 1; o < 64; o <<= 1) v += __shfl_xor(v, o);
    return v;
}
__device__ __forceinline__ float sigmoidf_(float x) { return 1.0f / (1.0f + __expf(-x)); }
__device__ __forceinline__ float siluf_(float x) { return x / (1.0f + __expf(-x)); }
__device__ __forceinline__ float gelu_tanh(float x) { const float u = 0.7978845608028654f * (x + 0.044715f * x * x * x); const float e = __expf(2.0f * u); return x * (1.0f - 1.0f / (e + 1.0f)); }
__device__ __forceinline__ float softplusf_(float x) { return x > 20.f ? x : log1pf(__expf(x)); }

struct MapPlain { const float* W; int K, N; const float* ks; float sc; bf16* WT; int ldo;
    __device__ __forceinline__ float load(int k, int n) const { float v = W[(size_t)k * N + n]; if (ks) v *= ks[k]; return v * sc; }
    __device__ __forceinline__ bf16* dst(int n) const { return WT + (size_t)n * ldo; } };
struct MapWin { const float* W; const float* ks; bf16* WT; int N;
    __device__ __forceinline__ float load(int k, int n) const { return W[(size_t)k * cf::IN_TOTAL + n + (n >= cf::O_DT ? 8 : 0)] * ks[k]; }
    __device__ __forceinline__ bf16* dst(int n) const { return WT + (size_t)n * 1024; } };
struct MapW13 { const float* w1; const float* w3; const float* ks; bf16* WT; int F, N;
    __device__ __forceinline__ float load(int k, int n) const { const int j = n & 31, base = n - j, mat = j >> 4, f = (base >> 1) + (j & 15); const ptrdiff_t dsel = mat ? (w3 - w1) : (ptrdiff_t)0; float v = w1[dsel + (ptrdiff_t)((size_t)k * F + f)]; if (ks) v *= ks[k]; return v; }
    __device__ __forceinline__ bf16* dst(int n) const { const int j = n & 31, base = n - j, mat = j >> 4, fi = j & 15; return WT + (size_t)(base + 8 * (fi >> 2) + 4 * mat + (fi & 3)) * 1024; } };
template <class Map> __device__ __forceinline__ void cvt_item(const Map& mp, int item, LAS float* scr, int lane) {
    const int nblk = mp.N / 32, kb = item / nblk, nb = item % nblk, k0 = 64 * kb, n0 = 32 * nb;
#pragma unroll 8
    for (int i = 0; i < 32; ++i) { const int kk = 2 * i + (lane >> 5); scr[kk * 33 + (lane & 31)] = mp.load(k0 + kk, n0 + (lane & 31)); }
    LDS_WAIT(); asm volatile("" ::: "memory");
    const int c = lane & 7;
#pragma unroll
    for (int j = 0; j < 4; ++j) { const int n = (lane >> 3) + 8 * j; const LAS float* s = scr + (8 * c) * 33 + n;
        v4u o; o.x = pk2(s[0 * 33], s[1 * 33]); o.y = pk2(s[2 * 33], s[3 * 33]); o.z = pk2(s[4 * 33], s[5 * 33]); o.w = pk2(s[6 * 33], s[7 * 33]);
        *(v4u*)(mp.dst(n0 + n) + k0 + 8 * c) = o; }
    LDS_WAIT(); asm volatile("" ::: "memory");
}

__device__ __forceinline__ float norm_row(const float* xrow, bf16* orow, int lane, f32x4 (&v)[4]) {
    const f32x4* xr = (const f32x4*)xrow + lane; float ss = 0.f;
#pragma unroll
    for (int j = 0; j < 4; ++j) { v[j] = xr[64 * j]; ss += (v[j].x * v[j].x + v[j].y * v[j].y) + (v[j].z * v[j].z + v[j].w * v[j].w); }
    const float r = 1.0f / sqrtf(wave_sum(ss) * (1.0f / 1024.0f) + 1e-6f);
    unsigned long long* o8 = (unsigned long long*)orow + lane;
#pragma unroll
    for (int j = 0; j < 4; ++j) o8[64 * j] = (unsigned long long)pk2(v[j].x * r, v[j].y * r) | ((unsigned long long)pk2(v[j].z * r, v[j].w * r) << 32);
    return r;
}
__device__ __forceinline__ void row_dot8(const f32x4 (&v)[4], const LAS float* w8, int lane, float (&lg)[8]) {
#pragma unroll
    for (int e = 0; e < 8; ++e) lg[e] = 0.f;
#pragma unroll
    for (int j = 0; j < 4; ++j)
#pragma unroll
        for (int q = 0; q < 4; ++q) { const int i = 256 * j + 4 * lane + q; const f32x4 wa = *(const LAS f32x4*)(w8 + i * 8), wb = *(const LAS f32x4*)(w8 + i * 8 + 4); const float x = v[j][q];
            lg[0] += x * wa.x; lg[1] += x * wa.y; lg[2] += x * wa.z; lg[3] += x * wa.w; lg[4] += x * wb.x; lg[5] += x * wb.y; lg[6] += x * wb.z; lg[7] += x * wb.w; }
#pragma unroll
    for (int e = 0; e < 8; ++e) lg[e] = wave_sum(lg[e]);
}

#define PH_VARS int tid_ = wave_s * 64 + lane_id_fresh(); asm volatile("" : "+v"(tid_)); const int tid = tid_, lane = tid & 63, wave = __builtin_amdgcn_readfirstlane(tid >> 6); \
    const int G = opq((int)gridDim.x), bx = opq((int)blockIdx.x), vcu = (G % 8 == 0) ? (bx % 8) * (G / 8) + bx / 8 : bx; \
    const int gw = vcu * NWAVES + wave, NGW = G * NWAVES, gt = vcu * 512 + tid, NGT = G * 512; \
    LAS float* scr = (LAS float*)(lds + wave * 16384); LAS float* w8 = (LAS float*)lds; LAS float* xch = (LAS float*)(lds + XCH_OFF); \
    (void)lane; (void)gw; (void)NGW; (void)gt; (void)NGT; (void)scr; (void)w8; (void)xch; (void)bx;
#define ws (opqp(p.ws))
#define ctl ((unsigned*)(ws + WS_CTL))
#define GRID_BAR() do { if (single) { XcdBarrier b2_ = bar; b2_.bar = ctl + CW_BAR; xcd_barrier(b2_, wave_s); } } while (0)
#define IN(k) (lo <= (k) && (k) < hi)
#define x_ (opqp(p.in[0]))
#define mem_ (opqp(p.in[1]))
#define positions_ ((const int*)opqp(p.in[2]))
#define norm_mix (opqp(p.in[3]))
#define w_in (opqp(p.in[4]))
#define b_gate (opqp(p.in[5]))
#define w_branch (opqp(p.in[29]))
#define w_out (opqp(p.in[30]))
#define norm_xa (opqp(p.in[31]))
#define norm_mem (opqp(p.in[32]))
#define xa_wq (opqp(p.in[33]))
#define xa_wk (opqp(p.in[34]))
#define xa_wv (opqp(p.in[35]))
#define xa_wo (opqp(p.in[36]))
#define norm_ffn (opqp(p.in[37]))
#define ffn_w1 (opqp(p.in[38]))
#define ffn_w3 (opqp(p.in[39]))
#define ffn_w2 (opqp(p.in[40]))
#define moe_router (opqp(p.in[41]))
#define moe_w1 (opqp(p.in[42]))
#define moe_w3 (opqp(p.in[43]))
#define moe_w2 (opqp(p.in[44]))
#define norm_final (opqp(p.in[45]))
#define H (opqp(p.out))
#define HN ((bf16*)(ws + WS_HN))
#define KVB ((bf16*)(ws + WS_KV))
#define COS ((float*)(ws + WS_TAB))
#define SIN (COS + (size_t)T * 32)
#define DT ((float*)(ws + WS_DT))
#define MNR ((bf16*)(ws + WS_MNR))
#define PROJB ((bf16*)(ws + R_PROJB))
#define GATE ((bf16*)(ws + R_GATE))
#define BR ((bf16*)(ws + R_BR))
#define XBCC ((bf16*)(ws + R_XBCC))
#define XLC ((bf16*)(ws + R_XLC))
#define MP ((float*)(ws + R_MP))
#define MERGED ((bf16*)(ws + R_MERGED))
#define XQ ((bf16*)(ws + R_XQ))
#define PB ((bf16*)(ws + R_P))
#define XO ((bf16*)(ws + R_XO))
#define ACT ((bf16*)(ws + R_ACT))
#define W13E ((bf16*)(ws + M_W13E))
#define W2E ((bf16*)(ws + M_W2E))
#define XS ((bf16*)(ws + M_XS))
#define ACTE ((bf16*)(ws + M_ACTE))
#define TOPI ((i32x4*)(ws + WS_TOPI))
#define TOPW ((f32x2*)(ws + WS_TOPW))
#define SLOT ((i32x2*)(ws + WS_SLOT))
#define CNT ((int*)(ctl + CW_CNT))
#define W13 ((bf16*)(ws + WS_W13))
#define W2T ((bf16*)(ws + WS_W2))
#define CVT_LOOP(NITEMS, ...) do { for (int it = (gw + NGW - rot % NGW) % NGW; it < (NITEMS); it += NGW) { __VA_ARGS__; cvt_item(m, it, scr, lane); } rot += (NITEMS); } while (0)

__global__ void __launch_bounds__(NWAVES * 64, 2) mega(Params p) {
    using namespace cf;
    extern __shared__ __attribute__((aligned(16))) unsigned char lds_raw[];
    LAS unsigned char* lds = (LAS unsigned char*)lds_raw;
    const int wave_s = __builtin_amdgcn_readfirstlane((int)threadIdx.x >> 6);
    for (int u = threadIdx.x; u < (LDS_BYTES - LDSCTL_OFF) / 4; u += NWAVES * 64) ((LAS unsigned*)(lds + LDSCTL_OFF))[u] = 0u;
    __syncthreads();
    const bool single = (p.ph_hi - p.ph_lo) > 1;
    XcdBarrier bar; bar.bar = ctl + CW_BAR; bar.x = 0; bar.st = (volatile LAS unsigned*)(lds + LDSCTL_OFF) + 8;
    if (single) bar = xcd_barrier_post(ctl + CW_BAR, (volatile LAS unsigned*)(lds + LDSCTL_OFF) + 8, wave_s);
    const int lo = p.ph_lo, hi = p.ph_hi;


    if (IN(0)) { PH_VARS
        {
            int rot = 0;
            for (int l = 0; l < 2; ++l) {
                unsigned char* wl = ws + WS_W + (size_t)l * WL_STRIDE;
                CVT_LOOP(16 * 280, MapWin m{w_in + (size_t)l * D * IN_TOTAL, norm_mix + l * D, (bf16*)(wl + WL_WIN), 8960});
                CVT_LOOP(8 * 16, MapPlain m{opqp(p.in[14]) + (size_t)l * 512 * 512, 512, 512, nullptr, 1.f, (bf16*)(wl + WL_GLU), 512});
                for (int k = 0; k < 4; ++k) CVT_LOOP(8 * 32, MapPlain m{w_branch + ((size_t)l * 4 + k) * 512 * 1024, 512, 1024, nullptr, 1.f, (bf16*)(wl + WL_WB) + k * 512, 2048});
                CVT_LOOP(16 * 32, MapPlain m{w_out + (size_t)l * D * D, D, D, nullptr, 1.f, (bf16*)(wl + WL_WOUT), D});
                CVT_LOOP(16 * 32, MapPlain m{xa_wq + (size_t)l * D * D, D, D, norm_xa + l * D, 0.0625f, (bf16*)(wl + WL_WQ), D});
                CVT_LOOP(16 * 32, MapPlain m{xa_wk + (size_t)l * D * D, D, D, norm_mem + l * D, 1.f, (bf16*)(wl + WL_WKV), D});
                CVT_LOOP(16 * 32, MapPlain m{xa_wv + (size_t)l * D * D, D, D, norm_mem + l * D, 1.f, (bf16*)(wl + WL_WKV) + (size_t)D * D, D});
                CVT_LOOP(16 * 32, MapPlain m{xa_wo + (size_t)l * D * D, D, D, nullptr, 1.f, (bf16*)(wl + WL_WO), D});
            }
            CVT_LOOP(16 * 176, MapW13 m{ffn_w1, ffn_w3, norm_ffn, W13, DFF, 2 * DFF});
            CVT_LOOP(44 * 32, MapPlain m{ffn_w2, DFF, D, nullptr, 1.f, W2T, DFF});
        }
        for (int i = gt; i < T * 32; i += NGT) { const int row = i >> 5, f = i & 31; const float inv_freq = (float)exp(-(double)f / 32.0 * 9.210340371976184); const float ang = (float)positions_[row] * inv_freq;
            COS[i] = (float)cos((double)ang); SIN[i] = (float)sin((double)ang); }
        for (int row = gw; row < TM; row += NGW) { f32x4 v[4]; (void)norm_row(mem_ + (size_t)row * D, MNR + (size_t)row * D, lane, v); }
        __syncthreads();
        for (int i = tid; i < 8192; i += 512) w8[i] = norm_mix[i >> 3] * w_in[(size_t)(i >> 3) * IN_TOTAL + O_DT + (i & 7)];
        __syncthreads();
        for (int row = gw; row < T; row += NGW) { f32x4 v[4]; const float r = norm_row(x_ + (size_t)row * D, HN + (size_t)row * D, lane, v); float lg[8]; row_dot8(v, w8, lane, lg);
            float mine = 0.f;
#pragma unroll
            for (int e = 0; e < 8; ++e) if (lane == e) mine = lg[e];
            if (lane < 8) DT[(size_t)row * 8 + lane] = softplusf_(r * mine + opqp(p.in[17])[lane]); }
        GRID_BAR();
    }


    { constexpr int layer = 0;
        const int pb = 1 + layer * 20;
#define WLP (ws + WS_W + (size_t)layer * WL_STRIDE)
#define WIN ((const bf16*)(WLP + WL_WIN))
#define WGLU ((const bf16*)(WLP + WL_GLU))
#define WB ((const bf16*)(WLP + WL_WB))
#define WOUT ((const bf16*)(WLP + WL_WOUT))
#define WQ ((const bf16*)(WLP + WL_WQ))
#define WO ((const bf16*)(WLP + WL_WO))
#define KX (KVB + (size_t)layer * 4194304)
#define VT (KX + 2097152)
        if (IN(pb + 0)) { PH_VARS
            if (layer == 0) {
                pg8::Gemm g{1024, 1024, 1024}; pg8::KVOrder S; S.mnr_ = (const char*)MNR; S.WKV0 = (const char*)(ws + WS_W + WL_WKV); S.WKV1 = (const char*)(ws + WS_W + WL_STRIDE + WL_WKV); S.G = G; S.c = bx;
                pg8::EpiKV E{KVB};
                pg8::gemm_phase<pg8::EpiKV, pg8::KVOrder, false, false>(lds, g, S, E, wave_s);
            }
            pg8::Gemm g{1024, 1024, 1024}; pg8::PlainOrder S; S.A = (const char*)HN; S.B = (const char*)WIN; S.nM = 64; S.nN = 35; S.lda = 1024; S.ldb = 1024; S.G = G; S.c = bx;
            pg8::EpiProj E{PROJB, GATE, b_gate + layer * 4096};
            pg8::gemm_phase<pg8::EpiProj, pg8::PlainOrder, false, false>(lds, g, S, E, wave_s);
            GRID_BAR();
        }
        if (IN(pb + 1)) { PH_VARS
            const float* cw = opqp(p.in[15]) + layer * 4 * 768; const float* cb = opqp(p.in[16]) + layer * 768; const float* lw = opqp(p.in[22]) + layer * 4 * 512; const float* lb = opqp(p.in[23]) + layer * 512;
            for (int it = gt; it < T * 224; it += NGT) {
                const int row = it / 224, j = it % 224, t = row & (L - 1);
                if (j < 160) {
                    const bool isx = j < 96; const int c0 = isx ? j * 8 : (j - 96) * 8, C = isx ? 768 : 512; const float* w = isx ? cw : lw; const float* bb = isx ? cb : lb;
                    const bf16* src = PROJB + (size_t)row * PJ + (isx ? C_XBC : C_XL) + c0;
                    float acc[8];
#pragma unroll
                    for (int q = 0; q < 8; ++q) acc[q] = bb[c0 + q];
#pragma unroll
                    for (int tap = 0; tap < 4; ++tap) { if (t - 3 + tap >= 0) { const v4u xv = *(const v4u*)(src - (ptrdiff_t)(3 - tap) * PJ); const float* wt = w + tap * C + c0;
                        acc[0] += wt[0] * bflo(xv.x); acc[1] += wt[1] * bfhi(xv.x); acc[2] += wt[2] * bflo(xv.y); acc[3] += wt[3] * bfhi(xv.y);
                        acc[4] += wt[4] * bflo(xv.z); acc[5] += wt[5] * bfhi(xv.z); acc[6] += wt[6] * bflo(xv.w); acc[7] += wt[7] * bfhi(xv.w); } }
                    if (isx) {
#pragma unroll
                        for (int q = 0; q < 8; ++q) acc[q] = siluf_(acc[q]); }
                    v4u o; o.x = pk2(acc[0], acc[1]); o.y = pk2(acc[2], acc[3]); o.z = pk2(acc[4], acc[5]); o.w = pk2(acc[6], acc[7]);
                    *(v4u*)((isx ? XBCC + (size_t)row * 768 : XLC + (size_t)row * 512) + c0) = o;
                } else {
                    const bool isk = j >= 192; const int jj = isk ? j - 192 : j - 160, h = jj >> 2, i0 = (jj & 3) * 8; const float sc = isk ? 0.125f : 1.0f;
                    bf16* q1 = PROJB + (size_t)row * PJ + (isk ? C_K : C_Q) + h * 64 + i0; bf16* q2 = q1 + 32;
                    const v4u a = *(const v4u*)q1, b = *(const v4u*)q2;
                    const f32x4 c0v = *(const f32x4*)(COS + (size_t)row * 32 + i0), c1v = *(const f32x4*)(COS + (size_t)row * 32 + i0 + 4), s0v = *(const f32x4*)(SIN + (size_t)row * 32 + i0), s1v = *(const f32x4*)(SIN + (size_t)row * 32 + i0 + 4);
                    const float x1[8] = {bflo(a.x), bfhi(a.x), bflo(a.y), bfhi(a.y), bflo(a.z), bfhi(a.z), bflo(a.w), bfhi(a.w)};
                    const float x2[8] = {bflo(b.x), bfhi(b.x), bflo(b.y), bfhi(b.y), bflo(b.z), bfhi(b.z), bflo(b.w), bfhi(b.w)};
                    const float cc[8] = {c0v.x, c0v.y, c0v.z, c0v.w, c1v.x, c1v.y, c1v.z, c1v.w}, ss[8] = {s0v.x, s0v.y, s0v.z, s0v.w, s1v.x, s1v.y, s1v.z, s1v.w};
                    float o1[8], o2[8];
#pragma unroll
                    for (int q = 0; q < 8; ++q) { o1[q] = (x1[q] * cc[q] - x2[q] * ss[q]) * sc; o2[q] = (x2[q] * cc[q] + x1[q] * ss[q]) * sc; }
                    v4u w1; w1.x = pk2(o1[0], o1[1]); w1.y = pk2(o1[2], o1[3]); w1.z = pk2(o1[4], o1[5]); w1.w = pk2(o1[6], o1[7]);
                    v4u w2; w2.x = pk2(o2[0], o2[1]); w2.y = pk2(o2[2], o2[3]); w2.z = pk2(o2[4], o2[5]); w2.w = pk2(o2[6], o2[7]);
                    *(v4u*)q1 = w1; *(v4u*)q2 = w2;
                }
            }
            GRID_BAR();
        }
        if (IN(pb + 2)) { PH_VARS
            bf16* YS = HN;
            for (int wu = gw; wu < 832; wu += NGW) {
                if (wu < 256) {
                    const int un = wu >> 2, sub = wu & 3, b = un >> 3, hh = un & 7, g = hh >> 2, pp = sub * 16 + (lane >> 2), nq = lane & 3;
                    const float Aa = -__expf(opqp(p.in[18])[layer * 8 + hh]), Dk = opqp(p.in[19])[layer * 8 + hh];
                    float S[16];
#pragma unroll
                    for (int j = 0; j < 16; ++j) S[j] = 0.f;
                    for (int t = 0; t < L; ++t) {
                        const size_t row = (size_t)b * L + t; const bf16* xr = XBCC + row * 768;
                        const float dtv = DT[row * 8 + hh], xv = bf1(xr[hh * 64 + pp]);
                        const v4u b0 = *(const v4u*)(xr + 512 + g * 64 + nq * 16), b1 = *(const v4u*)(xr + 512 + g * 64 + nq * 16 + 8), c0 = *(const v4u*)(xr + 640 + g * 64 + nq * 16), c1 = *(const v4u*)(xr + 640 + g * 64 + nq * 16 + 8);
                        const float Bv[16] = {bflo(b0.x), bfhi(b0.x), bflo(b0.y), bfhi(b0.y), bflo(b0.z), bfhi(b0.z), bflo(b0.w), bfhi(b0.w), bflo(b1.x), bfhi(b1.x), bflo(b1.y), bfhi(b1.y), bflo(b1.z), bfhi(b1.z), bflo(b1.w), bfhi(b1.w)};
                        const float Cv[16] = {bflo(c0.x), bfhi(c0.x), bflo(c0.y), bfhi(c0.y), bflo(c0.z), bfhi(c0.z), bflo(c0.w), bfhi(c0.w), bflo(c1.x), bfhi(c1.x), bflo(c1.y), bfhi(c1.y), bflo(c1.z), bfhi(c1.z), bflo(c1.w), bfhi(c1.w)};
                        const float da = __expf(dtv * Aa), xdt = xv * dtv; float acc = 0.f;
#pragma unroll
                        for (int j = 0; j < 16; ++j) { S[j] = da * S[j] + xdt * Bv[j]; acc += Cv[j] * S[j]; }
                        acc += __shfl_xor(acc, 1); acc += __shfl_xor(acc, 2);
                        if (nq == 0) BR[row * 2048 + 512 + hh * 64 + pp] = (bf16)f2bf(acc + Dk * xv);
                    }
                } else if (wu < 512) {
                    const int un = (wu - 256) >> 2, sub = wu & 3, b = un >> 3, hh = un & 7, e = sub * 16 + (lane >> 2), dq = lane & 3;
                    const float gamma = 1.0f - exp2f(-5.0f - (float)hh);
                    float S[16];
#pragma unroll
                    for (int j = 0; j < 16; ++j) S[j] = 0.f;
                    for (int t = 0; t < L; ++t) {
                        const size_t row = (size_t)b * L + t; const bf16* pr = PROJB + row * PJ;
                        const float vv = bf1(pr[C_V + hh * 64 + e]);
                        const v4u k0 = *(const v4u*)(pr + C_K + hh * 64 + dq * 16), k1 = *(const v4u*)(pr + C_K + hh * 64 + dq * 16 + 8), q0 = *(const v4u*)(pr + C_Q + hh * 64 + dq * 16), q1 = *(const v4u*)(pr + C_Q + hh * 64 + dq * 16 + 8);
                        const float Kv[16] = {bflo(k0.x), bfhi(k0.x), bflo(k0.y), bfhi(k0.y), bflo(k0.z), bfhi(k0.z), bflo(k0.w), bfhi(k0.w), bflo(k1.x), bfhi(k1.x), bflo(k1.y), bfhi(k1.y), bflo(k1.z), bfhi(k1.z), bflo(k1.w), bfhi(k1.w)};
                        const float Qv[16] = {bflo(q0.x), bfhi(q0.x), bflo(q0.y), bfhi(q0.y), bflo(q0.z), bfhi(q0.z), bflo(q0.w), bfhi(q0.w), bflo(q1.x), bfhi(q1.x), bflo(q1.y), bfhi(q1.y), bflo(q1.z), bfhi(q1.z), bflo(q1.w), bfhi(q1.w)};
                        float acc = 0.f;
#pragma unroll
                        for (int j = 0; j < 16; ++j) { S[j] = gamma * S[j] + Kv[j] * vv; acc += Qv[j] * S[j]; }
                        acc += __shfl_xor(acc, 1); acc += __shfl_xor(acc, 2);
                        if (dq == 0) BR[row * 2048 + 1024 + hh * 64 + e] = (bf16)f2bf(acc);
                    }
                } else if (wu < 768) {
                    const int un = wu - 512, b = un >> 5, g = un & 31, n = lane;
                    const float* lam_re = opqp(p.in[6]) + layer * 2048; const float* lam_im = opqp(p.in[7]) + layer * 2048; const float* b_re = opqp(p.in[8]) + layer * 32768; const float* b_im = opqp(p.in[9]) + layer * 32768;
                    const float* c_re = opqp(p.in[10]) + layer * 32768; const float* c_im = opqp(p.in[11]) + layer * 32768; const float* dsk = opqp(p.in[12]) + layer * 512;
                    const float lr = lam_re[g * 64 + n], li = lam_im[g * 64 + n], step = expf(opqp(p.in[13])[layer * 32 + g]);
                    const float mag = expf(lr * step), ar = mag * cosf(li * step), ai = mag * sinf(li * step);
                    const float inv = 1.0f / (lr * lr + li * li);
                    const float cr = ((ar - 1.0f) * lr + ai * li) * inv, ci = (ai * lr - (ar - 1.0f) * li) * inv;
                    float bbr[16], bbi[16], cre[16], cim[16];
#pragma unroll
                    for (int h = 0; h < 16; ++h) { const float br_ = b_re[(g * 64 + n) * 16 + h], bi_ = b_im[(g * 64 + n) * 16 + h];
                        bbr[h] = cr * br_ - ci * bi_; bbi[h] = cr * bi_ + ci * br_; cre[h] = c_re[(g * 16 + h) * 64 + n]; cim[h] = c_im[(g * 16 + h) * 64 + n]; }
                    const float dmine = dsk[g * 16 + (n & 15)];
                    float sr = 0.f, si = 0.f;
                    for (int t = 0; t < L; ++t) {
                        const size_t row = (size_t)b * L + t; const bf16* up = PROJB + row * PJ + C_U + g * 16;
                        const v4u u0 = *(const v4u*)up, u1 = *(const v4u*)(up + 8);
                        const float u[16] = {bflo(u0.x), bfhi(u0.x), bflo(u0.y), bfhi(u0.y), bflo(u0.z), bfhi(u0.z), bflo(u0.w), bfhi(u0.w), bflo(u1.x), bfhi(u1.x), bflo(u1.y), bfhi(u1.y), bflo(u1.z), bfhi(u1.z), bflo(u1.w), bfhi(u1.w)};
                        float bur = 0.f, bui = 0.f;
#pragma unroll
                        for (int h = 0; h < 16; ++h) { bur += u[h] * bbr[h]; bui += u[h] * bbi[h]; }
                        const float nr = ar * sr - ai * si + bur, ni = ar * si + ai * sr + bui; sr = nr; si = ni;
                        float mine = 0.f, umine = 0.f;
#pragma unroll
                        for (int h = 0; h < 16; ++h) { const float y = wave_sum(sr * cre[h] - si * cim[h]); if (n == h) { mine = y; umine = u[h]; } }
                        if (n < 16) YS[row * 512 + g * 16 + n] = (bf16)f2bf(gelu_tanh(mine + dmine * umine));
                    }
                } else {
                    const int un = wu - 768, b = un >> 3, blk = un & 7, j = lane;
                    LAS bf16* wA = (LAS bf16*)scr; LAS bf16* wX = wA + 4096;
                    for (int i = 0; i < 64; ++i) { wA[i * 64 + j] = (bf16)f2bf(opqp(p.in[24])[layer * 32768 + (blk * 64 + i) * 64 + j]); wX[i * 64 + j] = (bf16)f2bf(opqp(p.in[26])[layer * 32768 + (blk * 64 + i) * 64 + j]); }
                    LDS_WAIT();
                    const float bA = opqp(p.in[25])[layer * 512 + blk * 64 + j], bX = opqp(p.in[27])[layer * 512 + blk * 64 + j], sp = softplusf_(-opqp(p.in[28])[layer * 512 + blk * 64 + j]);
                    float hs = 0.f;
                    for (int t = 0; t < L; ++t) {
                        const size_t row = (size_t)b * L + t;
                        const float xc = bf1(XLC[row * 512 + blk * 64 + j]);
                        float ra = bA, ri = bX;
#pragma unroll
                        for (int i = 0; i < 64; ++i) { const float xi = __shfl(xc, i); ra += xi * bf1(wA[i * 64 + j]); ri += xi * bf1(wX[i * 64 + j]); }
                        const float r = sigmoidf_(ra), ig = sigmoidf_(ri);
                        const float log_a = -8.0f * r * sp, a = __expf(log_a);
                        const float mult = sqrtf(fmaxf(-expm1f(2.0f * log_a), 0.f));
                        hs = a * hs + mult * ig * xc;
                        BR[row * 2048 + 1536 + blk * 64 + j] = (bf16)f2bf(hs * gelu_tanh(bf1(PROJB[row * PJ + C_GL + blk * 64 + j])));
                    }
                }
            }
            GRID_BAR();
        }
        if (IN(pb + 3)) { PH_VARS
            const float* snw = opqp(p.in[20]) + layer * 512; const float* rnw = opqp(p.in[21]) + layer * 512;
            for (int row = gw; row < T; row += NGW) {
                bf16* y = BR + (size_t)row * 2048; const bf16* pr = PROJB + (size_t)row * PJ;
                {
                    const v4u yw = *(const v4u*)(y + 512 + 8 * lane), zw = *(const v4u*)(pr + C_Z + 8 * lane);
                    float v[8] = {bflo(yw.x), bfhi(yw.x), bflo(yw.y), bfhi(yw.y), bflo(yw.z), bfhi(yw.z), bflo(yw.w), bfhi(yw.w)};
                    const float z[8] = {bflo(zw.x), bfhi(zw.x), bflo(zw.y), bfhi(zw.y), bflo(zw.z), bfhi(zw.z), bflo(zw.w), bfhi(zw.w)};
                    float ss = 0.f;
#pragma unroll
                    for (int q = 0; q < 8; ++q) { v[q] *= siluf_(z[q]); ss += v[q] * v[q]; }
                    const float r = 1.0f / sqrtf(wave_sum(ss) * (1.0f / 512.0f) + 1e-6f);
#pragma unroll
                    for (int q = 0; q < 8; ++q) v[q] *= r * snw[8 * lane + q];
                    v4u o; o.x = pk2(v[0], v[1]); o.y = pk2(v[2], v[3]); o.z = pk2(v[4], v[5]); o.w = pk2(v[6], v[7]);
                    *(v4u*)(y + 512 + 8 * lane) = o;
                }
                {
                    const v4u yw = *(const v4u*)(y + 1024 + 8 * lane), gw_ = *(const v4u*)(pr + C_G + 8 * lane);
                    float v[8] = {bflo(yw.x), bfhi(yw.x), bflo(yw.y), bfhi(yw.y), bflo(yw.z), bfhi(yw.z), bflo(yw.w), bfhi(yw.w)};
                    const float gg[8] = {bflo(gw_.x), bfhi(gw_.x), bflo(gw_.y), bfhi(gw_.y), bflo(gw_.z), bfhi(gw_.z), bflo(gw_.w), bfhi(gw_.w)};
                    float s = 0.f;
#pragma unroll
                    for (int q = 0; q < 8; ++q) s += v[q];
                    s += __shfl_xor(s, 1); s += __shfl_xor(s, 2); s += __shfl_xor(s, 4);
                    const float mu = s * (1.0f / 64.0f); float q2 = 0.f;
#pragma unroll
                    for (int q = 0; q < 8; ++q) { v[q] -= mu; q2 += v[q] * v[q]; }
                    q2 += __shfl_xor(q2, 1); q2 += __shfl_xor(q2, 2); q2 += __shfl_xor(q2, 4);
                    const float rs = 1.0f / sqrtf(q2 * (1.0f / 64.0f) + 1e-6f);
#pragma unroll
                    for (int q = 0; q < 8; ++q) v[q] = siluf_(gg[q]) * (v[q] * rs * rnw[8 * lane + q]);
                    v4u o; o.x = pk2(v[0], v[1]); o.y = pk2(v[2], v[3]); o.z = pk2(v[4], v[5]); o.w = pk2(v[6], v[7]);
                    *(v4u*)(y + 1024 + 8 * lane) = o;
                }
            }
            pg8::Gemm g{512, 512, 512}; pg8::PlainOrder S; S.A = (const char*)HN; S.B = (const char*)WGLU; S.nM = 64; S.nN = 2; S.lda = 512; S.ldb = 512; S.G = G; S.c = bx;
            pg8::EpiGlu E{HN, BR};
            pg8::gemm_phase<pg8::EpiGlu, pg8::PlainOrder, false, false>(lds, g, S, E, wave_s);
            GRID_BAR();
        }
        if (IN(pb + 4)) { PH_VARS
#ifdef MK_EXP_A
            pg8::Gemm g{2048, 2048, 2048}; pg8::PlainOrder S; S.A = (const char*)BR; S.B = (const char*)WB; S.nM = 64; S.nN = 4; S.lda = 2048; S.ldb = 2048; S.G = G; S.c = bx;
            pg8::EpiStore E{MERGED, 1024};
            pg8::gemm_phase<pg8::EpiStore, pg8::PlainOrder, false, false>(lds, g, S, E, wave_s);
#else
            pg8::Gemm g{2048, 2048, 512}; pg8::MergeOrder S; S.br_ = (const char*)BR; S.wb_ = (const char*)WB; S.G = G; S.c = bx;
            pg8::EpiMerge E{GATE, MERGED};
            pg8::gemm_phase<pg8::EpiMerge, pg8::MergeOrder, false, false>(lds, g, S, E, wave_s);
#endif
            GRID_BAR();
        }
        if (IN(pb + 5)) { PH_VARS
            pg8::Gemm g{1024, 1024, 1024}; pg8::PlainOrder S; S.A = (const char*)MERGED; S.B = (const char*)WOUT; S.nM = 64; S.nN = 4; S.lda = 1024; S.ldb = 1024; S.G = G; S.c = bx;
            pg8::EpiRes E{layer == 0 ? x_ : (const float*)H, H};
            pg8::gemm_phase<pg8::EpiRes, pg8::PlainOrder, false, false>(lds, g, S, E, wave_s);
            GRID_BAR();
        }
        if (IN(pb + 6)) { PH_VARS
            for (int row = gw; row < T; row += NGW) { f32x4 v[4]; (void)norm_row(H + (size_t)row * D, HN + (size_t)row * D, lane, v); }
            GRID_BAR();
        }
        if (IN(pb + 7)) { PH_VARS
            pg8::Gemm g{1024, 1024, 1024}; pg8::PlainOrder S; S.A = (const char*)HN; S.B = (const char*)WQ; S.nM = 64; S.nN = 4; S.lda = 1024; S.ldb = 1024; S.G = G; S.c = bx;
            pg8::EpiStore E{XQ, 1024};
            pg8::gemm_phase<pg8::EpiStore, pg8::PlainOrder, false, false>(lds, g, S, E, wave_s);
            GRID_BAR();
        }
        if (IN(pb + 8)) { PH_VARS
            pg8::Gemm g{1024, 1024, 256}; pg8::QKOrder S; S.xq_ = (const char*)XQ; S.kx_ = (const char*)KX; S.G = G; S.c = bx;
            pg8::EpiSoftmax E{PB, (PG8_LAS float*)xch};
            for (int sb = 0; sb < 256; sb += G) { S.base = sb; pg8::gemm_phase<pg8::EpiSoftmax, pg8::QKOrder, false, false>(lds, g, S, E, wave_s); }
            GRID_BAR();
        }
        if (IN(pb + 9)) { PH_VARS
            pg8::Gemm g{1024, 256, 256}; pg8::PVOrder S; S.p_ = (const char*)PB; S.vt_ = (const char*)VT; S.G = G; S.c = bx;
            pg8::EpiStore E{XO, 1024};
            pg8::gemm_phase<pg8::EpiStore, pg8::PVOrder, false, false>(lds, g, S, E, wave_s);
            GRID_BAR();
        }
        if (IN(pb + 10)) { PH_VARS
            pg8::Gemm g{1024, 1024, 1024}; pg8::PlainOrder S; S.A = (const char*)XO; S.B = (const char*)WO; S.nM = 64; S.nN = 4; S.lda = 1024; S.ldb = 1024; S.G = G; S.c = bx;
            pg8::EpiRes E{H, H};
            pg8::gemm_phase<pg8::EpiRes, pg8::PlainOrder, false, false>(lds, g, S, E, wave_s);
            GRID_BAR();
        }
        if (layer == 0) {
            if (IN(pb + 11)) { PH_VARS
                for (int row = gw; row < T; row += NGW) { f32x4 v[4]; (void)norm_row(H + (size_t)row * D, HN + (size_t)row * D, lane, v); }
                GRID_BAR();
            }
            if (IN(pb + 12)) { PH_VARS
                pg8::Gemm g{1024, 1024, 1024}; pg8::PlainOrder S; S.A = (const char*)HN; S.B = (const char*)W13; S.nM = 64; S.nN = 22; S.lda = 1024; S.ldb = 1024; S.G = G; S.c = bx;
                pg8::EpiSwiglu E{ACT, DFF};
                pg8::gemm_phase<pg8::EpiSwiglu, pg8::PlainOrder, false, false>(lds, g, S, E, wave_s);
                GRID_BAR();
            }
            if (IN(pb + 13)) { PH_VARS
                pg8::Gemm g{DFF, DFF, DFF}; pg8::PlainOrder S; S.A = (const char*)ACT; S.B = (const char*)W2T; S.nM = 64; S.nN = 4; S.lda = DFF; S.ldb = DFF; S.G = G; S.c = bx;
                pg8::EpiRes E{H, H};
                pg8::gemm_phase<pg8::EpiRes, pg8::PlainOrder, false, false>(lds, g, S, E, wave_s);
                GRID_BAR();
            }
            if (IN(pb + 14)) { PH_VARS
                for (int i = tid; i < 8192; i += 512) w8[i] = norm_mix[D + (i >> 3)] * w_in[(size_t)D * IN_TOTAL + (size_t)(i >> 3) * IN_TOTAL + O_DT + (i & 7)];
                __syncthreads();
                for (int row = gw; row < T; row += NGW) { f32x4 v[4]; const float r = norm_row(H + (size_t)row * D, HN + (size_t)row * D, lane, v); float lg[8]; row_dot8(v, w8, lane, lg);
                    float mine = 0.f;
#pragma unroll
                    for (int e = 0; e < 8; ++e) if (lane == e) mine = lg[e];
                    if (lane < 8) DT[(size_t)row * 8 + lane] = softplusf_(r * mine + opqp(p.in[17])[8 + lane]); }
                __syncthreads();
                GRID_BAR();
            }
        } else {
            if (IN(pb + 11)) { PH_VARS
                for (int i = tid; i < 8192; i += 512) w8[i] = norm_ffn[D + (i >> 3)] * moe_router[i];
                __syncthreads();
                for (int row = gw; row < T; row += NGW) { f32x4 v[4]; const float r = norm_row(H + (size_t)row * D, HN + (size_t)row * D, lane, v); float lg[8]; row_dot8(v, w8, lane, lg);
                    if (lane == 0) {
                        int i1 = 0; float v1 = lg[0];
#pragma unroll
                        for (int e = 1; e < 8; ++e) if (lg[e] > v1) { v1 = lg[e]; i1 = e; }
                        int i2 = 0; float v2 = -3.0e38f;
#pragma unroll
                        for (int e = 0; e < 8; ++e) if (e != i1 && lg[e] > v2) { v2 = lg[e]; i2 = e; }
                        const float w1 = 1.0f / (1.0f + expf(r * (v2 - v1))), w2 = 1.0f - w1;
                        const int r1 = atomicAdd(&CNT[i1], 1), r2 = atomicAdd(&CNT[i2], 1);
                        TOPI[row] = (i32x4){i1, i2, r1, r2}; TOPW[row] = (f32x2){w1, w2};
                    } }
                __syncthreads();
                {
                    int rot = 0;
                    for (int e = 0; e < NE; ++e) {
                        CVT_LOOP(16 * 224, MapW13 m{moe_w1 + (size_t)e * D * DFE, moe_w3 + (size_t)e * D * DFE, norm_ffn + D, W13E + (size_t)e * 2 * DFE * D, DFE, 2 * DFE});
                        CVT_LOOP(56 * 32, MapPlain m{moe_w2 + (size_t)e * DFE * D, DFE, D, nullptr, 1.f, W2E + (size_t)e * D * DFE, DFE});
                    }
                }
                GRID_BAR();
            }
            int t1 = 0, t2 = 0, t3 = 0, t4 = 0, t5 = 0, t6 = 0, t7 = 0, ntiles = 0;
            if (lo <= pb + 14 && hi > pb + 12) {
                int acc = 0;
#pragma unroll
                for (int e = 0; e < 8; ++e) { const int c = __hip_atomic_load(&CNT[e], RLX_AGENT); acc += (c + 255) >> 8;
                    if (e == 0) t1 = acc; if (e == 1) t2 = acc; if (e == 2) t3 = acc; if (e == 3) t4 = acc; if (e == 4) t5 = acc; if (e == 5) t6 = acc; if (e == 6) t7 = acc; if (e == 7) ntiles = acc; }
            }
            if (IN(pb + 12)) { PH_VARS
                for (int row = gw; row < T; row += NGW) {
                    const i32x4 ti = TOPI[row];
                    const int e1 = ti.x, e2 = ti.y;
                    const int s1 = (e1 == 0 ? 0 : e1 == 1 ? t1 : e1 == 2 ? t2 : e1 == 3 ? t3 : e1 == 4 ? t4 : e1 == 5 ? t5 : e1 == 6 ? t6 : t7) * 256 + ti.z;
                    const int s2 = (e2 == 0 ? 0 : e2 == 1 ? t1 : e2 == 2 ? t2 : e2 == 3 ? t3 : e2 == 4 ? t4 : e2 == 5 ? t5 : e2 == 6 ? t6 : t7) * 256 + ti.w;
                    const v4u a = *((const v4u*)(HN + (size_t)row * D) + lane), b = *((const v4u*)(HN + (size_t)row * D) + 64 + lane);
                    v4u* d1 = (v4u*)(XS + (size_t)s1 * D); v4u* d2 = (v4u*)(XS + (size_t)s2 * D);
                    d1[lane] = a; d1[64 + lane] = b; d2[lane] = a; d2[64 + lane] = b;
                    if (lane == 0) SLOT[row] = (i32x2){s1, s2};
                }
                GRID_BAR();
            }
            if (IN(pb + 13)) { PH_VARS
                pg8::Gemm g{1024, 1024, 1024}; pg8::MoeOrder S; S.A = (const char*)XS; S.B = (const char*)W13E; S.estride = (size_t)2 * DFE * D * 2; S.lda = 1024; S.ldb = 1024; S.ntiles = ntiles; S.nN = 28; S.G = G; S.c = bx;
                S.t1 = t1; S.t2 = t2; S.t3 = t3; S.t4 = t4; S.t5 = t5; S.t6 = t6; S.t7 = t7;
                pg8::EpiSwiglu E{ACTE, DFE};
                pg8::gemm_phase<pg8::EpiSwiglu, pg8::MoeOrder, false, false>(lds, g, S, E, wave_s);
                GRID_BAR();
            }
            if (IN(pb + 14)) { PH_VARS
                pg8::Gemm g{DFE, DFE, DFE}; pg8::MoeOrder S; S.A = (const char*)ACTE; S.B = (const char*)W2E; S.estride = (size_t)D * DFE * 2; S.lda = DFE; S.ldb = DFE; S.ntiles = ntiles; S.nN = 4; S.G = G; S.c = bx;
                S.t1 = t1; S.t2 = t2; S.t3 = t3; S.t4 = t4; S.t5 = t5; S.t6 = t6; S.t7 = t7;
                pg8::EpiStore E{XS, 1024};
                pg8::gemm_phase<pg8::EpiStore, pg8::MoeOrder, false, false>(lds, g, S, E, wave_s);
                GRID_BAR();
            }
            if (IN(pb + 15)) { PH_VARS
                const unsigned bad = __hip_atomic_load(ctl + CW_BAR + XB_TMO, RLX_AGENT);
                for (int row = gw; row < T; row += NGW) {
                    const i32x2 sl = SLOT[row]; const f32x2 tw = TOPW[row];
                    const f32x4* hr = (const f32x4*)(H + (size_t)row * D) + lane; const v2u* y1 = (const v2u*)(XS + (size_t)sl.x * D) + lane; const v2u* y2 = (const v2u*)(XS + (size_t)sl.y * D) + lane;
                    f32x4 v[4]; float ss = 0.f;
#pragma unroll
                    for (int j = 0; j < 4; ++j) { v[j] = hr[64 * j]; const v2u a = y1[64 * j], b = y2[64 * j];
                        v[j].x += tw.x * bflo(a.x) + tw.y * bflo(b.x); v[j].y += tw.x * bfhi(a.x) + tw.y * bfhi(b.x); v[j].z += tw.x * bflo(a.y) + tw.y * bflo(b.y); v[j].w += tw.x * bfhi(a.y) + tw.y * bfhi(b.y);
                        ss += (v[j].x * v[j].x + v[j].y * v[j].y) + (v[j].z * v[j].z + v[j].w * v[j].w); }
                    float r = 1.0f / sqrtf(wave_sum(ss) * (1.0f / 1024.0f) + 1e-6f);
                    if (bad) r = __builtin_nanf("");
                    f32x4* orow = (f32x4*)(H + (size_t)row * D) + lane;
#pragma unroll
                    for (int j = 0; j < 4; ++j) { const f32x4 g4 = *((const f32x4*)norm_final + lane + 64 * j); orow[64 * j] = v[j] * r * g4; }
                }
            }
        }
        }
    { constexpr int layer = 1;
        const int pb = 1 + layer * 20;
#define WLP (ws + WS_W + (size_t)layer * WL_STRIDE)
#define WIN ((const bf16*)(WLP + WL_WIN))
#define WGLU ((const bf16*)(WLP + WL_GLU))
#define WB ((const bf16*)(WLP + WL_WB))
#define WOUT ((const bf16*)(WLP + WL_WOUT))
#define WQ ((const bf16*)(WLP + WL_WQ))
#define WO ((const bf16*)(WLP + WL_WO))
#define KX (KVB + (size_t)layer * 4194304)
#define VT (KX + 2097152)
        if (IN(pb + 0)) { PH_VARS
            if (layer == 0) {
                pg8::Gemm g{1024, 1024, 1024}; pg8::KVOrder S; S.mnr_ = (const char*)MNR; S.WKV0 = (const char*)(ws + WS_W + WL_WKV); S.WKV1 = (const char*)(ws + WS_W + WL_STRIDE + WL_WKV); S.G = G; S.c = bx;
                pg8::EpiKV E{KVB};
                pg8::gemm_phase<pg8::EpiKV, pg8::KVOrder, false, false>(lds, g, S, E, wave_s);
            }
            pg8::Gemm g{1024, 1024, 1024}; pg8::PlainOrder S; S.A = (const char*)HN; S.B = (const char*)WIN; S.nM = 64; S.nN = 35; S.lda = 1024; S.ldb = 1024; S.G = G; S.c = bx;
            pg8::EpiProj E{PROJB, GATE, b_gate + layer * 4096};
            pg8::gemm_phase<pg8::EpiProj, pg8::PlainOrder, false, false>(lds, g, S, E, wave_s);
            GRID_BAR();
        }
        if (IN(pb + 1)) { PH_VARS
            const float* cw = opqp(p.in[15]) + layer * 4 * 768; const float* cb = opqp(p.in[16]) + layer * 768; const float* lw = opqp(p.in[22]) + layer * 4 * 512; const float* lb = opqp(p.in[23]) + layer * 512;
            for (int it = gt; it < T * 224; it += NGT) {
                const int row = it / 224, j = it % 224, t = row & (L - 1);
                if (j < 160) {
                    const bool isx = j < 96; const int c0 = isx ? j * 8 : (j - 96) * 8, C = isx ? 768 : 512; const float* w = isx ? cw : lw; const float* bb = isx ? cb : lb;
                    const bf16* src = PROJB + (size_t)row * PJ + (isx ? C_XBC : C_XL) + c0;
                    float acc[8];
#pragma unroll
                    for (int q = 0; q < 8; ++q) acc[q] = bb[c0 + q];
#pragma unroll
                    for (int tap = 0; tap < 4; ++tap) { if (t - 3 + tap >= 0) { const v4u xv = *(const v4u*)(src - (ptrdiff_t)(3 - tap) * PJ); const float* wt = w + tap * C + c0;
                        acc[0] += wt[0] * bflo(xv.x); acc[1] += wt[1] * bfhi(xv.x); acc[2] += wt[2] * bflo(xv.y); acc[3] += wt[3] * bfhi(xv.y);
                        acc[4] += wt[4] * bflo(xv.z); acc[5] += wt[5] * bfhi(xv.z); acc[6] += wt[6] * bflo(xv.w); acc[7] += wt[7] * bfhi(xv.w); } }
                    if (isx) {
#pragma unroll
                        for (int q = 0; q < 8; ++q) acc[q] = siluf_(acc[q]); }
                    v4u o; o.x = pk2(acc[0], acc[1]); o.y = pk2(acc[2], acc[3]); o.z = pk2(acc[4], acc[5]); o.w = pk2(acc[6], acc[7]);
                    *(v4u*)((isx ? XBCC + (size_t)row * 768 : XLC + (size_t)row * 512) + c0) = o;
                } else {
                    const bool isk = j >= 192; const int jj = isk ? j - 192 : j - 160, h = jj >> 2, i0 = (jj & 3) * 8; const float sc = isk ? 0.125f : 1.0f;
                    bf16* q1 = PROJB + (size_t)row * PJ + (isk ? C_K : C_Q) + h * 64 + i0; bf16* q2 = q1 + 32;
                    const v4u a = *(const v4u*)q1, b = *(const v4u*)q2;
                    const f32x4 c0v = *(const f32x4*)(COS + (size_t)row * 32 + i0), c1v = *(const f32x4*)(COS + (size_t)row * 32 + i0 + 4), s0v = *(const f32x4*)(SIN + (size_t)row * 32 + i0), s1v = *(const f32x4*)(SIN + (size_t)row * 32 + i0 + 4);
                    const float x1[8] = {bflo(a.x), bfhi(a.x), bflo(a.y), bfhi(a.y), bflo(a.z), bfhi(a.z), bflo(a.w), bfhi(a.w)};
                    const float x2[8] = {bflo(b.x), bfhi(b.x), bflo(b.y), bfhi(b.y), bflo(b.z), bfhi(b.z), bflo(b.w), bfhi(b.w)};
                    const float cc[8] = {c0v.x, c0v.y, c0v.z, c0v.w, c1v.x, c1v.y, c1v.z, c1v.w}, ss[8] = {s0v.x, s0v.y, s0v.z, s0v.w, s1v.x, s1v.y, s1v.z, s1v.w};
                    float o1[8], o2[8];
#pragma unroll
                    for (int q = 0; q < 8; ++q) { o1[q] = (x1[q] * cc[q] - x2[q] * ss[q]) * sc; o2[q] = (x2[q] * cc[q] + x1[q] * ss[q]) * sc; }
                    v4u w1; w1.x = pk2(o1[0], o1[1]); w1.y = pk2(o1[2], o1[3]); w1.z = pk2(o1[4], o1[5]); w1.w = pk2(o1[6], o1[7]);
                    v4u w2; w2.x = pk2(o2[0], o2[1]); w2.y = pk2(o2[2], o2[3]); w2.z = pk2(o2[4], o2[5]); w2.w = pk2(o2[6], o2[7]);
                    *(v4u*)q1 = w1; *(v4u*)q2 = w2;
                }
            }
            GRID_BAR();
        }
        if (IN(pb + 2)) { PH_VARS
            bf16* YS = HN;
            for (int wu = gw; wu < 832; wu += NGW) {
                if (wu < 256) {
                    const int un = wu >> 2, sub = wu & 3, b = un >> 3, hh = un & 7, g = hh >> 2, pp = sub * 16 + (lane >> 2), nq = lane & 3;
                    const float Aa = -__expf(opqp(p.in[18])[layer * 8 + hh]), Dk = opqp(p.in[19])[layer * 8 + hh];
                    float S[16];
#pragma unroll
                    for (int j = 0; j < 16; ++j) S[j] = 0.f;
                    for (int t = 0; t < L; ++t) {
                        const size_t row = (size_t)b * L + t; const bf16* xr = XBCC + row * 768;
                        const float dtv = DT[row * 8 + hh], xv = bf1(xr[hh * 64 + pp]);
                        const v4u b0 = *(const v4u*)(xr + 512 + g * 64 + nq * 16), b1 = *(const v4u*)(xr + 512 + g * 64 + nq * 16 + 8), c0 = *(const v4u*)(xr + 640 + g * 64 + nq * 16), c1 = *(const v4u*)(xr + 640 + g * 64 + nq * 16 + 8);
                        const float Bv[16] = {bflo(b0.x), bfhi(b0.x), bflo(b0.y), bfhi(b0.y), bflo(b0.z), bfhi(b0.z), bflo(b0.w), bfhi(b0.w), bflo(b1.x), bfhi(b1.x), bflo(b1.y), bfhi(b1.y), bflo(b1.z), bfhi(b1.z), bflo(b1.w), bfhi(b1.w)};
                        const float Cv[16] = {bflo(c0.x), bfhi(c0.x), bflo(c0.y), bfhi(c0.y), bflo(c0.z), bfhi(c0.z), bflo(c0.w), bfhi(c0.w), bflo(c1.x), bfhi(c1.x), bflo(c1.y), bfhi(c1.y), bflo(c1.z), bfhi(c1.z), bflo(c1.w), bfhi(c1.w)};
                        const float da = __expf(dtv * Aa), xdt = xv * dtv; float acc = 0.f;
#pragma unroll
                        for (int j = 0; j < 16; ++j) { S[j] = da * S[j] + xdt * Bv[j]; acc += Cv[j] * S[j]; }
                        acc += __shfl_xor(acc, 1); acc += __shfl_xor(acc, 2);
                        if (nq == 0) BR[row * 2048 + 512 + hh * 64 + pp] = (bf16)f2bf(acc + Dk * xv);
                    }
                } else if (wu < 512) {
                    const int un = (wu - 256) >> 2, sub = wu & 3, b = un >> 3, hh = un & 7, e = sub * 16 + (lane >> 2), dq = lane & 3;
                    const float gamma = 1.0f - exp2f(-5.0f - (float)hh);
                    float S[16];
#pragma unroll
                    for (int j = 0; j < 16; ++j) S[j] = 0.f;
                    for (int t = 0; t < L; ++t) {
                        const size_t row = (size_t)b * L + t; const bf16* pr = PROJB + row * PJ;
                        const float vv = bf1(pr[C_V + hh * 64 + e]);
                        const v4u k0 = *(const v4u*)(pr + C_K + hh * 64 + dq * 16), k1 = *(const v4u*)(pr + C_K + hh * 64 + dq * 16 + 8), q0 = *(const v4u*)(pr + C_Q + hh * 64 + dq * 16), q1 = *(const v4u*)(pr + C_Q + hh * 64 + dq * 16 + 8);
                        const float Kv[16] = {bflo(k0.x), bfhi(k0.x), bflo(k0.y), bfhi(k0.y), bflo(k0.z), bfhi(k0.z), bflo(k0.w), bfhi(k0.w), bflo(k1.x), bfhi(k1.x), bflo(k1.y), bfhi(k1.y), bflo(k1.z), bfhi(k1.z), bflo(k1.w), bfhi(k1.w)};
                        const float Qv[16] = {bflo(q0.x), bfhi(q0.x), bflo(q0.y), bfhi(q0.y), bflo(q0.z), bfhi(q0.z), bflo(q0.w), bfhi(q0.w), bflo(q1.x), bfhi(q1.x), bflo(q1.y), bfhi(q1.y), bflo(q1.z), bfhi(q1.z), bflo(q1.w), bfhi(q1.w)};
                        float acc = 0.f;
#pragma unroll
                        for (int j = 0; j < 16; ++j) { S[j] = gamma * S[j] + Kv[j] * vv; acc += Qv[j] * S[j]; }
                        acc += __shfl_xor(acc, 1); acc += __shfl_xor(acc, 2);
                        if (dq == 0) BR[row * 2048 + 1024 + hh * 64 + e] = (bf16)f2bf(acc);
                    }
                } else if (wu < 768) {
                    const int un = wu - 512, b = un >> 5, g = un & 31, n = lane;
                    const float* lam_re = opqp(p.in[6]) + layer * 2048; const float* lam_im = opqp(p.in[7]) + layer * 2048; const float* b_re = opqp(p.in[8]) + layer * 32768; const float* b_im = opqp(p.in[9]) + layer * 32768;
                    const float* c_re = opqp(p.in[10]) + layer * 32768; const float* c_im = opqp(p.in[11]) + layer * 32768; const float* dsk = opqp(p.in[12]) + layer * 512;
                    const float lr = lam_re[g * 64 + n], li = lam_im[g * 64 + n], step = expf(opqp(p.in[13])[layer * 32 + g]);
                    const float mag = expf(lr * step), ar = mag * cosf(li * step), ai = mag * sinf(li * step);
                    const float inv = 1.0f / (lr * lr + li * li);
                    const float cr = ((ar - 1.0f) * lr + ai * li) * inv, ci = (ai * lr - (ar - 1.0f) * li) * inv;
                    float bbr[16], bbi[16], cre[16], cim[16];
#pragma unroll
                    for (int h = 0; h < 16; ++h) { const float br_ = b_re[(g * 64 + n) * 16 + h], bi_ = b_im[(g * 64 + n) * 16 + h];
                        bbr[h] = cr * br_ - ci * bi_; bbi[h] = cr * bi_ + ci * br_; cre[h] = c_re[(g * 16 + h) * 64 + n]; cim[h] = c_im[(g * 16 + h) * 64 + n]; }
                    const float dmine = dsk[g * 16 + (n & 15)];
                    float sr = 0.f, si = 0.f;
                    for (int t = 0; t < L; ++t) {
                        const size_t row = (size_t)b * L + t; const bf16* up = PROJB + row * PJ + C_U + g * 16;
                        const v4u u0 = *(const v4u*)up, u1 = *(const v4u*)(up + 8);
                        const float u[16] = {bflo(u0.x), bfhi(u0.x), bflo(u0.y), bfhi(u0.y), bflo(u0.z), bfhi(u0.z), bflo(u0.w), bfhi(u0.w), bflo(u1.x), bfhi(u1.x), bflo(u1.y), bfhi(u1.y), bflo(u1.z), bfhi(u1.z), bflo(u1.w), bfhi(u1.w)};
                        float bur = 0.f, bui = 0.f;
#pragma unroll
                        for (int h = 0; h < 16; ++h) { bur += u[h] * bbr[h]; bui += u[h] * bbi[h]; }
                        const float nr = ar * sr - ai * si + bur, ni = ar * si + ai * sr + bui; sr = nr; si = ni;
                        float mine = 0.f, umine = 0.f;
#pragma unroll
                        for (int h = 0; h < 16; ++h) { const float y = wave_sum(sr * cre[h] - si * cim[h]); if (n == h) { mine = y; umine = u[h]; } }
                        if (n < 16) YS[row * 512 + g * 16 + n] = (bf16)f2bf(gelu_tanh(mine + dmine * umine));
                    }
                } else {
                    const int un = wu - 768, b = un >> 3, blk = un & 7, j = lane;
                    LAS bf16* wA = (LAS bf16*)scr; LAS bf16* wX = wA + 4096;
                    for (int i = 0; i < 64; ++i) { wA[i * 64 + j] = (bf16)f2bf(opqp(p.in[24])[layer * 32768 + (blk * 64 + i) * 64 + j]); wX[i * 64 + j] = (bf16)f2bf(opqp(p.in[26])[layer * 32768 + (blk * 64 + i) * 64 + j]); }
                    LDS_WAIT();
                    const float bA = opqp(p.in[25])[layer * 512 + blk * 64 + j], bX = opqp(p.in[27])[layer * 512 + blk * 64 + j], sp = softplusf_(-opqp(p.in[28])[layer * 512 + blk * 64 + j]);
                    float hs = 0.f;
                    for (int t = 0; t < L; ++t) {
                        const size_t row = (size_t)b * L + t;
                        const float xc = bf1(XLC[row * 512 + blk * 64 + j]);
                        float ra = bA, ri = bX;
#pragma unroll
                        for (int i = 0; i < 64; ++i) { const float xi = __shfl(xc, i); ra += xi * bf1(wA[i * 64 + j]); ri += xi * bf1(wX[i * 64 + j]); }
                        const float r = sigmoidf_(ra), ig = sigmoidf_(ri);
                        const float log_a = -8.0f * r * sp, a = __expf(log_a);
                        const float mult = sqrtf(fmaxf(-expm1f(2.0f * log_a), 0.f));
                        hs = a * hs + mult * ig * xc;
                        BR[row * 2048 + 1536 + blk * 64 + j] = (bf16)f2bf(hs * gelu_tanh(bf1(PROJB[row * PJ + C_GL + blk * 64 + j])));
                    }
                }
            }
            GRID_BAR();
        }
        if (IN(pb + 3)) { PH_VARS
            const float* snw = opqp(p.in[20]) + layer * 512; const float* rnw = opqp(p.in[21]) + layer * 512;
            for (int row = gw; row < T; row += NGW) {
                bf16* y = BR + (size_t)row * 2048; const bf16* pr = PROJB + (size_t)row * PJ;
                {
                    const v4u yw = *(const v4u*)(y + 512 + 8 * lane), zw = *(const v4u*)(pr + C_Z + 8 * lane);
                    float v[8] = {bflo(yw.x), bfhi(yw.x), bflo(yw.y), bfhi(yw.y), bflo(yw.z), bfhi(yw.z), bflo(yw.w), bfhi(yw.w)};
                    const float z[8] = {bflo(zw.x), bfhi(zw.x), bflo(zw.y), bfhi(zw.y), bflo(zw.z), bfhi(zw.z), bflo(zw.w), bfhi(zw.w)};
                    float ss = 0.f;
#pragma unroll
                    for (int q = 0; q < 8; ++q) { v[q] *= siluf_(z[q]); ss += v[q] * v[q]; }
                    const float r = 1.0f / sqrtf(wave_sum(ss) * (1.0f / 512.0f) + 1e-6f);
#pragma unroll
                    for (int q = 0; q < 8; ++q) v[q] *= r * snw[8 * lane + q];
                    v4u o; o.x = pk2(v[0], v[1]); o.y = pk2(v[2], v[3]); o.z = pk2(v[4], v[5]); o.w = pk2(v[6], v[7]);
                    *(v4u*)(y + 512 + 8 * lane) = o;
                }
                {
                    const v4u yw = *(const v4u*)(y + 1024 + 8 * lane), gw_ = *(const v4u*)(pr + C_G + 8 * lane);
                    float v[8] = {bflo(yw.x), bfhi(yw.x), bflo(yw.y), bfhi(yw.y), bflo(yw.z), bfhi(yw.z), bflo(yw.w), bfhi(yw.w)};
                    const float gg[8] = {bflo(gw_.x), bfhi(gw_.x), bflo(gw_.y), bfhi(gw_.y), bflo(gw_.z), bfhi(gw_.z), bflo(gw_.w), bfhi(gw_.w)};
                    float s = 0.f;
#pragma unroll
                    for (int q = 0; q < 8; ++q) s += v[q];
                    s += __shfl_xor(s, 1); s += __shfl_xor(s, 2); s += __shfl_xor(s, 4);
                    const float mu = s * (1.0f / 64.0f); float q2 = 0.f;
#pragma unroll
                    for (int q = 0; q < 8; ++q) { v[q] -= mu; q2 += v[q] * v[q]; }
                    q2 += __shfl_xor(q2, 1); q2 += __shfl_xor(q2, 2); q2 += __shfl_xor(q2, 4);
                    const float rs = 1.0f / sqrtf(q2 * (1.0f / 64.0f) + 1e-6f);
#pragma unroll
                    for (int q = 0; q < 8; ++q) v[q] = siluf_(gg[q]) * (v[q] * rs * rnw[8 * lane + q]);
                    v4u o; o.x = pk2(v[0], v[1]); o.y = pk2(v[2], v[3]); o.z = pk2(v[4], v[5]); o.w = pk2(v[6], v[7]);
                    *(v4u*)(y + 1024 + 8 * lane) = o;
                }
            }
            pg8::Gemm g{512, 512, 512}; pg8::PlainOrder S; S.A = (const char*)HN; S.B = (const char*)WGLU; S.nM = 64; S.nN = 2; S.lda = 512; S.ldb = 512; S.G = G; S.c = bx;
            pg8::EpiGlu E{HN, BR};
            pg8::gemm_phase<pg8::EpiGlu, pg8::PlainOrder, false, false>(lds, g, S, E, wave_s);
            GRID_BAR();
        }
        if (IN(pb + 4)) { PH_VARS
#ifdef MK_EXP_A
            pg8::Gemm g{2048, 2048, 2048}; pg8::PlainOrder S; S.A = (const char*)BR; S.B = (const char*)WB; S.nM = 64; S.nN = 4; S.lda = 2048; S.ldb = 2048; S.G = G; S.c = bx;
            pg8::EpiStore E{MERGED, 1024};
            pg8::gemm_phase<pg8::EpiStore, pg8::PlainOrder, false, false>(lds, g, S, E, wave_s);
#else
            pg8::Gemm g{2048, 2048, 512}; pg8::MergeOrder S; S.br_ = (const char*)BR; S.wb_ = (const char*)WB; S.G = G; S.c = bx;
            pg8::EpiMerge E{GATE, MERGED};
            pg8::gemm_phase<pg8::EpiMerge, pg8::MergeOrder, false, false>(lds, g, S, E, wave_s);
#endif
            GRID_BAR();
        }
        if (IN(pb + 5)) { PH_VARS
            pg8::Gemm g{1024, 1024, 1024}; pg8::PlainOrder S; S.A = (const char*)MERGED; S.B = (const char*)WOUT; S.nM = 64; S.nN = 4; S.lda = 1024; S.ldb = 1024; S.G = G; S.c = bx;
            pg8::EpiRes E{layer == 0 ? x_ : (const float*)H, H};
            pg8::gemm_phase<pg8::EpiRes, pg8::PlainOrder, false, false>(lds, g, S, E, wave_s);
            GRID_BAR();
        }
        if (IN(pb + 6)) { PH_VARS
            for (int row = gw; row < T; row += NGW) { f32x4 v[4]; (void)norm_row(H + (size_t)row * D, HN + (size_t)row * D, lane, v); }
            GRID_BAR();
        }
        if (IN(pb + 7)) { PH_VARS
            pg8::Gemm g{1024, 1024, 1024}; pg8::PlainOrder S; S.A = (const char*)HN; S.B = (const char*)WQ; S.nM = 64; S.nN = 4; S.lda = 1024; S.ldb = 1024; S.G = G; S.c = bx;
            pg8::EpiStore E{XQ, 1024};
            pg8::gemm_phase<pg8::EpiStore, pg8::PlainOrder, false, false>(lds, g, S, E, wave_s);
            GRID_BAR();
        }
        if (IN(pb + 8)) { PH_VARS
            pg8::Gemm g{1024, 1024, 256}; pg8::QKOrder S; S.xq_ = (const char*)XQ; S.kx_ = (const char*)KX; S.G = G; S.c = bx;
            pg8::EpiSoftmax E{PB, (PG8_LAS float*)xch};
            for (int sb = 0; sb < 256; sb += G) { S.base = sb; pg8::gemm_phase<pg8::EpiSoftmax, pg8::QKOrder, false, false>(lds, g, S, E, wave_s); }
            GRID_BAR();
        }
        if (IN(pb + 9)) { PH_VARS
            pg8::Gemm g{1024, 256, 256}; pg8::PVOrder S; S.p_ = (const char*)PB; S.vt_ = (const char*)VT; S.G = G; S.c = bx;
            pg8::EpiStore E{XO, 1024};
            pg8::gemm_phase<pg8::EpiStore, pg8::PVOrder, false, false>(lds, g, S, E, wave_s);
            GRID_BAR();
        }
        if (IN(pb + 10)) { PH_VARS
            pg8::Gemm g{1024, 1024, 1024}; pg8::PlainOrder S; S.A = (const char*)XO; S.B = (const char*)WO; S.nM = 64; S.nN = 4; S.lda = 1024; S.ldb = 1024; S.G = G; S.c = bx;
            pg8::EpiRes E{H, H};
            pg8::gemm_phase<pg8::EpiRes, pg8::PlainOrder, false, false>(lds, g, S, E, wave_s);
            GRID_BAR();
        }
        if (layer == 0) {
            if (IN(pb + 11)) { PH_VARS
                for (int row = gw; row < T; row += NGW) { f32x4 v[4]; (void)norm_row(H + (size_t)row * D, HN + (size_t)row * D, lane, v); }
                GRID_BAR();
            }
            if (IN(pb + 12)) { PH_VARS
                pg8::Gemm g{1024, 1024, 1024}; pg8::PlainOrder S; S.A = (const char*)HN; S.B = (const char*)W13; S.nM = 64; S.nN = 22; S.lda = 1024; S.ldb = 1024; S.G = G; S.c = bx;
                pg8::EpiSwiglu E{ACT, DFF};
                pg8::gemm_phase<pg8::EpiSwiglu, pg8::PlainOrder, false, false>(lds, g, S, E, wave_s);
                GRID_BAR();
            }
            if (IN(pb + 13)) { PH_VARS
                pg8::Gemm g{DFF, DFF, DFF}; pg8::PlainOrder S; S.A = (const char*)ACT; S.B = (const char*)W2T; S.nM = 64; S.nN = 4; S.lda = DFF; S.ldb = DFF; S.G = G; S.c = bx;
                pg8::EpiRes E{H, H};
                pg8::gemm_phase<pg8::EpiRes, pg8::PlainOrder, false, false>(lds, g, S, E, wave_s);
                GRID_BAR();
            }
            if (IN(pb + 14)) { PH_VARS
                for (int i = tid; i < 8192; i += 512) w8[i] = norm_mix[D + (i >> 3)] * w_in[(size_t)D * IN_TOTAL + (size_t)(i >> 3) * IN_TOTAL + O_DT + (i & 7)];
                __syncthreads();
                for (int row = gw; row < T; row += NGW) { f32x4 v[4]; const float r = norm_row(H + (size_t)row * D, HN + (size_t)row * D, lane, v); float lg[8]; row_dot8(v, w8, lane, lg);
                    float mine = 0.f;
#pragma unroll
                    for (int e = 0; e < 8; ++e) if (lane == e) mine = lg[e];
                    if (lane < 8) DT[(size_t)row * 8 + lane] = softplusf_(r * mine + opqp(p.in[17])[8 + lane]); }
                __syncthreads();
                GRID_BAR();
            }
        } else {
            if (IN(pb + 11)) { PH_VARS
                for (int i = tid; i < 8192; i += 512) w8[i] = norm_ffn[D + (i >> 3)] * moe_router[i];
                __syncthreads();
                for (int row = gw; row < T; row += NGW) { f32x4 v[4]; const float r = norm_row(H + (size_t)row * D, HN + (size_t)row * D, lane, v); float lg[8]; row_dot8(v, w8, lane, lg);
                    if (lane == 0) {
                        int i1 = 0; float v1 = lg[0];
#pragma unroll
                        for (int e = 1; e < 8; ++e) if (lg[e] > v1) { v1 = lg[e]; i1 = e; }
                        int i2 = 0; float v2 = -3.0e38f;
#pragma unroll
                        for (int e = 0; e < 8; ++e) if (e != i1 && lg[e] > v2) { v2 = lg[e]; i2 = e; }
                        const float w1 = 1.0f / (1.0f + expf(r * (v2 - v1))), w2 = 1.0f - w1;
                        const int r1 = atomicAdd(&CNT[i1], 1), r2 = atomicAdd(&CNT[i2], 1);
                        TOPI[row] = (i32x4){i1, i2, r1, r2}; TOPW[row] = (f32x2){w1, w2};
                    } }
                __syncthreads();
                {
                    int rot = 0;
                    for (int e = 0; e < NE; ++e) {
                        CVT_LOOP(16 * 224, MapW13 m{moe_w1 + (size_t)e * D * DFE, moe_w3 + (size_t)e * D * DFE, norm_ffn + D, W13E + (size_t)e * 2 * DFE * D, DFE, 2 * DFE});
                        CVT_LOOP(56 * 32, MapPlain m{moe_w2 + (size_t)e * DFE * D, DFE, D, nullptr, 1.f, W2E + (size_t)e * D * DFE, DFE});
                    }
                }
                GRID_BAR();
            }
            int t1 = 0, t2 = 0, t3 = 0, t4 = 0, t5 = 0, t6 = 0, t7 = 0, ntiles = 0;
            if (lo <= pb + 14 && hi > pb + 12) {
                int acc = 0;
#pragma unroll
                for (int e = 0; e < 8; ++e) { const int c = __hip_atomic_load(&CNT[e], RLX_AGENT); acc += (c + 255) >> 8;
                    if (e == 0) t1 = acc; if (e == 1) t2 = acc; if (e == 2) t3 = acc; if (e == 3) t4 = acc; if (e == 4) t5 = acc; if (e == 5) t6 = acc; if (e == 6) t7 = acc; if (e == 7) ntiles = acc; }
            }
            if (IN(pb + 12)) { PH_VARS
                for (int row = gw; row < T; row += NGW) {
                    const i32x4 ti = TOPI[row];
                    const int e1 = ti.x, e2 = ti.y;
                    const int s1 = (e1 == 0 ? 0 : e1 == 1 ? t1 : e1 == 2 ? t2 : e1 == 3 ? t3 : e1 == 4 ? t4 : e1 == 5 ? t5 : e1 == 6 ? t6 : t7) * 256 + ti.z;
                    const int s2 = (e2 == 0 ? 0 : e2 == 1 ? t1 : e2 == 2 ? t2 : e2 == 3 ? t3 : e2 == 4 ? t4 : e2 == 5 ? t5 : e2 == 6 ? t6 : t7) * 256 + ti.w;
                    const v4u a = *((const v4u*)(HN + (size_t)row * D) + lane), b = *((const v4u*)(HN + (size_t)row * D) + 64 + lane);
                    v4u* d1 = (v4u*)(XS + (size_t)s1 * D); v4u* d2 = (v4u*)(XS + (size_t)s2 * D);
                    d1[lane] = a; d1[64 + lane] = b; d2[lane] = a; d2[64 + lane] = b;
                    if (lane == 0) SLOT[row] = (i32x2){s1, s2};
                }
                GRID_BAR();
            }
            if (IN(pb + 13)) { PH_VARS
                pg8::Gemm g{1024, 1024, 1024}; pg8::MoeOrder S; S.A = (const char*)XS; S.B = (const char*)W13E; S.estride = (size_t)2 * DFE * D * 2; S.lda = 1024; S.ldb = 1024; S.ntiles = ntiles; S.nN = 28; S.G = G; S.c = bx;
                S.t1 = t1; S.t2 = t2; S.t3 = t3; S.t4 = t4; S.t5 = t5; S.t6 = t6; S.t7 = t7;
                pg8::EpiSwiglu E{ACTE, DFE};
                pg8::gemm_phase<pg8::EpiSwiglu, pg8::MoeOrder, false, false>(lds, g, S, E, wave_s);
                GRID_BAR();
            }
            if (IN(pb + 14)) { PH_VARS
                pg8::Gemm g{DFE, DFE, DFE}; pg8::MoeOrder S; S.A = (const char*)ACTE; S.B = (const char*)W2E; S.estride = (size_t)D * DFE * 2; S.lda = DFE; S.ldb = DFE; S.ntiles = ntiles; S.nN = 4; S.G = G; S.c = bx;
                S.t1 = t1; S.t2 = t2; S.t3 = t3; S.t4 = t4; S.t5 = t5; S.t6 = t6; S.t7 = t7;
                pg8::EpiStore E{XS, 1024};
                pg8::gemm_phase<pg8::EpiStore, pg8::MoeOrder, false, false>(lds, g, S, E, wave_s);
                GRID_BAR();
            }
            if (IN(pb + 15)) { PH_VARS
                const unsigned bad = __hip_atomic_load(ctl + CW_BAR + XB_TMO, RLX_AGENT);
                for (int row = gw; row < T; row += NGW) {
                    const i32x2 sl = SLOT[row]; const f32x2 tw = TOPW[row];
                    const f32x4* hr = (const f32x4*)(H + (size_t)row * D) + lane; const v2u* y1 = (const v2u*)(XS + (size_t)sl.x * D) + lane; const v2u* y2 = (const v2u*)(XS + (size_t)sl.y * D) + lane;
                    f32x4 v[4]; float ss = 0.f;
#pragma unroll
                    for (int j = 0; j < 4; ++j) { v[j] = hr[64 * j]; const v2u a = y1[64 * j], b = y2[64 * j];
                        v[j].x += tw.x * bflo(a.x) + tw.y * bflo(b.x); v[j].y += tw.x * bfhi(a.x) + tw.y * bfhi(b.x); v[j].z += tw.x * bflo(a.y) + tw.y * bflo(b.y); v[j].w += tw.x * bfhi(a.y) + tw.y * bfhi(b.y);
                        ss += (v[j].x * v[j].x + v[j].y * v[j].y) + (v[j].z * v[j].z + v[j].w * v[j].w); }
                    float r = 1.0f / sqrtf(wave_sum(ss) * (1.0f / 1024.0f) + 1e-6f);
                    if (bad) r = __builtin_nanf("");
                    f32x4* orow = (f32x4*)(H + (size_t)row * D) + lane;
#pragma unroll
                    for (int j = 0; j < 4; ++j) { const f32x4 g4 = *((const f32x4*)norm_final + lane + 64 * j); orow[64 * j] = v[j] * r * g4; }
                }
            }
        }
        }
#ifdef MK_DUMP
    if (IN(99)) { PH_VARS
        for (int row = gw; row < cf::T; row += NGW) {
#pragma unroll
            for (int j = 0; j < 16; ++j) { const int cc = lane + 64 * j; float v;
#if MK_DUMP == 1
                v = (cc < 512 ? bf1(HN[(size_t)row * 512 + cc]) : bf1(BR[(size_t)row * 2048 + cc])) + bf1(BR[(size_t)row * 2048 + cc + 1024]);
#elif MK_DUMP == 2
                v = bf1(PROJB[(size_t)row * cf::PJ + cc]) + bf1(PROJB[(size_t)row * cf::PJ + cc + 1024]) + bf1(PROJB[(size_t)row * cf::PJ + cc + 2048]) + bf1(PROJB[(size_t)row * cf::PJ + cc + 3072]) + bf1(GATE[(size_t)row * 4096 + cc]) + bf1(GATE[(size_t)row * 4096 + 3072 + cc]) + (cc < 768 ? bf1(PROJB[(size_t)row * cf::PJ + cc + 4096]) : 0.f);
#elif MK_DUMP == 5
                v = bf1(GATE[(size_t)row * 4096 + cc]) + bf1(GATE[(size_t)row * 4096 + 1024 + cc]) + bf1(GATE[(size_t)row * 4096 + 2048 + cc]) + bf1(GATE[(size_t)row * 4096 + 3072 + cc]);
#elif MK_DUMP == 7
                v = bf1(GATE[(size_t)row * 4096 + MK_GB * 1024 + cc]);
#elif MK_DUMP == 3
                v = bf1(BR[(size_t)row * 2048 + cc]) + bf1(BR[(size_t)row * 2048 + cc + 1024]);
#elif MK_DUMP == 4
                v = bf1(MERGED[(size_t)row * 1024 + cc]);
#endif
                H[(size_t)row * 1024 + cc] = v; }
        }
    }
#endif
#undef IN
#undef GRID_BAR
#undef ws
#undef ctl
#undef H
}

#undef PH_VARS
#undef ws
#undef ctl
#undef GRID_BAR
#undef IN
#undef x_
#undef mem_
#undef positions_
#undef norm_mix
#undef w_in
#undef b_gate
#undef w_branch
#undef w_out
#undef norm_xa
#undef norm_mem
#undef xa_wq
#undef xa_wk
#undef xa_wv
#undef xa_wo
#undef norm_ffn
#undef ffn_w1
#undef ffn_w3
#undef ffn_w2
#undef moe_router
#undef moe_w1
#undef moe_w3
#undef moe_w2
#undef norm_final
#undef H
#undef HN
#undef KVB
#undef COS
#undef SIN
#undef DT
#undef MNR
#undef PROJB
#undef GATE
#undef BR
#undef XBCC
#undef XLC
#undef MP
#undef MERGED
#undef XQ
#undef PB
#undef XO
#undef ACT
#undef W13E
#undef W2E
#undef XS
#undef ACTE
#undef TOPI
#undef TOPW
#undef SLOT
#undef CNT
#undef W13
#undef W2T
#undef CVT_LOOP
#undef WLP
#undef WIN
#undef WGLU
#undef WB
#undef WOUT
#undef WQ
#undef WO
#undef KX
#undef VT
extern "C" void kernel_launch(void* const* d_in, const int* in_sizes, int n_in, void* d_out, int out_size, void* d_ws, size_t ws_size, hipStream_t stream) {
    static int grid = 0;
    if (grid == 0) {
        if (n_in != 46 || in_sizes[0] != cf::T * cf::D || out_size != cf::T * cf::D || ws_size < WS_NEED) { fprintf(stderr, "kernel_launch: unexpected shapes / workspace (n_in %d, in0 %d, out %d, ws %zu < %zu)\n", n_in, n_in > 0 ? in_sizes[0] : -1, out_size, ws_size, (size_t)WS_NEED); grid = -1; return; }
        int dev = 0, cus = 0, per_cu = 0;
        if (hipGetDevice(&dev) != hipSuccess || hipDeviceGetAttribute(&cus, hipDeviceAttributeMultiprocessorCount, dev) != hipSuccess) { grid = -1; return; }
        if (hipFuncSetAttribute((const void*)mega, hipFuncAttributeMaxDynamicSharedMemorySize, LDS_BYTES) != hipSuccess) { fprintf(stderr, "kernel_launch: hipFuncSetAttribute failed\n"); grid = -1; return; }
        if (hipOccupancyMaxActiveBlocksPerMultiprocessor(&per_cu, (const void*)mega, NWAVES * 64, LDS_BYTES) != hipSuccess || per_cu < 1) fprintf(stderr, "kernel_launch: occupancy query reports %d\n", per_cu);
        (void)hipGetLastError();
        grid = cus;
    }
    if (grid < 0) return;
    if (hipMemsetAsync((char*)d_ws + WS_CTL, 0, CTL_ZERO_BYTES, stream) != hipSuccess) return;
    Params a{};
    for (int i = 0; i < 46; ++i) a.in[i] = (const float*)d_in[i];
    a.out = (float*)d_out; a.ws = (unsigned char*)d_ws;
#ifdef MK_PER_PHASE
    for (int ph = 0; ph < MK_PER_PHASE; ++ph) { if (ph >= 16 && ph <= 20) continue; a.ph_lo = ph; a.ph_hi = ph + 1; hipLaunchKernelGGL(mega, dim3(grid), dim3(NWAVES * 64), LDS_BYTES, stream, a); }
#ifdef MK_DUMP
    a.ph_lo = 99; a.ph_hi = 100; hipLaunchKernelGGL(mega, dim3(grid), dim3(NWAVES * 64), LDS_BYTES, stream, a);
#endif
#elif defined(MK_SELFCHK)
    {
        using namespace nv;
        const float* x = (const float*)d_in[0]; char* wsb = (char*)d_ws;
        float* hn = (float*)wsb; float* PROJ = hn + (size_t)2048 * 1024; float* BRn = PROJ + (size_t)2048 * PW; float* TMP = BRn + (size_t)2048 * 2048; float* GLG = TMP + (size_t)2048 * 1024; float* MER = GLG + (size_t)2048 * 1024;
        float* ct = MER + (size_t)2048 * 1024; float* st = ct + (size_t)T * 32; float* hh = st + (size_t)T * 32;
        char* safe = wsb + (size_t)524 * 1048576; float* sBR = (float*)safe; float* sMER = sBR + (size_t)2048 * 2048; float* sH = sMER + (size_t)2048 * 1024; float* sPROJ = sH + (size_t)2048 * 1024; float* sGATE = sPROJ + (size_t)256 * PW; float* acc = sGATE + (size_t)256 * 4096;
        const float* Win = (const float*)d_in[4];
        hipLaunchKernelGGL(k_rope_tab, dim3((T * 32 + 255) / 256), dim3(256), 0, stream, (const int*)d_in[2], ct, st);
        hipLaunchKernelGGL(k_rmsnorm, dim3(2048 / 4), dim3(256), 0, stream, x, (const float*)d_in[3], hn, 2048);
        sgemm(stream, false, hn, D, Win, IN_TOTAL, PROJ, PW, 2048, PW, D);
        hipMemcpyAsync(sPROJ, PROJ, (size_t)256 * PW * 4, hipMemcpyDeviceToDevice, stream);
        hipLaunchKernelGGL(k_s5_scan, dim3(32), dim3(64), 0, stream, PROJ, BRn, (const float*)d_in[6], (const float*)d_in[7], (const float*)d_in[8], (const float*)d_in[9], (const float*)d_in[10], (const float*)d_in[11], (const float*)d_in[12], (const float*)d_in[13]);
        sgemm(stream, false, BRn, 2048, (const float*)d_in[14], 512, TMP, 512, 2048, 512, 512);
        hipLaunchKernelGGL(k_s5_gate, dim3((2048 * 512 + 255) / 256), dim3(256), 0, stream, BRn, TMP, 2048);
        hipLaunchKernelGGL(k_conv_inplace, dim3((768 + 255) / 256), dim3(256), 0, stream, PROJ, PW, OFF_XBC, 768, (const float*)d_in[15], (const float*)d_in[16], 1, 1);
        hipLaunchKernelGGL(k_ssd_scan, dim3(8), dim3(256), 0, stream, PROJ, BRn, (const float*)d_in[17], (const float*)d_in[18], (const float*)d_in[19]);
        hipLaunchKernelGGL(k_ssd_post, dim3(2048 / 4), dim3(256), 0, stream, BRn, PROJ, (const float*)d_in[20], 2048);
        hipLaunchKernelGGL(k_rope, dim3((2048 * 256 + 255) / 256), dim3(256), 0, stream, PROJ, ct, st, 0, 2048);
        hipLaunchKernelGGL(k_ret_scan, dim3(8), dim3(256), 0, stream, PROJ, BRn);
        hipLaunchKernelGGL(k_ret_post, dim3(2048 / 4), dim3(256), 0, stream, BRn, PROJ, (const float*)d_in[21], 2048);
        hipLaunchKernelGGL(k_conv_inplace, dim3((512 + 255) / 256), dim3(256), 0, stream, PROJ, PW, OFF_XL, 512, (const float*)d_in[22], (const float*)d_in[23], 0, 1);
        hipLaunchKernelGGL(k_lru_scan, dim3(8), dim3(64), 0, stream, PROJ, BRn, (const float*)d_in[24], (const float*)d_in[25], (const float*)d_in[26], (const float*)d_in[27], (const float*)d_in[28]);
        for (int k = 0; k < 4; ++k) {
            sgemm(stream, false, BRn + k * 512, 2048, (const float*)d_in[29] + (size_t)k * 512 * 1024, 1024, TMP, 1024, 2048, 1024, 512);
            sgemm(stream, false, hn, D, Win + OFF_GATE + k * 1024, IN_TOTAL, GLG, 1024, 2048, 1024, D);
            hipLaunchKernelGGL(k_dbg_gate, dim3((256 * 1024 + 255) / 256), dim3(256), 0, stream, sGATE + k * 1024, GLG, (const float*)d_in[5] + k * 1024);
            hipLaunchKernelGGL(k_gate_acc, dim3((2048 * 1024 + 255) / 256), dim3(256), 0, stream, MER, TMP, GLG, (const float*)d_in[5] + k * 1024, k == 0 ? 1 : 0, 2048);
        }
        hipMemcpyAsync(hh, x, (size_t)2048 * 1024 * 4, hipMemcpyDeviceToDevice, stream);
        sgemm(stream, true, MER, 1024, (const float*)d_in[30], D, hh, D, 2048, D, D);
        hipMemcpyAsync(sBR, BRn, (size_t)2048 * 2048 * 4, hipMemcpyDeviceToDevice, stream);
        hipMemcpyAsync(sMER, MER, (size_t)2048 * 1024 * 4, hipMemcpyDeviceToDevice, stream);
        hipMemcpyAsync(sH, hh, (size_t)2048 * 1024 * 4, hipMemcpyDeviceToDevice, stream);
        hipMemsetAsync((char*)d_ws + WS_CTL, 0, CTL_ZERO_BYTES, stream);
        a.ph_lo = 0; a.ph_hi = MK_SELFCHK;
        hipLaunchKernelGGL(mega, dim3(grid), dim3(NWAVES * 64), LDS_BYTES, stream, a);
        hipMemsetAsync(acc, 0, 256, stream);
        const unsigned short* PROJBp = (const unsigned short*)((char*)d_ws + R_PROJB); const unsigned short* GATEp = (const unsigned short*)((char*)d_ws + R_GATE); const unsigned short* BRp = (const unsigned short*)((char*)d_ws + R_BR); const unsigned short* MERp = (const unsigned short*)((char*)d_ws + R_MERGED);
        hipLaunchKernelGGL(k_dbg_cmp, dim3(256), dim3(256), 0, stream, sPROJ, PW, 0, (const void*)PROJBp, 4864, 0, 1, 256, 1792, acc + 0);
        hipLaunchKernelGGL(k_dbg_cmp, dim3(256), dim3(256), 0, stream, sPROJ, PW, 2824, (const void*)PROJBp, 4864, 2816, 1, 256, 1024, acc + 2);
        hipLaunchKernelGGL(k_dbg_cmp, dim3(256), dim3(256), 0, stream, sPROJ, PW, 3848, (const void*)PROJBp, 4864, 3840, 1, 256, 1024, acc + 4);
        for (int kk = 0; kk < 4; ++kk) hipLaunchKernelGGL(k_dbg_cmp, dim3(256), dim3(256), 0, stream, sGATE, 4096, kk * 1024, (const void*)GATEp, 4096, kk * 1024, 1, 256, 1024, acc + 6 + 2 * kk);
        if (MK_SELFCHK >= 5) for (int s = 0; s < 4; ++s) hipLaunchKernelGGL(k_dbg_cmp, dim3(256), dim3(256), 0, stream, sBR, 2048, s * 512, (const void*)BRp, 2048, s * 512, 1, 2048, 512, acc + 14 + 2 * s);
        if (MK_SELFCHK >= 6) hipLaunchKernelGGL(k_dbg_cmp, dim3(256), dim3(256), 0, stream, sMER, 1024, 0, (const void*)MERp, 1024, 0, 1, 2048, 1024, acc + 22);
        if (MK_SELFCHK >= 7) hipLaunchKernelGGL(k_dbg_cmp, dim3(256), dim3(256), 0, stream, sH, 1024, 0, (const void*)d_out, 1024, 0, 0, 2048, 1024, acc + 24);
        hipLaunchKernelGGL(k_dbg_report, dim3(1), dim3(1), 0, stream, acc, acc + 64);
        hipLaunchKernelGGL(k_dbg_fill, dim3(4096), dim3(256), 0, stream, (float*)d_out, acc + 64, (size_t)T * D);
        return;
    }
#elif defined(MK_HYBRID)
    a.ph_lo = 0; a.ph_hi = MK_HYBRID;
    hipLaunchKernelGGL(mega, dim3(grid), dim3(NWAVES * 64), LDS_BYTES, stream, a);
    nv::naive_from(MK_HYB_L, MK_HYB_S, d_in, d_out, d_ws, stream);
    return;
#else
    a.ph_lo = 0; a.ph_hi = 1000;
    hipLaunchKernelGGL(mega, dim3(grid), dim3(NWAVES * 64), LDS_BYTES, stream, a);
#endif
    const hipError_t le = hipPeekAtLastError();
    if (le != hipSuccess) fprintf(stderr, "kernel_launch: launch failed: %s\n", hipGetErrorName(le));
}
```

```cpp
#include <hip/hip_runtime.h>
#include <cstdio>
#include <cstdint>
__device__ __forceinline__ int lane_id_fresh() { int l; asm volatile("v_mbcnt_lo_u32_b32 %0, -1, 0\n\tv_mbcnt_hi_u32_b32 %0, -1, %0" : "=v"(l)); return l; }
namespace pg8 {
#define PG8_LAS __attribute__((address_space(3)))
typedef unsigned short bf16_t;
typedef short bf16x8 __attribute__((ext_vector_type(8)));
typedef float f32x4 __attribute__((ext_vector_type(4)));
typedef float f32x2 __attribute__((ext_vector_type(2)));
typedef unsigned u32x4 __attribute__((ext_vector_type(4)));
typedef unsigned u32x2 __attribute__((ext_vector_type(2)));
constexpr int BM = 256, BK = 64, HALF = 128, HTB = HALF * BK * 2  , STAGE_BYTES = 8 * HTB, NXCD = 8, WGM = 8;
__host__ __device__ __forceinline__ int lds_byte(int r, int c) { const int st = (r >> 4) * 2 + (c >> 5), rr = r & 15, cc = c & 31, ob = rr * 64 + cc * 2; return st * 1024 + (ob ^ (((ob >> 9) & 1) << 5)); }
__host__ __device__ __forceinline__ void stage_rc(int b, int& R, int& C) { const int st = b / 1024, sb = b % 1024, swz = sb ^ (((sb >> 9) & 1) << 5); R = (st >> 1) * 16 + swz / 64; C = (st & 1) * 32 + (swz % 64) / 2; }
__host__ __device__ __forceinline__ int perm32(int rho) { const int n = rho >> 4, i = rho & 15; return 8 * (i >> 2) + 4 * n + (i & 3); }

struct Unit { int pm, pn, z; const char* a; const char* b; };
struct Gemm { int lda, ldb, K; };

__device__ __forceinline__ void tile_map(int L, int nM, int nN, int& pm, int& pn) {
    const int nwg = nM * nN; int wgid = L;
    { const int q = nwg / NXCD, r = nwg % NXCD, xcd = wgid % NXCD, off = wgid / NXCD; wgid = (xcd < r ? xcd * (q + 1) : r * (q + 1) + (xcd - r) * q) + off; }
    const int nig = WGM * nN, gid = wgid / nig, fm = gid * WGM, gsz = (nM - fm) < WGM ? (nM - fm) : WGM;
    pm = fm + ((wgid % nig) % gsz); pn = (wgid % nig) / gsz;
}
typedef __bf16 bf16x2_t __attribute__((ext_vector_type(2)));
__device__ __forceinline__ unsigned cvt_pk_bf16(float lo, float hi) { const f32x2 v = {lo, hi}; return __builtin_bit_cast(unsigned, __builtin_convertvector(v, bf16x2_t)); }
__device__ __forceinline__ float bf_lo(unsigned w) { return __uint_as_float(w << 16); }
__device__ __forceinline__ float bf_hi(unsigned w) { return __uint_as_float(w & 0xffff0000u); }
__device__ __forceinline__ float fast_sigmoid(float x) { return __builtin_amdgcn_rcpf(1.0f + __builtin_amdgcn_exp2f(-1.4426950408889634f * x)); }

struct NoHooks { __device__ __forceinline__ void a_ready(const Unit&) const {} __device__ __forceinline__ void done(const Unit&) const {} };

typedef f32x4 AccT[2][2][4][2];
__device__ __forceinline__ u32x4 pack8(const f32x4 v0, const f32x4 v1) { u32x4 w; w.x = cvt_pk_bf16(v0[0], v0[1]); w.y = cvt_pk_bf16(v0[2], v0[3]); w.z = cvt_pk_bf16(v1[0], v1[1]); w.w = cvt_pk_bf16(v1[2], v1[3]); return w; }

struct EpiStore {
    static constexpr bool PERM = true, AFTER_DRAIN = false, KEEPS = false;
    bf16_t* O; int ldc;
    __device__ __forceinline__ void operator()(AccT& acc, const Unit& u, int wr, int wc, int fr, int fq) const {
        const int row0 = u.pm * BM + wr * 64 + fr, col0 = u.pn * BM + wc * 32 + 8 * fq;
#pragma unroll
        for (int ai = 0; ai < 2; ++ai)
#pragma unroll
            for (int m = 0; m < 4; ++m) { bf16_t* rowp = O + (size_t)(row0 + ai * HALF + m * 16) * ldc + col0;
#pragma unroll
                for (int bj = 0; bj < 2; ++bj) *(u32x4*)(rowp + bj * HALF) = pack8(acc[ai][bj][m][0], acc[ai][bj][m][1]); }
    }
};
struct EpiKV {
    static constexpr bool PERM = true, AFTER_DRAIN = false, KEEPS = false;
    bf16_t* kvb;
    __device__ __forceinline__ void operator()(AccT& acc, const Unit& u, int wr, int wc, int fr, int fq) const {
        const int l = u.z >> 1, isv = u.z & 1;
        bf16_t* base = kvb + (size_t)l * 4194304 + (isv ? 2097152 : 0);
        const int ldc = isv ? 256 : 1024;
        const int row0 = (isv ? (u.pn * 1024 + u.pm * 256) : u.pm * 256) + wr * 64 + fr, col0 = (isv ? 0 : u.pn * 256) + wc * 32 + 8 * fq;
#pragma unroll
        for (int ai = 0; ai < 2; ++ai)
#pragma unroll
            for (int m = 0; m < 4; ++m) { bf16_t* rowp = base + (size_t)(row0 + ai * HALF + m * 16) * ldc + col0;
#pragma unroll
                for (int bj = 0; bj < 2; ++bj) *(u32x4*)(rowp + bj * HALF) = pack8(acc[ai][bj][m][0], acc[ai][bj][m][1]); }
    }
};
#ifdef MK_GATE_LOGIT
#define GATE_ACT(x) (x)
#else
#define GATE_ACT(x) fast_sigmoid(x)
#endif
struct EpiProj {
    static constexpr bool PERM = true, AFTER_DRAIN = false, KEEPS = false;
    bf16_t* projb; bf16_t* gate; const float* bgate;
    __device__ __forceinline__ void operator()(AccT& acc, const Unit& u, int wr, int wc, int fr, int fq) const {
        const int row0 = u.pm * BM + wr * 64 + fr;
        if (u.pn < 19) {
            const int col0 = u.pn * BM + wc * 32 + 8 * fq;
#pragma unroll
            for (int ai = 0; ai < 2; ++ai)
#pragma unroll
                for (int m = 0; m < 4; ++m) { bf16_t* rowp = projb + (size_t)(row0 + ai * HALF + m * 16) * 4864 + col0;
#pragma unroll
                    for (int bj = 0; bj < 2; ++bj) *(u32x4*)(rowp + bj * HALF) = pack8(acc[ai][bj][m][0], acc[ai][bj][m][1]); }
        } else {
            const int col0 = (u.pn - 19) * BM + wc * 32 + 8 * fq;
            f32x4 bv[2][2];
#pragma unroll
            for (int bj = 0; bj < 2; ++bj)
#pragma unroll
                for (int n = 0; n < 2; ++n) bv[bj][n] = *(const f32x4*)(bgate + col0 + bj * HALF + 4 * n);
#pragma unroll
            for (int ai = 0; ai < 2; ++ai)
#pragma unroll
                for (int m = 0; m < 4; ++m) { bf16_t* rowp = gate + (size_t)(row0 + ai * HALF + m * 16) * 4096 + col0;
#pragma unroll
                    for (int bj = 0; bj < 2; ++bj) { f32x4 v0 = acc[ai][bj][m][0] + bv[bj][0], v1 = acc[ai][bj][m][1] + bv[bj][1];
#pragma unroll
                        for (int j = 0; j < 4; ++j) { v0[j] = GATE_ACT(v0[j]); v1[j] = GATE_ACT(v1[j]); }
                        *(u32x4*)(rowp + bj * HALF) = pack8(v0, v1); } }
        }
    }
};
struct EpiGlu {
    static constexpr bool PERM = true, AFTER_DRAIN = false, KEEPS = false;
    const bf16_t* ys; bf16_t* br;
    __device__ __forceinline__ void operator()(AccT& acc, const Unit& u, int wr, int wc, int fr, int fq) const {
        const int row0 = u.pm * BM + wr * 64 + fr, col0 = u.pn * BM + wc * 32 + 8 * fq;
#pragma unroll
        for (int ai = 0; ai < 2; ++ai)
#pragma unroll
            for (int m = 0; m < 4; ++m) { const size_t row = (size_t)(row0 + ai * HALF + m * 16);
#pragma unroll
                for (int bj = 0; bj < 2; ++bj) { const u32x4 yw = *(const u32x4*)(ys + row * 512 + col0 + bj * HALF);
                    f32x4 v0 = acc[ai][bj][m][0], v1 = acc[ai][bj][m][1];
                    v0[0] = bf_lo(yw.x) * fast_sigmoid(v0[0]); v0[1] = bf_hi(yw.x) * fast_sigmoid(v0[1]); v0[2] = bf_lo(yw.y) * fast_sigmoid(v0[2]); v0[3] = bf_hi(yw.y) * fast_sigmoid(v0[3]);
                    v1[0] = bf_lo(yw.z) * fast_sigmoid(v1[0]); v1[1] = bf_hi(yw.z) * fast_sigmoid(v1[1]); v1[2] = bf_lo(yw.w) * fast_sigmoid(v1[2]); v1[3] = bf_hi(yw.w) * fast_sigmoid(v1[3]);
                    *(u32x4*)(br + row * 2048 + col0 + bj * HALF) = pack8(v0, v1); } }
    }
};
struct EpiMerge {
    static constexpr bool PERM = true, AFTER_DRAIN = false, KEEPS = true;
    const bf16_t* gate; bf16_t* merged;
    __device__ __forceinline__ bool keep(const Unit& u) const { return u.z < 3; }
    __device__ __forceinline__ void operator()(AccT& acc, const Unit& u, int wr, int wc, int fr, int fq) const {
        const int row0 = u.pm * BM + wr * 64 + fr, col0 = u.pn * BM + wc * 32 + 8 * fq, k = u.z;
#pragma unroll
        for (int ai = 0; ai < 2; ++ai)
#pragma unroll
            for (int m = 0; m < 4; ++m) { const size_t row = (size_t)(row0 + ai * HALF + m * 16);
#pragma unroll
#ifdef MK_EXP_B
                for (int bj = 0; bj < 2; ++bj) { if (k == 3) *(u32x4*)(merged + row * 1024 + col0 + bj * HALF) = pack8(acc[ai][bj][m][0], acc[ai][bj][m][1]); continue;
                    const bf16_t* gp = gate + row * 4096 + k * 1024 + col0 + bj * HALF; const u32x4 gw = *(const u32x4*)gp;
#else
                for (int bj = 0; bj < 2; ++bj) { const bf16_t* gp = gate + row * 4096 + k * 1024 + col0 + bj * HALF; const u32x4 gw = *(const u32x4*)gp;
#endif
                    f32x4 g0 = (f32x4){bf_lo(gw.x), bf_hi(gw.x), bf_lo(gw.y), bf_hi(gw.y)}, g1 = (f32x4){bf_lo(gw.z), bf_hi(gw.z), bf_lo(gw.w), bf_hi(gw.w)};
#pragma unroll
                    for (int j = 0; j < 4; ++j) { g0[j] = fmaxf(g0[j], 1e-20f); g1[j] = fmaxf(g1[j], 1e-20f); }
                    if (k < 3) { const u32x4 nw = *(const u32x4*)(gp + 1024);
                        const f32x4 n0 = (f32x4){bf_lo(nw.x), bf_hi(nw.x), bf_lo(nw.y), bf_hi(nw.y)}, n1 = (f32x4){bf_lo(nw.z), bf_hi(nw.z), bf_lo(nw.w), bf_hi(nw.w)};
#pragma unroll
                        for (int j = 0; j < 4; ++j) { g0[j] *= __builtin_amdgcn_rcpf(fmaxf(n0[j], 1e-20f)); g1[j] *= __builtin_amdgcn_rcpf(fmaxf(n1[j], 1e-20f)); }
                        acc[ai][bj][m][0] *= g0; acc[ai][bj][m][1] *= g1; }
                    else *(u32x4*)(merged + row * 1024 + col0 + bj * HALF) = pack8(acc[ai][bj][m][0] * g0, acc[ai][bj][m][1] * g1); }
                if (m & 1) asm volatile("" ::: "memory"); }
    }
};
struct EpiRes {
    static constexpr bool PERM = false, AFTER_DRAIN = false, KEEPS = false;
    const float* in; float* out;
    __device__ __forceinline__ void operator()(AccT& acc, const Unit& u, int wr, int wc, int fr, int fq) const {
        const int row0 = u.pm * BM + wr * 64 + fr, col0 = u.pn * BM + wc * 32 + 4 * fq;
#pragma unroll
        for (int ai = 0; ai < 2; ++ai)
#pragma unroll
            for (int m = 0; m < 4; ++m) { const size_t off = (size_t)(row0 + ai * HALF + m * 16) * 1024 + col0;
#pragma unroll
                for (int bj = 0; bj < 2; ++bj)
#pragma unroll
                    for (int n = 0; n < 2; ++n) { const f32x4 bs = *(const f32x4*)(in + off + bj * HALF + n * 16); *(f32x4*)(out + off + bj * HALF + n * 16) = bs + acc[ai][bj][m][n]; }
                if (m & 1) asm volatile("" ::: "memory"); }
    }
};
struct EpiSoftmax {
    static constexpr bool PERM = true, AFTER_DRAIN = true, KEEPS = false;
    bf16_t* P; PG8_LAS float* xch;
    __device__ __forceinline__ void fused(AccT& acc, const Unit& u, int wr, int wc, int fr, int fq, PG8_LAS unsigned char*, int, int) const {
        PG8_LAS float* RM = xch; PG8_LAS float* RS = xch + 1024;
#pragma unroll
        for (int ai = 0; ai < 2; ++ai)
#pragma unroll
            for (int m = 0; m < 4; ++m) { float mx = -3.0e38f;
#pragma unroll
                for (int bj = 0; bj < 2; ++bj)
#pragma unroll
                    for (int n = 0; n < 2; ++n) { const f32x4 x = acc[ai][bj][m][n]; mx = fmaxf(mx, fmaxf(fmaxf(x[0], x[1]), fmaxf(x[2], x[3]))); }
                mx = fmaxf(mx, __shfl_xor(mx, 16)); mx = fmaxf(mx, __shfl_xor(mx, 32));
                if (fq == 0) RM[(ai * HALF + wr * 64 + m * 16 + fr) * 4 + wc] = mx; }
        asm volatile("s_waitcnt lgkmcnt(0)" ::: "memory"); __builtin_amdgcn_s_barrier(); asm volatile("" ::: "memory");
#pragma unroll
        for (int ai = 0; ai < 2; ++ai)
#pragma unroll
            for (int m = 0; m < 4; ++m) { const int r = ai * HALF + wr * 64 + m * 16 + fr; const f32x4 q = *(const PG8_LAS f32x4*)(RM + r * 4);
                const float mx = fmaxf(fmaxf(q[0], q[1]), fmaxf(q[2], q[3])) * 1.4426950408889634f; float s = 0.f;
#pragma unroll
                for (int bj = 0; bj < 2; ++bj)
#pragma unroll
                    for (int n = 0; n < 2; ++n) { f32x4 x = acc[ai][bj][m][n];
#pragma unroll
                        for (int j = 0; j < 4; ++j) { x[j] = __builtin_amdgcn_exp2f(x[j] * 1.4426950408889634f - mx); s += x[j]; }
                        acc[ai][bj][m][n] = x; }
                s += __shfl_xor(s, 16); s += __shfl_xor(s, 32);
                if (fq == 0) RS[r * 4 + wc] = s; }
        asm volatile("s_waitcnt lgkmcnt(0)" ::: "memory"); __builtin_amdgcn_s_barrier(); asm volatile("" ::: "memory");
        const int row0 = u.pm * BM + wr * 64 + fr, col0 = u.pn * BM + wc * 32 + 8 * fq;
#pragma unroll
        for (int ai = 0; ai < 2; ++ai)
#pragma unroll
            for (int m = 0; m < 4; ++m) { const int r = ai * HALF + wr * 64 + m * 16 + fr; const f32x4 q = *(const PG8_LAS f32x4*)(RS + r * 4);
                const float inv = __builtin_amdgcn_rcpf((q[0] + q[1]) + (q[2] + q[3]));
                bf16_t* rowp = P + (size_t)(row0 + ai * HALF + m * 16) * 1024 + col0;
#pragma unroll
                for (int bj = 0; bj < 2; ++bj) *(u32x4*)(rowp + bj * HALF) = pack8(acc[ai][bj][m][0] * inv, acc[ai][bj][m][1] * inv); }
    }
};
struct EpiSwiglu {
    static constexpr bool PERM = true, AFTER_DRAIN = false, KEEPS = false;
    bf16_t* act; int ldc;
    __device__ __forceinline__ void operator()(AccT& acc, const Unit& u, int wr, int wc, int fr, int fq) const {
        const int row0 = u.pm * BM + wr * 64 + fr, col0 = u.pn * 128 + wc * 16 + 4 * fq;
#pragma unroll
        for (int ai = 0; ai < 2; ++ai)
#pragma unroll
            for (int m = 0; m < 4; ++m) { bf16_t* rowp = act + (size_t)(row0 + ai * HALF + m * 16) * ldc + col0;
#pragma unroll
                for (int bj = 0; bj < 2; ++bj) { const f32x4 a = acc[ai][bj][m][0], b = acc[ai][bj][m][1]; f32x4 o;
#pragma unroll
                    for (int j = 0; j < 4; ++j) o[j] = a[j] * fast_sigmoid(a[j]) * b[j];
                    u32x2 w; w.x = cvt_pk_bf16(o[0], o[1]); w.y = cvt_pk_bf16(o[2], o[3]); *(u32x2*)(rowp + bj * 64) = w; } }
    }
};

struct PlainOrder : NoHooks {
    const char* A; const char* B; int nM, nN, lda, ldb, G, c;
    __device__ __forceinline__ bool next(int i, Unit& u) const { const int L = i * G + c; if (L >= nM * nN) return false; tile_map(L, nM, nN, u.pm, u.pn); u.z = 0;
        u.a = A + (size_t)u.pm * 256 * lda * 2; u.b = B + (size_t)u.pn * 256 * ldb * 2; return true; }
};
struct MergeOrder : NoHooks {
    const char* br_; const char* wb_; int G, c;
    __device__ __forceinline__ bool next(int i, Unit& u) const { const int t = c + (i >> 2) * G; if (t >= 256) return false; const int k = i & 3; tile_map(t, 64, 4, u.pm, u.pn); u.z = k;
        u.a = br_ + ((size_t)u.pm * 256 * 2048 + k * 512) * 2; u.b = wb_ + ((size_t)u.pn * 256 * 2048 + k * 512) * 2; return true; }
};
struct KVOrder : NoHooks {
    const char* mnr_; const char* WKV0; const char* WKV1; int G, c;
    __device__ __forceinline__ bool next(int i, Unit& u) const { const int L = i * G + c; if (L >= 128) return false; const int kind = L >> 5, t = L & 31, isv = kind & 1;
        const char* W = (kind >> 1) ? WKV1 : WKV0; u.z = kind;
        if (!isv) { u.pm = t & 7; u.pn = t >> 3; u.a = mnr_ + (size_t)u.pm * 256 * 1024 * 2; u.b = W + (size_t)u.pn * 256 * 1024 * 2; }
        else { u.pm = t & 3; u.pn = t >> 2; u.a = W + (size_t)(1024 + u.pm * 256) * 1024 * 2; u.b = mnr_ + (size_t)u.pn * 256 * 1024 * 2; }
        return true; }
};
struct QKOrder : NoHooks {
    const char* xq_; const char* kx_; int G, c, base;
    __device__ __forceinline__ bool next(int i, Unit& u) const { const int L = base + c; if (i > 0 || L >= 256) return false; tile_map(L, 64, 4, u.pm, u.pn); u.z = 0;
        u.a = xq_ + ((size_t)u.pm * 256 * 1024 + u.pn * 256) * 2; u.b = kx_ + ((size_t)(u.pm >> 3) * 256 * 1024 + u.pn * 256) * 2; return true; }
};
struct PVOrder : NoHooks {
    const char* p_; const char* vt_; int G, c;
    __device__ __forceinline__ bool next(int i, Unit& u) const { const int L = i * G + c; if (L >= 256) return false; tile_map(L, 64, 4, u.pm, u.pn); u.z = 0;
        u.a = p_ + ((size_t)u.pm * 256 * 1024 + u.pn * 256) * 2; u.b = vt_ + ((size_t)(u.pm >> 3) * 1024 + u.pn * 256) * 256 * 2; return true; }
};
struct MoeOrder : NoHooks {
    const char* A; const char* B; size_t estride; int lda, ldb, ntiles, nN, G, c; int t1, t2, t3, t4, t5, t6, t7;
    __device__ __forceinline__ bool next(int i, Unit& u) const { const int L = i * G + c; if (L >= ntiles * nN) return false; tile_map(L, ntiles, nN, u.pm, u.pn);
        const int rt = u.pm; const int e = (rt >= t1) + (rt >= t2) + (rt >= t3) + (rt >= t4) + (rt >= t5) + (rt >= t6) + (rt >= t7); u.z = e;
        u.a = A + (size_t)rt * 256 * lda * 2; u.b = B + (size_t)e * estride + (size_t)u.pn * 256 * ldb * 2; return true; }
};

template <class Epi, class Sched, bool ALIGN_EPI = false, bool SP2 = false>
__device__ __forceinline__ void gemm_phase(PG8_LAS unsigned char* lds, const Gemm g, const Sched& S, const Epi& E, const int wave_s) {
    int tid_ = wave_s * 64 + lane_id_fresh(); asm volatile("" : "+v"(tid_));
    const int tid = tid_, wid = __builtin_amdgcn_readfirstlane(tid >> 6), lane = tid & 63, wr = wid >> 2, wc = wid & 3, fr = lane & 15, fq = lane >> 4;
    const int K = g.K, nt = K / BK;
    unsigned voffA[2], voffB[2];
#pragma unroll
    for (int i = 0; i < 2; ++i) { int R, C; stage_rc(tid * 16 + i * 8192, R, C); const int Rb = Epi::PERM ? ((R & ~31) + perm32(R & 31)) : R;
        voffA[i] = (unsigned)(R * g.lda + C) * 2u; voffB[i] = (unsigned)(Rb * g.ldb + C) * 2u; }
    const size_t kstep = (size_t)(BK * 2);
    const size_t hstepA = (size_t)HALF * g.lda * 2, hstepB = (size_t)HALF * g.ldb * 2;
    const unsigned ldsw = (unsigned)wid * 1024u;
    const int aoff = lds_byte(wr * 64 + fr, fq * 8), boff = lds_byte(wc * 32 + fr, fq * 8);
#define PG8_SA(b, h) (((b) * 2 + (h)) * HTB)
#define PG8_SB(b, h) ((4 + (b) * 2 + (h)) * HTB)
#define PG8_STAGE(bufoff, gbase, voff) do { _Pragma("unroll") for (int _i = 0; _i < 2; ++_i) \
        __builtin_amdgcn_global_load_lds((const unsigned*)((const char*)(gbase) + (voff)[_i]), (PG8_LAS unsigned*)(lds + (bufoff) + ldsw + _i * 8192), 16, 0, 0); } while (0)
#define PG8_LDA(dst, b, h) do { _Pragma("unroll") for (int m = 0; m < 4; ++m) _Pragma("unroll") for (int k = 0; k < 2; ++k) dst[m][k] = *(const PG8_LAS bf16x8*)(lds + PG8_SA(b, h) + aoff + m * 2048 + k * 1024); } while (0)
#define PG8_LDB(dst, b, h) do { _Pragma("unroll") for (int n = 0; n < 2; ++n) _Pragma("unroll") for (int k = 0; k < 2; ++k) dst[n][k] = *(const PG8_LAS bf16x8*)(lds + PG8_SB(b, h) + boff + n * 2048 + k * 1024); } while (0)
#define PG8_MMA(ai, bj, At, Bt) do { __builtin_amdgcn_s_setprio(1); _Pragma("unroll") for (int m = 0; m < 4; ++m) _Pragma("unroll") for (int n = 0; n < 2; ++n) _Pragma("unroll") for (int k = 0; k < 2; ++k) \
        acc[ai][bj][m][n] = __builtin_amdgcn_mfma_f32_16x16x32_bf16(Bt[n][k], At[m][k], acc[ai][bj][m][n], 0, 0, 0); __builtin_amdgcn_s_setprio(0); } while (0)
#define PG8_WAIT_V(n) asm volatile("s_waitcnt vmcnt(" #n ")" ::: "memory")
#define PG8_WAIT_L(n) asm volatile("s_waitcnt lgkmcnt(" #n ")" ::: "memory")
#define PG8_BAR __builtin_amdgcn_s_barrier()
#define PG8_SCHED __builtin_amdgcn_sched_barrier(0)
    Unit cur, nxt; int ui = 0;
    if (!S.next(0, cur)) return;
    f32x4 acc[2][2][4][2];
#pragma unroll
    for (int a = 0; a < 2; ++a)
#pragma unroll
        for (int b = 0; b < 2; ++b)
#pragma unroll
            for (int m = 0; m < 4; ++m)
#pragma unroll
                for (int n = 0; n < 2; ++n) acc[a][b][m][n] = (f32x4){0.f, 0.f, 0.f, 0.f};
    bf16x8 At[4][2], B0[2][2], B1[2][2];
    const char* cA = cur.a; const char* cB = cur.b;
    S.a_ready(cur);
    if constexpr (SP2) {
        PG8_STAGE(PG8_SB(0, 0), cB, voffB); PG8_STAGE(PG8_SB(0, 1), cB + hstepB, voffB); PG8_STAGE(PG8_SA(0, 0), cA, voffA); PG8_STAGE(PG8_SA(0, 1), cA + hstepA, voffA);
        if (wr == 1) PG8_BAR;
        PG8_WAIT_V(2); PG8_BAR;
        PG8_STAGE(PG8_SB(1, 0), cB + kstep, voffB); PG8_STAGE(PG8_SA(1, 0), cA + kstep, voffA); PG8_STAGE(PG8_SB(1, 1), cB + hstepB + kstep, voffB);
        PG8_WAIT_V(6); PG8_BAR;
    } else {
        PG8_STAGE(PG8_SB(0, 0), cB, voffB); PG8_STAGE(PG8_SA(0, 0), cA, voffA); PG8_STAGE(PG8_SB(0, 1), cB + hstepB, voffB); PG8_STAGE(PG8_SA(0, 1), cA + hstepA, voffA);
        if (wr == 1) PG8_BAR;
        PG8_WAIT_V(4); PG8_BAR;
        PG8_STAGE(PG8_SB(1, 0), cB + kstep, voffB); PG8_STAGE(PG8_SA(1, 0), cA + kstep, voffA); PG8_STAGE(PG8_SB(1, 1), cB + hstepB + kstep, voffB);
        PG8_WAIT_V(6); PG8_BAR;
    }
    for (;;) {
        const bool has_next = S.next(ui + 1, nxt);
        const char* nA = has_next ? nxt.a : cA; const char* nB = has_next ? nxt.b : cB;
        for (int t = 0; t < nt; t += 2) {
            const bool last = (t == nt - 2);
            const char* a1 = cA + (size_t)(t + 1) * kstep;
            const char* a2 = last ? nA : cA + (size_t)(t + 2) * kstep; const char* b2 = last ? nB : cB + (size_t)(t + 2) * kstep;
            const char* a3 = a2 + kstep; const char* b3 = b2 + kstep;
            if (last && has_next) S.a_ready(nxt);
            if constexpr (SP2) {
            PG8_LDB(B0, 0, 0); PG8_LDB(B1, 0, 1); PG8_SCHED; PG8_LDA(At, 0, 0); PG8_STAGE(PG8_SA(1, 1), a1 + hstepA, voffA);
            PG8_WAIT_V(8); PG8_WAIT_L(0); PG8_BAR; PG8_MMA(0, 0, At, B0); PG8_MMA(0, 1, At, B1); PG8_BAR; PG8_SCHED;
            PG8_LDA(At, 0, 1); PG8_STAGE(PG8_SB(0, 0), b2, voffB); PG8_STAGE(PG8_SB(0, 1), b2 + hstepB, voffB); PG8_STAGE(PG8_SA(0, 0), a2, voffA);
            PG8_WAIT_V(8); PG8_WAIT_L(0); PG8_BAR; PG8_MMA(1, 0, At, B0); PG8_MMA(1, 1, At, B1); PG8_BAR; PG8_SCHED;
            PG8_LDB(B0, 1, 0); PG8_LDB(B1, 1, 1); PG8_SCHED; PG8_LDA(At, 1, 0); PG8_STAGE(PG8_SA(0, 1), a2 + hstepA, voffA);
            PG8_WAIT_V(8); PG8_WAIT_L(0); PG8_BAR; PG8_MMA(0, 0, At, B0); PG8_MMA(0, 1, At, B1); PG8_BAR; PG8_SCHED;
            PG8_LDA(At, 1, 1); PG8_STAGE(PG8_SB(1, 0), b3, voffB); PG8_STAGE(PG8_SB(1, 1), b3 + hstepB, voffB); PG8_STAGE(PG8_SA(1, 0), a3, voffA);
            PG8_WAIT_V(8); PG8_WAIT_L(0); PG8_BAR; PG8_MMA(1, 0, At, B0); PG8_MMA(1, 1, At, B1); PG8_BAR; PG8_SCHED;
            } else {
            PG8_LDB(B0, 0, 0); PG8_SCHED; PG8_LDA(At, 0, 0); PG8_STAGE(PG8_SA(1, 1), a1 + hstepA, voffA);
            PG8_WAIT_L(8); PG8_BAR; PG8_WAIT_L(0); PG8_MMA(0, 0, At, B0); PG8_BAR; PG8_SCHED;
            PG8_LDB(B1, 0, 1); PG8_STAGE(PG8_SB(0, 0), b2, voffB);
            PG8_BAR; PG8_WAIT_L(0); PG8_MMA(0, 1, At, B1); PG8_BAR;
            PG8_LDA(At, 0, 1); PG8_STAGE(PG8_SA(0, 0), a2, voffA);
            PG8_BAR; PG8_WAIT_L(0); PG8_MMA(1, 0, At, B0); PG8_BAR; PG8_SCHED;
            PG8_STAGE(PG8_SB(0, 1), b2 + hstepB, voffB);
            PG8_WAIT_V(6); PG8_BAR; PG8_MMA(1, 1, At, B1); PG8_BAR;
            PG8_LDB(B0, 1, 0); PG8_SCHED; PG8_LDA(At, 1, 0); PG8_STAGE(PG8_SA(0, 1), a2 + hstepA, voffA);
            PG8_WAIT_L(8); PG8_BAR; PG8_WAIT_L(0); PG8_MMA(0, 0, At, B0); PG8_BAR; PG8_SCHED;
            PG8_LDB(B1, 1, 1); PG8_STAGE(PG8_SB(1, 0), b3, voffB);
            PG8_BAR; PG8_WAIT_L(0); PG8_MMA(0, 1, At, B1); PG8_BAR;
            PG8_LDA(At, 1, 1); PG8_STAGE(PG8_SA(1, 0), a3, voffA);
            PG8_BAR; PG8_WAIT_L(0); PG8_MMA(1, 0, At, B0); PG8_BAR; PG8_SCHED;
            PG8_STAGE(PG8_SB(1, 1), b3 + hstepB, voffB);
            PG8_WAIT_V(6); PG8_BAR; PG8_MMA(1, 1, At, B1); PG8_BAR;
            }
        }
        if constexpr (ALIGN_EPI) { if (wr == 0) PG8_BAR; }
        if constexpr (!Epi::AFTER_DRAIN) { const int l2_ = lane_id_fresh(); E(acc, cur, wr, wc, l2_ & 15, l2_ >> 4); S.done(cur); }
        if (!has_next) break;
        bool zero_acc = true; if constexpr (Epi::KEEPS) zero_acc = !E.keep(cur);
        if (zero_acc) {
#pragma unroll
        for (int a = 0; a < 2; ++a)
#pragma unroll
            for (int b = 0; b < 2; ++b)
#pragma unroll
                for (int m = 0; m < 4; ++m)
#pragma unroll
                    for (int n = 0; n < 2; ++n) acc[a][b][m][n] = (f32x4){0.f, 0.f, 0.f, 0.f};
        }
        cur = nxt; cA = nA; cB = nB; ++ui;
        if constexpr (ALIGN_EPI) { if (wr == 1) PG8_BAR; }
    }
    PG8_WAIT_V(0);
    if constexpr (!ALIGN_EPI) { if (wr == 0) PG8_BAR; }
    PG8_BAR;
    if constexpr (Epi::AFTER_DRAIN) { const int l3_ = lane_id_fresh(); E.fused(acc, cur, wr, wc, l3_ & 15, l3_ >> 4, lds, wid, l3_); S.done(cur); }
#undef PG8_SA
#undef PG8_SB
#undef PG8_STAGE
#undef PG8_LDA
#undef PG8_LDB
#undef PG8_MMA
#undef PG8_WAIT_V
#undef PG8_WAIT_L
#undef PG8_BAR
#undef PG8_SCHED
}
}

#define GAS __attribute__((address_space(1)))
#define LAS __attribute__((address_space(3)))
typedef unsigned short bf16;
typedef unsigned v4u __attribute__((ext_vector_type(4)));
typedef short bf16x8 __attribute__((ext_vector_type(8)));
typedef unsigned v2u __attribute__((ext_vector_type(2)));
typedef float f32x4 __attribute__((ext_vector_type(4)));
typedef float f32x2 __attribute__((ext_vector_type(2)));
typedef int i32x4 __attribute__((ext_vector_type(4)));
typedef int i32x2 __attribute__((ext_vector_type(2)));
#define RLX_AGENT __ATOMIC_RELAXED, __HIP_MEMORY_SCOPE_AGENT
#define LDS_WAIT() asm volatile("s_waitcnt lgkmcnt(0)" ::: "memory")
#define VM_WAIT() asm volatile("s_waitcnt vmcnt(0)" ::: "memory")
__device__ __forceinline__ unsigned f2bf(float f) { unsigned u = __builtin_bit_cast(unsigned, f); return (u + 0x7fffu + ((u >> 16) & 1u)) >> 16; }
__device__ __forceinline__ unsigned pk2(float lo, float hi) { return f2bf(lo) | (f2bf(hi) << 16); }
__device__ __forceinline__ float bflo(unsigned w) { return __uint_as_float(w << 16); }
__device__ __forceinline__ float bfhi(unsigned w) { return __uint_as_float(w & 0xffff0000u); }
__device__ __forceinline__ float bf1(bf16 v) { return __uint_as_float((unsigned)v << 16); }

#define XB_TMO      128
#define XB_XCNT(j)  (256  + 64 * (j))
#define XB_XSUB(j)  (1280 + 64 * (j))
#define XB_XGEN(j)  (2304 + 64 * (j))
#define XB_TOP      3328
#define XB_TOPGEN   3392
#define XCD_BAR_WORDS 3456
#define XB_SPIN_CAP (1u << 18)

__device__ __forceinline__ unsigned xb_ld(unsigned* p)              { return __hip_atomic_load(p, __ATOMIC_RELAXED, __HIP_MEMORY_SCOPE_AGENT); }
__device__ __forceinline__ unsigned xb_add(unsigned* p, unsigned v) { return __hip_atomic_fetch_add(p, v, __ATOMIC_RELAXED, __HIP_MEMORY_SCOPE_AGENT); }
__device__ __forceinline__ unsigned xb_xcc_id() { return (unsigned)__builtin_amdgcn_s_getreg((3 << 11) | 20) & 0xFu; }
#define XB_SPIN(cond, bar) do { unsigned _sp = 0; while (cond) { __builtin_amdgcn_s_sleep(1); \
    if ((++_sp & 255u) == 0u) { if (xb_ld(&(bar)[XB_TMO])) break; if (_sp > XB_SPIN_CAP) { atomicAdd(&(bar)[XB_TMO], 1u); break; } } } } while (0)

struct XcdBarrier {
    unsigned* bar; unsigned x;
    volatile LAS unsigned* st;
};

__device__ __forceinline__ XcdBarrier xcd_barrier_post(unsigned* bar, volatile LAS unsigned* st, const int wave_s) {
    XcdBarrier b; b.bar = bar; b.x = xb_xcc_id(); b.st = st;
    if (wave_s == 0 && lane_id_fresh() == 0) (void)xb_add(&bar[XB_XCNT(b.x)], 1u);
    return b;
}
__device__ __forceinline__ void xcd_barrier_complete(unsigned* bar, unsigned x, unsigned& nloc, unsigned& nx) {
    const unsigned G = gridDim.x * gridDim.y * gridDim.z;
    unsigned sum, cnt, mine, sp = 0u;
    for (;;) {
        sum = 0u; cnt = 0u; mine = 0u;
#pragma unroll
        for (unsigned j = 0; j < 16; ++j) { const unsigned c = xb_ld(&bar[XB_XCNT(j)]); sum += c; cnt += (c > 0u) ? 1u : 0u; mine = (j == x) ? c : mine; }
        if (sum == G) break;
        __builtin_amdgcn_s_sleep(1);
        if ((++sp & 255u) == 0u) { if (xb_ld(&bar[XB_TMO])) break; if (sp > XB_SPIN_CAP) { atomicAdd(&bar[XB_TMO], 1u); break; } }
    }
    nloc = mine > 0u ? mine : 1u; nx = cnt > 0u ? cnt : 1u;
}

__device__ __forceinline__ void xcd_barrier(const XcdBarrier& b, const int wave_s) {
    asm volatile("s_waitcnt vmcnt(0)" ::: "memory");
    __syncthreads();
    if (wave_s == 0 && lane_id_fresh() == 0) {
        unsigned* bar = b.bar;
        __builtin_amdgcn_s_waitcnt(0);
        unsigned nloc = b.st[0], nx = b.st[1];
        if (nloc == 0u) { xcd_barrier_complete(bar, b.x, nloc, nx); b.st[0] = nloc; b.st[1] = nx; }
        const unsigned old = xb_add(&bar[XB_XSUB(b.x)], 1u);
        const unsigned gen = old / nloc;
        if (old + 1u == (gen + 1u) * nloc) {
            __builtin_amdgcn_fence(__ATOMIC_RELEASE, "agent");
            asm volatile("s_waitcnt vmcnt(0)" ::: "memory");
            const unsigned og = xb_add(&bar[XB_TOP], 1u);
            const unsigned tg = og / nx;
            if (og + 1u == (tg + 1u) * nx) xb_add(&bar[XB_TOPGEN], 1u);
            else XB_SPIN(xb_ld(&bar[XB_TOPGEN]) == tg, bar);
            __builtin_amdgcn_fence(__ATOMIC_ACQUIRE, "agent");
            xb_add(&bar[XB_XGEN(b.x)], 1u);
            asm volatile("s_waitcnt vmcnt(0)" ::: "memory");
        } else {
            XB_SPIN(xb_ld(&bar[XB_XGEN(b.x)]) == gen, bar);
            __builtin_amdgcn_fence(__ATOMIC_ACQUIRE, "agent");
            asm volatile("s_waitcnt vmcnt(0)" ::: "memory");
        }
    }
    __syncthreads();
}

constexpr int NWAVES = 8;
namespace cf {
constexpr int D = 1024, NB = 8, L = 2048, T = NB * L, NMEM = 256, TM = NB * NMEM, IN_TOTAL = 8968, DFF = 2816, DFE = 3584, NE = 8;
constexpr int PJ = 4864;
constexpr int C_U = 0, C_Z = 512, C_XBC = 1024, C_Q = 1792, C_K = 2304, C_V = 2816, C_G = 3328, C_XL = 3840, C_GL = 4352;
constexpr int O_DT = 1792, O_GATE = 4872;
constexpr int MAXSLOT = 34816;
}
constexpr size_t MiB = 1u << 20;
constexpr size_t WS_CTL = 0, CTL_ZERO_BYTES = 1 * MiB;
constexpr size_t WS_TOPI = 1 * MiB, WS_TOPW = WS_TOPI + 256 * 1024, WS_SLOT = WS_TOPW + 128 * 1024;
constexpr size_t WS_HN = 2 * MiB, WS_KV = 34 * MiB, WS_TAB = 50 * MiB, WS_DT = 54 * MiB, WS_MNR = 55 * MiB, WS_W = 59 * MiB;
constexpr size_t WL_STRIDE = 32 * MiB, WL_WIN = 0, WL_GLU = 17 * MiB + 512 * 1024, WL_WB = 18 * MiB, WL_WOUT = 22 * MiB, WL_WQ = 24 * MiB, WL_WKV = 26 * MiB, WL_WO = 30 * MiB;
constexpr size_t WS_W13 = 123 * MiB, WS_W2 = 134 * MiB, WS_R = 140 * MiB;
constexpr size_t R_PROJB = WS_R, R_GATE = WS_R + 152 * MiB, R_BR = WS_R + 280 * MiB, R_XBCC = WS_R + 344 * MiB, R_XLC = WS_R + 368 * MiB, R_END = WS_R + 384 * MiB;
constexpr size_t R_MP = WS_R, R_MERGED = WS_R + 64 * MiB;
constexpr size_t R_XQ = WS_R, R_P = WS_R + 32 * MiB, R_XO = WS_R + 64 * MiB;
constexpr size_t R_ACT = WS_R;
constexpr size_t M_W13E = 34 * MiB, M_W2E = 146 * MiB, M_XS = 202 * MiB, M_ACTE = 270 * MiB, M_END = 508 * MiB;
constexpr size_t WS_NEED = R_END > M_END ? R_END : M_END;
constexpr int CW_TMO = 0, CW_CODE = 1, CW_BAR = 4096, CW_CNT = 8192;
constexpr int RING_BYTES = 131072, LDSCTL_OFF = RING_BYTES, XCH_OFF = LDSCTL_OFF + 1024, LDS_BYTES = 147456;

struct Params { const float* in[46]; float* out; unsigned char* ws; int ph_lo, ph_hi; };

__device__ __forceinline__ int opq(int v) { asm volatile("" : "+s"(v)); return v; }
template <class Tp> __device__ __forceinline__ Tp* opqp(Tp* q) { return q + opq(0); }
__device__ __forceinline__ float wave_sum(float v) {
#pragma unroll
    for (int o = 1; o < 64; o <<= 1) v += __shfl_xor(v, o);
    return v;
}
__device__ __forceinline__ float sigmoidf_(float x) { return 1.0f / (1.0f + __expf(-x)); }
__device__ __forceinline__ float siluf_(float x) { return x / (1.0f + __expf(-x)); }
__device__ __forceinline__ float gelu_tanh(float x) { const float u = 0.7978845608028654f * (x + 0.044715f * x * x * x); const float e = __expf(2.0f * u); return x * (1.0f - 1.0f / (e + 1.0f)); }
__device__ __forceinline__ float softplusf_(float x) { return x > 20.f ? x : log1pf(__expf(x)); }

struct MapPlain { const float* W; int K, N; const float* ks; float sc; bf16* WT; int ldo;
    __device__ __forceinline__ float load(int k, int n) const { float v = W[(size_t)k * N + n]; if (ks) v *= ks[k]; return v * sc; }
    __device__ __forceinline__ bf16* dst(int n) const { return WT + (size_t)n * ldo; } };
struct MapWin { const float* W; const float* ks; bf16* WT; int N;
    __device__ __forceinline__ float load(int k, int n) const { return W[(size_t)k * cf::IN_TOTAL + n + (n >= cf::O_DT ? 8 : 0)] * ks[k]; }
    __device__ __forceinline__ bf16* dst(int n) const { return WT + (size_t)n * 1024; } };
struct MapW13 { const float* w1; const float* w3; const float* ks; bf16* WT; int F, N;
    __device__ __forceinline__ float load(int k, int n) const { const int j = n & 31, base = n - j, mat = j >> 4, f = (base >> 1) + (j & 15); const ptrdiff_t dsel = mat ? (w3 - w1) : (ptrdiff_t)0; float v = w1[dsel + (ptrdiff_t)((size_t)k * F + f)]; if (ks) v *= ks[k]; return v; }
    __device__ __forceinline__ bf16* dst(int n) const { const int j = n & 31, base = n - j, mat = j >> 4, fi = j & 15; return WT + (size_t)(base + 8 * (fi >> 2) + 4 * mat + (fi & 3)) * 1024; } };
template <class Map> __device__ __forceinline__ void cvt_item(const Map& mp, int item, LAS float* scr, int lane) {
    const int nblk = mp.N / 32, kb = item / nblk, nb = item % nblk, k0 = 64 * kb, n0 = 32 * nb;
#pragma unroll 8
    for (int i = 0; i < 32; ++i) { const int kk = 2 * i + (lane >> 5); scr[kk * 33 + (lane & 31)] = mp.load(k0 + kk, n0 + (lane & 31)); }
    LDS_WAIT(); asm volatile("" ::: "memory");
    const int c = lane & 7;
#pragma unroll
    for (int j = 0; j < 4; ++j) { const int n = (lane >> 3) + 8 * j; const LAS float* s = scr + (8 * c) * 33 + n;
        v4u o; o.x = pk2(s[0 * 33], s[1 * 33]); o.y = pk2(s[2 * 33], s[3 * 33]); o.z = pk2(s[4 * 33], s[5 * 33]); o.w = pk2(s[6 * 33], s[7 * 33]);
        *(v4u*)(mp.dst(n0 + n) + k0 + 8 * c) = o; }
    LDS_WAIT(); asm volatile("" ::: "memory");
}

__device__ __forceinline__ float norm_row(const float* xrow, bf16* orow, int lane, f32x4 (&v)[4]) {
    const f32x4* xr = (const f32x4*)xrow + lane; float ss = 0.f;
#pragma unroll
    for (int j = 0; j < 4; ++j) { v[j] = xr[64 * j]; ss += (v[j].x * v[j].x + v[j].y * v[j].y) + (v[j].z * v[j].z + v[j].w * v[j].w); }
    const float r = 1.0f / sqrtf(wave_sum(ss) * (1.0f / 1024.0f) + 1e-6f);
    unsigned long long* o8 = (unsigned long long*)orow + lane;
#pragma unroll
    for (int j = 0; j < 4; ++j) o8[64 * j] = (unsigned long long)pk2(v[j].x * r, v[j].y * r) | ((unsigned long long)pk2(v[j].z * r, v[j].w * r) << 32);
    return r;
}
__device__ __forceinline__ void row_dot8(const f32x4 (&v)[4], const LAS float* w8, int lane, float (&lg)[8]) {
#pragma unroll
    for (int e = 0; e < 8; ++e) lg[e] = 0.f;
#pragma unroll
    for (int j = 0; j < 4; ++j)
#pragma unroll
        for (int q = 0; q < 4; ++q) { const int i = 256 * j + 4 * lane + q; const f32x4 wa = *(const LAS f32x4*)(w8 + i * 8), wb = *(const LAS f32x4*)(w8 + i * 8 + 4); const float x = v[j][q];
            lg[0] += x * wa.x; lg[1] += x * wa.y; lg[2] += x * wa.z; lg[3] += x * wa.w; lg[4] += x * wb.x; lg[5] += x * wb.y; lg[6] += x * wb.z; lg[7] += x * wb.w; }
#pragma unroll
    for (int e = 0; e < 8; ++e) lg[e] = wave_sum(lg[e]);
}


#define MFMA16(a, b, c) __builtin_amdgcn_mfma_f32_16x16x32_bf16((a), (b), (c), 0, 0, 0)
__device__ __forceinline__ float bfs(short v) { return __uint_as_float(((unsigned)(unsigned short)v) << 16); }
__device__ __forceinline__ float ex2(float x) { return __builtin_amdgcn_exp2f(x); }
__device__ __forceinline__ bf16x8 pack8f(const f32x4 a, const f32x4 b) { v4u w; w.x = pg8::cvt_pk_bf16(a[0], a[1]); w.y = pg8::cvt_pk_bf16(a[2], a[3]); w.z = pg8::cvt_pk_bf16(b[0], b[1]); w.w = pg8::cvt_pk_bf16(b[2], b[3]); return __builtin_bit_cast(bf16x8, w); }
__device__ __forceinline__ v2u pack4f(const f32x4 a) { v2u w; w.x = pg8::cvt_pk_bf16(a[0], a[1]); w.y = pg8::cvt_pk_bf16(a[2], a[3]); return w; }

__device__ __forceinline__ void linattn_unit(const bf16* Q, const int qp, const bf16* K, const int kp, const bf16* V, const int vp, const float* dtp, const float dcoef, const float dskip,
                                             bf16* out, const int op, LAS unsigned char* sl, const int lane) {
    const int n16 = lane & 15, q = lane >> 4;
    LAS bf16* Vt = (LAS bf16*)sl;
    LAS bf16* Kt = Vt + 32 * 32;
    LAS bf16* St = Kt + 64 * 32;
    LAS float* la = (LAS float*)(St + 32 * 64);
    for (int i = lane; i < 32 * 64 / 2; i += 64) ((LAS unsigned*)St)[i] = 0u;
    f32x4 Sacc[4][2];
#pragma unroll
    for (int i = 0; i < 4; ++i) { Sacc[i][0] = (f32x4){0.f, 0.f, 0.f, 0.f}; Sacc[i][1] = (f32x4){0.f, 0.f, 0.f, 0.f}; }
    const f32x4 z4 = (f32x4){0.f, 0.f, 0.f, 0.f};
    const int posn = 8 * (n16 >> 2) + (n16 & 3);
    const int vrow = lane >> 1, vcol = (lane & 1) * 16, vpos = 8 * ((vrow & 15) >> 2) + 4 * (vrow >> 4) + (vrow & 3);
    for (int c = 0; c < cf::L / 32; ++c) {
        const int t0 = c * 32;
        float xl = dtp ? dtp[(size_t)(t0 + (lane & 31)) * 8] * dcoef : dcoef;
#pragma unroll
        for (int off = 1; off < 32; off <<= 1) { const float y = __shfl_up(xl, off); if ((lane & 31) >= off) xl += y; }
        if (lane < 32) la[lane] = xl;
        const float a_end = __shfl(xl, 31);
        bf16x8 Qf[2][2], Kf[2][2];
#pragma unroll
        for (int j = 0; j < 2; ++j)
#pragma unroll
            for (int ks = 0; ks < 2; ++ks) { Qf[j][ks] = *(const bf16x8*)(Q + (size_t)(t0 + 16 * j + n16) * qp + 32 * ks + 8 * q); Kf[j][ks] = *(const bf16x8*)(K + (size_t)(t0 + 16 * j + n16) * kp + 32 * ks + 8 * q); }
        const float vsc = dtp ? dtp[(size_t)(t0 + vrow) * 8] : 1.0f;
        const bf16x8 vv0 = *(const bf16x8*)(V + (size_t)(t0 + vrow) * vp + vcol), vv1 = *(const bf16x8*)(V + (size_t)(t0 + vrow) * vp + vcol + 8);
        const f32x4 as0 = *(const LAS f32x4*)(la + 4 * q), as1 = *(const LAS f32x4*)(la + 16 + 4 * q); const float al0 = la[n16], al1 = la[16 + n16];
        f32x4 s00 = MFMA16(Kf[0][0], Qf[0][0], z4); s00 = MFMA16(Kf[0][1], Qf[0][1], s00);
        f32x4 s01 = MFMA16(Kf[0][0], Qf[1][0], z4); s01 = MFMA16(Kf[0][1], Qf[1][1], s01);
        f32x4 s11 = MFMA16(Kf[1][0], Qf[1][0], z4); s11 = MFMA16(Kf[1][1], Qf[1][1], s11);
#pragma unroll
        for (int r = 0; r < 4; ++r) { const bool ok = n16 >= 4 * q + r;
            s00[r] = ok ? s00[r] * ex2(al0 - as0[r]) : 0.f; s01[r] = s01[r] * ex2(al1 - as0[r]); s11[r] = ok ? s11[r] * ex2(al1 - as1[r]) : 0.f; }
        const bf16x8 Pf0 = pack8f(s00, z4), Pf1 = pack8f(s01, s11);
        const float w0 = ex2(a_end - al0), w1 = ex2(a_end - al1);
#pragma unroll
        for (int i = 0; i < 2; ++i)
#pragma unroll
            for (int ks = 0; ks < 2; ++ks)
#pragma unroll
                for (int jj = 0; jj < 8; jj += 2) { const float wv = i ? w1 : w0; const unsigned pw = pg8::cvt_pk_bf16(bfs(Kf[i][ks][jj]) * wv, bfs(Kf[i][ks][jj + 1]) * wv); const int d = 32 * ks + 8 * q + jj;
                    Kt[d * 32 + posn + 4 * i] = (bf16)(pw & 0xffffu); Kt[(d + 1) * 32 + posn + 4 * i] = (bf16)(pw >> 16); }
#pragma unroll
        for (int jj = 0; jj < 8; jj += 2) { const unsigned pa = pg8::cvt_pk_bf16(bfs(vv0[jj]) * vsc, bfs(vv0[jj + 1]) * vsc), pb = pg8::cvt_pk_bf16(bfs(vv1[jj]) * vsc, bfs(vv1[jj + 1]) * vsc);
            Vt[(vcol + jj) * 32 + vpos] = (bf16)(pa & 0xffffu); Vt[(vcol + jj + 1) * 32 + vpos] = (bf16)(pa >> 16); Vt[(vcol + 8 + jj) * 32 + vpos] = (bf16)(pb & 0xffffu); Vt[(vcol + 9 + jj) * 32 + vpos] = (bf16)(pb >> 16); }
        bf16x8 Vf[2], Sf[2][2];
#pragma unroll
        for (int t = 0; t < 2; ++t) { Vf[t] = *(const LAS bf16x8*)(Vt + (16 * t + n16) * 32 + 8 * q); Sf[t][0] = *(const LAS bf16x8*)(St + (16 * t + n16) * 64 + 8 * q); Sf[t][1] = *(const LAS bf16x8*)(St + (16 * t + n16) * 64 + 32 + 8 * q); }
        const float ea0 = ex2(al0), ea1 = ex2(al1);
#pragma unroll
        for (int t = 0; t < 2; ++t)
#pragma unroll
            for (int j = 0; j < 2; ++j) {
                f32x4 y = MFMA16(Vf[t], j ? Pf1 : Pf0, z4);
                f32x4 cr = MFMA16(Sf[t][0], Qf[j][0], z4); cr = MFMA16(Sf[t][1], Qf[j][1], cr);
                y += cr * (j ? ea1 : ea0);
                const size_t row = (size_t)(t0 + 16 * j + n16);
                if (dskip != 0.f) { const v2u xw = *(const v2u*)(V + row * vp + 16 * t + 4 * q); y[0] += dskip * bflo(xw.x); y[1] += dskip * bfhi(xw.x); y[2] += dskip * bflo(xw.y); y[3] += dskip * bfhi(xw.y); }
                *(v2u*)(out + row * op + 16 * t + 4 * q) = pack4f(y);
            }
        const float dec = ex2(a_end);
#pragma unroll
        for (int dt = 0; dt < 4; ++dt) { const bf16x8 Ktf = *(const LAS bf16x8*)(Kt + (16 * dt + n16) * 32 + 8 * q);
#pragma unroll
            for (int et = 0; et < 2; ++et) { Sacc[dt][et] = MFMA16(Ktf, Vf[et], Sacc[dt][et] * dec); *(LAS v2u*)(St + (16 * et + n16) * 64 + 16 * dt + 4 * q) = pack4f(Sacc[dt][et]); } }
    }
}

__device__ __forceinline__ void s5_unit(const bf16* U, bf16* Y, const float* lam_re, const float* lam_im, const float* b_re, const float* b_im, const float* c_re, const float* c_im, const float* dsk, const float step,
                                        LAS unsigned char* sl, const int lane) {
    const int n16 = lane & 15, q = lane >> 4;
    LAS float* BU = (LAS float*)sl;
    LAS bf16* SI = (LAS bf16*)(sl + 8192);
    float ar, ai;
    { const float lr = lam_re[lane], li = lam_im[lane], mag = expf(lr * step); ar = mag * cosf(li * step); ai = mag * sinf(li * step); }
    bf16x8 Bbf[8], Ccf[4];
#pragma unroll
    for (int tl = 0; tl < 8; ++tl) {
        const int idx = 16 * tl + n16, st = idx & 63; float v[8];
        const float lr = lam_re[st], li = lam_im[st], mag = expf(lr * step), sar = mag * cosf(li * step), sai = mag * sinf(li * step), inv = 1.0f / (lr * lr + li * li);
        const float cr = ((sar - 1.0f) * lr + sai * li) * inv, ci = (sai * lr - (sar - 1.0f) * li) * inv;
#pragma unroll
        for (int jj = 0; jj < 8; ++jj) { float x = 0.f; if (q < 2) { const float br_ = b_re[st * 16 + 8 * q + jj], bi_ = b_im[st * 16 + 8 * q + jj]; x = idx < 64 ? cr * br_ - ci * bi_ : cr * bi_ + ci * br_; } v[jj] = x; }
        Bbf[tl] = pack8f((f32x4){v[0], v[1], v[2], v[3]}, (f32x4){v[4], v[5], v[6], v[7]});
    }
#pragma unroll
    for (int ks = 0; ks < 4; ++ks) {
        float v[8];
#pragma unroll
        for (int jj = 0; jj < 8; ++jj) { const int idx = 32 * ks + 8 * q + jj; v[jj] = idx < 64 ? c_re[n16 * 64 + idx] : -c_im[n16 * 64 + idx - 64]; }
        Ccf[ks] = pack8f((f32x4){v[0], v[1], v[2], v[3]}, (f32x4){v[4], v[5], v[6], v[7]});
    }
    const f32x4 dk = *(const f32x4*)(dsk + 4 * q);
    const f32x4 z4 = (f32x4){0.f, 0.f, 0.f, 0.f};
    float sr = 0.f, si = 0.f;
    for (int c = 0; c < cf::L / 16; ++c) {
        const bf16* urow = U + (size_t)(c * 16 + n16) * cf::PJ;
        bf16x8 Uf = (bf16x8){0, 0, 0, 0, 0, 0, 0, 0}; if (q < 2) Uf = *(const bf16x8*)(urow + 8 * q);
        const v2u uw = *(const v2u*)(urow + 4 * q);
#pragma unroll
        for (int tl = 0; tl < 8; ++tl) { const f32x4 d = MFMA16(Uf, Bbf[tl], z4);
#pragma unroll
            for (int r = 0; r < 4; ++r) BU[(4 * q + r) * 128 + 16 * tl + n16] = d[r]; }
#pragma unroll
        for (int t = 0; t < 16; ++t) { const float bre = BU[t * 128 + lane], bim = BU[t * 128 + 64 + lane];
            const float nr = ar * sr - ai * si + bre, ni = ar * si + ai * sr + bim; sr = nr; si = ni;
            const unsigned pw = pg8::cvt_pk_bf16(sr, si); SI[t * 128 + lane] = (bf16)(pw & 0xffffu); SI[t * 128 + 64 + lane] = (bf16)(pw >> 16); }
        f32x4 y = z4;
#pragma unroll
        for (int ks = 0; ks < 4; ++ks) { const bf16x8 Sfr = *(const LAS bf16x8*)(SI + n16 * 128 + 32 * ks + 8 * q); y = MFMA16(Ccf[ks], Sfr, y); }
        y[0] = gelu_tanh(y[0] + dk[0] * bflo(uw.x)); y[1] = gelu_tanh(y[1] + dk[1] * bfhi(uw.x)); y[2] = gelu_tanh(y[2] + dk[2] * bflo(uw.y)); y[3] = gelu_tanh(y[3] + dk[3] * bfhi(uw.y));
        *(v2u*)(Y + (size_t)(c * 16 + n16) * 512 + 4 * q) = pack4f(y);
    }
}

__device__ __forceinline__ void lru_unit(const bf16* XC  , const bf16* GL  , bf16* out  ,
                                         const float* wa  , const float* wx, const float ba, const float bx, const float sp, const int jq, const int lane) {
    const int n16 = lane & 15, q = lane >> 4;
    bf16x8 Waf[2], Wxf[2];
#pragma unroll
    for (int ks = 0; ks < 2; ++ks) { float va[8], vx[8];
#pragma unroll
        for (int jj = 0; jj < 8; ++jj) { const int i = 32 * ks + 8 * q + jj; va[jj] = wa[i * 64 + jq * 16 + n16]; vx[jj] = wx[i * 64 + jq * 16 + n16]; }
        Waf[ks] = pack8f((f32x4){va[0], va[1], va[2], va[3]}, (f32x4){va[4], va[5], va[6], va[7]}); Wxf[ks] = pack8f((f32x4){vx[0], vx[1], vx[2], vx[3]}, (f32x4){vx[4], vx[5], vx[6], vx[7]}); }
    const f32x4 z4 = (f32x4){0.f, 0.f, 0.f, 0.f};
    float hprev = 0.f;
    for (int c = 0; c < cf::L / 16; ++c) {
        const int t0 = c * 16;
        const bf16x8 X0 = *(const bf16x8*)(XC + (size_t)(t0 + n16) * 512 + 8 * q), X1 = *(const bf16x8*)(XC + (size_t)(t0 + n16) * 512 + 32 + 8 * q);
        f32x4 ra = MFMA16(X0, Waf[0], z4); ra = MFMA16(X1, Waf[1], ra);
        f32x4 ri = MFMA16(X0, Wxf[0], z4); ri = MFMA16(X1, Wxf[1], ri);
        float a[4], bb[4], gv[4];
#pragma unroll
        for (int r = 0; r < 4; ++r) { const size_t row = (size_t)(t0 + 4 * q + r);
            const float xcv = bf1(XC[row * 512 + jq * 16 + n16]); gv[r] = bf1(GL[row * cf::PJ + n16]);
            const float rr = sigmoidf_(ra[r] + ba), ii = sigmoidf_(ri[r] + bx), la_ = -8.0f * rr * sp; a[r] = __expf(la_);
            bb[r] = sqrtf(fmaxf(1.0f - a[r] * a[r], 0.f)) * ii * xcv; }
        float A = a[0] * a[1] * a[2] * a[3], B = ((bb[0] * a[1] + bb[1]) * a[2] + bb[2]) * a[3] + bb[3];
        { const float Au = __shfl_up(A, 16), Bu = __shfl_up(B, 16); if (q >= 1) { B = A * Bu + B; A = A * Au; } }
        { const float Au = __shfl_up(A, 32), Bu = __shfl_up(B, 32); if (q >= 2) { B = A * Bu + B; A = A * Au; } }
        float Ae = __shfl_up(A, 16), Be = __shfl_up(B, 16); if (q == 0) { Ae = 1.0f; Be = 0.f; }
        float h = Ae * hprev + Be;
#pragma unroll
        for (int r = 0; r < 4; ++r) { h = a[r] * h + bb[r]; out[(size_t)(t0 + 4 * q + r) * 2048 + n16] = (bf16)f2bf(h * gelu_tanh(gv[r])); }
        hprev = __shfl(h, 48 + n16);
    }
}

#define PH_VARS int tid_ = wave_s * 64 + lane_id_fresh(); asm volatile("" : "+v"(tid_)); const int tid = tid_, lane = tid & 63, wave = __builtin_amdgcn_readfirstlane(tid >> 6); \
    const int G = opq((int)gridDim.x), bx = opq((int)blockIdx.x), vcu = (G % 8 == 0) ? (bx % 8) * (G / 8) + bx / 8 : bx; \
    const int gw = vcu * NWAVES + wave, NGW = G * NWAVES, gt = vcu * 512 + tid, NGT = G * 512; \
    LAS float* scr = (LAS float*)(lds + wave * 16384); LAS float* w8 = (LAS float*)lds; LAS float* xch = (LAS float*)(lds + XCH_OFF); \
    (void)lane; (void)gw; (void)NGW; (void)gt; (void)NGT; (void)scr; (void)w8; (void)xch; (void)bx;
#define ws (opqp(p.ws))
#define ctl ((unsigned*)(ws + WS_CTL))
#define GRID_BAR() do { if (single) { XcdBarrier b2_ = bar; b2_.bar = ctl + CW_BAR; xcd_barrier(b2_, wave_s); } } while (0)
#define IN(k) (lo <= (k) && (k) < hi)
#define x_ (opqp(p.in[0]))
#define mem_ (opqp(p.in[1]))
#define positions_ ((const int*)opqp(p.in[2]))
#define norm_mix (opqp(p.in[3]))
#define w_in (opqp(p.in[4]))
#define b_gate (opqp(p.in[5]))
#define w_branch (opqp(p.in[29]))
#define w_out (opqp(p.in[30]))
#define norm_xa (opqp(p.in[31]))
#define norm_mem (opqp(p.in[32]))
#define xa_wq (opqp(p.in[33]))
#define xa_wk (opqp(p.in[34]))
#define xa_wv (opqp(p.in[35]))
#define xa_wo (opqp(p.in[36]))
#define norm_ffn (opqp(p.in[37]))
#define ffn_w1 (opqp(p.in[38]))
#define ffn_w3 (opqp(p.in[39]))
#define ffn_w2 (opqp(p.in[40]))
#define moe_router (opqp(p.in[41]))
#define moe_w1 (opqp(p.in[42]))
#define moe_w3 (opqp(p.in[43]))
#define moe_w2 (opqp(p.in[44]))
#define norm_final (opqp(p.in[45]))
#define H (opqp(p.out))
#define HN ((bf16*)(ws + WS_HN))
#define KVB ((bf16*)(ws + WS_KV))
#define COS ((float*)(ws + WS_TAB))
#define SIN (COS + (size_t)T * 32)
#define DT ((float*)(ws + WS_DT))
#define MNR ((bf16*)(ws + WS_MNR))
#define PROJB ((bf16*)(ws + R_PROJB))
#define GATE ((bf16*)(ws + R_GATE))
#define BR ((bf16*)(ws + R_BR))
#define XBCC ((bf16*)(ws + R_XBCC))
#define XLC ((bf16*)(ws + R_XLC))
#define MP ((float*)(ws + R_MP))
#define MERGED ((bf16*)(ws + R_MERGED))
#define XQ ((bf16*)(ws + R_XQ))
#define PB ((bf16*)(ws + R_P))
#define XO ((bf16*)(ws + R_XO))
#define ACT ((bf16*)(ws + R_ACT))
#define W13E ((bf16*)(ws + M_W13E))
#define W2E ((bf16*)(ws + M_W2E))
#define XS ((bf16*)(ws + M_XS))
#define ACTE ((bf16*)(ws + M_ACTE))
#define TOPI ((i32x4*)(ws + WS_TOPI))
#define TOPW ((f32x2*)(ws + WS_TOPW))
#define SLOT ((i32x2*)(ws + WS_SLOT))
#define CNT ((int*)(ctl + CW_CNT))
#define W13 ((bf16*)(ws + WS_W13))
#define W2T ((bf16*)(ws + WS_W2))
#define CVT_LOOP(NITEMS, ...) do { for (int it = (gw + NGW - rot % NGW) % NGW; it < (NITEMS); it += NGW) { __VA_ARGS__; cvt_item(m, it, scr, lane); } rot += (NITEMS); } while (0)

__global__ void __launch_bounds__(NWAVES * 64, 2) mega(Params p) {
    using namespace cf;
    extern __shared__ __attribute__((aligned(16))) unsigned char lds_raw[];
    LAS unsigned char* lds = (LAS unsigned char*)lds_raw;
    const int wave_s = __builtin_amdgcn_readfirstlane((int)threadIdx.x >> 6);
    for (int u = threadIdx.x; u < (LDS_BYTES - LDSCTL_OFF) / 4; u += NWAVES * 64) ((LAS unsigned*)(lds + LDSCTL_OFF))[u] = 0u;
    __syncthreads();
    const bool single = (p.ph_hi - p.ph_lo) > 1;
    XcdBarrier bar; bar.bar = ctl + CW_BAR; bar.x = 0; bar.st = (volatile LAS unsigned*)(lds + LDSCTL_OFF) + 8;
    if (single) bar = xcd_barrier_post(ctl + CW_BAR, (volatile LAS unsigned*)(lds + LDSCTL_OFF) + 8, wave_s);
    const int lo = p.ph_lo, hi = p.ph_hi;


    if (IN(0)) { PH_VARS
        {
            int rot = 0;
            for (int l = 0; l < 2; ++l) {
                unsigned char* wl = ws + WS_W + (size_t)l * WL_STRIDE;
                CVT_LOOP(16 * 280, MapWin m{w_in + (size_t)l * D * IN_TOTAL, norm_mix + l * D, (bf16*)(wl + WL_WIN), 8960});
                CVT_LOOP(8 * 16, MapPlain m{opqp(p.in[14]) + (size_t)l * 512 * 512, 512, 512, nullptr, 1.f, (bf16*)(wl + WL_GLU), 512});
                for (int k = 0; k < 4; ++k) CVT_LOOP(8 * 32, MapPlain m{w_branch + ((size_t)l * 4 + k) * 512 * 1024, 512, 1024, nullptr, 1.f, (bf16*)(wl + WL_WB) + k * 512, 2048});
                CVT_LOOP(16 * 32, MapPlain m{w_out + (size_t)l * D * D, D, D, nullptr, 1.f, (bf16*)(wl + WL_WOUT), D});
                CVT_LOOP(16 * 32, MapPlain m{xa_wq + (size_t)l * D * D, D, D, norm_xa + l * D, 0.0625f, (bf16*)(wl + WL_WQ), D});
                CVT_LOOP(16 * 32, MapPlain m{xa_wk + (size_t)l * D * D, D, D, norm_mem + l * D, 1.f, (bf16*)(wl + WL_WKV), D});
                CVT_LOOP(16 * 32, MapPlain m{xa_wv + (size_t)l * D * D, D, D, norm_mem + l * D, 1.f, (bf16*)(wl + WL_WKV) + (size_t)D * D, D});
                CVT_LOOP(16 * 32, MapPlain m{xa_wo + (size_t)l * D * D, D, D, nullptr, 1.f, (bf16*)(wl + WL_WO), D});
            }
            CVT_LOOP(16 * 176, MapW13 m{ffn_w1, ffn_w3, norm_ffn, W13, DFF, 2 * DFF});
            CVT_LOOP(44 * 32, MapPlain m{ffn_w2, DFF, D, nullptr, 1.f, W2T, DFF});
        }
        for (int i = gt; i < T * 32; i += NGT) { const int row = i >> 5, f = i & 31; const float inv_freq = (float)exp(-(double)f / 32.0 * 9.210340371976184); const float ang = (float)positions_[row] * inv_freq;
            COS[i] = (float)cos((double)ang); SIN[i] = (float)sin((double)ang); }
        for (int row = gw; row < TM; row += NGW) { f32x4 v[4]; (void)norm_row(mem_ + (size_t)row * D, MNR + (size_t)row * D, lane, v); }
        __syncthreads();
        for (int i = tid; i < 8192; i += 512) w8[i] = norm_mix[i >> 3] * w_in[(size_t)(i >> 3) * IN_TOTAL + O_DT + (i & 7)];
        __syncthreads();
        for (int row = gw; row < T; row += NGW) { f32x4 v[4]; const float r = norm_row(x_ + (size_t)row * D, HN + (size_t)row * D, lane, v); float lg[8]; row_dot8(v, w8, lane, lg);
            float mine = 0.f;
#pragma unroll
            for (int e = 0; e < 8; ++e) if (lane == e) mine = lg[e];
            if (lane < 8) DT[(size_t)row * 8 + lane] = softplusf_(r * mine + opqp(p.in[17])[lane]); }
        GRID_BAR();
    }


    { constexpr int layer = 0;
        const int pb = 1 + layer * 20;
#define WLP (ws + WS_W + (size_t)layer * WL_STRIDE)
#define WIN ((const bf16*)(WLP + WL_WIN))
#define WGLU ((const bf16*)(WLP + WL_GLU))
#define WB ((const bf16*)(WLP + WL_WB))
#define WOUT ((const bf16*)(WLP + WL_WOUT))
#define WQ ((const bf16*)(WLP + WL_WQ))
#define WO ((const bf16*)(WLP + WL_WO))
#define KX (KVB + (size_t)layer * 4194304)
#define VT (KX + 2097152)
        if (IN(pb + 0)) { PH_VARS
            if (layer == 0) {
                pg8::Gemm g{1024, 1024, 1024}; pg8::KVOrder S; S.mnr_ = (const char*)MNR; S.WKV0 = (const char*)(ws + WS_W + WL_WKV); S.WKV1 = (const char*)(ws + WS_W + WL_STRIDE + WL_WKV); S.G = G; S.c = bx;
                pg8::EpiKV E{KVB};
                pg8::gemm_phase<pg8::EpiKV, pg8::KVOrder, false, false>(lds, g, S, E, wave_s);
            }
            pg8::Gemm g{1024, 1024, 1024}; pg8::PlainOrder S; S.A = (const char*)HN; S.B = (const char*)WIN; S.nM = 64; S.nN = 35; S.lda = 1024; S.ldb = 1024; S.G = G; S.c = bx;
            pg8::EpiProj E{PROJB, GATE, b_gate + layer * 4096};
            pg8::gemm_phase<pg8::EpiProj, pg8::PlainOrder, false, false>(lds, g, S, E, wave_s);
            GRID_BAR();
        }
        if (IN(pb + 1)) { PH_VARS
            const float* cw = opqp(p.in[15]) + layer * 4 * 768; const float* cb = opqp(p.in[16]) + layer * 768; const float* lw = opqp(p.in[22]) + layer * 4 * 512; const float* lb = opqp(p.in[23]) + layer * 512;
            for (int it = gt; it < T * 224; it += NGT) {
                const int row = it / 224, j = it % 224, t = row & (L - 1);
                if (j < 160) {
                    const bool isx = j < 96; const int c0 = isx ? j * 8 : (j - 96) * 8, C = isx ? 768 : 512; const float* w = isx ? cw : lw; const float* bb = isx ? cb : lb;
                    const bf16* src = PROJB + (size_t)row * PJ + (isx ? C_XBC : C_XL) + c0;
                    float acc[8];
#pragma unroll
                    for (int q = 0; q < 8; ++q) acc[q] = bb[c0 + q];
#pragma unroll
                    for (int tap = 0; tap < 4; ++tap) { if (t - 3 + tap >= 0) { const v4u xv = *(const v4u*)(src - (ptrdiff_t)(3 - tap) * PJ); const float* wt = w + tap * C + c0;
                        acc[0] += wt[0] * bflo(xv.x); acc[1] += wt[1] * bfhi(xv.x); acc[2] += wt[2] * bflo(xv.y); acc[3] += wt[3] * bfhi(xv.y);
                        acc[4] += wt[4] * bflo(xv.z); acc[5] += wt[5] * bfhi(xv.z); acc[6] += wt[6] * bflo(xv.w); acc[7] += wt[7] * bfhi(xv.w); } }
                    if (isx) {
#pragma unroll
                        for (int q = 0; q < 8; ++q) acc[q] = siluf_(acc[q]); }
                    v4u o; o.x = pk2(acc[0], acc[1]); o.y = pk2(acc[2], acc[3]); o.z = pk2(acc[4], acc[5]); o.w = pk2(acc[6], acc[7]);
                    *(v4u*)((isx ? XBCC + (size_t)row * 768 : XLC + (size_t)row * 512) + c0) = o;
                } else {
                    const bool isk = j >= 192; const int jj = isk ? j - 192 : j - 160, h = jj >> 2, i0 = (jj & 3) * 8; const float sc = isk ? 0.125f : 1.0f;
                    bf16* q1 = PROJB + (size_t)row * PJ + (isk ? C_K : C_Q) + h * 64 + i0; bf16* q2 = q1 + 32;
                    const v4u a = *(const v4u*)q1, b = *(const v4u*)q2;
                    const f32x4 c0v = *(const f32x4*)(COS + (size_t)row * 32 + i0), c1v = *(const f32x4*)(COS + (size_t)row * 32 + i0 + 4), s0v = *(const f32x4*)(SIN + (size_t)row * 32 + i0), s1v = *(const f32x4*)(SIN + (size_t)row * 32 + i0 + 4);
                    const float x1[8] = {bflo(a.x), bfhi(a.x), bflo(a.y), bfhi(a.y), bflo(a.z), bfhi(a.z), bflo(a.w), bfhi(a.w)};
                    const float x2[8] = {bflo(b.x), bfhi(b.x), bflo(b.y), bfhi(b.y), bflo(b.z), bfhi(b.z), bflo(b.w), bfhi(b.w)};
                    const float cc[8] = {c0v.x, c0v.y, c0v.z, c0v.w, c1v.x, c1v.y, c1v.z, c1v.w}, ss[8] = {s0v.x, s0v.y, s0v.z, s0v.w, s1v.x, s1v.y, s1v.z, s1v.w};
                    float o1[8], o2[8];
#pragma unroll
                    for (int q = 0; q < 8; ++q) { o1[q] = (x1[q] * cc[q] - x2[q] * ss[q]) * sc; o2[q] = (x2[q] * cc[q] + x1[q] * ss[q]) * sc; }
                    v4u w1; w1.x = pk2(o1[0], o1[1]); w1.y = pk2(o1[2], o1[3]); w1.z = pk2(o1[4], o1[5]); w1.w = pk2(o1[6], o1[7]);
                    v4u w2; w2.x = pk2(o2[0], o2[1]); w2.y = pk2(o2[2], o2[3]); w2.z = pk2(o2[4], o2[5]); w2.w = pk2(o2[6], o2[7]);
                    *(v4u*)q1 = w1; *(v4u*)q2 = w2;
                }
            }
            GRID_BAR();
        }
        if (IN(pb + 2)) { PH_VARS
            bf16* YS = HN;
#ifdef MK_NAIVE_MIX
            for (int wu = gw; wu < 832; wu += NGW) {
                if (wu < 256) {
                    const int un = wu >> 2, sub = wu & 3, b = un >> 3, hh = un & 7, g = hh >> 2, pp = sub * 16 + (lane >> 2), nq = lane & 3;
                    const float Aa = -__expf(opqp(p.in[18])[layer * 8 + hh]), Dk = opqp(p.in[19])[layer * 8 + hh];
                    float S[16];
#pragma unroll
                    for (int j = 0; j < 16; ++j) S[j] = 0.f;
                    for (int t = 0; t < L; ++t) {
                        const size_t row = (size_t)b * L + t; const bf16* xr = XBCC + row * 768;
                        const float dtv = DT[row * 8 + hh], xv = bf1(xr[hh * 64 + pp]);
                        const v4u b0 = *(const v4u*)(xr + 512 + g * 64 + nq * 16), b1 = *(const v4u*)(xr + 512 + g * 64 + nq * 16 + 8), c0 = *(const v4u*)(xr + 640 + g * 64 + nq * 16), c1 = *(const v4u*)(xr + 640 + g * 64 + nq * 16 + 8);
                        const float Bv[16] = {bflo(b0.x), bfhi(b0.x), bflo(b0.y), bfhi(b0.y), bflo(b0.z), bfhi(b0.z), bflo(b0.w), bfhi(b0.w), bflo(b1.x), bfhi(b1.x), bflo(b1.y), bfhi(b1.y), bflo(b1.z), bfhi(b1.z), bflo(b1.w), bfhi(b1.w)};
                        const float Cv[16] = {bflo(c0.x), bfhi(c0.x), bflo(c0.y), bfhi(c0.y), bflo(c0.z), bfhi(c0.z), bflo(c0.w), bfhi(c0.w), bflo(c1.x), bfhi(c1.x), bflo(c1.y), bfhi(c1.y), bflo(c1.z), bfhi(c1.z), bflo(c1.w), bfhi(c1.w)};
                        const float da = __expf(dtv * Aa), xdt = xv * dtv; float acc = 0.f;
#pragma unroll
                        for (int j = 0; j < 16; ++j) { S[j] = da * S[j] + xdt * Bv[j]; acc += Cv[j] * S[j]; }
                        acc += __shfl_xor(acc, 1); acc += __shfl_xor(acc, 2);
                        if (nq == 0) BR[row * 2048 + 512 + hh * 64 + pp] = (bf16)f2bf(acc + Dk * xv);
                    }
                } else if (wu < 512) {
                    const int un = (wu - 256) >> 2, sub = wu & 3, b = un >> 3, hh = un & 7, e = sub * 16 + (lane >> 2), dq = lane & 3;
                    const float gamma = 1.0f - exp2f(-5.0f - (float)hh);
                    float S[16];
#pragma unroll
                    for (int j = 0; j < 16; ++j) S[j] = 0.f;
                    for (int t = 0; t < L; ++t) {
                        const size_t row = (size_t)b * L + t; const bf16* pr = PROJB + row * PJ;
                        const float vv = bf1(pr[C_V + hh * 64 + e]);
                        const v4u k0 = *(const v4u*)(pr + C_K + hh * 64 + dq * 16), k1 = *(const v4u*)(pr + C_K + hh * 64 + dq * 16 + 8), q0 = *(const v4u*)(pr + C_Q + hh * 64 + dq * 16), q1 = *(const v4u*)(pr + C_Q + hh * 64 + dq * 16 + 8);
                        const float Kv[16] = {bflo(k0.x), bfhi(k0.x), bflo(k0.y), bfhi(k0.y), bflo(k0.z), bfhi(k0.z), bflo(k0.w), bfhi(k0.w), bflo(k1.x), bfhi(k1.x), bflo(k1.y), bfhi(k1.y), bflo(k1.z), bfhi(k1.z), bflo(k1.w), bfhi(k1.w)};
                        const float Qv[16] = {bflo(q0.x), bfhi(q0.x), bflo(q0.y), bfhi(q0.y), bflo(q0.z), bfhi(q0.z), bflo(q0.w), bfhi(q0.w), bflo(q1.x), bfhi(q1.x), bflo(q1.y), bfhi(q1.y), bflo(q1.z), bfhi(q1.z), bflo(q1.w), bfhi(q1.w)};
                        float acc = 0.f;
#pragma unroll
                        for (int j = 0; j < 16; ++j) { S[j] = gamma * S[j] + Kv[j] * vv; acc += Qv[j] * S[j]; }
                        acc += __shfl_xor(acc, 1); acc += __shfl_xor(acc, 2);
                        if (dq == 0) BR[row * 2048 + 1024 + hh * 64 + e] = (bf16)f2bf(acc);
                    }
                } else if (wu < 768) {
                    const int un = wu - 512, b = un >> 5, g = un & 31, n = lane;
                    const float* lam_re = opqp(p.in[6]) + layer * 2048; const float* lam_im = opqp(p.in[7]) + layer * 2048; const float* b_re = opqp(p.in[8]) + layer * 32768; const float* b_im = opqp(p.in[9]) + layer * 32768;
                    const float* c_re = opqp(p.in[10]) + layer * 32768; const float* c_im = opqp(p.in[11]) + layer * 32768; const float* dsk = opqp(p.in[12]) + layer * 512;
                    const float lr = lam_re[g * 64 + n], li = lam_im[g * 64 + n], step = expf(opqp(p.in[13])[layer * 32 + g]);
                    const float mag = expf(lr * step), ar = mag * cosf(li * step), ai = mag * sinf(li * step);
                    const float inv = 1.0f / (lr * lr + li * li);
                    const float cr = ((ar - 1.0f) * lr + ai * li) * inv, ci = (ai * lr - (ar - 1.0f) * li) * inv;
                    float bbr[16], bbi[16], cre[16], cim[16];
#pragma unroll
                    for (int h = 0; h < 16; ++h) { const float br_ = b_re[(g * 64 + n) * 16 + h], bi_ = b_im[(g * 64 + n) * 16 + h];
                        bbr[h] = cr * br_ - ci * bi_; bbi[h] = cr * bi_ + ci * br_; cre[h] = c_re[(g * 16 + h) * 64 + n]; cim[h] = c_im[(g * 16 + h) * 64 + n]; }
                    const float dmine = dsk[g * 16 + (n & 15)];
                    float sr = 0.f, si = 0.f;
                    for (int t = 0; t < L; ++t) {
                        const size_t row = (size_t)b * L + t; const bf16* up = PROJB + row * PJ + C_U + g * 16;
                        const v4u u0 = *(const v4u*)up, u1 = *(const v4u*)(up + 8);
                        const float u[16] = {bflo(u0.x), bfhi(u0.x), bflo(u0.y), bfhi(u0.y), bflo(u0.z), bfhi(u0.z), bflo(u0.w), bfhi(u0.w), bflo(u1.x), bfhi(u1.x), bflo(u1.y), bfhi(u1.y), bflo(u1.z), bfhi(u1.z), bflo(u1.w), bfhi(u1.w)};
                        float bur = 0.f, bui = 0.f;
#pragma unroll
                        for (int h = 0; h < 16; ++h) { bur += u[h] * bbr[h]; bui += u[h] * bbi[h]; }
                        const float nr = ar * sr - ai * si + bur, ni = ar * si + ai * sr + bui; sr = nr; si = ni;
                        float mine = 0.f, umine = 0.f;
#pragma unroll
                        for (int h = 0; h < 16; ++h) { const float y = wave_sum(sr * cre[h] - si * cim[h]); if (n == h) { mine = y; umine = u[h]; } }
                        if (n < 16) YS[row * 512 + g * 16 + n] = (bf16)f2bf(gelu_tanh(mine + dmine * umine));
                    }
                } else {
                    const int un = wu - 768, b = un >> 3, blk = un & 7, j = lane;
                    LAS bf16* wA = (LAS bf16*)scr; LAS bf16* wX = wA + 4096;
                    for (int i = 0; i < 64; ++i) { wA[i * 64 + j] = (bf16)f2bf(opqp(p.in[24])[layer * 32768 + (blk * 64 + i) * 64 + j]); wX[i * 64 + j] = (bf16)f2bf(opqp(p.in[26])[layer * 32768 + (blk * 64 + i) * 64 + j]); }
                    LDS_WAIT();
                    const float bA = opqp(p.in[25])[layer * 512 + blk * 64 + j], bX = opqp(p.in[27])[layer * 512 + blk * 64 + j], sp = softplusf_(-opqp(p.in[28])[layer * 512 + blk * 64 + j]);
                    float hs = 0.f;
                    for (int t = 0; t < L; ++t) {
                        const size_t row = (size_t)b * L + t;
                        const float xc = bf1(XLC[row * 512 + blk * 64 + j]);
                        float ra = bA, ri = bX;
#pragma unroll
                        for (int i = 0; i < 64; ++i) { const float xi = __shfl(xc, i); ra += xi * bf1(wA[i * 64 + j]); ri += xi * bf1(wX[i * 64 + j]); }
                        const float r = sigmoidf_(ra), ig = sigmoidf_(ri);
                        const float log_a = -8.0f * r * sp, a = __expf(log_a);
                        const float mult = sqrtf(fmaxf(-expm1f(2.0f * log_a), 0.f));
                        hs = a * hs + mult * ig * xc;
                        BR[row * 2048 + 1536 + blk * 64 + j] = (bf16)f2bf(hs * gelu_tanh(bf1(PROJB[row * PJ + C_GL + blk * 64 + j])));
                    }
                }
            }
#else
            for (int wu = gw; wu < 768; wu += NGW) {
                LAS unsigned char* sl = (LAS unsigned char*)scr;
                if (wu < 256) {
                    const int ty = wu >> 7, uu = wu & 127, b = uu >> 4, hh = (uu >> 1) & 7, eh = uu & 1; const size_t r0 = (size_t)b * L;
                    if (ty == 0) { const int g = hh >> 2; const float Aa = -__expf(opqp(p.in[18])[layer * 8 + hh]);
                        linattn_unit(XBCC + r0 * 768 + 640 + g * 64, 768, XBCC + r0 * 768 + 512 + g * 64, 768, XBCC + r0 * 768 + hh * 64 + eh * 32, 768, DT + r0 * 8 + hh, Aa * 1.4426950408889634f, opqp(p.in[19])[layer * 8 + hh],
                                     BR + r0 * 2048 + 512 + hh * 64 + eh * 32, 2048, sl, lane); }
                    else { const float lg = log2f(1.0f - exp2f(-5.0f - (float)hh));
                        linattn_unit(PROJB + r0 * PJ + C_Q + hh * 64, PJ, PROJB + r0 * PJ + C_K + hh * 64, PJ, PROJB + r0 * PJ + C_V + hh * 64 + eh * 32, PJ, nullptr, lg, 0.f,
                                     BR + r0 * 2048 + 1024 + hh * 64 + eh * 32, 2048, sl, lane); }
                } else if (wu < 512) {
                    const int un = wu - 256, b = un >> 5, g = un & 31; const size_t r0 = (size_t)b * L;
                    s5_unit(PROJB + r0 * PJ + C_U + g * 16, YS + r0 * 512 + g * 16, opqp(p.in[6]) + layer * 2048 + g * 64, opqp(p.in[7]) + layer * 2048 + g * 64, opqp(p.in[8]) + layer * 32768 + g * 1024, opqp(p.in[9]) + layer * 32768 + g * 1024,
                            opqp(p.in[10]) + layer * 32768 + g * 1024, opqp(p.in[11]) + layer * 32768 + g * 1024, opqp(p.in[12]) + layer * 512 + g * 16, expf(opqp(p.in[13])[layer * 32 + g]), sl, lane);
                } else {
                    const int un = wu - 512, b = un >> 5, blk = (un >> 2) & 7, jq = un & 3, ch = blk * 64 + jq * 16 + (lane & 15); const size_t r0 = (size_t)b * L;
                    lru_unit(XLC + r0 * 512 + blk * 64, PROJB + r0 * PJ + C_GL + blk * 64 + jq * 16, BR + r0 * 2048 + 1536 + blk * 64 + jq * 16, opqp(p.in[24]) + layer * 32768 + blk * 4096, opqp(p.in[26]) + layer * 32768 + blk * 4096,
                             opqp(p.in[25])[layer * 512 + ch], opqp(p.in[27])[layer * 512 + ch], softplusf_(-opqp(p.in[28])[layer * 512 + ch]), jq, lane);
                }
            }
#endif
            GRID_BAR();
        }
        if (IN(pb + 3)) { PH_VARS
            const float* snw = opqp(p.in[20]) + layer * 512; const float* rnw = opqp(p.in[21]) + layer * 512;
            for (int row = gw; row < T; row += NGW) {
                bf16* y = BR + (size_t)row * 2048; const bf16* pr = PROJB + (size_t)row * PJ;
                {
                    const v4u yw = *(const v4u*)(y + 512 + 8 * lane), zw = *(const v4u*)(pr + C_Z + 8 * lane);
                    float v[8] = {bflo(yw.x), bfhi(yw.x), bflo(yw.y), bfhi(yw.y), bflo(yw.z), bfhi(yw.z), bflo(yw.w), bfhi(yw.w)};
                    const float z[8] = {bflo(zw.x), bfhi(zw.x), bflo(zw.y), bfhi(zw.y), bflo(zw.z), bfhi(zw.z), bflo(zw.w), bfhi(zw.w)};
                    float ss = 0.f;
#pragma unroll
                    for (int q = 0; q < 8; ++q) { v[q] *= siluf_(z[q]); ss += v[q] * v[q]; }
                    const float r = 1.0f / sqrtf(wave_sum(ss) * (1.0f / 512.0f) + 1e-6f);
#pragma unroll
                    for (int q = 0; q < 8; ++q) v[q] *= r * snw[8 * lane + q];
                    v4u o; o.x = pk2(v[0], v[1]); o.y = pk2(v[2], v[3]); o.z = pk2(v[4], v[5]); o.w = pk2(v[6], v[7]);
                    *(v4u*)(y + 512 + 8 * lane) = o;
                }
                {
                    const v4u yw = *(const v4u*)(y + 1024 + 8 * lane), gw_ = *(const v4u*)(pr + C_G + 8 * lane);
                    float v[8] = {bflo(yw.x), bfhi(yw.x), bflo(yw.y), bfhi(yw.y), bflo(yw.z), bfhi(yw.z), bflo(yw.w), bfhi(yw.w)};
                    const float gg[8] = {bflo(gw_.x), bfhi(gw_.x), bflo(gw_.y), bfhi(gw_.y), bflo(gw_.z), bfhi(gw_.z), bflo(gw_.w), bfhi(gw_.w)};
                    float s = 0.f;
#pragma unroll
                    for (int q = 0; q < 8; ++q) s += v[q];
                    s += __shfl_xor(s, 1); s += __shfl_xor(s, 2); s += __shfl_xor(s, 4);
                    const float mu = s * (1.0f / 64.0f); float q2 = 0.f;
#pragma unroll
                    for (int q = 0; q < 8; ++q) { v[q] -= mu; q2 += v[q] * v[q]; }
                    q2 += __shfl_xor(q2, 1); q2 += __shfl_xor(q2, 2); q2 += __shfl_xor(q2, 4);
                    const float rs = 1.0f / sqrtf(q2 * (1.0f / 64.0f) + 1e-6f);
#pragma unroll
                    for (int q = 0; q < 8; ++q) v[q] = siluf_(gg[q]) * (v[q] * rs * rnw[8 * lane + q]);
                    v4u o; o.x = pk2(v[0], v[1]); o.y = pk2(v[2], v[3]); o.z = pk2(v[4], v[5]); o.w = pk2(v[6], v[7]);
                    *(v4u*)(y + 1024 + 8 * lane) = o;
                }
            }
            pg8::Gemm g{512, 512, 512}; pg8::PlainOrder S; S.A = (const char*)HN; S.B = (const char*)WGLU; S.nM = 64; S.nN = 2; S.lda = 512; S.ldb = 512; S.G = G; S.c = bx;
            pg8::EpiGlu E{HN, BR};
            pg8::gemm_phase<pg8::EpiGlu, pg8::PlainOrder, false, false>(lds, g, S, E, wave_s);
            GRID_BAR();
        }
        if (IN(pb + 4)) { PH_VARS
#ifdef MK_EXP_A
            pg8::Gemm g{2048, 2048, 2048}; pg8::PlainOrder S; S.A = (const char*)BR; S.B = (const char*)WB; S.nM = 64; S.nN = 4; S.lda = 2048; S.ldb = 2048; S.G = G; S.c = bx;
            pg8::EpiStore E{MERGED, 1024};
            pg8::gemm_phase<pg8::EpiStore, pg8::PlainOrder, false, false>(lds, g, S, E, wave_s);
#else
            pg8::Gemm g{2048, 2048, 512}; pg8::MergeOrder S; S.br_ = (const char*)BR; S.wb_ = (const char*)WB; S.G = G; S.c = bx;
            pg8::EpiMerge E{GATE, MERGED};
            pg8::gemm_phase<pg8::EpiMerge, pg8::MergeOrder, false, false>(lds, g, S, E, wave_s);
#endif
            GRID_BAR();
        }
        if (IN(pb + 5)) { PH_VARS
            pg8::Gemm g{1024, 1024, 1024}; pg8::PlainOrder S; S.A = (const char*)MERGED; S.B = (const char*)WOUT; S.nM = 64; S.nN = 4; S.lda = 1024; S.ldb = 1024; S.G = G; S.c = bx;
            pg8::EpiRes E{layer == 0 ? x_ : (const float*)H, H};
            pg8::gemm_phase<pg8::EpiRes, pg8::PlainOrder, false, false>(lds, g, S, E, wave_s);
            GRID_BAR();
        }
        if (IN(pb + 6)) { PH_VARS
            for (int row = gw; row < T; row += NGW) { f32x4 v[4]; (void)norm_row(H + (size_t)row * D, HN + (size_t)row * D, lane, v); }
            GRID_BAR();
        }
        if (IN(pb + 7)) { PH_VARS
            pg8::Gemm g{1024, 1024, 1024}; pg8::PlainOrder S; S.A = (const char*)HN; S.B = (const char*)WQ; S.nM = 64; S.nN = 4; S.lda = 1024; S.ldb = 1024; S.G = G; S.c = bx;
            pg8::EpiStore E{XQ, 1024};
            pg8::gemm_phase<pg8::EpiStore, pg8::PlainOrder, false, false>(lds, g, S, E, wave_s);
            GRID_BAR();
        }
        if (IN(pb + 8)) { PH_VARS
            pg8::Gemm g{1024, 1024, 256}; pg8::QKOrder S; S.xq_ = (const char*)XQ; S.kx_ = (const char*)KX; S.G = G; S.c = bx;
            pg8::EpiSoftmax E{PB, (PG8_LAS float*)xch};
            for (int sb = 0; sb < 256; sb += G) { S.base = sb; pg8::gemm_phase<pg8::EpiSoftmax, pg8::QKOrder, false, false>(lds, g, S, E, wave_s); }
            GRID_BAR();
        }
        if (IN(pb + 9)) { PH_VARS
            pg8::Gemm g{1024, 256, 256}; pg8::PVOrder S; S.p_ = (const char*)PB; S.vt_ = (const char*)VT; S.G = G; S.c = bx;
            pg8::EpiStore E{XO, 1024};
            pg8::gemm_phase<pg8::EpiStore, pg8::PVOrder, false, false>(lds, g, S, E, wave_s);
            GRID_BAR();
        }
        if (IN(pb + 10)) { PH_VARS
            pg8::Gemm g{1024, 1024, 1024}; pg8::PlainOrder S; S.A = (const char*)XO; S.B = (const char*)WO; S.nM = 64; S.nN = 4; S.lda = 1024; S.ldb = 1024; S.G = G; S.c = bx;
            pg8::EpiRes E{H, H};
            pg8::gemm_phase<pg8::EpiRes, pg8::PlainOrder, false, false>(lds, g, S, E, wave_s);
            GRID_BAR();
        }
        if (layer == 0) {
            if (IN(pb + 11)) { PH_VARS
                for (int row = gw; row < T; row += NGW) { f32x4 v[4]; (void)norm_row(H + (size_t)row * D, HN + (size_t)row * D, lane, v); }
                GRID_BAR();
            }
            if (IN(pb + 12)) { PH_VARS
                pg8::Gemm g{1024, 1024, 1024}; pg8::PlainOrder S; S.A = (const char*)HN; S.B = (const char*)W13; S.nM = 64; S.nN = 22; S.lda = 1024; S.ldb = 1024; S.G = G; S.c = bx;
                pg8::EpiSwiglu E{ACT, DFF};
                pg8::gemm_phase<pg8::EpiSwiglu, pg8::PlainOrder, false, false>(lds, g, S, E, wave_s);
                GRID_BAR();
            }
            if (IN(pb + 13)) { PH_VARS
                pg8::Gemm g{DFF, DFF, DFF}; pg8::PlainOrder S; S.A = (const char*)ACT; S.B = (const char*)W2T; S.nM = 64; S.nN = 4; S.lda = DFF; S.ldb = DFF; S.G = G; S.c = bx;
                pg8::EpiRes E{H, H};
                pg8::gemm_phase<pg8::EpiRes, pg8::PlainOrder, false, false>(lds, g, S, E, wave_s);
                GRID_BAR();
            }
            if (IN(pb + 14)) { PH_VARS
                for (int i = tid; i < 8192; i += 512) w8[i] = norm_mix[D + (i >> 3)] * w_in[(size_t)D * IN_TOTAL + (size_t)(i >> 3) * IN_TOTAL + O_DT + (i & 7)];
                __syncthreads();
                for (int row = gw; row < T; row += NGW) { f32x4 v[4]; const float r = norm_row(H + (size_t)row * D, HN + (size_t)row * D, lane, v); float lg[8]; row_dot8(v, w8, lane, lg);
                    float mine = 0.f;
#pragma unroll
                    for (int e = 0; e < 8; ++e) if (lane == e) mine = lg[e];
                    if (lane < 8) DT[(size_t)row * 8 + lane] = softplusf_(r * mine + opqp(p.in[17])[8 + lane]); }
                __syncthreads();
                GRID_BAR();
            }
        } else {
            if (IN(pb + 11)) { PH_VARS
                for (int i = tid; i < 8192; i += 512) w8[i] = norm_ffn[D + (i >> 3)] * moe_router[i];
                __syncthreads();
                for (int row = gw; row < T; row += NGW) { f32x4 v[4]; const float r = norm_row(H + (size_t)row * D, HN + (size_t)row * D, lane, v); float lg[8]; row_dot8(v, w8, lane, lg);
                    if (lane == 0) {
                        int i1 = 0; float v1 = lg[0];
#pragma unroll
                        for (int e = 1; e < 8; ++e) if (lg[e] > v1) { v1 = lg[e]; i1 = e; }
                        int i2 = 0; float v2 = -3.0e38f;
#pragma unroll
                        for (int e = 0; e < 8; ++e) if (e != i1 && lg[e] > v2) { v2 = lg[e]; i2 = e; }
                        const float w1 = 1.0f / (1.0f + expf(r * (v2 - v1))), w2 = 1.0f - w1;
                        const int r1 = atomicAdd(&CNT[i1], 1), r2 = atomicAdd(&CNT[i2], 1);
                        TOPI[row] = (i32x4){i1, i2, r1, r2}; TOPW[row] = (f32x2){w1, w2};
                    } }
                __syncthreads();
                {
                    int rot = 0;
                    for (int e = 0; e < NE; ++e) {
                        CVT_LOOP(16 * 224, MapW13 m{moe_w1 + (size_t)e * D * DFE, moe_w3 + (size_t)e * D * DFE, norm_ffn + D, W13E + (size_t)e * 2 * DFE * D, DFE, 2 * DFE});
                        CVT_LOOP(56 * 32, MapPlain m{moe_w2 + (size_t)e * DFE * D, DFE, D, nullptr, 1.f, W2E + (size_t)e * D * DFE, DFE});
                    }
                }
                GRID_BAR();
            }
            int t1 = 0, t2 = 0, t3 = 0, t4 = 0, t5 = 0, t6 = 0, t7 = 0, ntiles = 0;
            if (lo <= pb + 14 && hi > pb + 12) {
                int acc = 0;
#pragma unroll
                for (int e = 0; e < 8; ++e) { const int c = __hip_atomic_load(&CNT[e], RLX_AGENT); acc += (c + 255) >> 8;
                    if (e == 0) t1 = acc; if (e == 1) t2 = acc; if (e == 2) t3 = acc; if (e == 3) t4 = acc; if (e == 4) t5 = acc; if (e == 5) t6 = acc; if (e == 6) t7 = acc; if (e == 7) ntiles = acc; }
            }
            if (IN(pb + 12)) { PH_VARS
                for (int row = gw; row < T; row += NGW) {
                    const i32x4 ti = TOPI[row];
                    const int e1 = ti.x, e2 = ti.y;
                    const int s1 = (e1 == 0 ? 0 : e1 == 1 ? t1 : e1 == 2 ? t2 : e1 == 3 ? t3 : e1 == 4 ? t4 : e1 == 5 ? t5 : e1 == 6 ? t6 : t7) * 256 + ti.z;
                    const int s2 = (e2 == 0 ? 0 : e2 == 1 ? t1 : e2 == 2 ? t2 : e2 == 3 ? t3 : e2 == 4 ? t4 : e2 == 5 ? t5 : e2 == 6 ? t6 : t7) * 256 + ti.w;
                    const v4u a = *((const v4u*)(HN + (size_t)row * D) + lane), b = *((const v4u*)(HN + (size_t)row * D) + 64 + lane);
                    v4u* d1 = (v4u*)(XS + (size_t)s1 * D); v4u* d2 = (v4u*)(XS + (size_t)s2 * D);
                    d1[lane] = a; d1[64 + lane] = b; d2[lane] = a; d2[64 + lane] = b;
                    if (lane == 0) SLOT[row] = (i32x2){s1, s2};
                }
                GRID_BAR();
            }
            if (IN(pb + 13)) { PH_VARS
                pg8::Gemm g{1024, 1024, 1024}; pg8::MoeOrder S; S.A = (const char*)XS; S.B = (const char*)W13E; S.estride = (size_t)2 * DFE * D * 2; S.lda = 1024; S.ldb = 1024; S.ntiles = ntiles; S.nN = 28; S.G = G; S.c = bx;
                S.t1 = t1; S.t2 = t2; S.t3 = t3; S.t4 = t4; S.t5 = t5; S.t6 = t6; S.t7 = t7;
                pg8::EpiSwiglu E{ACTE, DFE};
                pg8::gemm_phase<pg8::EpiSwiglu, pg8::MoeOrder, false, false>(lds, g, S, E, wave_s);
                GRID_BAR();
            }
            if (IN(pb + 14)) { PH_VARS
                pg8::Gemm g{DFE, DFE, DFE}; pg8::MoeOrder S; S.A = (const char*)ACTE; S.B = (const char*)W2E; S.estride = (size_t)D * DFE * 2; S.lda = DFE; S.ldb = DFE; S.ntiles = ntiles; S.nN = 4; S.G = G; S.c = bx;
                S.t1 = t1; S.t2 = t2; S.t3 = t3; S.t4 = t4; S.t5 = t5; S.t6 = t6; S.t7 = t7;
                pg8::EpiStore E{XS, 1024};
                pg8::gemm_phase<pg8::EpiStore, pg8::MoeOrder, false, false>(lds, g, S, E, wave_s);
                GRID_BAR();
            }
            if (IN(pb + 15)) { PH_VARS
                const unsigned bad = __hip_atomic_load(ctl + CW_BAR + XB_TMO, RLX_AGENT);
                for (int row = gw; row < T; row += NGW) {
                    const i32x2 sl = SLOT[row]; const f32x2 tw = TOPW[row];
                    const f32x4* hr = (const f32x4*)(H + (size_t)row * D) + lane; const v2u* y1 = (const v2u*)(XS + (size_t)sl.x * D) + lane; const v2u* y2 = (const v2u*)(XS + (size_t)sl.y * D) + lane;
                    f32x4 v[4]; float ss = 0.f;
#pragma unroll
                    for (int j = 0; j < 4; ++j) { v[j] = hr[64 * j]; const v2u a = y1[64 * j], b = y2[64 * j];
                        v[j].x += tw.x * bflo(a.x) + tw.y * bflo(b.x); v[j].y += tw.x * bfhi(a.x) + tw.y * bfhi(b.x); v[j].z += tw.x * bflo(a.y) + tw.y * bflo(b.y); v[j].w += tw.x * bfhi(a.y) + tw.y * bfhi(b.y);
                        ss += (v[j].x * v[j].x + v[j].y * v[j].y) + (v[j].z * v[j].z + v[j].w * v[j].w); }
                    float r = 1.0f / sqrtf(wave_sum(ss) * (1.0f / 1024.0f) + 1e-6f);
                    if (bad) r = __builtin_nanf("");
                    f32x4* orow = (f32x4*)(H + (size_t)row * D) + lane;
#pragma unroll
                    for (int j = 0; j < 4; ++j) { const f32x4 g4 = *((const f32x4*)norm_final + lane + 64 * j); orow[64 * j] = v[j] * r * g4; }
                }
            }
        }
        }
    { constexpr int layer = 1;
        const int pb = 1 + layer * 20;
#define WLP (ws + WS_W + (size_t)layer * WL_STRIDE)
#define WIN ((const bf16*)(WLP + WL_WIN))
#define WGLU ((const bf16*)(WLP + WL_GLU))
#define WB ((const bf16*)(WLP + WL_WB))
#define WOUT ((const bf16*)(WLP + WL_WOUT))
#define WQ ((const bf16*)(WLP + WL_WQ))
#define WO ((const bf16*)(WLP + WL_WO))
#define KX (KVB + (size_t)layer * 4194304)
#define VT (KX + 2097152)
        if (IN(pb + 0)) { PH_VARS
            if (layer == 0) {
                pg8::Gemm g{1024, 1024, 1024}; pg8::KVOrder S; S.mnr_ = (const char*)MNR; S.WKV0 = (const char*)(ws + WS_W + WL_WKV); S.WKV1 = (const char*)(ws + WS_W + WL_STRIDE + WL_WKV); S.G = G; S.c = bx;
                pg8::EpiKV E{KVB};
                pg8::gemm_phase<pg8::EpiKV, pg8::KVOrder, false, false>(lds, g, S, E, wave_s);
            }
            pg8::Gemm g{1024, 1024, 1024}; pg8::PlainOrder S; S.A = (const char*)HN; S.B = (const char*)WIN; S.nM = 64; S.nN = 35; S.lda = 1024; S.ldb = 1024; S.G = G; S.c = bx;
            pg8::EpiProj E{PROJB, GATE, b_gate + layer * 4096};
            pg8::gemm_phase<pg8::EpiProj, pg8::PlainOrder, false, false>(lds, g, S, E, wave_s);
            GRID_BAR();
        }
        if (IN(pb + 1)) { PH_VARS
            const float* cw = opqp(p.in[15]) + layer * 4 * 768; const float* cb = opqp(p.in[16]) + layer * 768; const float* lw = opqp(p.in[22]) + layer * 4 * 512; const float* lb = opqp(p.in[23]) + layer * 512;
            for (int it = gt; it < T * 224; it += NGT) {
                const int row = it / 224, j = it % 224, t = row & (L - 1);
                if (j < 160) {
                    const bool isx = j < 96; const int c0 = isx ? j * 8 : (j - 96) * 8, C = isx ? 768 : 512; const float* w = isx ? cw : lw; const float* bb = isx ? cb : lb;
                    const bf16* src = PROJB + (size_t)row * PJ + (isx ? C_XBC : C_XL) + c0;
                    float acc[8];
#pragma unroll
                    for (int q = 0; q < 8; ++q) acc[q] = bb[c0 + q];
#pragma unroll
                    for (int tap = 0; tap < 4; ++tap) { if (t - 3 + tap >= 0) { const v4u xv = *(const v4u*)(src - (ptrdiff_t)(3 - tap) * PJ); const float* wt = w + tap * C + c0;
                        acc[0] += wt[0] * bflo(xv.x); acc[1] += wt[1] * bfhi(xv.x); acc[2] += wt[2] * bflo(xv.y); acc[3] += wt[3] * bfhi(xv.y);
                        acc[4] += wt[4] * bflo(xv.z); acc[5] += wt[5] * bfhi(xv.z); acc[6] += wt[6] * bflo(xv.w); acc[7] += wt[7] * bfhi(xv.w); } }
                    if (isx) {
#pragma unroll
                        for (int q = 0; q < 8; ++q) acc[q] = siluf_(acc[q]); }
                    v4u o; o.x = pk2(acc[0], acc[1]); o.y = pk2(acc[2], acc[3]); o.z = pk2(acc[4], acc[5]); o.w = pk2(acc[6], acc[7]);
                    *(v4u*)((isx ? XBCC + (size_t)row * 768 : XLC + (size_t)row * 512) + c0) = o;
                } else {
                    const bool isk = j >= 192; const int jj = isk ? j - 192 : j - 160, h = jj >> 2, i0 = (jj & 3) * 8; const float sc = isk ? 0.125f : 1.0f;
                    bf16* q1 = PROJB + (size_t)row * PJ + (isk ? C_K : C_Q) + h * 64 + i0; bf16* q2 = q1 + 32;
                    const v4u a = *(const v4u*)q1, b = *(const v4u*)q2;
                    const f32x4 c0v = *(const f32x4*)(COS + (size_t)row * 32 + i0), c1v = *(const f32x4*)(COS + (size_t)row * 32 + i0 + 4), s0v = *(const f32x4*)(SIN + (size_t)row * 32 + i0), s1v = *(const f32x4*)(SIN + (size_t)row * 32 + i0 + 4);
                    const float x1[8] = {bflo(a.x), bfhi(a.x), bflo(a.y), bfhi(a.y), bflo(a.z), bfhi(a.z), bflo(a.w), bfhi(a.w)};
                    const float x2[8] = {bflo(b.x), bfhi(b.x), bflo(b.y), bfhi(b.y), bflo(b.z), bfhi(b.z), bflo(b.w), bfhi(b.w)};
                    const float cc[8] = {c0v.x, c0v.y, c0v.z, c0v.w, c1v.x, c1v.y, c1v.z, c1v.w}, ss[8] = {s0v.x, s0v.y, s0v.z, s0v.w, s1v.x, s1v.y, s1v.z, s1v.w};
                    float o1[8], o2[8];
#pragma unroll
                    for (int q = 0; q < 8; ++q) { o1[q] = (x1[q] * cc[q] - x2[q] * ss[q]) * sc; o2[q] = (x2[q] * cc[q] + x1[q] * ss[q]) * sc; }
                    v4u w1; w1.x = pk2(o1[0], o1[1]); w1.y = pk2(o1[2], o1[3]); w1.z = pk2(o1[4], o1[5]); w1.w = pk2(o1[6], o1[7]);
                    v4u w2; w2.x = pk2(o2[0], o2[1]); w2.y = pk2(o2[2], o2[3]); w2.z = pk2(o2[4], o2[5]); w2.w = pk2(o2[6], o2[7]);
                    *(v4u*)q1 = w1; *(v4u*)q2 = w2;
                }
            }
            GRID_BAR();
        }
        if (IN(pb + 2)) { PH_VARS
            bf16* YS = HN;
#ifdef MK_NAIVE_MIX
            for (int wu = gw; wu < 832; wu += NGW) {
                if (wu < 256) {
                    const int un = wu >> 2, sub = wu & 3, b = un >> 3, hh = un & 7, g = hh >> 2, pp = sub * 16 + (lane >> 2), nq = lane & 3;
                    const float Aa = -__expf(opqp(p.in[18])[layer * 8 + hh]), Dk = opqp(p.in[19])[layer * 8 + hh];
                    float S[16];
#pragma unroll
                    for (int j = 0; j < 16; ++j) S[j] = 0.f;
                    for (int t = 0; t < L; ++t) {
                        const size_t row = (size_t)b * L + t; const bf16* xr = XBCC + row * 768;
                        const float dtv = DT[row * 8 + hh], xv = bf1(xr[hh * 64 + pp]);
                        const v4u b0 = *(const v4u*)(xr + 512 + g * 64 + nq * 16), b1 = *(const v4u*)(xr + 512 + g * 64 + nq * 16 + 8), c0 = *(const v4u*)(xr + 640 + g * 64 + nq * 16), c1 = *(const v4u*)(xr + 640 + g * 64 + nq * 16 + 8);
                        const float Bv[16] = {bflo(b0.x), bfhi(b0.x), bflo(b0.y), bfhi(b0.y), bflo(b0.z), bfhi(b0.z), bflo(b0.w), bfhi(b0.w), bflo(b1.x), bfhi(b1.x), bflo(b1.y), bfhi(b1.y), bflo(b1.z), bfhi(b1.z), bflo(b1.w), bfhi(b1.w)};
                        const float Cv[16] = {bflo(c0.x), bfhi(c0.x), bflo(c0.y), bfhi(c0.y), bflo(c0.z), bfhi(c0.z), bflo(c0.w), bfhi(c0.w), bflo(c1.x), bfhi(c1.x), bflo(c1.y), bfhi(c1.y), bflo(c1.z), bfhi(c1.z), bflo(c1.w), bfhi(c1.w)};
                        const float da = __expf(dtv * Aa), xdt = xv * dtv; float acc = 0.f;
#pragma unroll
                        for (int j = 0; j < 16; ++j) { S[j] = da * S[j] + xdt * Bv[j]; acc += Cv[j] * S[j]; }
                        acc += __shfl_xor(acc, 1); acc += __shfl_xor(acc, 2);
                        if (nq == 0) BR[row * 2048 + 512 + hh * 64 + pp] = (bf16)f2bf(acc + Dk * xv);
                    }
                } else if (wu < 512) {
                    const int un = (wu - 256) >> 2, sub = wu & 3, b = un >> 3, hh = un & 7, e = sub * 16 + (lane >> 2), dq = lane & 3;
                    const float gamma = 1.0f - exp2f(-5.0f - (float)hh);
                    float S[16];
#pragma unroll
                    for (int j = 0; j < 16; ++j) S[j] = 0.f;
                    for (int t = 0; t < L; ++t) {
                        const size_t row = (size_t)b * L + t; const bf16* pr = PROJB + row * PJ;
                        const float vv = bf1(pr[C_V + hh * 64 + e]);
                        const v4u k0 = *(const v4u*)(pr + C_K + hh * 64 + dq * 16), k1 = *(const v4u*)(pr + C_K + hh * 64 + dq * 16 + 8), q0 = *(const v4u*)(pr + C_Q + hh * 64 + dq * 16), q1 = *(const v4u*)(pr + C_Q + hh * 64 + dq * 16 + 8);
                        const float Kv[16] = {bflo(k0.x), bfhi(k0.x), bflo(k0.y), bfhi(k0.y), bflo(k0.z), bfhi(k0.z), bflo(k0.w), bfhi(k0.w), bflo(k1.x), bfhi(k1.x), bflo(k1.y), bfhi(k1.y), bflo(k1.z), bfhi(k1.z), bflo(k1.w), bfhi(k1.w)};
                        const float Qv[16] = {bflo(q0.x), bfhi(q0.x), bflo(q0.y), bfhi(q0.y), bflo(q0.z), bfhi(q0.z), bflo(q0.w), bfhi(q0.w), bflo(q1.x), bfhi(q1.x), bflo(q1.y), bfhi(q1.y), bflo(q1.z), bfhi(q1.z), bflo(q1.w), bfhi(q1.w)};
                        float acc = 0.f;
#pragma unroll
                        for (int j = 0; j < 16; ++j) { S[j] = gamma * S[j] + Kv[j] * vv; acc += Qv[j] * S[j]; }
                        acc += __shfl_xor(acc, 1); acc += __shfl_xor(acc, 2);
                        if (dq == 0) BR[row * 2048 + 1024 + hh * 64 + e] = (bf16)f2bf(acc);
                    }
                } else if (wu < 768) {
                    const int un = wu - 512, b = un >> 5, g = un & 31, n = lane;
                    const float* lam_re = opqp(p.in[6]) + layer * 2048; const float* lam_im = opqp(p.in[7]) + layer * 2048; const float* b_re = opqp(p.in[8]) + layer * 32768; const float* b_im = opqp(p.in[9]) + layer * 32768;
                    const float* c_re = opqp(p.in[10]) + layer * 32768; const float* c_im = opqp(p.in[11]) + layer * 32768; const float* dsk = opqp(p.in[12]) + layer * 512;
                    const float lr = lam_re[g * 64 + n], li = lam_im[g * 64 + n], step = expf(opqp(p.in[13])[layer * 32 + g]);
                    const float mag = expf(lr * step), ar = mag * cosf(li * step), ai = mag * sinf(li * step);
                    const float inv = 1.0f / (lr * lr + li * li);
                    const float cr = ((ar - 1.0f) * lr + ai * li) * inv, ci = (ai * lr - (ar - 1.0f) * li) * inv;
                    float bbr[16], bbi[16], cre[16], cim[16];
#pragma unroll
                    for (int h = 0; h < 16; ++h) { const float br_ = b_re[(g * 64 + n) * 16 + h], bi_ = b_im[(g * 64 + n) * 16 + h];
                        bbr[h] = cr * br_ - ci * bi_; bbi[h] = cr * bi_ + ci * br_; cre[h] = c_re[(g * 16 + h) * 64 + n]; cim[h] = c_im[(g * 16 + h) * 64 + n]; }
                    const float dmine = dsk[g * 16 + (n & 15)];
                    float sr = 0.f, si = 0.f;
                    for (int t = 0; t < L; ++t) {
                        const size_t row = (size_t)b * L + t; const bf16* up = PROJB + row * PJ + C_U + g * 16;
                        const v4u u0 = *(const v4u*)up, u1 = *(const v4u*)(up + 8);
                        const float u[16] = {bflo(u0.x), bfhi(u0.x), bflo(u0.y), bfhi(u0.y), bflo(u0.z), bfhi(u0.z), bflo(u0.w), bfhi(u0.w), bflo(u1.x), bfhi(u1.x), bflo(u1.y), bfhi(u1.y), bflo(u1.z), bfhi(u1.z), bflo(u1.w), bfhi(u1.w)};
                        float bur = 0.f, bui = 0.f;
#pragma unroll
                        for (int h = 0; h < 16; ++h) { bur += u[h] * bbr[h]; bui += u[h] * bbi[h]; }
                        const float nr = ar * sr - ai * si + bur, ni = ar * si + ai * sr + bui; sr = nr; si = ni;
                        float mine = 0.f, umine = 0.f;
#pragma unroll
                        for (int h = 0; h < 16; ++h) { const float y = wave_sum(sr * cre[h] - si * cim[h]); if (n == h) { mine = y; umine = u[h]; } }
                        if (n < 16) YS[row * 512 + g * 16 + n] = (bf16)f2bf(gelu_tanh(mine + dmine * umine));
                    }
                } else {
                    const int un = wu - 768, b = un >> 3, blk = un & 7, j = lane;
                    LAS bf16* wA = (LAS bf16*)scr; LAS bf16* wX = wA + 4096;
                    for (int i = 0; i < 64; ++i) { wA[i * 64 + j] = (bf16)f2bf(opqp(p.in[24])[layer * 32768 + (blk * 64 + i) * 64 + j]); wX[i * 64 + j] = (bf16)f2bf(opqp(p.in[26])[layer * 32768 + (blk * 64 + i) * 64 + j]); }
                    LDS_WAIT();
                    const float bA = opqp(p.in[25])[layer * 512 + blk * 64 + j], bX = opqp(p.in[27])[layer * 512 + blk * 64 + j], sp = softplusf_(-opqp(p.in[28])[layer * 512 + blk * 64 + j]);
                    float hs = 0.f;
                    for (int t = 0; t < L; ++t) {
                        const size_t row = (size_t)b * L + t;
                        const float xc = bf1(XLC[row * 512 + blk * 64 + j]);
                        float ra = bA, ri = bX;
#pragma unroll
                        for (int i = 0; i < 64; ++i) { const float xi = __shfl(xc, i); ra += xi * bf1(wA[i * 64 + j]); ri += xi * bf1(wX[i * 64 + j]); }
                        const float r = sigmoidf_(ra), ig = sigmoidf_(ri);
                        const float log_a = -8.0f * r * sp, a = __expf(log_a);
                        const float mult = sqrtf(fmaxf(-expm1f(2.0f * log_a), 0.f));
                        hs = a * hs + mult * ig * xc;
                        BR[row * 2048 + 1536 + blk * 64 + j] = (bf16)f2bf(hs * gelu_tanh(bf1(PROJB[row * PJ + C_GL + blk * 64 + j])));
                    }
                }
            }
#else
            for (int wu = gw; wu < 768; wu += NGW) {
                LAS unsigned char* sl = (LAS unsigned char*)scr;
                if (wu < 256) {
                    const int ty = wu >> 7, uu = wu & 127, b = uu >> 4, hh = (uu >> 1) & 7, eh = uu & 1; const size_t r0 = (size_t)b * L;
                    if (ty == 0) { const int g = hh >> 2; const float Aa = -__expf(opqp(p.in[18])[layer * 8 + hh]);
                        linattn_unit(XBCC + r0 * 768 + 640 + g * 64, 768, XBCC + r0 * 768 + 512 + g * 64, 768, XBCC + r0 * 768 + hh * 64 + eh * 32, 768, DT + r0 * 8 + hh, Aa * 1.4426950408889634f, opqp(p.in[19])[layer * 8 + hh],
                                     BR + r0 * 2048 + 512 + hh * 64 + eh * 32, 2048, sl, lane); }
                    else { const float lg = log2f(1.0f - exp2f(-5.0f - (float)hh));
                        linattn_unit(PROJB + r0 * PJ + C_Q + hh * 64, PJ, PROJB + r0 * PJ + C_K + hh * 64, PJ, PROJB + r0 * PJ + C_V + hh * 64 + eh * 32, PJ, nullptr, lg, 0.f,
                                     BR + r0 * 2048 + 1024 + hh * 64 + eh * 32, 2048, sl, lane); }
                } else if (wu < 512) {
                    const int un = wu - 256, b = un >> 5, g = un & 31; const size_t r0 = (size_t)b * L;
                    s5_unit(PROJB + r0 * PJ + C_U + g * 16, YS + r0 * 512 + g * 16, opqp(p.in[6]) + layer * 2048 + g * 64, opqp(p.in[7]) + layer * 2048 + g * 64, opqp(p.in[8]) + layer * 32768 + g * 1024, opqp(p.in[9]) + layer * 32768 + g * 1024,
                            opqp(p.in[10]) + layer * 32768 + g * 1024, opqp(p.in[11]) + layer * 32768 + g * 1024, opqp(p.in[12]) + layer * 512 + g * 16, expf(opqp(p.in[13])[layer * 32 + g]), sl, lane);
                } else {
                    const int un = wu - 512, b = un >> 5, blk = (un >> 2) & 7, jq = un & 3, ch = blk * 64 + jq * 16 + (lane & 15); const size_t r0 = (size_t)b * L;
                    lru_unit(XLC + r0 * 512 + blk * 64, PROJB + r0 * PJ + C_GL + blk * 64 + jq * 16, BR + r0 * 2048 + 1536 + blk * 64 + jq * 16, opqp(p.in[24]) + layer * 32768 + blk * 4096, opqp(p.in[26]) + layer * 32768 + blk * 4096,
                             opqp(p.in[25])[layer * 512 + ch], opqp(p.in[27])[layer * 512 + ch], softplusf_(-opqp(p.in[28])[layer * 512 + ch]), jq, lane);
                }
            }
#endif
            GRID_BAR();
        }
        if (IN(pb + 3)) { PH_VARS
            const float* snw = opqp(p.in[20]) + layer * 512; const float* rnw = opqp(p.in[21]) + layer * 512;
            for (int row = gw; row < T; row += NGW) {
                bf16* y = BR + (size_t)row * 2048; const bf16* pr = PROJB + (size_t)row * PJ;
                {
                    const v4u yw = *(const v4u*)(y + 512 + 8 * lane), zw = *(const v4u*)(pr + C_Z + 8 * lane);
                    float v[8] = {bflo(yw.x), bfhi(yw.x), bflo(yw.y), bfhi(yw.y), bflo(yw.z), bfhi(yw.z), bflo(yw.w), bfhi(yw.w)};
                    const float z[8] = {bflo(zw.x), bfhi(zw.x), bflo(zw.y), bfhi(zw.y), bflo(zw.z), bfhi(zw.z), bflo(zw.w), bfhi(zw.w)};
                    float ss = 0.f;
#pragma unroll
                    for (int q = 0; q < 8; ++q) { v[q] *= siluf_(z[q]); ss += v[q] * v[q]; }
                    const float r = 1.0f / sqrtf(wave_sum(ss) * (1.0f / 512.0f) + 1e-6f);
#pragma unroll
                    for (int q = 0; q < 8; ++q) v[q] *= r * snw[8 * lane + q];
                    v4u o; o.x = pk2(v[0], v[1]); o.y = pk2(v[2], v[3]); o.z = pk2(v[4], v[5]); o.w = pk2(v[6], v[7]);
                    *(v4u*)(y + 512 + 8 * lane) = o;
                }
                {
                    const v4u yw = *(const v4u*)(y + 1024 + 8 * lane), gw_ = *(const v4u*)(pr + C_G + 8 * lane);
                    float v[8] = {bflo(yw.x), bfhi(yw.x), bflo(yw.y), bfhi(yw.y), bflo(yw.z), bfhi(yw.z), bflo(yw.w), bfhi(yw.w)};
                    const float gg[8] = {bflo(gw_.x), bfhi(gw_.x), bflo(gw_.y), bfhi(gw_.y), bflo(gw_.z), bfhi(gw_.z), bflo(gw_.w), bfhi(gw_.w)};
                    float s = 0.f;
#pragma unroll
                    for (int q = 0; q < 8; ++q) s += v[q];
                    s += __shfl_xor(s, 1); s += __shfl_xor(s, 2); s += __shfl_xor(s, 4);
                    const float mu = s * (1.0f / 64.0f); float q2 = 0.f;
#pragma unroll
                    for (int q = 0; q < 8; ++q) { v[q] -= mu; q2 += v[q] * v[q]; }
                    q2 += __shfl_xor(q2, 1); q2 += __shfl_xor(q2, 2); q2 += __shfl_xor(q2, 4);
                    const float rs = 1.0f / sqrtf(q2 * (1.0f / 64.0f) + 1e-6f);
#pragma unroll
                    for (int q = 0; q < 8; ++q) v[q] = siluf_(gg[q]) * (v[q] * rs * rnw[8 * lane + q]);
                    v4u o; o.x = pk2(v[0], v[1]); o.y = pk2(v[2], v[3]); o.z = pk2(v[4], v[5]); o.w = pk2(v[6], v[7]);
                    *(v4u*)(y + 1024 + 8 * lane) = o;
                }
            }
            pg8::Gemm g{512, 512, 512}; pg8::PlainOrder S; S.A = (const char*)HN; S.B = (const char*)WGLU; S.nM = 64; S.nN = 2; S.lda = 512; S.ldb = 512; S.G = G; S.c = bx;
            pg8::EpiGlu E{HN, BR};
            pg8::gemm_phase<pg8::EpiGlu, pg8::PlainOrder, false, false>(lds, g, S, E, wave_s);
            GRID_BAR();
        }
        if (IN(pb + 4)) { PH_VARS
#ifdef MK_EXP_A
            pg8::Gemm g{2048, 2048, 2048}; pg8::PlainOrder S; S.A = (const char*)BR; S.B = (const char*)WB; S.nM = 64; S.nN = 4; S.lda = 2048; S.ldb = 2048; S.G = G; S.c = bx;
            pg8::EpiStore E{MERGED, 1024};
            pg8::gemm_phase<pg8::EpiStore, pg8::PlainOrder, false, false>(lds, g, S, E, wave_s);
#else
            pg8::Gemm g{2048, 2048, 512}; pg8::MergeOrder S; S.br_ = (const char*)BR; S.wb_ = (const char*)WB; S.G = G; S.c = bx;
            pg8::EpiMerge E{GATE, MERGED};
            pg8::gemm_phase<pg8::EpiMerge, pg8::MergeOrder, false, false>(lds, g, S, E, wave_s);
#endif
            GRID_BAR();
        }
        if (IN(pb + 5)) { PH_VARS
            pg8::Gemm g{1024, 1024, 1024}; pg8::PlainOrder S; S.A = (const char*)MERGED; S.B = (const char*)WOUT; S.nM = 64; S.nN = 4; S.lda = 1024; S.ldb = 1024; S.G = G; S.c = bx;
            pg8::EpiRes E{layer == 0 ? x_ : (const float*)H, H};
            pg8::gemm_phase<pg8::EpiRes, pg8::PlainOrder, false, false>(lds, g, S, E, wave_s);
            GRID_BAR();
        }
        if (IN(pb + 6)) { PH_VARS
            for (int row = gw; row < T; row += NGW) { f32x4 v[4]; (void)norm_row(H + (size_t)row * D, HN + (size_t)row * D, lane, v); }
            GRID_BAR();
        }
        if (IN(pb + 7)) { PH_VARS
            pg8::Gemm g{1024, 1024, 1024}; pg8::PlainOrder S; S.A = (const char*)HN; S.B = (const char*)WQ; S.nM = 64; S.nN = 4; S.lda = 1024; S.ldb = 1024; S.G = G; S.c = bx;
            pg8::EpiStore E{XQ, 1024};
            pg8::gemm_phase<pg8::EpiStore, pg8::PlainOrder, false, false>(lds, g, S, E, wave_s);
            GRID_BAR();
        }
        if (IN(pb + 8)) { PH_VARS
            pg8::Gemm g{1024, 1024, 256}; pg8::QKOrder S; S.xq_ = (const char*)XQ; S.kx_ = (const char*)KX; S.G = G; S.c = bx;
            pg8::EpiSoftmax E{PB, (PG8_LAS float*)xch};
            for (int sb = 0; sb < 256; sb += G) { S.base = sb; pg8::gemm_phase<pg8::EpiSoftmax, pg8::QKOrder, false, false>(lds, g, S, E, wave_s); }
            GRID_BAR();
        }
        if (IN(pb + 9)) { PH_VARS
            pg8::Gemm g{1024, 256, 256}; pg8::PVOrder S; S.p_ = (const char*)PB; S.vt_ = (const char*)VT; S.G = G; S.c = bx;
            pg8::EpiStore E{XO, 1024};
            pg8::gemm_phase<pg8::EpiStore, pg8::PVOrder, false, false>(lds, g, S, E, wave_s);
            GRID_BAR();
        }
        if (IN(pb + 10)) { PH_VARS
            pg8::Gemm g{1024, 1024, 1024}; pg8::PlainOrder S; S.A = (const char*)XO; S.B = (const char*)WO; S.nM = 64; S.nN = 4; S.lda = 1024; S.ldb = 1024; S.G = G; S.c = bx;
            pg8::EpiRes E{H, H};
            pg8::gemm_phase<pg8::EpiRes, pg8::PlainOrder, false, false>(lds, g, S, E, wave_s);
            GRID_BAR();
        }
        if (layer == 0) {
            if (IN(pb + 11)) { PH_VARS
                for (int row = gw; row < T; row += NGW) { f32x4 v[4]; (void)norm_row(H + (size_t)row * D, HN + (size_t)row * D, lane, v); }
                GRID_BAR();
            }
            if (IN(pb + 12)) { PH_VARS
                pg8::Gemm g{1024, 1024, 1024}; pg8::PlainOrder S; S.A = (const char*)HN; S.B = (const char*)W13; S.nM = 64; S.nN = 22; S.lda = 1024; S.ldb = 1024; S.G = G; S.c = bx;
                pg8::EpiSwiglu E{ACT, DFF};
                pg8::gemm_phase<pg8::EpiSwiglu, pg8::PlainOrder, false, false>(lds, g, S, E, wave_s);
                GRID_BAR();
            }
            if (IN(pb + 13)) { PH_VARS
                pg8::Gemm g{DFF, DFF, DFF}; pg8::PlainOrder S; S.A = (const char*)ACT; S.B = (const char*)W2T; S.nM = 64; S.nN = 4; S.lda = DFF; S.ldb = DFF; S.G = G; S.c = bx;
                pg8::EpiRes E{H, H};
                pg8::gemm_phase<pg8::EpiRes, pg8::PlainOrder, false, false>(lds, g, S, E, wave_s);
                GRID_BAR();
            }
            if (IN(pb + 14)) { PH_VARS
                for (int i = tid; i < 8192; i += 512) w8[i] = norm_mix[D + (i >> 3)] * w_in[(size_t)D * IN_TOTAL + (size_t)(i >> 3) * IN_TOTAL + O_DT + (i & 7)];
                __syncthreads();
                for (int row = gw; row < T; row += NGW) { f32x4 v[4]; const float r = norm_row(H + (size_t)row * D, HN + (size_t)row * D, lane, v); float lg[8]; row_dot8(v, w8, lane, lg);
                    float mine = 0.f;
#pragma unroll
                    for (int e = 0; e < 8; ++e) if (lane == e) mine = lg[e];
                    if (lane < 8) DT[(size_t)row * 8 + lane] = softplusf_(r * mine + opqp(p.in[17])[8 + lane]); }
                __syncthreads();
                GRID_BAR();
            }
        } else {
            if (IN(pb + 11)) { PH_VARS
                for (int i = tid; i < 8192; i += 512) w8[i] = norm_ffn[D + (i >> 3)] * moe_router[i];
                __syncthreads();
                for (int row = gw; row < T; row += NGW) { f32x4 v[4]; const float r = norm_row(H + (size_t)row * D, HN + (size_t)row * D, lane, v); float lg[8]; row_dot8(v, w8, lane, lg);
                    if (lane == 0) {
                        int i1 = 0; float v1 = lg[0];
#pragma unroll
                        for (int e = 1; e < 8; ++e) if (lg[e] > v1) { v1 = lg[e]; i1 = e; }
                        int i2 = 0; float v2 = -3.0e38f;
#pragma unroll
                        for (int e = 0; e < 8; ++e) if (e != i1 && lg[e] > v2) { v2 = lg[e]; i2 = e; }
                        const float w1 = 1.0f / (1.0f + expf(r * (v2 - v1))), w2 = 1.0f - w1;
                        const int r1 = atomicAdd(&CNT[i1], 1), r2 = atomicAdd(&CNT[i2], 1);
                        TOPI[row] = (i32x4){i1, i2, r1, r2}; TOPW[row] = (f32x2){w1, w2};
                    } }
                __syncthreads();
                {
                    int rot = 0;
                    for (int e = 0; e < NE; ++e) {
                        CVT_LOOP(16 * 224, MapW13 m{moe_w1 + (size_t)e * D * DFE, moe_w3 + (size_t)e * D * DFE, norm_ffn + D, W13E + (size_t)e * 2 * DFE * D, DFE, 2 * DFE});
                        CVT_LOOP(56 * 32, MapPlain m{moe_w2 + (size_t)e * DFE * D, DFE, D, nullptr, 1.f, W2E + (size_t)e * D * DFE, DFE});
                    }
                }
                GRID_BAR();
            }
            int t1 = 0, t2 = 0, t3 = 0, t4 = 0, t5 = 0, t6 = 0, t7 = 0, ntiles = 0;
            if (lo <= pb + 14 && hi > pb + 12) {
                int acc = 0;
#pragma unroll
                for (int e = 0; e < 8; ++e) { const int c = __hip_atomic_load(&CNT[e], RLX_AGENT); acc += (c + 255) >> 8;
                    if (e == 0) t1 = acc; if (e == 1) t2 = acc; if (e == 2) t3 = acc; if (e == 3) t4 = acc; if (e == 4) t5 = acc; if (e == 5) t6 = acc; if (e == 6) t7 = acc; if (e == 7) ntiles = acc; }
            }
            if (IN(pb + 12)) { PH_VARS
                for (int row = gw; row < T; row += NGW) {
                    const i32x4 ti = TOPI[row];
                    const int e1 = ti.x, e2 = ti.y;
                    const int s1 = (e1 == 0 ? 0 : e1 == 1 ? t1 : e1 == 2 ? t2 : e1 == 3 ? t3 : e1 == 4 ? t4 : e1 == 5 ? t5 : e1 == 6 ? t6 : t7) * 256 + ti.z;
                    const int s2 = (e2 == 0 ? 0 : e2 == 1 ? t1 : e2 == 2 ? t2 : e2 == 3 ? t3 : e2 == 4 ? t4 : e2 == 5 ? t5 : e2 == 6 ? t6 : t7) * 256 + ti.w;
                    const v4u a = *((const v4u*)(HN + (size_t)row * D) + lane), b = *((const v4u*)(HN + (size_t)row * D) + 64 + lane);
                    v4u* d1 = (v4u*)(XS + (size_t)s1 * D); v4u* d2 = (v4u*)(XS + (size_t)s2 * D);
                    d1[lane] = a; d1[64 + lane] = b; d2[lane] = a; d2[64 + lane] = b;
                    if (lane == 0) SLOT[row] = (i32x2){s1, s2};
                }
                GRID_BAR();
            }
            if (IN(pb + 13)) { PH_VARS
                pg8::Gemm g{1024, 1024, 1024}; pg8::MoeOrder S; S.A = (const char*)XS; S.B = (const char*)W13E; S.estride = (size_t)2 * DFE * D * 2; S.lda = 1024; S.ldb = 1024; S.ntiles = ntiles; S.nN = 28; S.G = G; S.c = bx;
                S.t1 = t1; S.t2 = t2; S.t3 = t3; S.t4 = t4; S.t5 = t5; S.t6 = t6; S.t7 = t7;
                pg8::EpiSwiglu E{ACTE, DFE};
                pg8::gemm_phase<pg8::EpiSwiglu, pg8::MoeOrder, false, false>(lds, g, S, E, wave_s);
                GRID_BAR();
            }
            if (IN(pb + 14)) { PH_VARS
                pg8::Gemm g{DFE, DFE, DFE}; pg8::MoeOrder S; S.A = (const char*)ACTE; S.B = (const char*)W2E; S.estride = (size_t)D * DFE * 2; S.lda = DFE; S.ldb = DFE; S.ntiles = ntiles; S.nN = 4; S.G = G; S.c = bx;
                S.t1 = t1; S.t2 = t2; S.t3 = t3; S.t4 = t4; S.t5 = t5; S.t6 = t6; S.t7 = t7;
                pg8::EpiStore E{XS, 1024};
                pg8::gemm_phase<pg8::EpiStore, pg8::MoeOrder, false, false>(lds, g, S, E, wave_s);
                GRID_BAR();
            }
            if (IN(pb + 15)) { PH_VARS
                const unsigned bad = __hip_atomic_load(ctl + CW_BAR + XB_TMO, RLX_AGENT);
                for (int row = gw; row < T; row += NGW) {
                    const i32x2 sl = SLOT[row]; const f32x2 tw = TOPW[row];
                    const f32x4* hr = (const f32x4*)(H + (size_t)row * D) + lane; const v2u* y1 = (const v2u*)(XS + (size_t)sl.x * D) + lane; const v2u* y2 = (const v2u*)(XS + (size_t)sl.y * D) + lane;
                    f32x4 v[4]; float ss = 0.f;
#pragma unroll
                    for (int j = 0; j < 4; ++j) { v[j] = hr[64 * j]; const v2u a = y1[64 * j], b = y2[64 * j];
                        v[j].x += tw.x * bflo(a.x) + tw.y * bflo(b.x); v[j].y += tw.x * bfhi(a.x) + tw.y * bfhi(b.x); v[j].z += tw.x * bflo(a.y) + tw.y * bflo(b.y); v[j].w += tw.x * bfhi(a.y) + tw.y * bfhi(b.y);
                        ss += (v[j].x * v[j].x + v[j].y * v[j].y) + (v[j].z * v[j].z + v[j].w * v[j].w); }
                    float r = 1.0f / sqrtf(wave_sum(ss) * (1.0f / 1024.0f) + 1e-6f);
                    if (bad) r = __builtin_nanf("");
                    f32x4* orow = (f32x4*)(H + (size_t)row * D) + lane;
#pragma unroll
                    for (int j = 0; j < 4; ++j) { const f32x4 g4 = *((const f32x4*)norm_final + lane + 64 * j); orow[64 * j] = v[j] * r * g4; }
                }
            }
        }
        }
#ifdef MK_DUMP
    if (IN(99)) { PH_VARS
        for (int row = gw; row < cf::T; row += NGW) {
#pragma unroll
            for (int j = 0; j < 16; ++j) { const int cc = lane + 64 * j; float v;
#if MK_DUMP == 1
                v = (cc < 512 ? bf1(HN[(size_t)row * 512 + cc]) : bf1(BR[(size_t)row * 2048 + cc])) + bf1(BR[(size_t)row * 2048 + cc + 1024]);
#elif MK_DUMP == 2
                v = bf1(PROJB[(size_t)row * cf::PJ + cc]) + bf1(PROJB[(size_t)row * cf::PJ + cc + 1024]) + bf1(PROJB[(size_t)row * cf::PJ + cc + 2048]) + bf1(PROJB[(size_t)row * cf::PJ + cc + 3072]) + bf1(GATE[(size_t)row * 4096 + cc]) + bf1(GATE[(size_t)row * 4096 + 3072 + cc]) + (cc < 768 ? bf1(PROJB[(size_t)row * cf::PJ + cc + 4096]) : 0.f);
#elif MK_DUMP == 5
                v = bf1(GATE[(size_t)row * 4096 + cc]) + bf1(GATE[(size_t)row * 4096 + 1024 + cc]) + bf1(GATE[(size_t)row * 4096 + 2048 + cc]) + bf1(GATE[(size_t)row * 4096 + 3072 + cc]);
#elif MK_DUMP == 7
                v = bf1(GATE[(size_t)row * 4096 + MK_GB * 1024 + cc]);
#elif MK_DUMP == 3
                v = bf1(BR[(size_t)row * 2048 + cc]) + bf1(BR[(size_t)row * 2048 + cc + 1024]);
#elif MK_DUMP == 4
                v = bf1(MERGED[(size_t)row * 1024 + cc]);
#endif
                H[(size_t)row * 1024 + cc] = v; }
        }
    }
#endif
#undef IN
#undef GRID_BAR
#undef ws
#undef ctl
#undef H
}

#undef PH_VARS
#undef ws
#undef ctl
#undef GRID_BAR
#undef IN
#undef x_
#undef mem_
#undef positions_
#undef norm_mix
#undef w_in
#undef b_gate
#undef w_branch
#undef w_out
#undef norm_xa
#undef norm_mem
#undef xa_wq
#undef xa_wk
#undef xa_wv
#undef xa_wo
#undef norm_ffn
#undef ffn_w1
#undef ffn_w3
#undef ffn_w2
#undef moe_router
#undef moe_w1
#undef moe_w3
#undef moe_w2
#undef norm_final
#undef H
#undef HN
#undef KVB
#undef COS
#undef SIN
#undef DT
#undef MNR
#undef PROJB
#undef GATE
#undef BR
#undef XBCC
#undef XLC
#undef MP
#undef MERGED
#undef XQ
#undef PB
#undef XO
#undef ACT
#undef W13E
#undef W2E
#undef XS
#undef ACTE
#undef TOPI
#undef TOPW
#undef SLOT
#undef CNT
#undef W13
#undef W2T
#undef CVT_LOOP
#undef WLP
#undef WIN
#undef WGLU
#undef WB
#undef WOUT
#undef WQ
#undef WO
#undef KX
#undef VT
extern "C" void kernel_launch(void* const* d_in, const int* in_sizes, int n_in, void* d_out, int out_size, void* d_ws, size_t ws_size, hipStream_t stream) {
    static int grid = 0;
    if (grid == 0) {
        if (n_in != 46 || in_sizes[0] != cf::T * cf::D || out_size != cf::T * cf::D || ws_size < WS_NEED) { fprintf(stderr, "kernel_launch: unexpected shapes / workspace (n_in %d, in0 %d, out %d, ws %zu < %zu)\n", n_in, n_in > 0 ? in_sizes[0] : -1, out_size, ws_size, (size_t)WS_NEED); grid = -1; return; }
        int dev = 0, cus = 0, per_cu = 0;
        if (hipGetDevice(&dev) != hipSuccess || hipDeviceGetAttribute(&cus, hipDeviceAttributeMultiprocessorCount, dev) != hipSuccess) { grid = -1; return; }
        if (hipFuncSetAttribute((const void*)mega, hipFuncAttributeMaxDynamicSharedMemorySize, LDS_BYTES) != hipSuccess) { fprintf(stderr, "kernel_launch: hipFuncSetAttribute failed\n"); grid = -1; return; }
        if (hipOccupancyMaxActiveBlocksPerMultiprocessor(&per_cu, (const void*)mega, NWAVES * 64, LDS_BYTES) != hipSuccess || per_cu < 1) fprintf(stderr, "kernel_launch: occupancy query reports %d\n", per_cu);
        (void)hipGetLastError();
        grid = cus;
    }
    if (grid < 0) return;
    if (hipMemsetAsync((char*)d_ws + WS_CTL, 0, CTL_ZERO_BYTES, stream) != hipSuccess) return;
    Params a{};
    for (int i = 0; i < 46; ++i) a.in[i] = (const float*)d_in[i];
    a.out = (float*)d_out; a.ws = (unsigned char*)d_ws;
#ifdef MK_PER_PHASE
    for (int ph = 0; ph < MK_PER_PHASE; ++ph) { if (ph >= 16 && ph <= 20) continue; a.ph_lo = ph; a.ph_hi = ph + 1; hipLaunchKernelGGL(mega, dim3(grid), dim3(NWAVES * 64), LDS_BYTES, stream, a); }
#ifdef MK_DUMP
    a.ph_lo = 99; a.ph_hi = 100; hipLaunchKernelGGL(mega, dim3(grid), dim3(NWAVES * 64), LDS_BYTES, stream, a);
#endif
#elif defined(MK_SELFCHK)
    {
        using namespace nv;
        const float* x = (const float*)d_in[0]; char* wsb = (char*)d_ws;
        float* hn = (float*)wsb; float* PROJ = hn + (size_t)2048 * 1024; float* BRn = PROJ + (size_t)2048 * PW; float* TMP = BRn + (size_t)2048 * 2048; float* GLG = TMP + (size_t)2048 * 1024; float* MER = GLG + (size_t)2048 * 1024;
        float* ct = MER + (size_t)2048 * 1024; float* st = ct + (size_t)T * 32; float* hh = st + (size_t)T * 32;
        char* safe = wsb + (size_t)524 * 1048576; float* sBR = (float*)safe; float* sMER = sBR + (size_t)2048 * 2048; float* sH = sMER + (size_t)2048 * 1024; float* sPROJ = sH + (size_t)2048 * 1024; float* sGATE = sPROJ + (size_t)256 * PW; float* acc = sGATE + (size_t)256 * 4096;
        const float* Win = (const float*)d_in[4];
        hipLaunchKernelGGL(k_rope_tab, dim3((T * 32 + 255) / 256), dim3(256), 0, stream, (const int*)d_in[2], ct, st);
        hipLaunchKernelGGL(k_rmsnorm, dim3(2048 / 4), dim3(256), 0, stream, x, (const float*)d_in[3], hn, 2048);
        sgemm(stream, false, hn, D, Win, IN_TOTAL, PROJ, PW, 2048, PW, D);
        hipMemcpyAsync(sPROJ, PROJ, (size_t)256 * PW * 4, hipMemcpyDeviceToDevice, stream);
        hipLaunchKernelGGL(k_s5_scan, dim3(32), dim3(64), 0, stream, PROJ, BRn, (const float*)d_in[6], (const float*)d_in[7], (const float*)d_in[8], (const float*)d_in[9], (const float*)d_in[10], (const float*)d_in[11], (const float*)d_in[12], (const float*)d_in[13]);
        sgemm(stream, false, BRn, 2048, (const float*)d_in[14], 512, TMP, 512, 2048, 512, 512);
        hipLaunchKernelGGL(k_s5_gate, dim3((2048 * 512 + 255) / 256), dim3(256), 0, stream, BRn, TMP, 2048);
        hipLaunchKernelGGL(k_conv_inplace, dim3((768 + 255) / 256), dim3(256), 0, stream, PROJ, PW, OFF_XBC, 768, (const float*)d_in[15], (const float*)d_in[16], 1, 1);
        hipLaunchKernelGGL(k_ssd_scan, dim3(8), dim3(256), 0, stream, PROJ, BRn, (const float*)d_in[17], (const float*)d_in[18], (const float*)d_in[19]);
        hipLaunchKernelGGL(k_ssd_post, dim3(2048 / 4), dim3(256), 0, stream, BRn, PROJ, (const float*)d_in[20], 2048);
        hipLaunchKernelGGL(k_rope, dim3((2048 * 256 + 255) / 256), dim3(256), 0, stream, PROJ, ct, st, 0, 2048);
        hipLaunchKernelGGL(k_ret_scan, dim3(8), dim3(256), 0, stream, PROJ, BRn);
        hipLaunchKernelGGL(k_ret_post, dim3(2048 / 4), dim3(256), 0, stream, BRn, PROJ, (const float*)d_in[21], 2048);
        hipLaunchKernelGGL(k_conv_inplace, dim3((512 + 255) / 256), dim3(256), 0, stream, PROJ, PW, OFF_XL, 512, (const float*)d_in[22], (const float*)d_in[23], 0, 1);
        hipLaunchKernelGGL(k_lru_scan, dim3(8), dim3(64), 0, stream, PROJ, BRn, (const float*)d_in[24], (const float*)d_in[25], (const float*)d_in[26], (const float*)d_in[27], (const float*)d_in[28]);
        for (int k = 0; k < 4; ++k) {
            sgemm(stream, false, BRn + k * 512, 2048, (const float*)d_in[29] + (size_t)k * 512 * 1024, 1024, TMP, 1024, 2048, 1024, 512);
            sgemm(stream, false, hn, D, Win + OFF_GATE + k * 1024, IN_TOTAL, GLG, 1024, 2048, 1024, D);
            hipLaunchKernelGGL(k_dbg_gate, dim3((256 * 1024 + 255) / 256), dim3(256), 0, stream, sGATE + k * 1024, GLG, (const float*)d_in[5] + k * 1024);
            hipLaunchKernelGGL(k_gate_acc, dim3((2048 * 1024 + 255) / 256), dim3(256), 0, stream, MER, TMP, GLG, (const float*)d_in[5] + k * 1024, k == 0 ? 1 : 0, 2048);
        }
        hipMemcpyAsync(hh, x, (size_t)2048 * 1024 * 4, hipMemcpyDeviceToDevice, stream);
        sgemm(stream, true, MER, 1024, (const float*)d_in[30], D, hh, D, 2048, D, D);
        hipMemcpyAsync(sBR, BRn, (size_t)2048 * 2048 * 4, hipMemcpyDeviceToDevice, stream);
        hipMemcpyAsync(sMER, MER, (size_t)2048 * 1024 * 4, hipMemcpyDeviceToDevice, stream);
        hipMemcpyAsync(sH, hh, (size_t)2048 * 1024 * 4, hipMemcpyDeviceToDevice, stream);
        hipMemsetAsync((char*)d_ws + WS_CTL, 0, CTL_ZERO_BYTES, stream);
        a.ph_lo = 0; a.ph_hi = MK_SELFCHK;
        hipLaunchKernelGGL(mega, dim3(grid), dim3(NWAVES * 64), LDS_BYTES, stream, a);
        hipMemsetAsync(acc, 0, 256, stream);
        const unsigned short* PROJBp = (const unsigned short*)((char*)d_ws + R_PROJB); const unsigned short* GATEp = (const unsigned short*)((char*)d_ws + R_GATE); const unsigned short* BRp = (const unsigned short*)((char*)d_ws + R_BR); const unsigned short* MERp = (const unsigned short*)((char*)d_ws + R_MERGED);
        hipLaunchKernelGGL(k_dbg_cmp, dim3(256), dim3(256), 0, stream, sPROJ, PW, 0, (const void*)PROJBp, 4864, 0, 1, 256, 1792, acc + 0);
        hipLaunchKernelGGL(k_dbg_cmp, dim3(256), dim3(256), 0, stream, sPROJ, PW, 2824, (const void*)PROJBp, 4864, 2816, 1, 256, 1024, acc + 2);
        hipLaunchKernelGGL(k_dbg_cmp, dim3(256), dim3(256), 0, stream, sPROJ, PW, 3848, (const void*)PROJBp, 4864, 3840, 1, 256, 1024, acc + 4);
        for (int kk = 0; kk < 4; ++kk) hipLaunchKernelGGL(k_dbg_cmp, dim3(256), dim3(256), 0, stream, sGATE, 4096, kk * 1024, (const void*)GATEp, 4096, kk * 1024, 1, 256, 1024, acc + 6 + 2 * kk);
        if (MK_SELFCHK >= 5) for (int s = 0; s < 4; ++s) hipLaunchKernelGGL(k_dbg_cmp, dim3(256), dim3(256), 0, stream, sBR, 2048, s * 512, (const void*)BRp, 2048, s * 512, 1, 2048, 512, acc + 14 + 2 * s);
        if (MK_SELFCHK >= 6) hipLaunchKernelGGL(k_dbg_cmp, dim3(256), dim3(256), 0, stream, sMER, 1024, 0, (const void*)MERp, 1024, 0, 1, 2048, 1024, acc + 22);
        if (MK_SELFCHK >= 7) hipLaunchKernelGGL(k_dbg_cmp, dim3(256), dim3(256), 0, stream, sH, 1024, 0, (const void*)d_out, 1024, 0, 0, 2048, 1024, acc + 24);
        hipLaunchKernelGGL(k_dbg_report, dim3(1), dim3(1), 0, stream, acc, acc + 64);
        hipLaunchKernelGGL(k_dbg_fill, dim3(4096), dim3(256), 0, stream, (float*)d_out, acc + 64, (size_t)T * D);
        return;
    }
#elif defined(MK_HYBRID)
    a.ph_lo = 0; a.ph_hi = MK_HYBRID;
    hipLaunchKernelGGL(mega, dim3(grid), dim3(NWAVES * 64), LDS_BYTES, stream, a);
    nv::naive_from(MK_HYB_L, MK_HYB_S, d_in, d_out, d_ws, stream);
    return;
#else
    a.ph_lo = 0; a.ph_hi = 1000;
    hipLaunchKernelGGL(mega, dim3(grid), dim3(NWAVES * 64), LDS_BYTES, stream, a);
#endif
    const hipError_t le = hipPeekAtLastError();
    if (le != hipSuccess) fprintf(stderr, "kernel_launch: launch failed: %s\n", hipGetErrorName(le));
}
```

```cpp
#define MK_NMIXB 128
#define MK_GW0 512
#define MK_GW1 1024
#include <hip/hip_runtime.h>
#include <cstdio>
#include <cstdint>
#include <type_traits>
__device__ __forceinline__ int lane_id_fresh() { int l; asm volatile("v_mbcnt_lo_u32_b32 %0, -1, 0\n\tv_mbcnt_hi_u32_b32 %0, -1, %0" : "=v"(l)); return l; }
namespace pg8 {
#define PG8_LAS __attribute__((address_space(3)))
typedef unsigned short bf16_t;
typedef short bf16x8 __attribute__((ext_vector_type(8)));
typedef float f32x4 __attribute__((ext_vector_type(4)));
typedef float f32x2 __attribute__((ext_vector_type(2)));
typedef unsigned u32x4 __attribute__((ext_vector_type(4)));
typedef unsigned u32x2 __attribute__((ext_vector_type(2)));
constexpr int BM = 256, BK = 64, HALF = 128, HTB = HALF * BK * 2  , STAGE_BYTES = 8 * HTB, NXCD = 8, WGM = 8;
__host__ __device__ __forceinline__ int lds_byte(int r, int c) { const int st = (r >> 4) * 2 + (c >> 5), rr = r & 15, cc = c & 31, ob = rr * 64 + cc * 2; return st * 1024 + (ob ^ (((ob >> 9) & 1) << 5)); }
__host__ __device__ __forceinline__ void stage_rc(int b, int& R, int& C) { const int st = b / 1024, sb = b % 1024, swz = sb ^ (((sb >> 9) & 1) << 5); R = (st >> 1) * 16 + swz / 64; C = (st & 1) * 32 + (swz % 64) / 2; }
__host__ __device__ __forceinline__ int perm32(int rho) { const int n = rho >> 4, i = rho & 15; return 8 * (i >> 2) + 4 * n + (i & 3); }

struct Unit { int pm, pn, z; const char* a; const char* b; };
struct Gemm { int lda, ldb, K; };

__device__ __forceinline__ void tile_map(int L, int nM, int nN, int& pm, int& pn) {
    const int nwg = nM * nN; int wgid = L;
    { const int q = nwg / NXCD, r = nwg % NXCD, xcd = wgid % NXCD, off = wgid / NXCD; wgid = (xcd < r ? xcd * (q + 1) : r * (q + 1) + (xcd - r) * q) + off; }
    const int nig = WGM * nN, gid = wgid / nig, fm = gid * WGM, gsz = (nM - fm) < WGM ? (nM - fm) : WGM;
    pm = fm + ((wgid % nig) % gsz); pn = (wgid % nig) / gsz;
}
typedef __bf16 bf16x2_t __attribute__((ext_vector_type(2)));
typedef int i32x4_ __attribute__((ext_vector_type(4)));
typedef int i32x8_ __attribute__((ext_vector_type(8)));
__device__ __forceinline__ unsigned cvt_pk_bf16(float lo, float hi) { const f32x2 v = {lo, hi}; return __builtin_bit_cast(unsigned, __builtin_convertvector(v, bf16x2_t)); }
__device__ __forceinline__ float bf_lo(unsigned w) { return __uint_as_float(w << 16); }
__device__ __forceinline__ float bf_hi(unsigned w) { return __uint_as_float(w & 0xffff0000u); }
__device__ __forceinline__ float fast_sigmoid(float x) { return __builtin_amdgcn_rcpf(1.0f + __builtin_amdgcn_exp2f(-1.4426950408889634f * x)); }

struct NoHooks { static constexpr bool GATHER = false, F8 = false; __device__ __forceinline__ void a_ready(const Unit&) const {} __device__ __forceinline__ void done(const Unit&) const {} __device__ __forceinline__ int rowof(int, int) const { return 0; } };

typedef f32x4 AccT[2][2][4][2];
__device__ __forceinline__ u32x4 pack8(const f32x4 v0, const f32x4 v1) { u32x4 w; w.x = cvt_pk_bf16(v0[0], v0[1]); w.y = cvt_pk_bf16(v0[2], v0[3]); w.z = cvt_pk_bf16(v1[0], v1[1]); w.w = cvt_pk_bf16(v1[2], v1[3]); return w; }

struct EpiStore {
    static constexpr bool PERM = true, AFTER_DRAIN = false, KEEPS = false;
    bf16_t* O; int ldc;
    __device__ __forceinline__ void operator()(AccT& acc, const Unit& u, int wr, int wc, int fr, int fq) const {
        const int row0 = u.pm * BM + wr * 64 + fr, col0 = u.pn * BM + wc * 32 + 8 * fq;
#pragma unroll
        for (int ai = 0; ai < 2; ++ai)
#pragma unroll
            for (int m = 0; m < 4; ++m) { bf16_t* rowp = O + (size_t)(row0 + ai * HALF + m * 16) * ldc + col0;
#pragma unroll
                for (int bj = 0; bj < 2; ++bj) *(u32x4*)(rowp + bj * HALF) = pack8(acc[ai][bj][m][0], acc[ai][bj][m][1]); }
    }
};
struct EpiStoreS {
    static constexpr bool PERM = true, AFTER_DRAIN = false, KEEPS = false;
    bf16_t* O; int ldc; float sc;
    __device__ __forceinline__ void operator()(AccT& acc, const Unit& u, int wr, int wc, int fr, int fq) const {
        const int row0 = u.pm * BM + wr * 64 + fr, col0 = u.pn * BM + wc * 32 + 8 * fq;
#pragma unroll
        for (int ai = 0; ai < 2; ++ai)
#pragma unroll
            for (int m = 0; m < 4; ++m) { bf16_t* rowp = O + (size_t)(row0 + ai * HALF + m * 16) * ldc + col0;
#pragma unroll
                for (int bj = 0; bj < 2; ++bj) *(u32x4*)(rowp + bj * HALF) = pack8(acc[ai][bj][m][0] * sc, acc[ai][bj][m][1] * sc); }
    }
};
struct EpiKV {
    static constexpr bool PERM = true, AFTER_DRAIN = false, KEEPS = false;
    bf16_t* kvb;
    __device__ __forceinline__ void operator()(AccT& acc, const Unit& u, int wr, int wc, int fr, int fq) const {
        const int l = u.z >> 1, isv = u.z & 1;
        bf16_t* base = kvb + (size_t)l * 4194304 + (isv ? 2097152 : 0);
        const int ldc = 1024;
        const int row0 = u.pm * 256 + wr * 64 + fr, col0 = u.pn * 256 + wc * 32 + 8 * fq;
#pragma unroll
        for (int ai = 0; ai < 2; ++ai)
#pragma unroll
            for (int m = 0; m < 4; ++m) { bf16_t* rowp = base + (size_t)(row0 + ai * HALF + m * 16) * ldc + col0;
#pragma unroll
                for (int bj = 0; bj < 2; ++bj) *(u32x4*)(rowp + bj * HALF) = pack8(acc[ai][bj][m][0], acc[ai][bj][m][1]); }
    }
};
#ifdef MK_GATE_LOGIT
#define GATE_ACT(x) (x)
#else
#define GATE_ACT(x) fast_sigmoid(x)
#endif
struct EpiProj {
    static constexpr bool PERM = true, AFTER_DRAIN = false, KEEPS = false;
    bf16_t* projb; bf16_t* gate; const float* bgate; float sc;
    __device__ __forceinline__ void operator()(AccT& acc, const Unit& u, int wr, int wc, int fr, int fq) const {
        const int row0 = u.pm * BM + wr * 64 + fr;
        if (u.pn < 19) {
            const int col0 = u.pn * BM + wc * 32 + 8 * fq;
#pragma unroll
            for (int ai = 0; ai < 2; ++ai)
#pragma unroll
                for (int m = 0; m < 4; ++m) { bf16_t* rowp = projb + (size_t)(row0 + ai * HALF + m * 16) * 4864 + col0;
#pragma unroll
                    for (int bj = 0; bj < 2; ++bj) *(u32x4*)(rowp + bj * HALF) = pack8(acc[ai][bj][m][0] * sc, acc[ai][bj][m][1] * sc); }
        } else {
            const int col0 = (u.pn - 19) * BM + wc * 32 + 8 * fq;
            f32x4 bv[2][2];
#pragma unroll
            for (int bj = 0; bj < 2; ++bj)
#pragma unroll
                for (int n = 0; n < 2; ++n) bv[bj][n] = *(const f32x4*)(bgate + col0 + bj * HALF + 4 * n);
#pragma unroll
            for (int ai = 0; ai < 2; ++ai)
#pragma unroll
                for (int m = 0; m < 4; ++m) { bf16_t* rowp = gate + (size_t)(row0 + ai * HALF + m * 16) * 4096 + col0;
#pragma unroll
                    for (int bj = 0; bj < 2; ++bj) { f32x4 v0 = acc[ai][bj][m][0] * sc + bv[bj][0], v1 = acc[ai][bj][m][1] * sc + bv[bj][1];
#pragma unroll
                        for (int j = 0; j < 4; ++j) { v0[j] = GATE_ACT(v0[j]); v1[j] = GATE_ACT(v1[j]); }
                        *(u32x4*)(rowp + bj * HALF) = pack8(v0, v1); } }
        }
    }
};
struct EpiGlu {
    static constexpr bool PERM = true, AFTER_DRAIN = false, KEEPS = false;
    const bf16_t* ys; bf16_t* br;
    __device__ __forceinline__ void operator()(AccT& acc, const Unit& u, int wr, int wc, int fr, int fq) const {
        const int row0 = u.pm * BM + wr * 64 + fr, col0 = u.pn * BM + wc * 32 + 8 * fq;
#pragma unroll
        for (int ai = 0; ai < 2; ++ai)
#pragma unroll
            for (int m = 0; m < 4; ++m) { const size_t row = (size_t)(row0 + ai * HALF + m * 16);
#pragma unroll
                for (int bj = 0; bj < 2; ++bj) { const u32x4 yw = *(const u32x4*)(ys + row * 512 + col0 + bj * HALF);
                    f32x4 v0 = acc[ai][bj][m][0], v1 = acc[ai][bj][m][1];
                    v0[0] = bf_lo(yw.x) * fast_sigmoid(v0[0]); v0[1] = bf_hi(yw.x) * fast_sigmoid(v0[1]); v0[2] = bf_lo(yw.y) * fast_sigmoid(v0[2]); v0[3] = bf_hi(yw.y) * fast_sigmoid(v0[3]);
                    v1[0] = bf_lo(yw.z) * fast_sigmoid(v1[0]); v1[1] = bf_hi(yw.z) * fast_sigmoid(v1[1]); v1[2] = bf_lo(yw.w) * fast_sigmoid(v1[2]); v1[3] = bf_hi(yw.w) * fast_sigmoid(v1[3]);
                    *(u32x4*)(br + row * 2048 + col0 + bj * HALF) = pack8(v0, v1); } }
    }
};
struct EpiMerge {
    static constexpr bool PERM = true, AFTER_DRAIN = false, KEEPS = true;
    const bf16_t* gate; bf16_t* merged;
    __device__ __forceinline__ bool keep(const Unit& u) const { return u.z < 3; }
    __device__ __forceinline__ void operator()(AccT& acc, const Unit& u, int wr, int wc, int fr, int fq) const {
        const int row0 = u.pm * BM + wr * 64 + fr, col0 = u.pn * BM + wc * 32 + 8 * fq, k = u.z;
        if (k < 3) {
#pragma unroll
            for (int ai = 0; ai < 2; ++ai) { u32x4 gw[4][2], nw[4][2];
#pragma unroll
                for (int m = 0; m < 4; ++m)
#pragma unroll
                    for (int bj = 0; bj < 2; ++bj) { const bf16_t* gp = gate + (size_t)(row0 + ai * HALF + m * 16) * 4096 + k * 1024 + col0 + bj * HALF; gw[m][bj] = *(const u32x4*)gp; nw[m][bj] = *(const u32x4*)(gp + 1024); }
#pragma unroll
                for (int m = 0; m < 4; ++m)
#pragma unroll
                    for (int bj = 0; bj < 2; ++bj) { const u32x4 a = gw[m][bj], b = nw[m][bj];
                        const f32x4 g0 = (f32x4){bf_lo(a.x), bf_hi(a.x), bf_lo(a.y), bf_hi(a.y)}, g1 = (f32x4){bf_lo(a.z), bf_hi(a.z), bf_lo(a.w), bf_hi(a.w)};
                        const f32x4 n0 = (f32x4){bf_lo(b.x), bf_hi(b.x), bf_lo(b.y), bf_hi(b.y)}, n1 = (f32x4){bf_lo(b.z), bf_hi(b.z), bf_lo(b.w), bf_hi(b.w)};
                        f32x4 r0, r1;
#pragma unroll
                        for (int j = 0; j < 4; ++j) { r0[j] = fmaxf(g0[j], 1e-20f) * __builtin_amdgcn_rcpf(fmaxf(n0[j], 1e-20f)); r1[j] = fmaxf(g1[j], 1e-20f) * __builtin_amdgcn_rcpf(fmaxf(n1[j], 1e-20f)); }
                        acc[ai][bj][m][0] *= r0; acc[ai][bj][m][1] *= r1; }
                asm volatile("" ::: "memory"); }
        } else {
#pragma unroll
            for (int ai = 0; ai < 2; ++ai) { u32x4 gw[4][2];
#pragma unroll
                for (int m = 0; m < 4; ++m)
#pragma unroll
                    for (int bj = 0; bj < 2; ++bj) gw[m][bj] = *(const u32x4*)(gate + (size_t)(row0 + ai * HALF + m * 16) * 4096 + k * 1024 + col0 + bj * HALF);
#pragma unroll
                for (int m = 0; m < 4; ++m)
#pragma unroll
                    for (int bj = 0; bj < 2; ++bj) { const u32x4 a = gw[m][bj];
                        f32x4 g0 = (f32x4){bf_lo(a.x), bf_hi(a.x), bf_lo(a.y), bf_hi(a.y)}, g1 = (f32x4){bf_lo(a.z), bf_hi(a.z), bf_lo(a.w), bf_hi(a.w)};
#pragma unroll
                        for (int j = 0; j < 4; ++j) { g0[j] = fmaxf(g0[j], 1e-20f); g1[j] = fmaxf(g1[j], 1e-20f); }
                        *(u32x4*)(merged + (size_t)(row0 + ai * HALF + m * 16) * 1024 + col0 + bj * HALF) = pack8(acc[ai][bj][m][0] * g0, acc[ai][bj][m][1] * g1); }
                asm volatile("" ::: "memory"); }
        }
    }
};
struct EpiRes {
    static constexpr bool PERM = false, AFTER_DRAIN = false, KEEPS = false;
    const float* in; float* out;
    __device__ __forceinline__ void operator()(AccT& acc, const Unit& u, int wr, int wc, int fr, int fq) const {
        const int row0 = u.pm * BM + wr * 64 + fr, col0 = u.pn * BM + wc * 32 + 4 * fq;
#pragma unroll
        for (int ai = 0; ai < 2; ++ai)
#pragma unroll
            for (int m = 0; m < 4; ++m) { const size_t off = (size_t)(row0 + ai * HALF + m * 16) * 1024 + col0;
#pragma unroll
                for (int bj = 0; bj < 2; ++bj)
#pragma unroll
                    for (int n = 0; n < 2; ++n) { const f32x4 bs = *(const f32x4*)(in + off + bj * HALF + n * 16); *(f32x4*)(out + off + bj * HALF + n * 16) = bs + acc[ai][bj][m][n]; }
                if (m == 3) asm volatile("" ::: "memory"); }
    }
};
struct EpiSoftmax {
    static constexpr bool PERM = true, AFTER_DRAIN = true, KEEPS = false;
    bf16_t* P; PG8_LAS float* xch;
    __device__ __forceinline__ void fused(AccT& acc, const Unit& u, int wr, int wc, int fr, int fq, PG8_LAS unsigned char*, int, int) const {
        PG8_LAS float* RM = xch; PG8_LAS float* RS = xch + 1024;
#pragma unroll
        for (int ai = 0; ai < 2; ++ai)
#pragma unroll
            for (int m = 0; m < 4; ++m) { float mx = -3.0e38f;
#pragma unroll
                for (int bj = 0; bj < 2; ++bj)
#pragma unroll
                    for (int n = 0; n < 2; ++n) { const f32x4 x = acc[ai][bj][m][n]; mx = fmaxf(mx, fmaxf(fmaxf(x[0], x[1]), fmaxf(x[2], x[3]))); }
                mx = fmaxf(mx, __shfl_xor(mx, 16)); mx = fmaxf(mx, __shfl_xor(mx, 32));
                if (fq == 0) RM[(ai * HALF + wr * 64 + m * 16 + fr) * 4 + wc] = mx; }
        asm volatile("s_waitcnt lgkmcnt(0)" ::: "memory"); __builtin_amdgcn_s_barrier(); asm volatile("" ::: "memory");
#pragma unroll
        for (int ai = 0; ai < 2; ++ai)
#pragma unroll
            for (int m = 0; m < 4; ++m) { const int r = ai * HALF + wr * 64 + m * 16 + fr; const f32x4 q = *(const PG8_LAS f32x4*)(RM + r * 4);
                const float mx = fmaxf(fmaxf(q[0], q[1]), fmaxf(q[2], q[3])) * 1.4426950408889634f; float s = 0.f;
#pragma unroll
                for (int bj = 0; bj < 2; ++bj)
#pragma unroll
                    for (int n = 0; n < 2; ++n) { f32x4 x = acc[ai][bj][m][n];
#pragma unroll
                        for (int j = 0; j < 4; ++j) { x[j] = __builtin_amdgcn_exp2f(x[j] * 1.4426950408889634f - mx); s += x[j]; }
                        acc[ai][bj][m][n] = x; }
                s += __shfl_xor(s, 16); s += __shfl_xor(s, 32);
                if (fq == 0) RS[r * 4 + wc] = s; }
        asm volatile("s_waitcnt lgkmcnt(0)" ::: "memory"); __builtin_amdgcn_s_barrier(); asm volatile("" ::: "memory");
        const int row0 = u.pm * BM + wr * 64 + fr, col0 = u.pn * BM + wc * 32 + 8 * fq;
#pragma unroll
        for (int ai = 0; ai < 2; ++ai)
#pragma unroll
            for (int m = 0; m < 4; ++m) { const int r = ai * HALF + wr * 64 + m * 16 + fr; const f32x4 q = *(const PG8_LAS f32x4*)(RS + r * 4);
                const float inv = __builtin_amdgcn_rcpf((q[0] + q[1]) + (q[2] + q[3]));
                bf16_t* rowp = P + (size_t)(row0 + ai * HALF + m * 16) * 1024 + col0;
#pragma unroll
                for (int bj = 0; bj < 2; ++bj) *(u32x4*)(rowp + bj * HALF) = pack8(acc[ai][bj][m][0] * inv, acc[ai][bj][m][1] * inv); }
    }
};
struct EpiSwiglu {
    static constexpr bool PERM = true, AFTER_DRAIN = false, KEEPS = false;
    bf16_t* act; int ldc; float sc;
    __device__ __forceinline__ void operator()(AccT& acc, const Unit& u, int wr, int wc, int fr, int fq) const {
        const int row0 = u.pm * BM + wr * 64 + fr, col0 = u.pn * 128 + wc * 16 + 4 * fq;
#pragma unroll
        for (int ai = 0; ai < 2; ++ai)
#pragma unroll
            for (int m = 0; m < 4; ++m) { bf16_t* rowp = act + (size_t)(row0 + ai * HALF + m * 16) * ldc + col0;
#pragma unroll
                for (int bj = 0; bj < 2; ++bj) { const f32x4 a = acc[ai][bj][m][0] * sc, b = acc[ai][bj][m][1] * sc; f32x4 o;
#pragma unroll
                    for (int j = 0; j < 4; ++j) o[j] = a[j] * fast_sigmoid(a[j]) * b[j];
                    u32x2 w; w.x = cvt_pk_bf16(o[0], o[1]); w.y = cvt_pk_bf16(o[2], o[3]); *(u32x2*)(rowp + bj * 64) = w; } }
    }
};
struct EpiSwigluF8 {
    static constexpr bool PERM = true, AFTER_DRAIN = false, KEEPS = false;
    unsigned char* act; int ldc; float sc, so;
    __device__ __forceinline__ void operator()(AccT& acc, const Unit& u, int wr, int wc, int fr, int fq) const {
        const int row0 = u.pm * BM + wr * 64 + fr, col0 = u.pn * 128 + wc * 16 + 4 * fq;
#pragma unroll
        for (int ai = 0; ai < 2; ++ai)
#pragma unroll
            for (int m = 0; m < 4; ++m) { unsigned char* rowp = act + (size_t)(row0 + ai * HALF + m * 16) * ldc + col0;
#pragma unroll
                for (int bj = 0; bj < 2; ++bj) { const f32x4 a = acc[ai][bj][m][0] * sc, b = acc[ai][bj][m][1] * sc; f32x4 o;
#pragma unroll
                    for (int j = 0; j < 4; ++j) o[j] = a[j] * fast_sigmoid(a[j]) * b[j] * so;
                    int w = 0; w = __builtin_amdgcn_cvt_pk_fp8_f32(o[0], o[1], w, false); w = __builtin_amdgcn_cvt_pk_fp8_f32(o[2], o[3], w, true); *(unsigned*)(rowp + bj * 64) = (unsigned)w; } }
    }
};

struct PlainOrder : NoHooks {
    const char* A; const char* B; int nM, nN, lda, ldb, G, c;
    __device__ __forceinline__ bool next(int i, Unit& u) const { const int L = i * G + c; if (L >= nM * nN) return false; tile_map(L, nM, nN, u.pm, u.pn); u.z = 0;
        u.a = A + (size_t)u.pm * 256 * lda * 2; u.b = B + (size_t)u.pn * 256 * ldb * 2; return true; }
};
struct PlainOrderOff : NoHooks {
    const char* A; const char* B; int nM, nN, lda, ldb, G, c, pn0, L0, L1;
    __device__ __forceinline__ bool next(int i, Unit& u) const { const int L = L0 + i * G + c; if (L >= L1) return false; tile_map(L, nM, nN, u.pm, u.pn); u.pn += pn0; u.z = 0;
        u.a = A + (size_t)u.pm * 256 * lda * 2; u.b = B + (size_t)u.pn * 256 * ldb * 2; return true; }
};
struct PlainOrderOffF8 : NoHooks {   static constexpr bool F8 = true;
    const char* A; const char* B; int nM, nN, lda, ldb, G, c, pn0, L0, L1;
    __device__ __forceinline__ bool next(int i, Unit& u) const { const int L = L0 + i * G + c; if (L >= L1) return false; tile_map(L, nM, nN, u.pm, u.pn); u.pn += pn0; u.z = 0;
        u.a = A + (size_t)u.pm * 256 * lda * 2; u.b = B + (size_t)u.pn * 256 * ldb * 2; return true; }
};
struct MergeOrder : NoHooks {
    const char* br_; const char* wb_; int G, c;
    __device__ __forceinline__ bool next(int i, Unit& u) const { const int t = c + (i >> 2) * G; if (t >= 256) return false; const int k = i & 3; tile_map(t, 64, 4, u.pm, u.pn); u.z = k;
        u.a = br_ + ((size_t)u.pm * 256 * 2048 + k * 512) * 2; u.b = wb_ + ((size_t)u.pn * 256 * 2048 + k * 512) * 2; return true; }
};
struct KVOrder : NoHooks {
    const char* mnr_; const char* WKV0; const char* WKV1; int G, c;
    __device__ __forceinline__ bool next(int i, Unit& u) const { const int L = i * G + c; if (L >= 128) return false; const int kind = L >> 5, t = L & 31, isv = kind & 1;
        const char* W = (kind >> 1) ? WKV1 : WKV0; u.z = kind;
        if (!isv) { u.pm = t & 7; u.pn = t >> 3; u.a = mnr_ + (size_t)u.pm * 256 * 1024 * 2; u.b = W + (size_t)u.pn * 256 * 1024 * 2; }
        else { u.pm = t & 7; u.pn = t >> 3; u.a = mnr_ + (size_t)u.pm * 256 * 1024 * 2; u.b = W + (size_t)(1024 + u.pn * 256) * 1024 * 2; }
        return true; }
};
struct VWOOrder : NoHooks {
    const char* wo_; const char* v_; int G, c;
    __device__ __forceinline__ bool next(int i, Unit& u) const { if (c < 0) return false; const int L = i * G + c; if (L >= 128) return false; const int b = L >> 4, h = (L >> 2) & 3, nt = L & 3; u.pm = b * 4 + nt; u.pn = h; u.z = 0;
        u.a = wo_ + ((size_t)nt * 256 * 1024 + h * 256) * 2; u.b = v_ + ((size_t)b * 256 * 1024 + h * 256) * 2; return true; }
};
struct PVWOrder : NoHooks {
    const char* p_; const char* vwo_; int G, c;
    __device__ __forceinline__ bool next(int i, Unit& u) const { const int L = i * G + c; if (L >= 256) return false; tile_map(L, 64, 4, u.pm, u.pn); u.z = 0;
        u.a = p_ + (size_t)u.pm * 256 * 1024 * 2; u.b = vwo_ + ((size_t)(u.pm >> 3) * 1024 + u.pn * 256) * 1024 * 2; return true; }
};
struct QKWOrder : NoHooks {
    const char* kx_; const char* wqn_; int G, c;
    __device__ __forceinline__ bool next(int i, Unit& u) const { if (c < 0) return false; const int L = i * G + c; if (L >= 128) return false; const int bh = L >> 2; u.pm = bh; u.pn = L & 3; u.z = 0;
        u.a = kx_ + ((size_t)(bh >> 2) * 256 * 1024 + (bh & 3) * 256) * 2; u.b = wqn_ + ((size_t)u.pn * 256 * 1024 + (bh & 3) * 256) * 2; return true; }
};
struct ScoreOrder : NoHooks {
    const char* hn_; const char* qkw_; int G, c, base;
    __device__ __forceinline__ bool next(int i, Unit& u) const { const int L = base + c; if (i > 0 || L >= 256) return false; tile_map(L, 64, 4, u.pm, u.pn); u.z = 0;
        u.a = hn_ + (size_t)u.pm * 256 * 1024 * 2; u.b = qkw_ + (size_t)((u.pm >> 3) * 4 + u.pn) * 256 * 1024 * 2; return true; }
};
struct QKOrder : NoHooks {
    const char* xq_; const char* kx_; int G, c, base;
    __device__ __forceinline__ bool next(int i, Unit& u) const { const int L = base + c; if (i > 0 || L >= 256) return false; tile_map(L, 64, 4, u.pm, u.pn); u.z = 0;
        u.a = xq_ + ((size_t)u.pm * 256 * 1024 + u.pn * 256) * 2; u.b = kx_ + ((size_t)(u.pm >> 3) * 256 * 1024 + u.pn * 256) * 2; return true; }
};
struct PVOrder : NoHooks {
    const char* p_; const char* vt_; int G, c;
    __device__ __forceinline__ bool next(int i, Unit& u) const { const int L = i * G + c; if (L >= 256) return false; tile_map(L, 64, 4, u.pm, u.pn); u.z = 0;
        u.a = p_ + ((size_t)u.pm * 256 * 1024 + u.pn * 256) * 2; u.b = vt_ + ((size_t)(u.pm >> 3) * 1024 + u.pn * 256) * 256 * 2; return true; }
};
struct EpiPartF32 {
    static constexpr bool PERM = true, AFTER_DRAIN = false, KEEPS = false;
    float* P;
    __device__ __forceinline__ void operator()(AccT& acc, const Unit& u, int wr, int wc, int fr, int fq) const {
        const int row0 = u.z * BM + wr * 64 + fr, col0 = u.pn * BM + wc * 32 + 8 * fq;
#pragma unroll
        for (int ai = 0; ai < 2; ++ai)
#pragma unroll
            for (int m = 0; m < 4; ++m) { float* rowp = P + (size_t)(row0 + ai * HALF + m * 16) * 1024 + col0;
#pragma unroll
                for (int bj = 0; bj < 2; ++bj) { *(f32x4*)(rowp + bj * HALF) = acc[ai][bj][m][0]; *(f32x4*)(rowp + bj * HALF + 4) = acc[ai][bj][m][1]; } }
    }
};
struct EpiPartF32S {
    static constexpr bool PERM = true, AFTER_DRAIN = false, KEEPS = false;
    float* P; float sc;
    __device__ __forceinline__ void operator()(AccT& acc, const Unit& u, int wr, int wc, int fr, int fq) const {
        const int row0 = u.z * BM + wr * 64 + fr, col0 = u.pn * BM + wc * 32 + 8 * fq;
#pragma unroll
        for (int ai = 0; ai < 2; ++ai)
#pragma unroll
            for (int m = 0; m < 4; ++m) { float* rowp = P + (size_t)(row0 + ai * HALF + m * 16) * 1024 + col0;
#pragma unroll
                for (int bj = 0; bj < 2; ++bj) { *(f32x4*)(rowp + bj * HALF) = acc[ai][bj][m][0] * sc; *(f32x4*)(rowp + bj * HALF + 4) = acc[ai][bj][m][1] * sc; } }
    }
};
struct MoeUpGather : NoHooks {
    static constexpr bool GATHER = true, F8 = true;
    const char* A; const char* B; size_t estride; int lda, ldb, ntiles, nN, G, c; int t1, t2, t3, t4, t5, t6, t7; const PG8_LAS int* tab;
    __device__ __forceinline__ bool next(int i, Unit& u) const { const int L = i * G + c; if (L >= ntiles * nN) return false; tile_map(L, ntiles, nN, u.pm, u.pn);
        const int rt = u.pm; const int e = (rt >= t1) + (rt >= t2) + (rt >= t3) + (rt >= t4) + (rt >= t5) + (rt >= t6) + (rt >= t7); u.z = e;
        u.a = A; u.b = B + (size_t)e * estride + (size_t)u.pn * 256 * ldb * 2; return true; }
    __device__ __forceinline__ int rowof(int ord, int r) const { return tab[ord * 256 + r]; }
};
struct MoeUpF8 : NoHooks {
    static constexpr bool F8 = true;
    const char* A; const char* B; size_t estride; int lda, ldb, ntiles, nN, G, c; int t1, t2, t3, t4, t5, t6, t7;
    __device__ __forceinline__ bool next(int i, Unit& u) const { const int L = i * G + c; if (L >= ntiles * nN) return false; tile_map(L, ntiles, nN, u.pm, u.pn);
        const int rt = u.pm; const int e = (rt >= t1) + (rt >= t2) + (rt >= t3) + (rt >= t4) + (rt >= t5) + (rt >= t6) + (rt >= t7); u.z = e;
        u.a = A + (size_t)rt * 256 * lda * 2; u.b = B + (size_t)e * estride + (size_t)u.pn * 256 * ldb * 2; return true; }
};
struct MoeDownOrder : NoHooks {
    const char* A; const char* B; size_t estride; int lda, ldb, G, c; int t1, t2, t3, t4, t5, t6, t7;
    __device__ __forceinline__ bool next(int i, Unit& u) const { const int L = i * G + c; if (L >= 512) return false; u.pm = L >> 2; u.pn = L & 3;
        const int rt = u.pm; const int e = (rt >= t1) + (rt >= t2) + (rt >= t3) + (rt >= t4) + (rt >= t5) + (rt >= t6) + (rt >= t7); u.z = e;
        u.a = A + (size_t)rt * 256 * lda * 2; u.b = B + (size_t)e * estride + (size_t)u.pn * 256 * ldb * 2; return true; }
};
struct MoeDownOrderF8 : NoHooks {   static constexpr bool F8 = true;
    const char* A; const char* B; size_t estride; int lda, ldb, G, c; int t1, t2, t3, t4, t5, t6, t7;
    __device__ __forceinline__ bool next(int i, Unit& u) const { const int L = i * G + c; if (L >= 512) return false; u.pm = L >> 2; u.pn = L & 3;
        const int rt = u.pm; const int e = (rt >= t1) + (rt >= t2) + (rt >= t3) + (rt >= t4) + (rt >= t5) + (rt >= t6) + (rt >= t7); u.z = e;
        u.a = A + (size_t)rt * 256 * lda * 2; u.b = B + (size_t)e * estride + (size_t)u.pn * 256 * ldb * 2; return true; }
};
struct MoeDownTail : NoHooks {
    const char* A; const char* B; size_t estride; int lda, ldb, ntiles, G, c; int t1, t2, t3, t4, t5, t6, t7;
    __device__ __forceinline__ bool next(int i, Unit& u) const { const int v = i * G + c; if (v >= (ntiles - 128) * 28) return false; u.pn = v & 3; const int w = v >> 2, s = w % 7, jr = w / 7;
        const int rt = 128 + jr; u.pm = rt; const int e = (rt >= t1) + (rt >= t2) + (rt >= t3) + (rt >= t4) + (rt >= t5) + (rt >= t6) + (rt >= t7); u.z = jr * 7 + s;
        u.a = A + ((size_t)rt * 256 * lda + s * 512) * 2; u.b = B + (size_t)e * estride + ((size_t)u.pn * 256 * ldb + s * 512) * 2; return true; }
};
struct MoeDownTailF8 : NoHooks {   static constexpr bool F8 = true;
    const char* A; const char* B; size_t estride; int lda, ldb, ntiles, G, c; int t1, t2, t3, t4, t5, t6, t7;
    __device__ __forceinline__ bool next(int i, Unit& u) const { const int v = i * G + c; if (v >= (ntiles - 128) * 28) return false; u.pn = v & 3; const int w = v >> 2, s = w % 7, jr = w / 7;
        const int rt = 128 + jr; u.pm = rt; const int e = (rt >= t1) + (rt >= t2) + (rt >= t3) + (rt >= t4) + (rt >= t5) + (rt >= t6) + (rt >= t7); u.z = jr * 7 + s;
        u.a = A + ((size_t)rt * 256 * lda + s * 256) * 2; u.b = B + (size_t)e * estride + ((size_t)u.pn * 256 * ldb + s * 256) * 2; return true; }
};
struct MoeOrder : NoHooks {
    const char* A; const char* B; size_t estride; int lda, ldb, ntiles, nN, G, c; int t1, t2, t3, t4, t5, t6, t7;
    __device__ __forceinline__ bool next(int i, Unit& u) const { const int L = i * G + c; if (L >= ntiles * nN) return false; tile_map(L, ntiles, nN, u.pm, u.pn);
        const int rt = u.pm; const int e = (rt >= t1) + (rt >= t2) + (rt >= t3) + (rt >= t4) + (rt >= t5) + (rt >= t6) + (rt >= t7); u.z = e;
        u.a = A + (size_t)rt * 256 * lda * 2; u.b = B + (size_t)e * estride + (size_t)u.pn * 256 * ldb * 2; return true; }
};

template <class Epi, class Sched, bool ALIGN_EPI = false, bool SP2 = false>
__device__ __forceinline__ void gemm_phase(PG8_LAS unsigned char* lds, const Gemm g, const Sched& S, const Epi& E, const int wave_s) {
    int tid_ = wave_s * 64 + lane_id_fresh(); asm volatile("" : "+v"(tid_));
    const int tid = tid_, wid = __builtin_amdgcn_readfirstlane(tid >> 6), lane = tid & 63, wr = wid >> 2, wc = wid & 3, fr = lane & 15, fq = lane >> 4;
    const int K = g.K, nt = K / BK;
    unsigned voffA[2], voffB[2];
#pragma unroll
    for (int i = 0; i < 2; ++i) { int R, C; stage_rc(tid * 16 + i * 8192, R, C); const int Rb = Epi::PERM ? ((R & ~31) + perm32(R & 31)) : R;
        voffA[i] = (unsigned)(R * g.lda + C) * 2u; voffB[i] = (unsigned)(Rb * g.ldb + C) * 2u; }
    const size_t kstep = (size_t)(BK * 2);
    const size_t hstepA = (size_t)HALF * g.lda * 2, hstepB = (size_t)HALF * g.ldb * 2;
    const unsigned ldsw = (unsigned)wid * 1024u;
    const int aoff = lds_byte(wr * 64 + fr, fq * 8), boff = lds_byte(wc * 32 + fr, fq * 8);
#define PG8_SA(b, h) (((b) * 2 + (h)) * HTB)
#define PG8_SB(b, h) ((4 + (b) * 2 + (h)) * HTB)
#define PG8_UBASE(gbase) ([&]() -> const char* { if constexpr (Sched::F8) { const unsigned long long p_ = (unsigned long long)(gbase); \
        return (const char*)(((unsigned long long)(unsigned)__builtin_amdgcn_readfirstlane((int)(unsigned)(p_ >> 32)) << 32) | (unsigned long long)(unsigned)__builtin_amdgcn_readfirstlane((int)(unsigned)p_)); } else { return (const char*)(gbase); } }())
#define PG8_STAGE(bufoff, gbase, voff) do { const char* gb_ = PG8_UBASE(gbase); _Pragma("unroll") for (int _i = 0; _i < 2; ++_i) \
        __builtin_amdgcn_global_load_lds((const unsigned*)(gb_ + (voff)[_i]), (PG8_LAS unsigned*)(lds + (bufoff) + ldsw + _i * 8192), 16, 0, 0); } while (0)
#define PG8_LDA(dst, b, h) do { if constexpr (Sched::F8) { _Pragma("unroll") for (int m = 0; m < 4; ++m) dst##8[m] = PG8_CAT8(*(const PG8_LAS bf16x8*)(lds + PG8_SA(b, h) + aoff + m * 2048), *(const PG8_LAS bf16x8*)(lds + PG8_SA(b, h) + aoff + m * 2048 + 1024)); } \
    else { _Pragma("unroll") for (int m = 0; m < 4; ++m) _Pragma("unroll") for (int k = 0; k < 2; ++k) dst[m][k] = *(const PG8_LAS bf16x8*)(lds + PG8_SA(b, h) + aoff + m * 2048 + k * 1024); } } while (0)
#define PG8_LDB(dst, b, h) do { if constexpr (Sched::F8) { _Pragma("unroll") for (int n = 0; n < 2; ++n) dst##8[n] = PG8_CAT8(*(const PG8_LAS bf16x8*)(lds + PG8_SB(b, h) + boff + n * 2048), *(const PG8_LAS bf16x8*)(lds + PG8_SB(b, h) + boff + n * 2048 + 1024)); } \
    else { _Pragma("unroll") for (int n = 0; n < 2; ++n) _Pragma("unroll") for (int k = 0; k < 2; ++k) dst[n][k] = *(const PG8_LAS bf16x8*)(lds + PG8_SB(b, h) + boff + n * 2048 + k * 1024); } } while (0)
#define PG8_CAT8(x0, x1) __builtin_shufflevector(__builtin_bit_cast(i32x4_, (x0)), __builtin_bit_cast(i32x4_, (x1)), 0, 1, 2, 3, 4, 5, 6, 7)
#define PG8_MMA(ai, bj, At, Bt) do { __builtin_amdgcn_s_setprio(1); if constexpr (Sched::F8) { _Pragma("unroll") for (int m = 0; m < 4; ++m) _Pragma("unroll") for (int n = 0; n < 2; ++n) \
        asm volatile("v_mfma_scale_f32_16x16x128_f8f6f4 %0, %1, %2, %0, %3, %3 op_sel_hi:[0,0,0]" : "+v"(acc[ai][bj][m][n]) : "v"(Bt##8[n]), "v"(At##8[m]), "v"(sc7f_)); }     \
      else { _Pragma("unroll") for (int m = 0; m < 4; ++m) _Pragma("unroll") for (int n = 0; n < 2; ++n) _Pragma("unroll") for (int k = 0; k < 2; ++k) \
        acc[ai][bj][m][n] = __builtin_amdgcn_mfma_f32_16x16x32_bf16(Bt[n][k], At[m][k], acc[ai][bj][m][n], 0, 0, 0); } __builtin_amdgcn_s_setprio(0); } while (0)
#define PG8_WAIT_V(n) asm volatile("s_waitcnt vmcnt(" #n ")" ::: "memory")
#define PG8_WAIT_L(n) asm volatile("s_waitcnt lgkmcnt(" #n ")" ::: "memory")
#define PG8_BAR __builtin_amdgcn_s_barrier()
#define PG8_SCHED __builtin_amdgcn_sched_barrier(0)
    Unit cur, nxt; int ui = 0;
    if (!S.next(0, cur)) return;
    static_assert(!Sched::GATHER || SP2, "row-gathered A staging is written for the SP2 schedule only");
    unsigned vgc[2][2] = {{0u, 0u}, {0u, 0u}}, vgn[2][2] = {{0u, 0u}, {0u, 0u}}, vgs[2][2] = {{0u, 0u}, {0u, 0u}};
#define PG8_GLOAD(vg, ord) do { _Pragma("unroll") for (int h_ = 0; h_ < 2; ++h_) _Pragma("unroll") for (int i_ = 0; i_ < 2; ++i_) { int R_, C_; stage_rc(tid * 16 + i_ * 8192, R_, C_); \
        vg[h_][i_] = (unsigned)(S.rowof((ord), h_ * HALF + R_) * g.lda + C_) * 2u; } } while (0)
#define PG8_STAGE_A(b, h, base, vg) do { if constexpr (Sched::GATHER) { PG8_STAGE(PG8_SA(b, h), (base), vg[h]); } else { PG8_STAGE(PG8_SA(b, h), (base) + (h) * hstepA, voffA); } } while (0)
    if constexpr (Sched::GATHER) PG8_GLOAD(vgc, 0);
    f32x4 acc[2][2][4][2];
#pragma unroll
    for (int a = 0; a < 2; ++a)
#pragma unroll
        for (int b = 0; b < 2; ++b)
#pragma unroll
            for (int m = 0; m < 4; ++m)
#pragma unroll
                for (int n = 0; n < 2; ++n) acc[a][b][m][n] = (f32x4){0.f, 0.f, 0.f, 0.f};
    bf16x8 At[4][2], B0[2][2], B1[2][2];
    int sc7f_ = 0x7F7F7F7F; asm volatile("" : "+v"(sc7f_));
    i32x8_ At8[4], B08[2], B18[2];
    const char* cA = cur.a; const char* cB = cur.b;
    S.a_ready(cur);
    if constexpr (SP2) {
        PG8_STAGE(PG8_SB(0, 0), cB, voffB); PG8_STAGE(PG8_SB(0, 1), cB + hstepB, voffB); PG8_STAGE_A(0, 0, cA, vgc); PG8_STAGE_A(0, 1, cA, vgc);
        if (wr == 1) PG8_BAR;
        PG8_WAIT_V(2); PG8_BAR;
        PG8_STAGE(PG8_SB(1, 0), cB + kstep, voffB); PG8_STAGE_A(1, 0, cA + kstep, vgc); PG8_STAGE(PG8_SB(1, 1), cB + hstepB + kstep, voffB);
        PG8_WAIT_V(6); PG8_BAR;
    } else {
        PG8_STAGE(PG8_SB(0, 0), cB, voffB); PG8_STAGE(PG8_SA(0, 0), cA, voffA); PG8_STAGE(PG8_SB(0, 1), cB + hstepB, voffB); PG8_STAGE(PG8_SA(0, 1), cA + hstepA, voffA);
        if (wr == 1) PG8_BAR;
        PG8_WAIT_V(4); PG8_BAR;
        PG8_STAGE(PG8_SB(1, 0), cB + kstep, voffB); PG8_STAGE(PG8_SA(1, 0), cA + kstep, voffA); PG8_STAGE(PG8_SB(1, 1), cB + hstepB + kstep, voffB);
        PG8_WAIT_V(6); PG8_BAR;
    }
    for (;;) {
        const bool has_next = S.next(ui + 1, nxt);
        if constexpr (Sched::GATHER) { if (has_next) PG8_GLOAD(vgn, ui + 1); }
        const char* nA = has_next ? nxt.a : cA; const char* nB = has_next ? nxt.b : cB;
#pragma nounroll
        for (int t = 0; t < nt; t += 2) {
            const bool last = (t == nt - 2);
            const char* a1 = cA + (size_t)(t + 1) * kstep;
            const char* a2 = last ? nA : cA + (size_t)(t + 2) * kstep; const char* b2 = last ? nB : cB + (size_t)(t + 2) * kstep;
            const char* a3 = a2 + kstep; const char* b3 = b2 + kstep;
            if (last && has_next) S.a_ready(nxt);
            if constexpr (Sched::GATHER) { const bool nx_ = last && has_next; _Pragma("unroll") for (int h_ = 0; h_ < 2; ++h_) _Pragma("unroll") for (int i_ = 0; i_ < 2; ++i_) vgs[h_][i_] = nx_ ? vgn[h_][i_] : vgc[h_][i_]; }
            if constexpr (SP2) {
            PG8_LDB(B0, 0, 0); PG8_LDB(B1, 0, 1); PG8_SCHED; PG8_LDA(At, 0, 0); PG8_STAGE_A(1, 1, a1, vgc);
            PG8_WAIT_V(8); PG8_WAIT_L(0); PG8_BAR; PG8_MMA(0, 0, At, B0); PG8_MMA(0, 1, At, B1); PG8_BAR; PG8_SCHED;
            PG8_LDA(At, 0, 1); PG8_STAGE(PG8_SB(0, 0), b2, voffB); PG8_STAGE(PG8_SB(0, 1), b2 + hstepB, voffB); PG8_STAGE_A(0, 0, a2, vgs);
            PG8_WAIT_V(8); PG8_WAIT_L(0); PG8_BAR; PG8_MMA(1, 0, At, B0); PG8_MMA(1, 1, At, B1); PG8_BAR; PG8_SCHED;
            PG8_LDB(B0, 1, 0); PG8_LDB(B1, 1, 1); PG8_SCHED; PG8_LDA(At, 1, 0); PG8_STAGE_A(0, 1, a2, vgs);
            PG8_WAIT_V(8); PG8_WAIT_L(0); PG8_BAR; PG8_MMA(0, 0, At, B0); PG8_MMA(0, 1, At, B1); PG8_BAR; PG8_SCHED;
            PG8_LDA(At, 1, 1); PG8_STAGE(PG8_SB(1, 0), b3, voffB); PG8_STAGE(PG8_SB(1, 1), b3 + hstepB, voffB); PG8_STAGE_A(1, 0, a3, vgs);
            PG8_WAIT_V(8); PG8_WAIT_L(0); PG8_BAR; PG8_MMA(1, 0, At, B0); PG8_MMA(1, 1, At, B1); PG8_BAR; PG8_SCHED;
            } else {
            PG8_LDB(B0, 0, 0); PG8_SCHED; PG8_LDA(At, 0, 0); PG8_STAGE(PG8_SA(1, 1), a1 + hstepA, voffA);
            PG8_WAIT_L(8); PG8_BAR; PG8_WAIT_L(0); PG8_MMA(0, 0, At, B0); PG8_BAR; PG8_SCHED;
            PG8_LDB(B1, 0, 1); PG8_STAGE(PG8_SB(0, 0), b2, voffB);
            PG8_BAR; PG8_WAIT_L(0); PG8_MMA(0, 1, At, B1); PG8_BAR;
            PG8_LDA(At, 0, 1); PG8_STAGE(PG8_SA(0, 0), a2, voffA);
            PG8_BAR; PG8_WAIT_L(0); PG8_MMA(1, 0, At, B0); PG8_BAR; PG8_SCHED;
            PG8_STAGE(PG8_SB(0, 1), b2 + hstepB, voffB);
            PG8_WAIT_V(6); PG8_BAR; PG8_MMA(1, 1, At, B1); PG8_BAR;
            PG8_LDB(B0, 1, 0); PG8_SCHED; PG8_LDA(At, 1, 0); PG8_STAGE(PG8_SA(0, 1), a2 + hstepA, voffA);
            PG8_WAIT_L(8); PG8_BAR; PG8_WAIT_L(0); PG8_MMA(0, 0, At, B0); PG8_BAR; PG8_SCHED;
            PG8_LDB(B1, 1, 1); PG8_STAGE(PG8_SB(1, 0), b3, voffB);
            PG8_BAR; PG8_WAIT_L(0); PG8_MMA(0, 1, At, B1); PG8_BAR;
            PG8_LDA(At, 1, 1); PG8_STAGE(PG8_SA(1, 0), a3, voffA);
            PG8_BAR; PG8_WAIT_L(0); PG8_MMA(1, 0, At, B0); PG8_BAR; PG8_SCHED;
            PG8_STAGE(PG8_SB(1, 1), b3 + hstepB, voffB);
            PG8_WAIT_V(6); PG8_BAR; PG8_MMA(1, 1, At, B1); PG8_BAR;
            }
        }
        if constexpr (Sched::F8) asm volatile("s_nop 15\n\ts_nop 7" ::: "memory");
        if constexpr (ALIGN_EPI) { if (wr == 0) PG8_BAR; }
        if constexpr (!Epi::AFTER_DRAIN) { const int l2_ = lane_id_fresh(); E(acc, cur, wr, wc, l2_ & 15, l2_ >> 4); S.done(cur); }
        if (!has_next) break;
        bool zero_acc = true; if constexpr (Epi::KEEPS) zero_acc = !E.keep(cur);
        if (zero_acc) {
#pragma unroll
        for (int a = 0; a < 2; ++a)
#pragma unroll
            for (int b = 0; b < 2; ++b)
#pragma unroll
                for (int m = 0; m < 4; ++m)
#pragma unroll
                    for (int n = 0; n < 2; ++n) acc[a][b][m][n] = (f32x4){0.f, 0.f, 0.f, 0.f};
        }
        cur = nxt; cA = nA; cB = nB; ++ui;
        if constexpr (Sched::GATHER) { _Pragma("unroll") for (int h_ = 0; h_ < 2; ++h_) _Pragma("unroll") for (int i_ = 0; i_ < 2; ++i_) vgc[h_][i_] = vgn[h_][i_]; }
        if constexpr (ALIGN_EPI) { if (wr == 1) PG8_BAR; }
    }
    PG8_WAIT_V(0);
    if constexpr (!ALIGN_EPI) { if (wr == 0) PG8_BAR; }
    PG8_BAR;
    if constexpr (Epi::AFTER_DRAIN) { const int l3_ = lane_id_fresh(); E.fused(acc, cur, wr, wc, l3_ & 15, l3_ >> 4, lds, wid, l3_); S.done(cur); }
#undef PG8_SA
#undef PG8_SB
#undef PG8_STAGE
#undef PG8_UBASE
#undef PG8_STAGE_A
#undef PG8_GLOAD
#undef PG8_LDA
#undef PG8_LDB
#undef PG8_MMA
#undef PG8_CAT8
#undef PG8_WAIT_V
#undef PG8_WAIT_L
#undef PG8_BAR
#undef PG8_SCHED
}
}

#define GAS __attribute__((address_space(1)))
#define LAS __attribute__((address_space(3)))
typedef unsigned short bf16;
typedef unsigned v4u __attribute__((ext_vector_type(4)));
typedef short bf16x8 __attribute__((ext_vector_type(8)));
typedef unsigned v2u __attribute__((ext_vector_type(2)));
typedef float f32x4 __attribute__((ext_vector_type(4)));
typedef float f32x2 __attribute__((ext_vector_type(2)));
typedef int i32x4 __attribute__((ext_vector_type(4)));
typedef int i32x2 __attribute__((ext_vector_type(2)));
#define RLX_AGENT __ATOMIC_RELAXED, __HIP_MEMORY_SCOPE_AGENT
#define LDS_WAIT() asm volatile("s_waitcnt lgkmcnt(0)" ::: "memory")
#define VM_WAIT() asm volatile("s_waitcnt vmcnt(0)" ::: "memory")
__device__ __forceinline__ unsigned f2bf(float f) { unsigned u = __builtin_bit_cast(unsigned, f); return (u + 0x7fffu + ((u >> 16) & 1u)) >> 16; }
__device__ __forceinline__ unsigned pk2(float lo, float hi) { return f2bf(lo) | (f2bf(hi) << 16); }
__device__ __forceinline__ float bflo(unsigned w) { return __uint_as_float(w << 16); }
__device__ __forceinline__ float bfhi(unsigned w) { return __uint_as_float(w & 0xffff0000u); }
__device__ __forceinline__ float bf1(bf16 v) { return __uint_as_float((unsigned)v << 16); }

#define XB_TMO      128
#define XB_XCNT(j)  (256  + 64 * (j))
#define XB_XSUB(j)  (1280 + 64 * (j))
#define XB_XGEN(j)  (2304 + 64 * (j))
#define XB_TOP      3328
#define XB_TOPGEN   3392
#define XCD_BAR_WORDS 3456
#define XB_SPIN_CAP (1u << 18)

__device__ __forceinline__ unsigned xb_ld(unsigned* p)              { return __hip_atomic_load(p, __ATOMIC_RELAXED, __HIP_MEMORY_SCOPE_AGENT); }
__device__ __forceinline__ unsigned xb_add(unsigned* p, unsigned v) { return __hip_atomic_fetch_add(p, v, __ATOMIC_RELAXED, __HIP_MEMORY_SCOPE_AGENT); }
__device__ __forceinline__ unsigned xb_xcc_id() { return (unsigned)__builtin_amdgcn_s_getreg((3 << 11) | 20) & 0xFu; }
#define XB_SPIN(cond, bar) do { unsigned _sp = 0; while (cond) { __builtin_amdgcn_s_sleep(1); \
    if ((++_sp & 255u) == 0u) { if (xb_ld(&(bar)[XB_TMO])) break; if (_sp > XB_SPIN_CAP) { atomicAdd(&(bar)[XB_TMO], 1u); break; } } } } while (0)

struct XcdBarrier {
    unsigned* bar; unsigned x;
    volatile LAS unsigned* st;
};

__device__ __forceinline__ XcdBarrier xcd_barrier_post(unsigned* bar, volatile LAS unsigned* st, const int wave_s) {
    XcdBarrier b; b.bar = bar; b.x = xb_xcc_id(); b.st = st;
    if (wave_s == 0 && lane_id_fresh() == 0) (void)xb_add(&bar[XB_XCNT(b.x)], 1u);
    return b;
}
__device__ __forceinline__ void xcd_barrier_complete(unsigned* bar, unsigned x, unsigned& nloc, unsigned& nx) {
    const unsigned G = gridDim.x * gridDim.y * gridDim.z;
    unsigned sum, cnt, mine, sp = 0u;
    for (;;) {
        sum = 0u; cnt = 0u; mine = 0u;
#pragma unroll
        for (unsigned j = 0; j < 16; ++j) { const unsigned c = xb_ld(&bar[XB_XCNT(j)]); sum += c; cnt += (c > 0u) ? 1u : 0u; mine = (j == x) ? c : mine; }
        if (sum == G) break;
        __builtin_amdgcn_s_sleep(1);
        if ((++sp & 255u) == 0u) { if (xb_ld(&bar[XB_TMO])) break; if (sp > XB_SPIN_CAP) { atomicAdd(&bar[XB_TMO], 1u); break; } }
    }
    nloc = mine > 0u ? mine : 1u; nx = cnt > 0u ? cnt : 1u;
}

__device__ __forceinline__ void xcd_barrier(const XcdBarrier& b, const int wave_s) {
    asm volatile("s_waitcnt vmcnt(0)" ::: "memory");
    __syncthreads();
    if (wave_s == 0 && lane_id_fresh() == 0) {
        unsigned* bar = b.bar;
        __builtin_amdgcn_s_waitcnt(0);
        unsigned nloc = b.st[0], nx = b.st[1];
        if (nloc == 0u) { xcd_barrier_complete(bar, b.x, nloc, nx); b.st[0] = nloc; b.st[1] = nx; }
        const unsigned old = xb_add(&bar[XB_XSUB(b.x)], 1u);
        const unsigned gen = old / nloc;
        if (old + 1u == (gen + 1u) * nloc) {
            __builtin_amdgcn_fence(__ATOMIC_RELEASE, "agent");
            asm volatile("s_waitcnt vmcnt(0)" ::: "memory");
            const unsigned og = xb_add(&bar[XB_TOP], 1u);
            const unsigned tg = og / nx;
            if (og + 1u == (tg + 1u) * nx) xb_add(&bar[XB_TOPGEN], 1u);
            else XB_SPIN(xb_ld(&bar[XB_TOPGEN]) == tg, bar);
            __builtin_amdgcn_fence(__ATOMIC_ACQUIRE, "agent");
            xb_add(&bar[XB_XGEN(b.x)], 1u);
            asm volatile("s_waitcnt vmcnt(0)" ::: "memory");
        } else {
            XB_SPIN(xb_ld(&bar[XB_XGEN(b.x)]) == gen, bar);
            __builtin_amdgcn_fence(__ATOMIC_ACQUIRE, "agent");
            asm volatile("s_waitcnt vmcnt(0)" ::: "memory");
        }
    }
    __syncthreads();
}

constexpr int NWAVES = 8;
#ifndef MK_TAIL0
#define MK_TAIL0 0
#endif
#ifndef MK_TAIL1
#define MK_TAIL1 0
#endif
#ifndef MK_GW0
#define MK_GW0 1024
#endif
#ifndef MK_GW1
#define MK_GW1 1024
#endif
#ifndef MK_NMIXB
#define MK_NMIXB 96
#endif
namespace cf {
constexpr int D = 1024, NB = 8, L = 2048, T = NB * L, NMEM = 256, TM = NB * NMEM, IN_TOTAL = 8968, DFF = 2816, DFE = 3584, NE = 8;
constexpr int PJ = 4864;
constexpr int C_U = 0, C_Z = 512, C_XBC = 1024, C_Q = 1792, C_K = 2304, C_V = 2816, C_G = 3328, C_XL = 3840, C_GL = 4352;
constexpr int O_DT = 1792, O_GATE = 4872;
constexpr int MAXSLOT = 34816;
}
constexpr size_t MiB = 1u << 20;
constexpr size_t WS_CTL = 0, CTL_ZERO_BYTES = 1 * MiB;
constexpr size_t WS_TOPI = 1 * MiB, WS_TOPW = WS_TOPI + 256 * 1024, WS_SLOT = WS_TOPW + 128 * 1024;
constexpr size_t WS_HN = 2 * MiB, WS_KV = 34 * MiB, WS_TAB = 50 * MiB, WS_DT = 54 * MiB, WS_MNR = 55 * MiB, WS_W = 59 * MiB;
constexpr size_t WL_STRIDE = 32 * MiB, WL_WIN = 0, WL_GLU = 17 * MiB + 512 * 1024, WL_WB = 18 * MiB, WL_WOUT = 22 * MiB, WL_WQ = 24 * MiB, WL_WKV = 26 * MiB, WL_WO = 30 * MiB;
constexpr size_t WS_W13 = 123 * MiB, WS_W2 = 134 * MiB, WS_R = 140 * MiB;
constexpr size_t R_PROJB = WS_R, R_GATE = WS_R + 152 * MiB, R_BR = WS_R + 280 * MiB, R_XBCC = WS_R + 344 * MiB, R_XLC = WS_R + 368 * MiB, R_YS = WS_R + 384 * MiB, R_QKW = WS_R + 400 * MiB, R_END = WS_R + 416 * MiB;
constexpr size_t R_MP = WS_R, R_MERGED = WS_R + 64 * MiB;
constexpr size_t R_XQ = WS_R, R_P = WS_R + 32 * MiB, R_XO = WS_R + 64 * MiB;
constexpr size_t R_ACT = WS_R;
constexpr size_t M_W13E = 34 * MiB, M_W2E = 146 * MiB, M_XS = 202 * MiB, M_ACTE = 270 * MiB, M_END = 508 * MiB;
constexpr size_t WS_NEED = R_END > M_END ? R_END : M_END;
constexpr int CW_TMO = 0, CW_CODE = 1, CW_BAR = 4096, CW_CNT = 8192;
constexpr int RING_BYTES = 131072, LDSCTL_OFF = RING_BYTES, XCH_OFF = LDSCTL_OFF + 1024, LDS_BYTES = 147456;

struct Params { const float* in[46]; float* out; unsigned char* ws; int ph_lo, ph_hi; };

__device__ __forceinline__ int opq(int v) { asm volatile("" : "+s"(v)); return v; }
template <class Tp> __device__ __forceinline__ Tp* opqp(Tp* q) { return q + opq(0); }
#define DPPF_(v, ctrl, rm, bc) __builtin_bit_cast(float, __builtin_amdgcn_update_dpp(0, __builtin_bit_cast(int, (v)), (ctrl), (rm), 0xF, (bc)))
__device__ __forceinline__ float sum8(float v) {
    v += DPPF_(v, 0xB1, 0xF, true); v += DPPF_(v, 0x4E, 0xF, true); v += DPPF_(v, 0x141, 0xF, true); return v;
}
__device__ __forceinline__ float wave_sum(float v) {
    v = sum8(v); v += DPPF_(v, 0x140, 0xF, true); v += DPPF_(v, 0x142, 0xA, false); v += DPPF_(v, 0x143, 0xC, false);
    return __builtin_bit_cast(float, __builtin_amdgcn_readlane(__builtin_bit_cast(int, v), 63));
}
__device__ __forceinline__ float fexp_(float x) { return __builtin_amdgcn_exp2f(1.4426950408889634f * x); }
__device__ __forceinline__ float sigmoidf_(float x) { return __builtin_amdgcn_rcpf(1.0f + __builtin_amdgcn_exp2f(-1.4426950408889634f * x)); }
__device__ __forceinline__ float siluf_(float x) { return x * __builtin_amdgcn_rcpf(1.0f + __builtin_amdgcn_exp2f(-1.4426950408889634f * x)); }
__device__ __forceinline__ float gelu_tanh(float x) { const float u = 0.7978845608028654f * (x + 0.044715f * x * x * x); const float e = __builtin_amdgcn_exp2f(2.8853900817779268f * u); return x * (1.0f - __builtin_amdgcn_rcpf(e + 1.0f)); }
__device__ __forceinline__ float softplusf_(float x) { return x > 20.f ? x : log1pf(__expf(x)); }

struct MapPlain { const float* W; int K, N; const float* ks; float sc; bf16* WT; int ldo;
    __device__ __forceinline__ f32x4 load4(int k, int n0, int j4) const { return *(const f32x4*)(W + (size_t)k * N + n0 + 4 * j4); }
    __device__ __forceinline__ int nl(int j4) const { return 4 * j4; }
    __device__ __forceinline__ float scale(int k) const { return ks ? ks[k] * sc : sc; }
    __device__ __forceinline__ bf16* dst(int n) const { return WT + (size_t)n * ldo; } };
struct MapWin { const float* W; const float* ks; bf16* WT; int N;
    __device__ __forceinline__ f32x4 load4(int k, int n0, int j4) const { return *(const f32x4*)(W + (size_t)k * cf::IN_TOTAL + n0 + 4 * j4 + (n0 >= cf::O_DT ? 8 : 0)); }
    __device__ __forceinline__ int nl(int j4) const { return 4 * j4; }
    __device__ __forceinline__ float scale(int k) const { return ks[k]; }
    __device__ __forceinline__ bf16* dst(int n) const { return WT + (size_t)n * 1024; } };
struct MapW13 { const float* w1; const float* w3; const float* ks; bf16* WT; int F, N;
    __device__ __forceinline__ f32x4 load4(int k, int n0, int j4) const { const int gi = j4 >> 3, mat = (j4 >> 2) & 1, fi4 = j4 & 3; const ptrdiff_t dsel = mat ? (w3 - w1) : (ptrdiff_t)0;
        return *(const f32x4*)(w1 + dsel + (ptrdiff_t)((size_t)k * F + (n0 >> 1) + 16 * gi + 4 * fi4)); }
    __device__ __forceinline__ int nl(int j4) const { return 32 * (j4 >> 3) + 8 * (j4 & 3) + 4 * ((j4 >> 2) & 1); }
    __device__ __forceinline__ float scale(int k) const { return ks ? ks[k] : 1.0f; }
    __device__ __forceinline__ bf16* dst(int n) const { return WT + (size_t)n * 1024; } };
template <class Map> __device__ __forceinline__ void cvt_item8(const Map& mp, int item, LAS float* scr, int lane, const float wscale, const int pitch) {
    LAS unsigned char* T = (LAS unsigned char*)scr;
    const int nblk = mp.N / 64, kb = item / nblk, nb = item % nblk, k0 = 64 * kb, n0 = 64 * nb;
    f32x4 v[16];
#pragma unroll
    for (int it = 0; it < 16; ++it) { const int e = it * 64 + lane; v[it] = mp.load4(k0 + (e >> 4), n0, e & 15); }
#pragma unroll
    for (int it = 0; it < 16; ++it) { const int e = it * 64 + lane, k = e >> 4, nl = mp.nl(e & 15); const float sc = mp.scale(k0 + k) * wscale;
        int p = 0; p = __builtin_amdgcn_cvt_pk_fp8_f32(v[it][0] * sc, v[it][1] * sc, p, false); p = __builtin_amdgcn_cvt_pk_fp8_f32(v[it][2] * sc, v[it][3] * sc, p, true);
        T[(nl + 0) * 80 + k] = (unsigned char)(p & 0xff); T[(nl + 1) * 80 + k] = (unsigned char)((p >> 8) & 0xff); T[(nl + 2) * 80 + k] = (unsigned char)((p >> 16) & 0xff); T[(nl + 3) * 80 + k] = (unsigned char)((unsigned)p >> 24); }
    LDS_WAIT(); asm volatile("" ::: "memory");
#pragma unroll
    for (int it = 0; it < 4; ++it) { const int e = it * 64 + lane, nl = e >> 2, c4 = e & 3; const LAS unsigned* tp = (const LAS unsigned*)(T + nl * 80 + 16 * c4);
        v4u w; w.x = tp[0]; w.y = tp[1]; w.z = tp[2]; w.w = tp[3]; *(v4u*)((unsigned char*)mp.WT + (size_t)(n0 + nl) * pitch + k0 + 16 * c4) = w; }
    LDS_WAIT(); asm volatile("" ::: "memory");
}
template <class Map> __device__ __forceinline__ void cvt_item(const Map& mp, int item, LAS float* scr, int lane) {
    LAS bf16* T = (LAS bf16*)scr;
    const int nblk = mp.N / 64, kb = item / nblk, nb = item % nblk, k0 = 64 * kb, n0 = 64 * nb;
    f32x4 v[16];
#pragma unroll
    for (int it = 0; it < 16; ++it) { const int e = it * 64 + lane; v[it] = mp.load4(k0 + (e >> 4), n0, e & 15); }
#pragma unroll
    for (int it = 0; it < 16; ++it) { const int e = it * 64 + lane, k = e >> 4, nl = mp.nl(e & 15); const float sc = mp.scale(k0 + k);
        const unsigned p0 = pg8::cvt_pk_bf16(v[it][0] * sc, v[it][1] * sc), p1 = pg8::cvt_pk_bf16(v[it][2] * sc, v[it][3] * sc);
        T[(nl + 0) * 66 + k] = (bf16)(p0 & 0xffffu); T[(nl + 1) * 66 + k] = (bf16)(p0 >> 16); T[(nl + 2) * 66 + k] = (bf16)(p1 & 0xffffu); T[(nl + 3) * 66 + k] = (bf16)(p1 >> 16); }
    LDS_WAIT(); asm volatile("" ::: "memory");
#pragma unroll
    for (int it = 0; it < 8; ++it) { const int e = it * 64 + lane, nl = e >> 3, c8 = e & 7; const LAS unsigned* tp = (const LAS unsigned*)(T + nl * 66 + 8 * c8);
        v4u w; w.x = tp[0]; w.y = tp[1]; w.z = tp[2]; w.w = tp[3]; *(v4u*)(mp.dst(n0 + nl) + k0 + 8 * c8) = w; }
    LDS_WAIT(); asm volatile("" ::: "memory");
}

__device__ __forceinline__ float norm_row(const float* xrow, bf16* orow, int lane, f32x4 (&v)[4]) {
    const f32x4* xr = (const f32x4*)xrow + lane; float ss = 0.f;
#pragma unroll
    for (int j = 0; j < 4; ++j) { v[j] = xr[64 * j]; ss += (v[j].x * v[j].x + v[j].y * v[j].y) + (v[j].z * v[j].z + v[j].w * v[j].w); }
    const float r = 1.0f / sqrtf(wave_sum(ss) * (1.0f / 1024.0f) + 1e-6f);
    unsigned long long* o8 = (unsigned long long*)orow + lane;
#pragma unroll
    for (int j = 0; j < 4; ++j) o8[64 * j] = (unsigned long long)pk2(v[j].x * r, v[j].y * r) | ((unsigned long long)pk2(v[j].z * r, v[j].w * r) << 32);
    return r;
}
template <class Post> __device__ __forceinline__ void norm_rows(const float* X, bf16* O, const int nrows, const int gw, const int NGW, const int lane, Post post) {
    for (int r0 = gw; r0 < nrows; r0 += 4 * NGW) {
        f32x4 v0[4], v1[4], v2[4], v3[4];
        { const int q1 = r0 + NGW < nrows ? r0 + NGW : r0, q2 = r0 + 2 * NGW < nrows ? r0 + 2 * NGW : r0, q3 = r0 + 3 * NGW < nrows ? r0 + 3 * NGW : r0;
          const f32x4* x0 = (const f32x4*)(X + (size_t)r0 * 1024) + lane; const f32x4* x1 = (const f32x4*)(X + (size_t)q1 * 1024) + lane; const f32x4* x2 = (const f32x4*)(X + (size_t)q2 * 1024) + lane; const f32x4* x3 = (const f32x4*)(X + (size_t)q3 * 1024) + lane;
#pragma unroll
          for (int j = 0; j < 4; ++j) { v0[j] = x0[64 * j]; v1[j] = x1[64 * j]; v2[j] = x2[64 * j]; v3[j] = x3[64 * j]; } }
#define NR_ONE_(vv, row_) do { const int rw_ = (row_); if (rw_ < nrows) { float ss = 0.f; _Pragma("unroll") for (int j = 0; j < 4; ++j) ss += (vv[j].x * vv[j].x + vv[j].y * vv[j].y) + (vv[j].z * vv[j].z + vv[j].w * vv[j].w); \
            const float r = 1.0f / sqrtf(wave_sum(ss) * (1.0f / 1024.0f) + 1e-6f); unsigned long long* o8 = (unsigned long long*)(O + (size_t)rw_ * 1024) + lane; \
            _Pragma("unroll") for (int j = 0; j < 4; ++j) o8[64 * j] = (unsigned long long)pk2(vv[j].x * r, vv[j].y * r) | ((unsigned long long)pk2(vv[j].z * r, vv[j].w * r) << 32); \
            post(rw_, r, vv); } } while (0)
        NR_ONE_(v0, r0); NR_ONE_(v1, r0 + NGW); NR_ONE_(v2, r0 + 2 * NGW); NR_ONE_(v3, r0 + 3 * NGW);
#undef NR_ONE_
    }
}
struct NoPost { __device__ __forceinline__ void operator()(int, float, const f32x4 (&)[4]) const {} };
__device__ __forceinline__ void row_dot8(const f32x4 (&v)[4], const LAS float* w8, int lane, float (&lg)[8]) {
#pragma unroll
    for (int e = 0; e < 8; ++e) lg[e] = 0.f;
#pragma unroll
    for (int j = 0; j < 4; ++j)
#pragma unroll
        for (int q = 0; q < 4; ++q) { const int i = 256 * j + 4 * lane + q; const f32x4 wa = *(const LAS f32x4*)(w8 + i * 8), wb = *(const LAS f32x4*)(w8 + i * 8 + 4); const float x = v[j][q];
            lg[0] += x * wa.x; lg[1] += x * wa.y; lg[2] += x * wa.z; lg[3] += x * wa.w; lg[4] += x * wb.x; lg[5] += x * wb.y; lg[6] += x * wb.z; lg[7] += x * wb.w; }
#pragma unroll
    for (int e = 0; e < 8; ++e) lg[e] = wave_sum(lg[e]);
}


#define MFMA16(a, b, c) __builtin_amdgcn_mfma_f32_16x16x32_bf16((a), (b), (c), 0, 0, 0)
__device__ __forceinline__ float bfs(short v) { return __uint_as_float(((unsigned)(unsigned short)v) << 16); }
__device__ __forceinline__ float ex2(float x) { return __builtin_amdgcn_exp2f(x); }
__device__ __forceinline__ bf16x8 pack8f(const f32x4 a, const f32x4 b) { v4u w; w.x = pg8::cvt_pk_bf16(a[0], a[1]); w.y = pg8::cvt_pk_bf16(a[2], a[3]); w.z = pg8::cvt_pk_bf16(b[0], b[1]); w.w = pg8::cvt_pk_bf16(b[2], b[3]); return __builtin_bit_cast(bf16x8, w); }
__device__ __forceinline__ v2u pack4f(const f32x4 a) { v2u w; w.x = pg8::cvt_pk_bf16(a[0], a[1]); w.y = pg8::cvt_pk_bf16(a[2], a[3]); return w; }

struct LaChunk { float dtl, vsc; bf16x8 Qf[2][2], Kf[2][2], vv0, vv1; v2u xs[2][2]; };
__device__ __forceinline__ void la_load(LaChunk& ck, const int t0, const bf16* Q, const int qp, const bf16* K, const int kp, const bf16* V, const int vp, const float* dtp, const bool skip, const int lane) {
    const int n16 = lane & 15, q = lane >> 4, vrow = lane >> 1, vcol = (lane & 1) * 16;
    ck.dtl = dtp ? dtp[(size_t)(t0 + (lane & 31)) * 8] : 0.f; ck.vsc = dtp ? dtp[(size_t)(t0 + vrow) * 8] : 1.0f;
#pragma unroll
    for (int j = 0; j < 2; ++j)
#pragma unroll
        for (int ks = 0; ks < 2; ++ks) { ck.Qf[j][ks] = *(const bf16x8*)(Q + (size_t)(t0 + 16 * j + n16) * qp + 32 * ks + 8 * q); ck.Kf[j][ks] = *(const bf16x8*)(K + (size_t)(t0 + 16 * j + n16) * kp + 32 * ks + 8 * q); }
    ck.vv0 = *(const bf16x8*)(V + (size_t)(t0 + vrow) * vp + vcol); ck.vv1 = *(const bf16x8*)(V + (size_t)(t0 + vrow) * vp + vcol + 8);
#pragma unroll
    for (int t = 0; t < 2; ++t)
#pragma unroll
        for (int j = 0; j < 2; ++j) ck.xs[t][j] = skip ? *(const v2u*)(V + (size_t)(t0 + 16 * j + n16) * vp + 16 * t + 4 * q) : (v2u){0u, 0u};
}
__device__ __forceinline__ void linattn_unit(const bf16* Q, const int qp, const bf16* K, const int kp, const bf16* V, const int vp, const float* dtp, const float dcoef, const float dskip,
                                             bf16* out, const int op, LAS unsigned char* sl, const int lane) {
    const int n16 = lane & 15, q = lane >> 4;
    LAS bf16* Vt = (LAS bf16*)sl;
    LAS bf16* Kt = Vt + 32 * 32;
    LAS bf16* St = Kt + 64 * 32;
    LAS float* la = (LAS float*)(St + 32 * 64);
    for (int i = lane; i < 32 * 64 / 2; i += 64) ((LAS unsigned*)St)[i] = 0u;
    f32x4 Sacc[4][2];
#pragma unroll
    for (int i = 0; i < 4; ++i) { Sacc[i][0] = (f32x4){0.f, 0.f, 0.f, 0.f}; Sacc[i][1] = (f32x4){0.f, 0.f, 0.f, 0.f}; }
    const f32x4 z4 = (f32x4){0.f, 0.f, 0.f, 0.f};
    const int posn = 8 * (n16 >> 2) + (n16 & 3);
    const int vrow = lane >> 1, vcol = (lane & 1) * 16, vpos = 8 * ((vrow & 15) >> 2) + 4 * (vrow >> 4) + (vrow & 3);
    const bool skip = dskip != 0.f;
    { const unsigned dm_ = *(const unsigned*)Q; asm volatile("" :: "v"(dm_)); const unsigned dl_ = ((LAS unsigned*)St)[lane]; asm volatile("" :: "v"(dl_)); }
    LaChunk nx; la_load(nx, 0, Q, qp, K, kp, V, vp, dtp, skip, lane);
    asm volatile("" : "+v"(nx.Qf[0][0]), "+v"(nx.Qf[0][1]), "+v"(nx.Qf[1][0]), "+v"(nx.Qf[1][1]), "+v"(nx.Kf[0][0]), "+v"(nx.Kf[0][1]), "+v"(nx.Kf[1][0]), "+v"(nx.Kf[1][1]), "+v"(nx.vv0), "+v"(nx.vv1) :: "memory");
    for (int c = 0; c < cf::L / 32; ++c) {
        const int t0 = c * 32;
        const LaChunk ck = nx;
        if (c + 1 < cf::L / 32) la_load(nx, t0 + 32, Q, qp, K, kp, V, vp, dtp, skip, lane);
        float xl = dtp ? ck.dtl * dcoef : dcoef;
#pragma unroll
        for (int off = 1; off < 32; off <<= 1) { const float y = __shfl_up(xl, off); if ((lane & 31) >= off) xl += y; }
        if (lane < 32) la[lane] = xl;
        const float a_end = __shfl(xl, 31);
        const f32x4 as0 = *(const LAS f32x4*)(la + 4 * q), as1 = *(const LAS f32x4*)(la + 16 + 4 * q); const float al0 = la[n16], al1 = la[16 + n16];
        f32x4 s00 = MFMA16(ck.Kf[0][0], ck.Qf[0][0], z4); s00 = MFMA16(ck.Kf[0][1], ck.Qf[0][1], s00);
        f32x4 s01 = MFMA16(ck.Kf[0][0], ck.Qf[1][0], z4); s01 = MFMA16(ck.Kf[0][1], ck.Qf[1][1], s01);
        f32x4 s11 = MFMA16(ck.Kf[1][0], ck.Qf[1][0], z4); s11 = MFMA16(ck.Kf[1][1], ck.Qf[1][1], s11);
#pragma unroll
        for (int r = 0; r < 4; ++r) { const bool ok = n16 >= 4 * q + r;
            s00[r] = ok ? s00[r] * ex2(al0 - as0[r]) : 0.f; s01[r] = s01[r] * ex2(al1 - as0[r]); s11[r] = ok ? s11[r] * ex2(al1 - as1[r]) : 0.f; }
        const bf16x8 Pf0 = pack8f(s00, z4), Pf1 = pack8f(s01, s11);
        const float w0 = ex2(a_end - al0), w1 = ex2(a_end - al1);
#pragma unroll
        for (int i = 0; i < 2; ++i)
#pragma unroll
            for (int ks = 0; ks < 2; ++ks)
#pragma unroll
                for (int jj = 0; jj < 8; jj += 2) { const float wv = i ? w1 : w0; const unsigned pw = pg8::cvt_pk_bf16(bfs(ck.Kf[i][ks][jj]) * wv, bfs(ck.Kf[i][ks][jj + 1]) * wv); const int d = 32 * ks + 8 * q + jj;
                    Kt[d * 32 + posn + 4 * i] = (bf16)(pw & 0xffffu); Kt[(d + 1) * 32 + posn + 4 * i] = (bf16)(pw >> 16); }
#pragma unroll
        for (int jj = 0; jj < 8; jj += 2) { const unsigned pa = pg8::cvt_pk_bf16(bfs(ck.vv0[jj]) * ck.vsc, bfs(ck.vv0[jj + 1]) * ck.vsc), pb = pg8::cvt_pk_bf16(bfs(ck.vv1[jj]) * ck.vsc, bfs(ck.vv1[jj + 1]) * ck.vsc);
            Vt[(vcol + jj) * 32 + vpos] = (bf16)(pa & 0xffffu); Vt[(vcol + jj + 1) * 32 + vpos] = (bf16)(pa >> 16); Vt[(vcol + 8 + jj) * 32 + vpos] = (bf16)(pb & 0xffffu); Vt[(vcol + 9 + jj) * 32 + vpos] = (bf16)(pb >> 16); }
        bf16x8 Vf[2], Sf[2][2];
#pragma unroll
        for (int t = 0; t < 2; ++t) { Vf[t] = *(const LAS bf16x8*)(Vt + (16 * t + n16) * 32 + 8 * q); Sf[t][0] = *(const LAS bf16x8*)(St + (16 * t + n16) * 64 + 8 * q); Sf[t][1] = *(const LAS bf16x8*)(St + (16 * t + n16) * 64 + 32 + 8 * q); }
        const float ea0 = ex2(al0), ea1 = ex2(al1);
#pragma unroll
        for (int t = 0; t < 2; ++t)
#pragma unroll
            for (int j = 0; j < 2; ++j) {
                f32x4 y = MFMA16(Vf[t], j ? Pf1 : Pf0, z4);
                f32x4 cr = MFMA16(Sf[t][0], ck.Qf[j][0], z4); cr = MFMA16(Sf[t][1], ck.Qf[j][1], cr);
                y += cr * (j ? ea1 : ea0);
                const size_t row = (size_t)(t0 + 16 * j + n16);
                if (skip) { const v2u xw = ck.xs[t][j]; y[0] += dskip * bflo(xw.x); y[1] += dskip * bfhi(xw.x); y[2] += dskip * bflo(xw.y); y[3] += dskip * bfhi(xw.y); }
                *(v2u*)(out + row * op + 16 * t + 4 * q) = pack4f(y);
            }
        const float dec = ex2(a_end);
#pragma unroll
        for (int dt = 0; dt < 4; ++dt) { const bf16x8 Ktf = *(const LAS bf16x8*)(Kt + (16 * dt + n16) * 32 + 8 * q);
#pragma unroll
            for (int et = 0; et < 2; ++et) { Sacc[dt][et] = MFMA16(Ktf, Vf[et], Sacc[dt][et] * dec); *(LAS v2u*)(St + (16 * et + n16) * 64 + 16 * dt + 4 * q) = pack4f(Sacc[dt][et]); } }
    }
}

__device__ __forceinline__ void s5_unit(const bf16* U, bf16* Y, const float* lam_re, const float* lam_im, const float* b_re, const float* b_im, const float* c_re, const float* c_im, const float* dsk, const float step,
                                        LAS unsigned char* sl, const int lane) {
    const int n16 = lane & 15, q = lane >> 4;
    LAS float* BU = (LAS float*)sl;
    LAS bf16* SI = (LAS bf16*)(sl + 8192);
    float ar, ai;
    { const float lr = lam_re[lane], li = lam_im[lane], mag = expf(lr * step); ar = mag * cosf(li * step); ai = mag * sinf(li * step); }
    bf16x8 Bbf[8], Ccf[4];
#pragma unroll
    for (int tl = 0; tl < 8; ++tl) {
        const int idx = 16 * tl + n16, st = idx & 63; float v[8];
        const float lr = lam_re[st], li = lam_im[st], mag = expf(lr * step), sar = mag * cosf(li * step), sai = mag * sinf(li * step), inv = 1.0f / (lr * lr + li * li);
        const float cr = ((sar - 1.0f) * lr + sai * li) * inv, ci = (sai * lr - (sar - 1.0f) * li) * inv;
#pragma unroll
        for (int jj = 0; jj < 8; ++jj) { float x = 0.f; if (q < 2) { const float br_ = b_re[st * 16 + 8 * q + jj], bi_ = b_im[st * 16 + 8 * q + jj]; x = idx < 64 ? cr * br_ - ci * bi_ : cr * bi_ + ci * br_; } v[jj] = x; }
        Bbf[tl] = pack8f((f32x4){v[0], v[1], v[2], v[3]}, (f32x4){v[4], v[5], v[6], v[7]});
    }
#pragma unroll
    for (int ks = 0; ks < 4; ++ks) {
        float v[8];
#pragma unroll
        for (int jj = 0; jj < 8; ++jj) { const int idx = 32 * ks + 8 * q + jj; v[jj] = idx < 64 ? c_re[n16 * 64 + idx] : -c_im[n16 * 64 + idx - 64]; }
        Ccf[ks] = pack8f((f32x4){v[0], v[1], v[2], v[3]}, (f32x4){v[4], v[5], v[6], v[7]});
    }
    const f32x4 dk = *(const f32x4*)(dsk + 4 * q);
    const f32x4 z4 = (f32x4){0.f, 0.f, 0.f, 0.f};
    const bf16x8 zf = (bf16x8){0, 0, 0, 0, 0, 0, 0, 0};
    float sr = 0.f, si = 0.f;
    bf16x8 nUf[2]; v2u nuw[2];
#pragma unroll
    for (int mt = 0; mt < 2; ++mt) { const bf16* urow = U + (size_t)(16 * mt + n16) * cf::PJ; nUf[mt] = q < 2 ? *(const bf16x8*)(urow + 8 * q) : zf; nuw[mt] = *(const v2u*)(urow + 4 * q); }
    for (int c = 0; c < cf::L / 32; ++c) {
        bf16x8 Uf[2]; v2u uw[2];
#pragma unroll
        for (int mt = 0; mt < 2; ++mt) { Uf[mt] = nUf[mt]; uw[mt] = nuw[mt]; }
        if (c + 1 < cf::L / 32) {
#pragma unroll
            for (int mt = 0; mt < 2; ++mt) { const bf16* urow = U + (size_t)((c + 1) * 32 + 16 * mt + n16) * cf::PJ; nUf[mt] = q < 2 ? *(const bf16x8*)(urow + 8 * q) : zf; nuw[mt] = *(const v2u*)(urow + 4 * q); } }
#pragma unroll
        for (int mt = 0; mt < 2; ++mt) {
            f32x4 d8[8];
#pragma unroll
            for (int tl = 0; tl < 8; ++tl) d8[tl] = MFMA16(Uf[mt], Bbf[tl], z4);
            asm volatile("" : "+v"(d8[0]), "+v"(d8[1]), "+v"(d8[2]), "+v"(d8[3]), "+v"(d8[4]), "+v"(d8[5]), "+v"(d8[6]), "+v"(d8[7]));
#pragma unroll
            for (int tl = 0; tl < 8; ++tl) {
#pragma unroll
                for (int r = 0; r < 4; ++r) BU[(4 * q + r) * 128 + 16 * tl + n16] = d8[tl][r]; }
#pragma unroll
            for (int t = 0; t < 16; ++t) { const float bre = BU[t * 128 + lane], bim = BU[t * 128 + 64 + lane];
                const float nr = ar * sr - ai * si + bre, ni = ar * si + ai * sr + bim; sr = nr; si = ni;
                const unsigned pw = pg8::cvt_pk_bf16(sr, si); SI[(16 * mt + t) * 128 + lane] = (bf16)(pw & 0xffffu); SI[(16 * mt + t) * 128 + 64 + lane] = (bf16)(pw >> 16); }
        }
        f32x4 yy[2] = {z4, z4};
#pragma unroll
        for (int ks = 0; ks < 4; ++ks) { const bf16x8 Sf0 = *(const LAS bf16x8*)(SI + n16 * 128 + 32 * ks + 8 * q), Sf1 = *(const LAS bf16x8*)(SI + (16 + n16) * 128 + 32 * ks + 8 * q);
            yy[0] = MFMA16(Ccf[ks], Sf0, yy[0]); yy[1] = MFMA16(Ccf[ks], Sf1, yy[1]); }
#pragma unroll
        for (int mt = 0; mt < 2; ++mt) {
            f32x4 y = yy[mt];
            y[0] = gelu_tanh(y[0] + dk[0] * bflo(uw[mt].x)); y[1] = gelu_tanh(y[1] + dk[1] * bfhi(uw[mt].x)); y[2] = gelu_tanh(y[2] + dk[2] * bflo(uw[mt].y)); y[3] = gelu_tanh(y[3] + dk[3] * bfhi(uw[mt].y));
            *(v2u*)(Y + (size_t)(c * 32 + 16 * mt + n16) * 512 + 4 * q) = pack4f(y);
        }
    }
}

struct LruChunk { bf16x8 X[2][2], Gf[2]; };
__device__ __forceinline__ void lru_load(LruChunk& ck, const int t0, const bf16* XC, const bf16* GLb, const int ksel, const int lane) {
    const int n16 = lane & 15, q = lane >> 4;
#pragma unroll
    for (int mt = 0; mt < 2; ++mt) { const size_t row = (size_t)(t0 + 8 * (n16 >> 2) + 4 * mt + (n16 & 3));
        ck.X[mt][0] = *(const bf16x8*)(XC + row * 512 + 8 * q); ck.X[mt][1] = *(const bf16x8*)(XC + row * 512 + 32 + 8 * q); ck.Gf[mt] = *(const bf16x8*)(GLb + row * cf::PJ + 32 * ksel + 8 * q); }
}
__device__ __forceinline__ void lru_unit(const bf16* XC  , const bf16* GLb  , bf16* out  ,
                                         const float* wa  , const float* wx, const float ba, const float bx, const float sp, const int jq, const int lane) {
    const int n16 = lane & 15, q = lane >> 4, ksel = jq >> 1;
    bf16x8 Waf[2], Wxf[2], Idf;
#pragma unroll
    for (int ks = 0; ks < 2; ++ks) { float va[8], vx[8];
#pragma unroll
        for (int jj = 0; jj < 8; ++jj) { const int i = 32 * ks + 8 * q + jj; va[jj] = wa[i * 64 + jq * 16 + n16]; vx[jj] = wx[i * 64 + jq * 16 + n16]; }
        Waf[ks] = pack8f((f32x4){va[0], va[1], va[2], va[3]}, (f32x4){va[4], va[5], va[6], va[7]}); Wxf[ks] = pack8f((f32x4){vx[0], vx[1], vx[2], vx[3]}, (f32x4){vx[4], vx[5], vx[6], vx[7]}); }
    { float vi[8];
#pragma unroll
      for (int jj = 0; jj < 8; ++jj) vi[jj] = (8 * q + jj == (jq & 1) * 16 + n16) ? 1.0f : 0.f;
      Idf = pack8f((f32x4){vi[0], vi[1], vi[2], vi[3]}, (f32x4){vi[4], vi[5], vi[6], vi[7]}); }
    const f32x4 z4 = (f32x4){0.f, 0.f, 0.f, 0.f};
    float hprev = 0.f;
    LruChunk nx; lru_load(nx, 0, XC, GLb, ksel, lane);
    for (int c = 0; c < cf::L / 32; ++c) {
        const int t0 = c * 32;
        const LruChunk ck = nx;
        if (c + 1 < cf::L / 32) lru_load(nx, t0 + 32, XC, GLb, ksel, lane);
        float a[8], bb[8], gv[8];
        float A = 1.0f, B = 0.f;
#pragma unroll
        for (int mt = 0; mt < 2; ++mt) {
            f32x4 ra = MFMA16(ck.X[mt][0], Waf[0], z4); ra = MFMA16(ck.X[mt][1], Waf[1], ra);
            f32x4 ri = MFMA16(ck.X[mt][0], Wxf[0], z4); ri = MFMA16(ck.X[mt][1], Wxf[1], ri);
            const f32x4 xc = MFMA16(ksel ? ck.X[mt][1] : ck.X[mt][0], Idf, z4), gl = MFMA16(ck.Gf[mt], Idf, z4);
#pragma unroll
            for (int r = 0; r < 4; ++r) { const int k = 4 * mt + r;
                const float rr = sigmoidf_(ra[r] + ba), ii = sigmoidf_(ri[r] + bx), la_ = -8.0f * rr * sp; a[k] = fexp_(la_);
                bb[k] = __builtin_amdgcn_sqrtf(fmaxf(1.0f - a[k] * a[k], 0.f)) * ii * xc[r]; gv[k] = gl[r];
                B = a[k] * B + bb[k]; A *= a[k]; }
        }
        { const float Au = __shfl_up(A, 16), Bu = __shfl_up(B, 16); if (q >= 1) { B = A * Bu + B; A = A * Au; } }
        { const float Au = __shfl_up(A, 32), Bu = __shfl_up(B, 32); if (q >= 2) { B = A * Bu + B; A = A * Au; } }
        float Ae = __shfl_up(A, 16), Be = __shfl_up(B, 16); if (q == 0) { Ae = 1.0f; Be = 0.f; }
        float h = Ae * hprev + Be;
#pragma unroll
        for (int k = 0; k < 8; ++k) { h = a[k] * h + bb[k]; out[(size_t)(t0 + 8 * q + k) * 2048 + n16] = (bf16)f2bf(h * gelu_tanh(gv[k])); }
        hprev = __shfl(h, 48 + n16);
    }
}

#define PH_VARS int tid_ = wave_s * 64 + lane_id_fresh(); asm volatile("" : "+v"(tid_)); const int tid = tid_, lane = tid & 63, wave = __builtin_amdgcn_readfirstlane(tid >> 6); \
    const int G = opq((int)gridDim.x), bx = opq((int)blockIdx.x), vcu = (G % 8 == 0) ? (bx % 8) * (G / 8) + bx / 8 : bx; \
    const int gw = vcu * NWAVES + wave, NGW = G * NWAVES, gt = vcu * 512 + tid, NGT = G * 512; \
    LAS float* scr = (LAS float*)(lds + wave * 16384); LAS float* w8 = (LAS float*)lds; LAS float* xch = (LAS float*)(lds + XCH_OFF); \
    (void)lane; (void)gw; (void)NGW; (void)gt; (void)NGT; (void)scr; (void)w8; (void)xch; (void)bx;
#define ws (opqp(p.ws))
#define ctl ((unsigned*)(ws + WS_CTL))
#define GRID_BAR() do { if (single) { XcdBarrier b2_ = bar; b2_.bar = ctl + CW_BAR; xcd_barrier(b2_, wave_s); } } while (0)
#ifdef MK_TPROBE
#define GRID_BARC(c) do { GRID_BAR(); if (single && blockIdx.x == 0 && wave_s == 0 && lane_id_fresh() == 0) { unsigned long long* tl_ = (unsigned long long*)(ctl + 20000); const unsigned long long now_ = wall_clock64(); \
    if ((MK_TPROBE >> (c)) & 1) { unsigned* ac_ = ctl + 20100; *ac_ += (unsigned)(now_ - tl_[0]); } tl_[0] = now_; } } while (0)
#else
#define GRID_BARC(c) GRID_BAR()
#endif
#define IN(k) (lo <= (k) && (k) < hi)
#define x_ (opqp(p.in[0]))
#define mem_ (opqp(p.in[1]))
#define positions_ ((const int*)opqp(p.in[2]))
#define norm_mix (opqp(p.in[3]))
#define w_in (opqp(p.in[4]))
#define b_gate (opqp(p.in[5]))
#define w_branch (opqp(p.in[29]))
#define w_out (opqp(p.in[30]))
#define norm_xa (opqp(p.in[31]))
#define norm_mem (opqp(p.in[32]))
#define xa_wq (opqp(p.in[33]))
#define xa_wk (opqp(p.in[34]))
#define xa_wv (opqp(p.in[35]))
#define xa_wo (opqp(p.in[36]))
#define norm_ffn (opqp(p.in[37]))
#define ffn_w1 (opqp(p.in[38]))
#define ffn_w3 (opqp(p.in[39]))
#define ffn_w2 (opqp(p.in[40]))
#define moe_router (opqp(p.in[41]))
#define moe_w1 (opqp(p.in[42]))
#define moe_w3 (opqp(p.in[43]))
#define moe_w2 (opqp(p.in[44]))
#define norm_final (opqp(p.in[45]))
#define H (opqp(p.out))
#define HN ((bf16*)(ws + WS_HN))
#define KVB ((bf16*)(ws + WS_KV))
#define COS ((float*)(ws + WS_TAB))
#define SIN (COS + (size_t)T * 32)
#define DT ((float*)(ws + WS_DT))
#define MNR ((bf16*)(ws + WS_MNR))
#define PROJB ((bf16*)(ws + R_PROJB))
#define GATE ((bf16*)(ws + R_GATE))
#define BR ((bf16*)(ws + R_BR))
#define XBCC ((bf16*)(ws + R_XBCC))
#define XLC ((bf16*)(ws + R_XLC))
#define YSB ((bf16*)(ws + R_YS))
#define QKW ((bf16*)(ws + R_QKW))
#define MP ((float*)(ws + R_MP))
#define MERGED ((bf16*)(ws + R_MERGED))
#define XQ ((bf16*)(ws + R_XQ))
#define VWO ((bf16*)(ws + R_XQ))
#define PB ((bf16*)(ws + R_P))
#define XO ((bf16*)(ws + R_XO))
#define ACT ((bf16*)(ws + R_ACT))
#define W13E ((bf16*)(ws + M_W13E))
#define W2E ((bf16*)(ws + M_W2E))
#define XS ((bf16*)(ws + M_XS))
#define ACTE ((bf16*)(ws + M_ACTE))
#define YPART ((float*)(ws + M_W13E))
#define TOPI ((i32x4*)(ws + WS_TOPI))
#define TOPW ((f32x2*)(ws + WS_TOPW))
#define SLOT ((i32x2*)(ws + WS_SLOT))
#define HN8L1 ((unsigned char*)(ws + WS_W))
#define XS8 ((unsigned char*)(ws + M_XS))
#define HN8 ((unsigned char*)(ws + M_XS + 36 * MiB))
#define ROWOF ((int*)(ws + WS_CTL + 512 * 1024))
#define CNT ((int*)(ctl + CW_CNT))
#define W13 ((bf16*)(ws + WS_W13))
#define W2T ((bf16*)(ws + WS_W2))
#define CVT_LOOP(NITEMS, ...) do { for (int it = (gw + NGW - rot % NGW) % NGW; it < (NITEMS); it += NGW) { __VA_ARGS__; cvt_item(m, it, scr, lane); } rot += (NITEMS); } while (0)
#define CVT_LOOP8(NITEMS, WSC, PITCH, ...) do { for (int it = (gw + NGW - rot % NGW) % NGW; it < (NITEMS); it += NGW) { __VA_ARGS__; cvt_item8(m, it, scr, lane, (WSC), (PITCH)); } rot += (NITEMS); } while (0)

__global__ void __launch_bounds__(NWAVES * 64, 2) mega(Params p) {
    using namespace cf;
    extern __shared__ __attribute__((aligned(16))) unsigned char lds_raw[];
    LAS unsigned char* lds = (LAS unsigned char*)lds_raw;
    const int wave_s = __builtin_amdgcn_readfirstlane((int)threadIdx.x >> 6);
    for (int u = threadIdx.x; u < (LDS_BYTES - LDSCTL_OFF) / 4; u += NWAVES * 64) ((LAS unsigned*)(lds + LDSCTL_OFF))[u] = 0u;
    __syncthreads();
    const bool single = (p.ph_hi - p.ph_lo) > 1;
    XcdBarrier bar; bar.bar = ctl + CW_BAR; bar.x = 0; bar.st = (volatile LAS unsigned*)(lds + LDSCTL_OFF) + 8;
    if (single) bar = xcd_barrier_post(ctl + CW_BAR, (volatile LAS unsigned*)(lds + LDSCTL_OFF) + 8, wave_s);
#ifdef MK_TPROBE
    if (blockIdx.x == 0 && wave_s == 0 && lane_id_fresh() == 0) ((unsigned long long*)(ctl + 20000))[0] = wall_clock64();
#endif
    const int lo = p.ph_lo, hi = p.ph_hi;


    if (IN(0)) { PH_VARS
        {
            int rot = 0;
            {
                unsigned char* wl = ws + WS_W;
                CVT_LOOP(16 * 140, MapWin m{w_in, norm_mix, (bf16*)(wl + WL_WIN), 8960});
                CVT_LOOP(8 * 8, MapPlain m{opqp(p.in[14]), 512, 512, nullptr, 1.f, (bf16*)(wl + WL_GLU), 512});
                for (int k = 0; k < 4; ++k) CVT_LOOP(8 * 16, MapPlain m{w_branch + (size_t)k * 512 * 1024, 512, 1024, nullptr, 1.f, (bf16*)(wl + WL_WB) + k * 512, 2048});
                CVT_LOOP(16 * 16, MapPlain m{w_out, D, D, nullptr, 1.f, (bf16*)(wl + WL_WOUT), D});
                for (int l = 0; l < 2; ++l) { unsigned char* wk = ws + WS_W + (size_t)l * WL_STRIDE;
                    CVT_LOOP(16 * 16, MapPlain m{xa_wk + (size_t)l * D * D, D, D, norm_mem + l * D, 1.f, (bf16*)(wk + WL_WKV), D});
                    CVT_LOOP(16 * 16, MapPlain m{xa_wv + (size_t)l * D * D, D, D, norm_mem + l * D, 1.f, (bf16*)(wk + WL_WKV) + (size_t)D * D, D}); }
            }
        }
        for (int i = gt; i < T * 32; i += NGT) { const int row = i >> 5, f = i & 31; const float inv_freq = (float)exp(-(double)f / 32.0 * 9.210340371976184); const float ang = (float)positions_[row] * inv_freq;
            COS[i] = (float)cos((double)ang); SIN[i] = (float)sin((double)ang); }
        norm_rows(mem_, MNR, TM, gw, NGW, lane, NoPost{});
        __syncthreads();
        for (int i = tid; i < 8192; i += 512) w8[i] = norm_mix[i >> 3] * w_in[(size_t)(i >> 3) * IN_TOTAL + O_DT + (i & 7)];
        __syncthreads();
        norm_rows(x_, HN, T, gw, NGW, lane, [&](const int row, const float r, const f32x4 (&v)[4]) { float lg[8]; row_dot8(v, w8, lane, lg);
            float mine = 0.f;
#pragma unroll
            for (int e = 0; e < 8; ++e) if (lane == e) mine = lg[e];
            if (lane < 8) DT[(size_t)row * 8 + lane] = softplusf_(r * mine + opqp(p.in[17])[lane]); });
        GRID_BARC(0);
    }


    { constexpr int layer = 0;
        const int pb = 1 + layer * 20;
#define WLP (ws + WS_W + (size_t)layer * WL_STRIDE)
#define WIN ((const bf16*)(WLP + WL_WIN))
#define WGLU ((const bf16*)(WLP + WL_GLU))
#define WB ((const bf16*)(WLP + WL_WB))
#define WOUT ((const bf16*)(WLP + WL_WOUT))
#define WQ ((const bf16*)(WLP + WL_WQ))
#define WO ((const bf16*)(WLP + WL_WO))
#define KX (KVB + (size_t)layer * 4194304)
#define VT (KX + 2097152)
        if (IN(pb + 0)) { PH_VARS
            pg8::Gemm g{1024, 1024, 1024}; pg8::PlainOrder S; S.A = (const char*)HN; S.B = (const char*)WIN; S.nM = 64; S.nN = 19; S.lda = 1024; S.ldb = 1024; S.G = G; S.c = bx;
            pg8::EpiProj E{PROJB, GATE, b_gate + layer * 4096, 1.0f};
            pg8::gemm_phase<pg8::EpiProj, pg8::PlainOrder, true, true>(lds, g, S, E, wave_s);
            GRID_BARC(1);
        }
        if (IN(pb + 1)) { PH_VARS
            const float* cw = opqp(p.in[15]) + layer * 4 * 768; const float* cb = opqp(p.in[16]) + layer * 768; const float* lw = opqp(p.in[22]) + layer * 4 * 512; const float* lb = opqp(p.in[23]) + layer * 512;
            for (int it = gt; it < T * 224; it += NGT) {
                const int row = it / 224, j = it % 224, t = row & (L - 1);
                if (j < 160) {
                    const bool isx = j < 96; const int c0 = isx ? j * 8 : (j - 96) * 8, C = isx ? 768 : 512; const float* w = isx ? cw : lw; const float* bb = isx ? cb : lb;
                    const bf16* src = PROJB + (size_t)row * PJ + (isx ? C_XBC : C_XL) + c0;
                    float acc[8];
#pragma unroll
                    for (int q = 0; q < 8; ++q) acc[q] = bb[c0 + q];
#pragma unroll
                    for (int tap = 0; tap < 4; ++tap) { if (t - 3 + tap >= 0) { const v4u xv = *(const v4u*)(src - (ptrdiff_t)(3 - tap) * PJ); const float* wt = w + tap * C + c0;
                        acc[0] += wt[0] * bflo(xv.x); acc[1] += wt[1] * bfhi(xv.x); acc[2] += wt[2] * bflo(xv.y); acc[3] += wt[3] * bfhi(xv.y);
                        acc[4] += wt[4] * bflo(xv.z); acc[5] += wt[5] * bfhi(xv.z); acc[6] += wt[6] * bflo(xv.w); acc[7] += wt[7] * bfhi(xv.w); } }
                    if (isx) {
#pragma unroll
                        for (int q = 0; q < 8; ++q) acc[q] = siluf_(acc[q]); }
                    v4u o; o.x = pk2(acc[0], acc[1]); o.y = pk2(acc[2], acc[3]); o.z = pk2(acc[4], acc[5]); o.w = pk2(acc[6], acc[7]);
                    *(v4u*)((isx ? XBCC + (size_t)row * 768 : XLC + (size_t)row * 512) + c0) = o;
                } else {
                    const bool isk = j >= 192; const int jj = isk ? j - 192 : j - 160, h = jj >> 2, i0 = (jj & 3) * 8; const float sc = isk ? 0.125f : 1.0f;
                    bf16* q1 = PROJB + (size_t)row * PJ + (isk ? C_K : C_Q) + h * 64 + i0; bf16* q2 = q1 + 32;
                    const v4u a = *(const v4u*)q1, b = *(const v4u*)q2;
                    const f32x4 c0v = *(const f32x4*)(COS + (size_t)row * 32 + i0), c1v = *(const f32x4*)(COS + (size_t)row * 32 + i0 + 4), s0v = *(const f32x4*)(SIN + (size_t)row * 32 + i0), s1v = *(const f32x4*)(SIN + (size_t)row * 32 + i0 + 4);
                    const float x1[8] = {bflo(a.x), bfhi(a.x), bflo(a.y), bfhi(a.y), bflo(a.z), bfhi(a.z), bflo(a.w), bfhi(a.w)};
                    const float x2[8] = {bflo(b.x), bfhi(b.x), bflo(b.y), bfhi(b.y), bflo(b.z), bfhi(b.z), bflo(b.w), bfhi(b.w)};
                    const float cc[8] = {c0v.x, c0v.y, c0v.z, c0v.w, c1v.x, c1v.y, c1v.z, c1v.w}, ss[8] = {s0v.x, s0v.y, s0v.z, s0v.w, s1v.x, s1v.y, s1v.z, s1v.w};
                    float o1[8], o2[8];
#pragma unroll
                    for (int q = 0; q < 8; ++q) { o1[q] = (x1[q] * cc[q] - x2[q] * ss[q]) * sc; o2[q] = (x2[q] * cc[q] + x1[q] * ss[q]) * sc; }
                    v4u w1; w1.x = pk2(o1[0], o1[1]); w1.y = pk2(o1[2], o1[3]); w1.z = pk2(o1[4], o1[5]); w1.w = pk2(o1[6], o1[7]);
                    v4u w2; w2.x = pk2(o2[0], o2[1]); w2.y = pk2(o2[2], o2[3]); w2.z = pk2(o2[4], o2[5]); w2.w = pk2(o2[6], o2[7]);
                    *(v4u*)q1 = w1; *(v4u*)q2 = w2;
                }
            }
            GRID_BARC(2);
        }
        if (IN(pb + 2)) { PH_VARS
            bf16* YS = YSB;
#ifdef MK_NAIVE_MIX
            for (int wu = gw; wu < 832; wu += NGW) {
                if (wu < 256) {
                    const int un = wu >> 2, sub = wu & 3, b = un >> 3, hh = un & 7, g = hh >> 2, pp = sub * 16 + (lane >> 2), nq = lane & 3;
                    const float Aa = -__expf(opqp(p.in[18])[layer * 8 + hh]), Dk = opqp(p.in[19])[layer * 8 + hh];
                    float S[16];
#pragma unroll
                    for (int j = 0; j < 16; ++j) S[j] = 0.f;
                    for (int t = 0; t < L; ++t) {
                        const size_t row = (size_t)b * L + t; const bf16* xr = XBCC + row * 768;
                        const float dtv = DT[row * 8 + hh], xv = bf1(xr[hh * 64 + pp]);
                        const v4u b0 = *(const v4u*)(xr + 512 + g * 64 + nq * 16), b1 = *(const v4u*)(xr + 512 + g * 64 + nq * 16 + 8), c0 = *(const v4u*)(xr + 640 + g * 64 + nq * 16), c1 = *(const v4u*)(xr + 640 + g * 64 + nq * 16 + 8);
                        const float Bv[16] = {bflo(b0.x), bfhi(b0.x), bflo(b0.y), bfhi(b0.y), bflo(b0.z), bfhi(b0.z), bflo(b0.w), bfhi(b0.w), bflo(b1.x), bfhi(b1.x), bflo(b1.y), bfhi(b1.y), bflo(b1.z), bfhi(b1.z), bflo(b1.w), bfhi(b1.w)};
                        const float Cv[16] = {bflo(c0.x), bfhi(c0.x), bflo(c0.y), bfhi(c0.y), bflo(c0.z), bfhi(c0.z), bflo(c0.w), bfhi(c0.w), bflo(c1.x), bfhi(c1.x), bflo(c1.y), bfhi(c1.y), bflo(c1.z), bfhi(c1.z), bflo(c1.w), bfhi(c1.w)};
                        const float da = __expf(dtv * Aa), xdt = xv * dtv; float acc = 0.f;
#pragma unroll
                        for (int j = 0; j < 16; ++j) { S[j] = da * S[j] + xdt * Bv[j]; acc += Cv[j] * S[j]; }
                        acc += __shfl_xor(acc, 1); acc += __shfl_xor(acc, 2);
                        if (nq == 0) BR[row * 2048 + 512 + hh * 64 + pp] = (bf16)f2bf(acc + Dk * xv);
                    }
                } else if (wu < 512) {
                    const int un = (wu - 256) >> 2, sub = wu & 3, b = un >> 3, hh = un & 7, e = sub * 16 + (lane >> 2), dq = lane & 3;
                    const float gamma = 1.0f - exp2f(-5.0f - (float)hh);
                    float S[16];
#pragma unroll
                    for (int j = 0; j < 16; ++j) S[j] = 0.f;
                    for (int t = 0; t < L; ++t) {
                        const size_t row = (size_t)b * L + t; const bf16* pr = PROJB + row * PJ;
                        const float vv = bf1(pr[C_V + hh * 64 + e]);
                        const v4u k0 = *(const v4u*)(pr + C_K + hh * 64 + dq * 16), k1 = *(const v4u*)(pr + C_K + hh * 64 + dq * 16 + 8), q0 = *(const v4u*)(pr + C_Q + hh * 64 + dq * 16), q1 = *(const v4u*)(pr + C_Q + hh * 64 + dq * 16 + 8);
                        const float Kv[16] = {bflo(k0.x), bfhi(k0.x), bflo(k0.y), bfhi(k0.y), bflo(k0.z), bfhi(k0.z), bflo(k0.w), bfhi(k0.w), bflo(k1.x), bfhi(k1.x), bflo(k1.y), bfhi(k1.y), bflo(k1.z), bfhi(k1.z), bflo(k1.w), bfhi(k1.w)};
                        const float Qv[16] = {bflo(q0.x), bfhi(q0.x), bflo(q0.y), bfhi(q0.y), bflo(q0.z), bfhi(q0.z), bflo(q0.w), bfhi(q0.w), bflo(q1.x), bfhi(q1.x), bflo(q1.y), bfhi(q1.y), bflo(q1.z), bfhi(q1.z), bflo(q1.w), bfhi(q1.w)};
                        float acc = 0.f;
#pragma unroll
                        for (int j = 0; j < 16; ++j) { S[j] = gamma * S[j] + Kv[j] * vv; acc += Qv[j] * S[j]; }
                        acc += __shfl_xor(acc, 1); acc += __shfl_xor(acc, 2);
                        if (dq == 0) BR[row * 2048 + 1024 + hh * 64 + e] = (bf16)f2bf(acc);
                    }
                } else if (wu < 768) {
                    const int un = wu - 512, b = un >> 5, g = un & 31, n = lane;
                    const float* lam_re = opqp(p.in[6]) + layer * 2048; const float* lam_im = opqp(p.in[7]) + layer * 2048; const float* b_re = opqp(p.in[8]) + layer * 32768; const float* b_im = opqp(p.in[9]) + layer * 32768;
                    const float* c_re = opqp(p.in[10]) + layer * 32768; const float* c_im = opqp(p.in[11]) + layer * 32768; const float* dsk = opqp(p.in[12]) + layer * 512;
                    const float lr = lam_re[g * 64 + n], li = lam_im[g * 64 + n], step = expf(opqp(p.in[13])[layer * 32 + g]);
                    const float mag = expf(lr * step), ar = mag * cosf(li * step), ai = mag * sinf(li * step);
                    const float inv = 1.0f / (lr * lr + li * li);
                    const float cr = ((ar - 1.0f) * lr + ai * li) * inv, ci = (ai * lr - (ar - 1.0f) * li) * inv;
                    float bbr[16], bbi[16], cre[16], cim[16];
#pragma unroll
                    for (int h = 0; h < 16; ++h) { const float br_ = b_re[(g * 64 + n) * 16 + h], bi_ = b_im[(g * 64 + n) * 16 + h];
                        bbr[h] = cr * br_ - ci * bi_; bbi[h] = cr * bi_ + ci * br_; cre[h] = c_re[(g * 16 + h) * 64 + n]; cim[h] = c_im[(g * 16 + h) * 64 + n]; }
                    const float dmine = dsk[g * 16 + (n & 15)];
                    float sr = 0.f, si = 0.f;
                    for (int t = 0; t < L; ++t) {
                        const size_t row = (size_t)b * L + t; const bf16* up = PROJB + row * PJ + C_U + g * 16;
                        const v4u u0 = *(const v4u*)up, u1 = *(const v4u*)(up + 8);
                        const float u[16] = {bflo(u0.x), bfhi(u0.x), bflo(u0.y), bfhi(u0.y), bflo(u0.z), bfhi(u0.z), bflo(u0.w), bfhi(u0.w), bflo(u1.x), bfhi(u1.x), bflo(u1.y), bfhi(u1.y), bflo(u1.z), bfhi(u1.z), bflo(u1.w), bfhi(u1.w)};
                        float bur = 0.f, bui = 0.f;
#pragma unroll
                        for (int h = 0; h < 16; ++h) { bur += u[h] * bbr[h]; bui += u[h] * bbi[h]; }
                        const float nr = ar * sr - ai * si + bur, ni = ar * si + ai * sr + bui; sr = nr; si = ni;
                        float mine = 0.f, umine = 0.f;
#pragma unroll
                        for (int h = 0; h < 16; ++h) { const float y = wave_sum(sr * cre[h] - si * cim[h]); if (n == h) { mine = y; umine = u[h]; } }
                        if (n < 16) YS[row * 512 + g * 16 + n] = (bf16)f2bf(gelu_tanh(mine + dmine * umine));
                    }
                } else {
                    const int un = wu - 768, b = un >> 3, blk = un & 7, j = lane;
                    LAS bf16* wA = (LAS bf16*)scr; LAS bf16* wX = wA + 4096;
                    for (int i = 0; i < 64; ++i) { wA[i * 64 + j] = (bf16)f2bf(opqp(p.in[24])[layer * 32768 + (blk * 64 + i) * 64 + j]); wX[i * 64 + j] = (bf16)f2bf(opqp(p.in[26])[layer * 32768 + (blk * 64 + i) * 64 + j]); }
                    LDS_WAIT();
                    const float bA = opqp(p.in[25])[layer * 512 + blk * 64 + j], bX = opqp(p.in[27])[layer * 512 + blk * 64 + j], sp = softplusf_(-opqp(p.in[28])[layer * 512 + blk * 64 + j]);
                    float hs = 0.f;
                    for (int t = 0; t < L; ++t) {
                        const size_t row = (size_t)b * L + t;
                        const float xc = bf1(XLC[row * 512 + blk * 64 + j]);
                        float ra = bA, ri = bX;
#pragma unroll
                        for (int i = 0; i < 64; ++i) { const float xi = __shfl(xc, i); ra += xi * bf1(wA[i * 64 + j]); ri += xi * bf1(wX[i * 64 + j]); }
                        const float r = sigmoidf_(ra), ig = sigmoidf_(ri);
                        const float log_a = -8.0f * r * sp, a = __expf(log_a);
                        const float mult = sqrtf(fmaxf(-expm1f(2.0f * log_a), 0.f));
                        hs = a * hs + mult * ig * xc;
                        BR[row * 2048 + 1536 + blk * 64 + j] = (bf16)f2bf(hs * gelu_tanh(bf1(PROJB[row * PJ + C_GL + blk * 64 + j])));
                    }
                }
            }
#else
            const int NMIXB = G >= 192 ? MK_NMIXB : G / 2;
            if (vcu >= NMIXB) {
                if (layer == 0) {
                    { const int gw = (vcu - NMIXB) * NWAVES + wave, NGW = (G - NMIXB) * NWAVES; int rot = 0;
                      CVT_LOOP(16 * 16, MapPlain m{xa_wo, D, D, nullptr, 1.f, (bf16*)(ws + WS_W + WL_WO), D});
                      CVT_LOOP(16 * 88, MapW13 m{ffn_w1, ffn_w3, norm_ffn, W13, DFF, 2 * DFF});
                      CVT_LOOP(44 * 16, MapPlain m{ffn_w2, DFF, D, nullptr, 1.f, W2T, DFF});
                      { unsigned char* wl = ws + WS_W + WL_STRIDE;
                        { for (int it = (gw + NGW - rot % NGW) % NGW; it < 16 * 140; it += NGW) { if (it % 140 < 76) { MapWin m{w_in + (size_t)D * IN_TOTAL, norm_mix + D, (bf16*)(wl + WL_WIN), 8960}; cvt_item(m, it, scr, lane); }
                            else { MapWin m{w_in + (size_t)D * IN_TOTAL, norm_mix + D, (bf16*)(wl + WL_WIN + (size_t)4864 * 2048 - (size_t)4864 * 1024), 8960}; cvt_item8(m, it, scr, lane, 64.0f, 1024); } } rot += 16 * 140; }
                        CVT_LOOP(8 * 8, MapPlain m{opqp(p.in[14]) + (size_t)512 * 512, 512, 512, nullptr, 1.f, (bf16*)(wl + WL_GLU), 512});
                        for (int k = 0; k < 4; ++k) CVT_LOOP(8 * 16, MapPlain m{w_branch + ((size_t)4 + k) * 512 * 1024, 512, 1024, nullptr, 1.f, (bf16*)(wl + WL_WB) + k * 512, 2048});
                        CVT_LOOP(16 * 16, MapPlain m{w_out + (size_t)D * D, D, D, nullptr, 1.f, (bf16*)(wl + WL_WOUT), D});
                        CVT_LOOP(16 * 16, MapPlain m{xa_wo + (size_t)D * D, D, D, nullptr, 1.f, (bf16*)(wl + WL_WO), D}); } }
                    for (int ll = 0; ll < 2; ++ll) {
                        const float* wq = xa_wq + (size_t)ll * D * D; const float* nx = norm_xa + ll * D; bf16* dq = (bf16*)(ws + WS_W + (size_t)ll * WL_STRIDE + WL_WQ);
                        for (int i8 = ((vcu - NMIXB) * NWAVES + wave) * 64 + lane; i8 < D * D / 8; i8 += (G - NMIXB) * NWAVES * 64) { const float sc = nx[i8 >> 7] * 0.0625f;
                            const f32x4 v0 = *(const f32x4*)(wq + (size_t)i8 * 8), v1 = *(const f32x4*)(wq + (size_t)i8 * 8 + 4);
                            v4u o; o.x = pg8::cvt_pk_bf16(v0[0] * sc, v0[1] * sc); o.y = pg8::cvt_pk_bf16(v0[2] * sc, v0[3] * sc); o.z = pg8::cvt_pk_bf16(v1[0] * sc, v1[1] * sc); o.w = pg8::cvt_pk_bf16(v1[2] * sc, v1[3] * sc);
                            *(v4u*)(dq + (size_t)i8 * 8) = o; } }
                    __syncthreads();
                    pg8::Gemm g{1024, 1024, 1024}; pg8::KVOrder S; S.mnr_ = (const char*)MNR; S.WKV0 = (const char*)(ws + WS_W + WL_WKV); S.WKV1 = (const char*)(ws + WS_W + WL_STRIDE + WL_WKV); S.G = G - NMIXB; S.c = vcu - NMIXB;
                    pg8::EpiKV E{KVB};
                    pg8::gemm_phase<pg8::EpiKV, pg8::KVOrder, true, true>(lds, g, S, E, wave_s);
                }
                using POF = std::conditional<layer == 1, pg8::PlainOrderOffF8, pg8::PlainOrderOff>::type; constexpr int ldw = layer == 1 ? 512 : 1024; constexpr float psc = layer == 1 ? 1.0f / 64.0f : 1.0f;
                pg8::Gemm g{ldw, ldw, ldw}; POF S; S.A = layer == 1 ? (const char*)HN8L1 : (const char*)HN; S.B = layer == 1 ? (const char*)WIN + (size_t)4864 * 2048 - (size_t)4864 * 1024 : (const char*)WIN; S.nM = 64; S.nN = 16; S.lda = ldw; S.ldb = ldw; S.G = G - NMIXB; S.c = vcu - NMIXB; S.pn0 = 19; S.L0 = 0; S.L1 = (layer == 0 ? MK_GW0 : MK_GW1) - (layer == 0 ? MK_TAIL0 : MK_TAIL1);
                pg8::EpiProj E{PROJB, GATE, b_gate + layer * 4096, psc};
                pg8::gemm_phase<pg8::EpiProj, POF, true, true>(lds, g, S, E, wave_s);
            } else
            for (int wu = wave * NMIXB + vcu; wu < 768; wu += NMIXB * NWAVES) {
#ifdef MK_MIXONLY
                if ((wu < 256 ? 0 : wu < 512 ? 1 : 2) != MK_MIXONLY) continue;
#endif
                LAS unsigned char* sl = (LAS unsigned char*)scr; const int ln_ = lane_id_fresh();
                if (wu < 256) {
                    const int ty = wu >> 7, uu = wu & 127, b = uu >> 4, hh = (uu >> 1) & 7, eh = uu & 1; const size_t r0 = (size_t)b * L;
                    if (ty == 0) { const int g = hh >> 2; const float Aa = -__expf(opqp(p.in[18])[layer * 8 + hh]);
                        linattn_unit(XBCC + r0 * 768 + 640 + g * 64, 768, XBCC + r0 * 768 + 512 + g * 64, 768, XBCC + r0 * 768 + hh * 64 + eh * 32, 768, DT + r0 * 8 + hh, Aa * 1.4426950408889634f, opqp(p.in[19])[layer * 8 + hh],
                                     BR + r0 * 2048 + 512 + hh * 64 + eh * 32, 2048, sl, ln_); }
                    else { const float lg = log2f(1.0f - exp2f(-5.0f - (float)hh));
                        linattn_unit(PROJB + r0 * PJ + C_Q + hh * 64, PJ, PROJB + r0 * PJ + C_K + hh * 64, PJ, PROJB + r0 * PJ + C_V + hh * 64 + eh * 32, PJ, nullptr, lg, 0.f,
                                     BR + r0 * 2048 + 1024 + hh * 64 + eh * 32, 2048, sl, ln_); }
                } else if (wu < 512) {
                    const int un = wu - 256, b = un >> 5, g = un & 31; const size_t r0 = (size_t)b * L;
                    s5_unit(PROJB + r0 * PJ + C_U + g * 16, YS + r0 * 512 + g * 16, opqp(p.in[6]) + layer * 2048 + g * 64, opqp(p.in[7]) + layer * 2048 + g * 64, opqp(p.in[8]) + layer * 32768 + g * 1024, opqp(p.in[9]) + layer * 32768 + g * 1024,
                            opqp(p.in[10]) + layer * 32768 + g * 1024, opqp(p.in[11]) + layer * 32768 + g * 1024, opqp(p.in[12]) + layer * 512 + g * 16, expf(opqp(p.in[13])[layer * 32 + g]), sl, ln_);
                } else {
                    const int un = wu - 512, b = un >> 5, blk = (un >> 2) & 7, jq = un & 3, ch = blk * 64 + jq * 16 + (ln_ & 15); const size_t r0 = (size_t)b * L;
                    lru_unit(XLC + r0 * 512 + blk * 64, PROJB + r0 * PJ + C_GL + blk * 64, BR + r0 * 2048 + 1536 + blk * 64 + jq * 16, opqp(p.in[24]) + layer * 32768 + blk * 4096, opqp(p.in[26]) + layer * 32768 + blk * 4096,
                             opqp(p.in[25])[layer * 512 + ch], opqp(p.in[27])[layer * 512 + ch], softplusf_(-opqp(p.in[28])[layer * 512 + ch]), jq, ln_);
                }
            }
            if (vcu < NMIXB && (layer == 0 ? MK_TAIL0 : MK_TAIL1) > 0) {
                __syncthreads();
                pg8::Gemm g{1024, 1024, 1024}; pg8::PlainOrderOff S; S.A = (const char*)HN; S.B = (const char*)WIN; S.nM = 64; S.nN = 16; S.lda = 1024; S.ldb = 1024; S.G = NMIXB; S.c = vcu; S.pn0 = 19; S.L0 = (layer == 0 ? MK_GW0 : MK_GW1) - (layer == 0 ? MK_TAIL0 : MK_TAIL1); S.L1 = (layer == 0 ? MK_GW0 : MK_GW1);
                pg8::EpiProj E{PROJB, GATE, b_gate + layer * 4096, 1.0f};
                pg8::gemm_phase<pg8::EpiProj, pg8::PlainOrderOff, true, true>(lds, g, S, E, wave_s);
            }
#endif
            GRID_BARC(3);
        }
        if (IN(pb + 3)) { PH_VARS
            const float* snw = opqp(p.in[20]) + layer * 512; const float* rnw = opqp(p.in[21]) + layer * 512;
            for (int row = gw; row < T; row += NGW) {
                bf16* y = BR + (size_t)row * 2048; const bf16* pr = PROJB + (size_t)row * PJ;
                {
                    const v4u yw = *(const v4u*)(y + 512 + 8 * lane), zw = *(const v4u*)(pr + C_Z + 8 * lane);
                    float v[8] = {bflo(yw.x), bfhi(yw.x), bflo(yw.y), bfhi(yw.y), bflo(yw.z), bfhi(yw.z), bflo(yw.w), bfhi(yw.w)};
                    const float z[8] = {bflo(zw.x), bfhi(zw.x), bflo(zw.y), bfhi(zw.y), bflo(zw.z), bfhi(zw.z), bflo(zw.w), bfhi(zw.w)};
                    float ss = 0.f;
#pragma unroll
                    for (int q = 0; q < 8; ++q) { v[q] *= siluf_(z[q]); ss += v[q] * v[q]; }
                    const float r = 1.0f / sqrtf(wave_sum(ss) * (1.0f / 512.0f) + 1e-6f);
#pragma unroll
                    for (int q = 0; q < 8; ++q) v[q] *= r * snw[8 * lane + q];
                    v4u o; o.x = pk2(v[0], v[1]); o.y = pk2(v[2], v[3]); o.z = pk2(v[4], v[5]); o.w = pk2(v[6], v[7]);
                    *(v4u*)(y + 512 + 8 * lane) = o;
                }
                {
                    const v4u yw = *(const v4u*)(y + 1024 + 8 * lane), gw_ = *(const v4u*)(pr + C_G + 8 * lane);
                    float v[8] = {bflo(yw.x), bfhi(yw.x), bflo(yw.y), bfhi(yw.y), bflo(yw.z), bfhi(yw.z), bflo(yw.w), bfhi(yw.w)};
                    const float gg[8] = {bflo(gw_.x), bfhi(gw_.x), bflo(gw_.y), bfhi(gw_.y), bflo(gw_.z), bfhi(gw_.z), bflo(gw_.w), bfhi(gw_.w)};
                    float s = 0.f;
#pragma unroll
                    for (int q = 0; q < 8; ++q) s += v[q];
                    s = sum8(s);
                    const float mu = s * (1.0f / 64.0f); float q2 = 0.f;
#pragma unroll
                    for (int q = 0; q < 8; ++q) { v[q] -= mu; q2 += v[q] * v[q]; }
                    q2 = sum8(q2);
                    const float rs = 1.0f / sqrtf(q2 * (1.0f / 64.0f) + 1e-6f);
#pragma unroll
                    for (int q = 0; q < 8; ++q) v[q] = siluf_(gg[q]) * (v[q] * rs * rnw[8 * lane + q]);
                    v4u o; o.x = pk2(v[0], v[1]); o.y = pk2(v[2], v[3]); o.z = pk2(v[4], v[5]); o.w = pk2(v[6], v[7]);
                    *(v4u*)(y + 1024 + 8 * lane) = o;
                }
            }
            pg8::Gemm g{512, 512, 512}; pg8::PlainOrder S; S.A = (const char*)YSB; S.B = (const char*)WGLU; S.nM = 64; S.nN = 2; S.lda = 512; S.ldb = 512; S.G = G; S.c = bx;
            pg8::EpiGlu E{YSB, BR};
            pg8::gemm_phase<pg8::EpiGlu, pg8::PlainOrder, true, true>(lds, g, S, E, wave_s);
            {
                const int qoff = G >= 256 ? 128 : 0;
                pg8::Gemm gq{1024, 1024, 256}; pg8::QKWOrder Sq; Sq.kx_ = (const char*)KX; Sq.wqn_ = (const char*)WQ; Sq.G = G - qoff; Sq.c = bx - qoff;
                pg8::EpiStore Eq{QKW, 1024};
                pg8::gemm_phase<pg8::EpiStore, pg8::QKWOrder, false, false>(lds, gq, Sq, Eq, wave_s);
            }
            if ((layer == 0 ? MK_GW0 : MK_GW1) < 1024) {
                using POF2 = std::conditional<layer == 1, pg8::PlainOrderOffF8, pg8::PlainOrderOff>::type; constexpr int ldw2 = layer == 1 ? 512 : 1024; constexpr float psc2 = layer == 1 ? 1.0f / 64.0f : 1.0f;
                pg8::Gemm g2{ldw2, ldw2, ldw2}; POF2 S2; S2.A = layer == 1 ? (const char*)HN8L1 : (const char*)HN; S2.B = layer == 1 ? (const char*)WIN + (size_t)4864 * 2048 - (size_t)4864 * 1024 : (const char*)WIN; S2.nM = 64; S2.nN = 16; S2.lda = ldw2; S2.ldb = ldw2; S2.G = G; S2.c = vcu; S2.pn0 = 19; S2.L0 = (layer == 0 ? MK_GW0 : MK_GW1); S2.L1 = 1024;
                pg8::EpiProj E2{PROJB, GATE, b_gate + layer * 4096, psc2};
                pg8::gemm_phase<pg8::EpiProj, POF2, true, true>(lds, g2, S2, E2, wave_s);
            }
            GRID_BARC(4);
        }
        if (IN(pb + 4)) { PH_VARS
#ifdef MK_EXP_A
            pg8::Gemm g{2048, 2048, 2048}; pg8::PlainOrder S; S.A = (const char*)BR; S.B = (const char*)WB; S.nM = 64; S.nN = 4; S.lda = 2048; S.ldb = 2048; S.G = G; S.c = bx;
            pg8::EpiStore E{MERGED, 1024};
            pg8::gemm_phase<pg8::EpiStore, pg8::PlainOrder, true, true>(lds, g, S, E, wave_s);
#else
            pg8::Gemm g{2048, 2048, 512}; pg8::MergeOrder S; S.br_ = (const char*)BR; S.wb_ = (const char*)WB; S.G = G; S.c = bx;
            pg8::EpiMerge E{GATE, MERGED};
            pg8::gemm_phase<pg8::EpiMerge, pg8::MergeOrder, true, true>(lds, g, S, E, wave_s);
#endif
            GRID_BARC(5);
        }
        if (IN(pb + 5)) { PH_VARS
            pg8::Gemm g{1024, 1024, 1024}; pg8::PlainOrder S; S.A = (const char*)MERGED; S.B = (const char*)WOUT; S.nM = 64; S.nN = 4; S.lda = 1024; S.ldb = 1024; S.G = G; S.c = bx;
            pg8::EpiRes E{layer == 0 ? x_ : (const float*)H, H};
            pg8::gemm_phase<pg8::EpiRes, pg8::PlainOrder, true, true>(lds, g, S, E, wave_s);
            GRID_BARC(6);
        }
        if (IN(pb + 6)) { PH_VARS
            {
                const int voff = G >= 256 ? G - 128 : 0;
                pg8::Gemm gv{1024, 1024, 256}; pg8::VWOOrder Sv; Sv.wo_ = (const char*)WO; Sv.v_ = (const char*)VT; Sv.G = G - voff; Sv.c = bx - voff;
                pg8::EpiStore Ev{VWO, 1024};
                pg8::gemm_phase<pg8::EpiStore, pg8::VWOOrder, false, false>(lds, gv, Sv, Ev, wave_s);
            }
            norm_rows(H, HN, T, gw, NGW, lane, NoPost{});
            GRID_BARC(7);
        }
        if (IN(pb + 8)) { PH_VARS
            pg8::Gemm g{1024, 1024, 1024}; pg8::ScoreOrder S; S.hn_ = (const char*)HN; S.qkw_ = (const char*)QKW; S.G = G; S.c = bx;
            pg8::EpiSoftmax E{PB, (PG8_LAS float*)xch};
            for (int sb = 0; sb < 256; sb += G) { S.base = sb; pg8::gemm_phase<pg8::EpiSoftmax, pg8::ScoreOrder, false, false>(lds, g, S, E, wave_s); }
            GRID_BARC(9);
        }
        if (IN(pb + 10)) { PH_VARS
            pg8::Gemm g{1024, 1024, 1024}; pg8::PVWOrder S; S.p_ = (const char*)PB; S.vwo_ = (const char*)VWO; S.G = G; S.c = bx;
            pg8::EpiRes E{H, H};
            pg8::gemm_phase<pg8::EpiRes, pg8::PVWOrder, true, true>(lds, g, S, E, wave_s);
            GRID_BARC(11);
        }
        if (layer == 0) {
            if (IN(pb + 11)) { PH_VARS
                norm_rows(H, HN, T, gw, NGW, lane, NoPost{});
                GRID_BARC(7);
            }
            if (IN(pb + 12)) { PH_VARS
                pg8::Gemm g{1024, 1024, 1024}; pg8::PlainOrder S; S.A = (const char*)HN; S.B = (const char*)W13; S.nM = 64; S.nN = 22; S.lda = 1024; S.ldb = 1024; S.G = G; S.c = bx;
                pg8::EpiSwiglu E{ACT, DFF, 1.0f};
                pg8::gemm_phase<pg8::EpiSwiglu, pg8::PlainOrder, true, true>(lds, g, S, E, wave_s);
                GRID_BARC(12);
            }
            if (IN(pb + 13)) { PH_VARS
                pg8::Gemm g{DFF, DFF, DFF}; pg8::PlainOrder S; S.A = (const char*)ACT; S.B = (const char*)W2T; S.nM = 64; S.nN = 4; S.lda = DFF; S.ldb = DFF; S.G = G; S.c = bx;
                pg8::EpiRes E{H, H};
                pg8::gemm_phase<pg8::EpiRes, pg8::PlainOrder, true, true>(lds, g, S, E, wave_s);
                GRID_BARC(13);
            }
            if (IN(pb + 14)) { PH_VARS
                for (int i = tid; i < 8192; i += 512) w8[i] = norm_mix[D + (i >> 3)] * w_in[(size_t)D * IN_TOTAL + (size_t)(i >> 3) * IN_TOTAL + O_DT + (i & 7)];
                __syncthreads();
                norm_rows(H, HN, T, gw, NGW, lane, [&](const int row, const float r, const f32x4 (&v)[4]) { float lg[8]; row_dot8(v, w8, lane, lg);
                    float mine = 0.f;
#pragma unroll
                    for (int e = 0; e < 8; ++e) if (lane == e) mine = lg[e];
                    if (lane < 8) DT[(size_t)row * 8 + lane] = softplusf_(r * mine + opqp(p.in[17])[8 + lane]);
                    { unsigned* h8 = (unsigned*)(HN8L1 + (size_t)row * 1024) + lane;
#pragma unroll
                      for (int j = 0; j < 4; ++j) { int p8 = 0; p8 = __builtin_amdgcn_cvt_pk_fp8_f32(v[j].x * r, v[j].y * r, p8, false); p8 = __builtin_amdgcn_cvt_pk_fp8_f32(v[j].z * r, v[j].w * r, p8, true); h8[64 * j] = (unsigned)p8; } } });
                __syncthreads();
                GRID_BARC(7);
            }
        } else {
            if (IN(pb + 11)) { PH_VARS
                for (int i = tid; i < 8192; i += 512) w8[i] = norm_ffn[D + (i >> 3)] * moe_router[i];
                LAS int* lcnt = (LAS int*)(lds + 40960); LAS int* lbase = lcnt + 8; LAS i32x4* lti = (LAS i32x4*)(lds + 41984);
                if (tid < 8) lcnt[tid] = 0;
                __syncthreads();
                { int it = 0;
                norm_rows(H, HN, T, gw, NGW, lane, [&](const int row, const float r, const f32x4 (&v)[4]) { float lg[8]; row_dot8(v, w8, lane, lg);
                    { unsigned* h8 = (unsigned*)(HN8 + (size_t)row * 1024) + lane;
#pragma unroll
                      for (int j = 0; j < 4; ++j) { int p8 = 0; p8 = __builtin_amdgcn_cvt_pk_fp8_f32(v[j].x * r, v[j].y * r, p8, false); p8 = __builtin_amdgcn_cvt_pk_fp8_f32(v[j].z * r, v[j].w * r, p8, true); h8[64 * j] = (unsigned)p8; } }
                    if (lane == 0) {
                        int i1 = 0; float v1 = lg[0];
#pragma unroll
                        for (int e = 1; e < 8; ++e) if (lg[e] > v1) { v1 = lg[e]; i1 = e; }
                        int i2 = 0; float v2 = -3.0e38f;
#pragma unroll
                        for (int e = 0; e < 8; ++e) if (e != i1 && lg[e] > v2) { v2 = lg[e]; i2 = e; }
                        const float w1 = 1.0f / (1.0f + expf(r * (v2 - v1))), w2 = 1.0f - w1;
                        const int r1 = __hip_atomic_fetch_add(lcnt + i1, 1, __ATOMIC_RELAXED, __HIP_MEMORY_SCOPE_WORKGROUP), r2 = __hip_atomic_fetch_add(lcnt + i2, 1, __ATOMIC_RELAXED, __HIP_MEMORY_SCOPE_WORKGROUP);
                        lti[wave * 32 + (it & 31)] = (i32x4){i1, i2, r1, r2}; TOPW[row] = (f32x2){w1, w2};
                    } ++it; }); }
                __syncthreads();
                if (tid < 8) lbase[tid] = atomicAdd(&CNT[tid], lcnt[tid]);
                __syncthreads();
                { int it = 0;
                for (int row = gw; row < T; row += NGW, ++it) if (lane == 0) { i32x4 ti = lti[wave * 32 + (it & 31)]; ti.z += lbase[ti.x]; ti.w += lbase[ti.y]; TOPI[row] = ti; } }
                __syncthreads();
                {
                    int rot = 0;
                    for (int e = 0; e < NE; ++e) {
                        CVT_LOOP8(16 * 112, 64.0f, 1024, MapW13 m{moe_w1 + (size_t)e * D * DFE, moe_w3 + (size_t)e * D * DFE, norm_ffn + D, (bf16*)((unsigned char*)W13E + (size_t)e * 2 * DFE * D), DFE, 2 * DFE});
                        CVT_LOOP8(56 * 16, 64.0f, DFE, MapPlain m{moe_w2 + (size_t)e * DFE * D, DFE, D, nullptr, 1.f, (bf16*)((unsigned char*)W2E + (size_t)e * D * DFE), DFE});
                    }
                }
                GRID_BARC(14);
            }
            int t1 = 0, t2 = 0, t3 = 0, t4 = 0, t5 = 0, t6 = 0, t7 = 0, ntiles = 0;
            if (lo <= pb + 14 && hi > pb + 12) {
                int acc = 0;
#pragma unroll
                for (int e = 0; e < 8; ++e) { const int c = __hip_atomic_load(&CNT[e], RLX_AGENT); acc += (c + 255) >> 8;
                    if (e == 0) t1 = acc; if (e == 1) t2 = acc; if (e == 2) t3 = acc; if (e == 3) t4 = acc; if (e == 4) t5 = acc; if (e == 5) t6 = acc; if (e == 6) t7 = acc; if (e == 7) ntiles = acc; }
            }
            if (IN(pb + 12)) { PH_VARS
                for (int row = gw; row < T; row += NGW) {
                    const i32x4 ti = TOPI[row];
                    const int e1 = ti.x, e2 = ti.y;
                    const int s1 = (e1 == 0 ? 0 : e1 == 1 ? t1 : e1 == 2 ? t2 : e1 == 3 ? t3 : e1 == 4 ? t4 : e1 == 5 ? t5 : e1 == 6 ? t6 : t7) * 256 + ti.z;
                    const int s2 = (e2 == 0 ? 0 : e2 == 1 ? t1 : e2 == 2 ? t2 : e2 == 3 ? t3 : e2 == 4 ? t4 : e2 == 5 ? t5 : e2 == 6 ? t6 : t7) * 256 + ti.w;
                    if (lane == 0) { SLOT[row] = (i32x2){s1, s2}; ROWOF[s1] = row; ROWOF[s2] = row; }
                }
                GRID_BARC(15);
            }
            if (IN(pb + 13)) { PH_VARS
                pg8::Gemm g{512, 512, 512}; pg8::MoeUpGather S; S.A = (const char*)HN8; S.B = (const char*)W13E; S.estride = (size_t)2 * DFE * D; S.lda = 512; S.ldb = 512; S.ntiles = ntiles; S.nN = 28; S.G = G; S.c = bx;
                S.t1 = t1; S.t2 = t2; S.t3 = t3; S.t4 = t4; S.t5 = t5; S.t6 = t6; S.t7 = t7;
                { LAS int* tab = (LAS int*)(lds + XCH_OFF); S.tab = tab;
                  for (int i = 0; i < 15; ++i) { pg8::Unit u; if (!S.next(i, u)) break; if (tid < 256) tab[i * 256 + tid] = ROWOF[u.pm * 256 + tid]; }
                  __syncthreads(); }
                pg8::EpiSwigluF8 E{(unsigned char*)ACTE, DFE, 1.0f / 64.0f, 2.0f};
                pg8::gemm_phase<pg8::EpiSwigluF8, pg8::MoeUpGather, false, true>(lds, g, S, E, wave_s);
                GRID_BARC(16);
            }
            if (IN(pb + 14)) { PH_VARS
                { pg8::Gemm g{DFE / 2, DFE / 2, DFE / 2}; pg8::MoeDownOrderF8 S; S.A = (const char*)ACTE; S.B = (const char*)W2E; S.estride = (size_t)D * DFE; S.lda = DFE / 2; S.ldb = DFE / 2; S.G = G; S.c = vcu;
                  S.t1 = t1; S.t2 = t2; S.t3 = t3; S.t4 = t4; S.t5 = t5; S.t6 = t6; S.t7 = t7;
                  pg8::EpiStoreS E{XS, 1024, 1.0f / 128.0f};
                  pg8::gemm_phase<pg8::EpiStoreS, pg8::MoeDownOrderF8, true, true>(lds, g, S, E, wave_s); }
                { pg8::Gemm g{DFE / 2, DFE / 2, 256}; pg8::MoeDownTailF8 S; S.A = (const char*)ACTE; S.B = (const char*)W2E; S.estride = (size_t)D * DFE; S.lda = DFE / 2; S.ldb = DFE / 2; S.ntiles = ntiles; S.G = G; S.c = vcu;
                  S.t1 = t1; S.t2 = t2; S.t3 = t3; S.t4 = t4; S.t5 = t5; S.t6 = t6; S.t7 = t7;
                  pg8::EpiPartF32S E{YPART, 1.0f / 128.0f};
                  pg8::gemm_phase<pg8::EpiPartF32S, pg8::MoeDownTailF8, true, true>(lds, g, S, E, wave_s); }
                GRID_BARC(17);
            }
            if (IN(pb + 15)) { PH_VARS
                const unsigned bad = __hip_atomic_load(ctl + CW_BAR + XB_TMO, RLX_AGENT);
                for (int row = gw; row < T; row += NGW) {
                    const i32x2 sl = SLOT[row]; const f32x2 tw = TOPW[row];
                    const f32x4* hr = (const f32x4*)(H + (size_t)row * D) + lane;
                    f32x4 v[4]; float ss = 0.f;
#pragma unroll
                    for (int j = 0; j < 4; ++j) v[j] = hr[64 * j];
#pragma unroll
                    for (int k = 0; k < 2; ++k) { const int s_ = k ? sl.y : sl.x; const float w_ = k ? tw.y : tw.x;
                        if (s_ < 32768) { const v2u* y = (const v2u*)(XS + (size_t)s_ * D) + lane;
#pragma unroll
                            for (int j = 0; j < 4; ++j) { const v2u a = y[64 * j]; v[j].x += w_ * bflo(a.x); v[j].y += w_ * bfhi(a.x); v[j].z += w_ * bflo(a.y); v[j].w += w_ * bfhi(a.y); } }
                        else { const f32x4* yp = (const f32x4*)(YPART + ((size_t)((s_ >> 8) - 128) * 7 * 256 + (s_ & 255)) * 1024) + lane;
                            for (int p7 = 0; p7 < 7; ++p7)
#pragma unroll
                                for (int j = 0; j < 4; ++j) v[j] += yp[(size_t)p7 * 256 * 256 + 64 * j] * w_; } }
#pragma unroll
                    for (int j = 0; j < 4; ++j) ss += (v[j].x * v[j].x + v[j].y * v[j].y) + (v[j].z * v[j].z + v[j].w * v[j].w);
                    float r = 1.0f / sqrtf(wave_sum(ss) * (1.0f / 1024.0f) + 1e-6f);
                    if (bad) r = __builtin_nanf("");
                    f32x4* orow = (f32x4*)(H + (size_t)row * D) + lane;
#pragma unroll
                    for (int j = 0; j < 4; ++j) { const f32x4 g4 = *((const f32x4*)norm_final + lane + 64 * j); orow[64 * j] = v[j] * r * g4; }
                }
            }
        }
        }
    { constexpr int layer = 1;
        const int pb = 1 + layer * 20;
#define WLP (ws + WS_W + (size_t)layer * WL_STRIDE)
#define WIN ((const bf16*)(WLP + WL_WIN))
#define WGLU ((const bf16*)(WLP + WL_GLU))
#define WB ((const bf16*)(WLP + WL_WB))
#define WOUT ((const bf16*)(WLP + WL_WOUT))
#define WQ ((const bf16*)(WLP + WL_WQ))
#define WO ((const bf16*)(WLP + WL_WO))
#define KX (KVB + (size_t)layer * 4194304)
#define VT (KX + 2097152)
        if (IN(pb + 0)) { PH_VARS
            pg8::Gemm g{1024, 1024, 1024}; pg8::PlainOrder S; S.A = (const char*)HN; S.B = (const char*)WIN; S.nM = 64; S.nN = 19; S.lda = 1024; S.ldb = 1024; S.G = G; S.c = bx;
            pg8::EpiProj E{PROJB, GATE, b_gate + layer * 4096, 1.0f};
            pg8::gemm_phase<pg8::EpiProj, pg8::PlainOrder, true, true>(lds, g, S, E, wave_s);
            GRID_BARC(1);
        }
        if (IN(pb + 1)) { PH_VARS
            const float* cw = opqp(p.in[15]) + layer * 4 * 768; const float* cb = opqp(p.in[16]) + layer * 768; const float* lw = opqp(p.in[22]) + layer * 4 * 512; const float* lb = opqp(p.in[23]) + layer * 512;
            for (int it = gt; it < T * 224; it += NGT) {
                const int row = it / 224, j = it % 224, t = row & (L - 1);
                if (j < 160) {
                    const bool isx = j < 96; const int c0 = isx ? j * 8 : (j - 96) * 8, C = isx ? 768 : 512; const float* w = isx ? cw : lw; const float* bb = isx ? cb : lb;
                    const bf16* src = PROJB + (size_t)row * PJ + (isx ? C_XBC : C_XL) + c0;
                    float acc[8];
#pragma unroll
                    for (int q = 0; q < 8; ++q) acc[q] = bb[c0 + q];
#pragma unroll
                    for (int tap = 0; tap < 4; ++tap) { if (t - 3 + tap >= 0) { const v4u xv = *(const v4u*)(src - (ptrdiff_t)(3 - tap) * PJ); const float* wt = w + tap * C + c0;
                        acc[0] += wt[0] * bflo(xv.x); acc[1] += wt[1] * bfhi(xv.x); acc[2] += wt[2] * bflo(xv.y); acc[3] += wt[3] * bfhi(xv.y);
                        acc[4] += wt[4] * bflo(xv.z); acc[5] += wt[5] * bfhi(xv.z); acc[6] += wt[6] * bflo(xv.w); acc[7] += wt[7] * bfhi(xv.w); } }
                    if (isx) {
#pragma unroll
                        for (int q = 0; q < 8; ++q) acc[q] = siluf_(acc[q]); }
                    v4u o; o.x = pk2(acc[0], acc[1]); o.y = pk2(acc[2], acc[3]); o.z = pk2(acc[4], acc[5]); o.w = pk2(acc[6], acc[7]);
                    *(v4u*)((isx ? XBCC + (size_t)row * 768 : XLC + (size_t)row * 512) + c0) = o;
                } else {
                    const bool isk = j >= 192; const int jj = isk ? j - 192 : j - 160, h = jj >> 2, i0 = (jj & 3) * 8; const float sc = isk ? 0.125f : 1.0f;
                    bf16* q1 = PROJB + (size_t)row * PJ + (isk ? C_K : C_Q) + h * 64 + i0; bf16* q2 = q1 + 32;
                    const v4u a = *(const v4u*)q1, b = *(const v4u*)q2;
                    const f32x4 c0v = *(const f32x4*)(COS + (size_t)row * 32 + i0), c1v = *(const f32x4*)(COS + (size_t)row * 32 + i0 + 4), s0v = *(const f32x4*)(SIN + (size_t)row * 32 + i0), s1v = *(const f32x4*)(SIN + (size_t)row * 32 + i0 + 4);
                    const float x1[8] = {bflo(a.x), bfhi(a.x), bflo(a.y), bfhi(a.y), bflo(a.z), bfhi(a.z), bflo(a.w), bfhi(a.w)};
                    const float x2[8] = {bflo(b.x), bfhi(b.x), bflo(b.y), bfhi(b.y), bflo(b.z), bfhi(b.z), bflo(b.w), bfhi(b.w)};
                    const float cc[8] = {c0v.x, c0v.y, c0v.z, c0v.w, c1v.x, c1v.y, c1v.z, c1v.w}, ss[8] = {s0v.x, s0v.y, s0v.z, s0v.w, s1v.x, s1v.y, s1v.z, s1v.w};
                    float o1[8], o2[8];
#pragma unroll
                    for (int q = 0; q < 8; ++q) { o1[q] = (x1[q] * cc[q] - x2[q] * ss[q]) * sc; o2[q] = (x2[q] * cc[q] + x1[q] * ss[q]) * sc; }
                    v4u w1; w1.x = pk2(o1[0], o1[1]); w1.y = pk2(o1[2], o1[3]); w1.z = pk2(o1[4], o1[5]); w1.w = pk2(o1[6], o1[7]);
                    v4u w2; w2.x = pk2(o2[0], o2[1]); w2.y = pk2(o2[2], o2[3]); w2.z = pk2(o2[4], o2[5]); w2.w = pk2(o2[6], o2[7]);
                    *(v4u*)q1 = w1; *(v4u*)q2 = w2;
                }
            }
            GRID_BARC(2);
        }
        if (IN(pb + 2)) { PH_VARS
            bf16* YS = YSB;
#ifdef MK_NAIVE_MIX
            for (int wu = gw; wu < 832; wu += NGW) {
                if (wu < 256) {
                    const int un = wu >> 2, sub = wu & 3, b = un >> 3, hh = un & 7, g = hh >> 2, pp = sub * 16 + (lane >> 2), nq = lane & 3;
                    const float Aa = -__expf(opqp(p.in[18])[layer * 8 + hh]), Dk = opqp(p.in[19])[layer * 8 + hh];
                    float S[16];
#pragma unroll
                    for (int j = 0; j < 16; ++j) S[j] = 0.f;
                    for (int t = 0; t < L; ++t) {
                        const size_t row = (size_t)b * L + t; const bf16* xr = XBCC + row * 768;
                        const float dtv = DT[row * 8 + hh], xv = bf1(xr[hh * 64 + pp]);
                        const v4u b0 = *(const v4u*)(xr + 512 + g * 64 + nq * 16), b1 = *(const v4u*)(xr + 512 + g * 64 + nq * 16 + 8), c0 = *(const v4u*)(xr + 640 + g * 64 + nq * 16), c1 = *(const v4u*)(xr + 640 + g * 64 + nq * 16 + 8);
                        const float Bv[16] = {bflo(b0.x), bfhi(b0.x), bflo(b0.y), bfhi(b0.y), bflo(b0.z), bfhi(b0.z), bflo(b0.w), bfhi(b0.w), bflo(b1.x), bfhi(b1.x), bflo(b1.y), bfhi(b1.y), bflo(b1.z), bfhi(b1.z), bflo(b1.w), bfhi(b1.w)};
                        const float Cv[16] = {bflo(c0.x), bfhi(c0.x), bflo(c0.y), bfhi(c0.y), bflo(c0.z), bfhi(c0.z), bflo(c0.w), bfhi(c0.w), bflo(c1.x), bfhi(c1.x), bflo(c1.y), bfhi(c1.y), bflo(c1.z), bfhi(c1.z), bflo(c1.w), bfhi(c1.w)};
                        const float da = __expf(dtv * Aa), xdt = xv * dtv; float acc = 0.f;
#pragma unroll
                        for (int j = 0; j < 16; ++j) { S[j] = da * S[j] + xdt * Bv[j]; acc += Cv[j] * S[j]; }
                        acc += __shfl_xor(acc, 1); acc += __shfl_xor(acc, 2);
                        if (nq == 0) BR[row * 2048 + 512 + hh * 64 + pp] = (bf16)f2bf(acc + Dk * xv);
                    }
                } else if (wu < 512) {
                    const int un = (wu - 256) >> 2, sub = wu & 3, b = un >> 3, hh = un & 7, e = sub * 16 + (lane >> 2), dq = lane & 3;
                    const float gamma = 1.0f - exp2f(-5.0f - (float)hh);
                    float S[16];
#pragma unroll
                    for (int j = 0; j < 16; ++j) S[j] = 0.f;
                    for (int t = 0; t < L; ++t) {
                        const size_t row = (size_t)b * L + t; const bf16* pr = PROJB + row * PJ;
                        const float vv = bf1(pr[C_V + hh * 64 + e]);
                        const v4u k0 = *(const v4u*)(pr + C_K + hh * 64 + dq * 16), k1 = *(const v4u*)(pr + C_K + hh * 64 + dq * 16 + 8), q0 = *(const v4u*)(pr + C_Q + hh * 64 + dq * 16), q1 = *(const v4u*)(pr + C_Q + hh * 64 + dq * 16 + 8);
                        const float Kv[16] = {bflo(k0.x), bfhi(k0.x), bflo(k0.y), bfhi(k0.y), bflo(k0.z), bfhi(k0.z), bflo(k0.w), bfhi(k0.w), bflo(k1.x), bfhi(k1.x), bflo(k1.y), bfhi(k1.y), bflo(k1.z), bfhi(k1.z), bflo(k1.w), bfhi(k1.w)};
                        const float Qv[16] = {bflo(q0.x), bfhi(q0.x), bflo(q0.y), bfhi(q0.y), bflo(q0.z), bfhi(q0.z), bflo(q0.w), bfhi(q0.w), bflo(q1.x), bfhi(q1.x), bflo(q1.y), bfhi(q1.y), bflo(q1.z), bfhi(q1.z), bflo(q1.w), bfhi(q1.w)};
                        float acc = 0.f;
#pragma unroll
                        for (int j = 0; j < 16; ++j) { S[j] = gamma * S[j] + Kv[j] * vv; acc += Qv[j] * S[j]; }
                        acc += __shfl_xor(acc, 1); acc += __shfl_xor(acc, 2);
                        if (dq == 0) BR[row * 2048 + 1024 + hh * 64 + e] = (bf16)f2bf(acc);
                    }
                } else if (wu < 768) {
                    const int un = wu - 512, b = un >> 5, g = un & 31, n = lane;
                    const float* lam_re = opqp(p.in[6]) + layer * 2048; const float* lam_im = opqp(p.in[7]) + layer * 2048; const float* b_re = opqp(p.in[8]) + layer * 32768; const float* b_im = opqp(p.in[9]) + layer * 32768;
                    const float* c_re = opqp(p.in[10]) + layer * 32768; const float* c_im = opqp(p.in[11]) + layer * 32768; const float* dsk = opqp(p.in[12]) + layer * 512;
                    const float lr = lam_re[g * 64 + n], li = lam_im[g * 64 + n], step = expf(opqp(p.in[13])[layer * 32 + g]);
                    const float mag = expf(lr * step), ar = mag * cosf(li * step), ai = mag * sinf(li * step);
                    const float inv = 1.0f / (lr * lr + li * li);
                    const float cr = ((ar - 1.0f) * lr + ai * li) * inv, ci = (ai * lr - (ar - 1.0f) * li) * inv;
                    float bbr[16], bbi[16], cre[16], cim[16];
#pragma unroll
                    for (int h = 0; h < 16; ++h) { const float br_ = b_re[(g * 64 + n) * 16 + h], bi_ = b_im[(g * 64 + n) * 16 + h];
                        bbr[h] = cr * br_ - ci * bi_; bbi[h] = cr * bi_ + ci * br_; cre[h] = c_re[(g * 16 + h) * 64 + n]; cim[h] = c_im[(g * 16 + h) * 64 + n]; }
                    const float dmine = dsk[g * 16 + (n & 15)];
                    float sr = 0.f, si = 0.f;
                    for (int t = 0; t < L; ++t) {
                        const size_t row = (size_t)b * L + t; const bf16* up = PROJB + row * PJ + C_U + g * 16;
                        const v4u u0 = *(const v4u*)up, u1 = *(const v4u*)(up + 8);
                        const float u[16] = {bflo(u0.x), bfhi(u0.x), bflo(u0.y), bfhi(u0.y), bflo(u0.z), bfhi(u0.z), bflo(u0.w), bfhi(u0.w), bflo(u1.x), bfhi(u1.x), bflo(u1.y), bfhi(u1.y), bflo(u1.z), bfhi(u1.z), bflo(u1.w), bfhi(u1.w)};
                        float bur = 0.f, bui = 0.f;
#pragma unroll
                        for (int h = 0; h < 16; ++h) { bur += u[h] * bbr[h]; bui += u[h] * bbi[h]; }
                        const float nr = ar * sr - ai * si + bur, ni = ar * si + ai * sr + bui; sr = nr; si = ni;
                        float mine = 0.f, umine = 0.f;
#pragma unroll
                        for (int h = 0; h < 16; ++h) { const float y = wave_sum(sr * cre[h] - si * cim[h]); if (n == h) { mine = y; umine = u[h]; } }
                        if (n < 16) YS[row * 512 + g * 16 + n] = (bf16)f2bf(gelu_tanh(mine + dmine * umine));
                    }
                } else {
                    const int un = wu - 768, b = un >> 3, blk = un & 7, j = lane;
                    LAS bf16* wA = (LAS bf16*)scr; LAS bf16* wX = wA + 4096;
                    for (int i = 0; i < 64; ++i) { wA[i * 64 + j] = (bf16)f2bf(opqp(p.in[24])[layer * 32768 + (blk * 64 + i) * 64 + j]); wX[i * 64 + j] = (bf16)f2bf(opqp(p.in[26])[layer * 32768 + (blk * 64 + i) * 64 + j]); }
                    LDS_WAIT();
                    const float bA = opqp(p.in[25])[layer * 512 + blk * 64 + j], bX = opqp(p.in[27])[layer * 512 + blk * 64 + j], sp = softplusf_(-opqp(p.in[28])[layer * 512 + blk * 64 + j]);
                    float hs = 0.f;
                    for (int t = 0; t < L; ++t) {
                        const size_t row = (size_t)b * L + t;
                        const float xc = bf1(XLC[row * 512 + blk * 64 + j]);
                        float ra = bA, ri = bX;
#pragma unroll
                        for (int i = 0; i < 64; ++i) { const float xi = __shfl(xc, i); ra += xi * bf1(wA[i * 64 + j]); ri += xi * bf1(wX[i * 64 + j]); }
                        const float r = sigmoidf_(ra), ig = sigmoidf_(ri);
                        const float log_a = -8.0f * r * sp, a = __expf(log_a);
                        const float mult = sqrtf(fmaxf(-expm1f(2.0f * log_a), 0.f));
                        hs = a * hs + mult * ig * xc;
                        BR[row * 2048 + 1536 + blk * 64 + j] = (bf16)f2bf(hs * gelu_tanh(bf1(PROJB[row * PJ + C_GL + blk * 64 + j])));
                    }
                }
            }
#else
            const int NMIXB = G >= 192 ? MK_NMIXB : G / 2;
            if (vcu >= NMIXB) {
                if (layer == 0) {
                    { const int gw = (vcu - NMIXB) * NWAVES + wave, NGW = (G - NMIXB) * NWAVES; int rot = 0;
                      CVT_LOOP(16 * 16, MapPlain m{xa_wo, D, D, nullptr, 1.f, (bf16*)(ws + WS_W + WL_WO), D});
                      CVT_LOOP(16 * 88, MapW13 m{ffn_w1, ffn_w3, norm_ffn, W13, DFF, 2 * DFF});
                      CVT_LOOP(44 * 16, MapPlain m{ffn_w2, DFF, D, nullptr, 1.f, W2T, DFF});
                      { unsigned char* wl = ws + WS_W + WL_STRIDE;
                        { for (int it = (gw + NGW - rot % NGW) % NGW; it < 16 * 140; it += NGW) { if (it % 140 < 76) { MapWin m{w_in + (size_t)D * IN_TOTAL, norm_mix + D, (bf16*)(wl + WL_WIN), 8960}; cvt_item(m, it, scr, lane); }
                            else { MapWin m{w_in + (size_t)D * IN_TOTAL, norm_mix + D, (bf16*)(wl + WL_WIN + (size_t)4864 * 2048 - (size_t)4864 * 1024), 8960}; cvt_item8(m, it, scr, lane, 64.0f, 1024); } } rot += 16 * 140; }
                        CVT_LOOP(8 * 8, MapPlain m{opqp(p.in[14]) + (size_t)512 * 512, 512, 512, nullptr, 1.f, (bf16*)(wl + WL_GLU), 512});
                        for (int k = 0; k < 4; ++k) CVT_LOOP(8 * 16, MapPlain m{w_branch + ((size_t)4 + k) * 512 * 1024, 512, 1024, nullptr, 1.f, (bf16*)(wl + WL_WB) + k * 512, 2048});
                        CVT_LOOP(16 * 16, MapPlain m{w_out + (size_t)D * D, D, D, nullptr, 1.f, (bf16*)(wl + WL_WOUT), D});
                        CVT_LOOP(16 * 16, MapPlain m{xa_wo + (size_t)D * D, D, D, nullptr, 1.f, (bf16*)(wl + WL_WO), D}); } }
                    for (int ll = 0; ll < 2; ++ll) {
                        const float* wq = xa_wq + (size_t)ll * D * D; const float* nx = norm_xa + ll * D; bf16* dq = (bf16*)(ws + WS_W + (size_t)ll * WL_STRIDE + WL_WQ);
                        for (int i8 = ((vcu - NMIXB) * NWAVES + wave) * 64 + lane; i8 < D * D / 8; i8 += (G - NMIXB) * NWAVES * 64) { const float sc = nx[i8 >> 7] * 0.0625f;
                            const f32x4 v0 = *(const f32x4*)(wq + (size_t)i8 * 8), v1 = *(const f32x4*)(wq + (size_t)i8 * 8 + 4);
                            v4u o; o.x = pg8::cvt_pk_bf16(v0[0] * sc, v0[1] * sc); o.y = pg8::cvt_pk_bf16(v0[2] * sc, v0[3] * sc); o.z = pg8::cvt_pk_bf16(v1[0] * sc, v1[1] * sc); o.w = pg8::cvt_pk_bf16(v1[2] * sc, v1[3] * sc);
                            *(v4u*)(dq + (size_t)i8 * 8) = o; } }
                    __syncthreads();
                    pg8::Gemm g{1024, 1024, 1024}; pg8::KVOrder S; S.mnr_ = (const char*)MNR; S.WKV0 = (const char*)(ws + WS_W + WL_WKV); S.WKV1 = (const char*)(ws + WS_W + WL_STRIDE + WL_WKV); S.G = G - NMIXB; S.c = vcu - NMIXB;
                    pg8::EpiKV E{KVB};
                    pg8::gemm_phase<pg8::EpiKV, pg8::KVOrder, true, true>(lds, g, S, E, wave_s);
                }
                using POF = std::conditional<layer == 1, pg8::PlainOrderOffF8, pg8::PlainOrderOff>::type; constexpr int ldw = layer == 1 ? 512 : 1024; constexpr float psc = layer == 1 ? 1.0f / 64.0f : 1.0f;
                pg8::Gemm g{ldw, ldw, ldw}; POF S; S.A = layer == 1 ? (const char*)HN8L1 : (const char*)HN; S.B = layer == 1 ? (const char*)WIN + (size_t)4864 * 2048 - (size_t)4864 * 1024 : (const char*)WIN; S.nM = 64; S.nN = 16; S.lda = ldw; S.ldb = ldw; S.G = G - NMIXB; S.c = vcu - NMIXB; S.pn0 = 19; S.L0 = 0; S.L1 = (layer == 0 ? MK_GW0 : MK_GW1) - (layer == 0 ? MK_TAIL0 : MK_TAIL1);
                pg8::EpiProj E{PROJB, GATE, b_gate + layer * 4096, psc};
                pg8::gemm_phase<pg8::EpiProj, POF, true, true>(lds, g, S, E, wave_s);
            } else
            for (int wu = wave * NMIXB + vcu; wu < 768; wu += NMIXB * NWAVES) {
#ifdef MK_MIXONLY
                if ((wu < 256 ? 0 : wu < 512 ? 1 : 2) != MK_MIXONLY) continue;
#endif
                LAS unsigned char* sl = (LAS unsigned char*)scr; const int ln_ = lane_id_fresh();
                if (wu < 256) {
                    const int ty = wu >> 7, uu = wu & 127, b = uu >> 4, hh = (uu >> 1) & 7, eh = uu & 1; const size_t r0 = (size_t)b * L;
                    if (ty == 0) { const int g = hh >> 2; const float Aa = -__expf(opqp(p.in[18])[layer * 8 + hh]);
                        linattn_unit(XBCC + r0 * 768 + 640 + g * 64, 768, XBCC + r0 * 768 + 512 + g * 64, 768, XBCC + r0 * 768 + hh * 64 + eh * 32, 768, DT + r0 * 8 + hh, Aa * 1.4426950408889634f, opqp(p.in[19])[layer * 8 + hh],
                                     BR + r0 * 2048 + 512 + hh * 64 + eh * 32, 2048, sl, ln_); }
                    else { const float lg = log2f(1.0f - exp2f(-5.0f - (float)hh));
                        linattn_unit(PROJB + r0 * PJ + C_Q + hh * 64, PJ, PROJB + r0 * PJ + C_K + hh * 64, PJ, PROJB + r0 * PJ + C_V + hh * 64 + eh * 32, PJ, nullptr, lg, 0.f,
                                     BR + r0 * 2048 + 1024 + hh * 64 + eh * 32, 2048, sl, ln_); }
                } else if (wu < 512) {
                    const int un = wu - 256, b = un >> 5, g = un & 31; const size_t r0 = (size_t)b * L;
                    s5_unit(PROJB + r0 * PJ + C_U + g * 16, YS + r0 * 512 + g * 16, opqp(p.in[6]) + layer * 2048 + g * 64, opqp(p.in[7]) + layer * 2048 + g * 64, opqp(p.in[8]) + layer * 32768 + g * 1024, opqp(p.in[9]) + layer * 32768 + g * 1024,
                            opqp(p.in[10]) + layer * 32768 + g * 1024, opqp(p.in[11]) + layer * 32768 + g * 1024, opqp(p.in[12]) + layer * 512 + g * 16, expf(opqp(p.in[13])[layer * 32 + g]), sl, ln_);
                } else {
                    const int un = wu - 512, b = un >> 5, blk = (un >> 2) & 7, jq = un & 3, ch = blk * 64 + jq * 16 + (ln_ & 15); const size_t r0 = (size_t)b * L;
                    lru_unit(XLC + r0 * 512 + blk * 64, PROJB + r0 * PJ + C_GL + blk * 64, BR + r0 * 2048 + 1536 + blk * 64 + jq * 16, opqp(p.in[24]) + layer * 32768 + blk * 4096, opqp(p.in[26]) + layer * 32768 + blk * 4096,
                             opqp(p.in[25])[layer * 512 + ch], opqp(p.in[27])[layer * 512 + ch], softplusf_(-opqp(p.in[28])[layer * 512 + ch]), jq, ln_);
                }
            }
            if (vcu < NMIXB && (layer == 0 ? MK_TAIL0 : MK_TAIL1) > 0) {
                __syncthreads();
                pg8::Gemm g{1024, 1024, 1024}; pg8::PlainOrderOff S; S.A = (const char*)HN; S.B = (const char*)WIN; S.nM = 64; S.nN = 16; S.lda = 1024; S.ldb = 1024; S.G = NMIXB; S.c = vcu; S.pn0 = 19; S.L0 = (layer == 0 ? MK_GW0 : MK_GW1) - (layer == 0 ? MK_TAIL0 : MK_TAIL1); S.L1 = (layer == 0 ? MK_GW0 : MK_GW1);
                pg8::EpiProj E{PROJB, GATE, b_gate + layer * 4096, 1.0f};
                pg8::gemm_phase<pg8::EpiProj, pg8::PlainOrderOff, true, true>(lds, g, S, E, wave_s);
            }
#endif
            GRID_BARC(3);
        }
        if (IN(pb + 3)) { PH_VARS
            const float* snw = opqp(p.in[20]) + layer * 512; const float* rnw = opqp(p.in[21]) + layer * 512;
            for (int row = gw; row < T; row += NGW) {
                bf16* y = BR + (size_t)row * 2048; const bf16* pr = PROJB + (size_t)row * PJ;
                {
                    const v4u yw = *(const v4u*)(y + 512 + 8 * lane), zw = *(const v4u*)(pr + C_Z + 8 * lane);
                    float v[8] = {bflo(yw.x), bfhi(yw.x), bflo(yw.y), bfhi(yw.y), bflo(yw.z), bfhi(yw.z), bflo(yw.w), bfhi(yw.w)};
                    const float z[8] = {bflo(zw.x), bfhi(zw.x), bflo(zw.y), bfhi(zw.y), bflo(zw.z), bfhi(zw.z), bflo(zw.w), bfhi(zw.w)};
                    float ss = 0.f;
#pragma unroll
                    for (int q = 0; q < 8; ++q) { v[q] *= siluf_(z[q]); ss += v[q] * v[q]; }
                    const float r = 1.0f / sqrtf(wave_sum(ss) * (1.0f / 512.0f) + 1e-6f);
#pragma unroll
                    for (int q = 0; q < 8; ++q) v[q] *= r * snw[8 * lane + q];
                    v4u o; o.x = pk2(v[0], v[1]); o.y = pk2(v[2], v[3]); o.z = pk2(v[4], v[5]); o.w = pk2(v[6], v[7]);
                    *(v4u*)(y + 512 + 8 * lane) = o;
                }
                {
                    const v4u yw = *(const v4u*)(y + 1024 + 8 * lane), gw_ = *(const v4u*)(pr + C_G + 8 * lane);
                    float v[8] = {bflo(yw.x), bfhi(yw.x), bflo(yw.y), bfhi(yw.y), bflo(yw.z), bfhi(yw.z), bflo(yw.w), bfhi(yw.w)};
                    const float gg[8] = {bflo(gw_.x), bfhi(gw_.x), bflo(gw_.y), bfhi(gw_.y), bflo(gw_.z), bfhi(gw_.z), bflo(gw_.w), bfhi(gw_.w)};
                    float s = 0.f;
#pragma unroll
                    for (int q = 0; q < 8; ++q) s += v[q];
                    s = sum8(s);
                    const float mu = s * (1.0f / 64.0f); float q2 = 0.f;
#pragma unroll
                    for (int q = 0; q < 8; ++q) { v[q] -= mu; q2 += v[q] * v[q]; }
                    q2 = sum8(q2);
                    const float rs = 1.0f / sqrtf(q2 * (1.0f / 64.0f) + 1e-6f);
#pragma unroll
                    for (int q = 0; q < 8; ++q) v[q] = siluf_(gg[q]) * (v[q] * rs * rnw[8 * lane + q]);
                    v4u o; o.x = pk2(v[0], v[1]); o.y = pk2(v[2], v[3]); o.z = pk2(v[4], v[5]); o.w = pk2(v[6], v[7]);
                    *(v4u*)(y + 1024 + 8 * lane) = o;
                }
            }
            pg8::Gemm g{512, 512, 512}; pg8::PlainOrder S; S.A = (const char*)YSB; S.B = (const char*)WGLU; S.nM = 64; S.nN = 2; S.lda = 512; S.ldb = 512; S.G = G; S.c = bx;
            pg8::EpiGlu E{YSB, BR};
            pg8::gemm_phase<pg8::EpiGlu, pg8::PlainOrder, true, true>(lds, g, S, E, wave_s);
            {
                const int qoff = G >= 256 ? 128 : 0;
                pg8::Gemm gq{1024, 1024, 256}; pg8::QKWOrder Sq; Sq.kx_ = (const char*)KX; Sq.wqn_ = (const char*)WQ; Sq.G = G - qoff; Sq.c = bx - qoff;
                pg8::EpiStore Eq{QKW, 1024};
                pg8::gemm_phase<pg8::EpiStore, pg8::QKWOrder, false, false>(lds, gq, Sq, Eq, wave_s);
            }
            if ((layer == 0 ? MK_GW0 : MK_GW1) < 1024) {
                using POF2 = std::conditional<layer == 1, pg8::PlainOrderOffF8, pg8::PlainOrderOff>::type; constexpr int ldw2 = layer == 1 ? 512 : 1024; constexpr float psc2 = layer == 1 ? 1.0f / 64.0f : 1.0f;
                pg8::Gemm g2{ldw2, ldw2, ldw2}; POF2 S2; S2.A = layer == 1 ? (const char*)HN8L1 : (const char*)HN; S2.B = layer == 1 ? (const char*)WIN + (size_t)4864 * 2048 - (size_t)4864 * 1024 : (const char*)WIN; S2.nM = 64; S2.nN = 16; S2.lda = ldw2; S2.ldb = ldw2; S2.G = G; S2.c = vcu; S2.pn0 = 19; S2.L0 = (layer == 0 ? MK_GW0 : MK_GW1); S2.L1 = 1024;
                pg8::EpiProj E2{PROJB, GATE, b_gate + layer * 4096, psc2};
                pg8::gemm_phase<pg8::EpiProj, POF2, true, true>(lds, g2, S2, E2, wave_s);
            }
            GRID_BARC(4);
        }
        if (IN(pb + 4)) { PH_VARS
#ifdef MK_EXP_A
            pg8::Gemm g{2048, 2048, 2048}; pg8::PlainOrder S; S.A = (const char*)BR; S.B = (const char*)WB; S.nM = 64; S.nN = 4; S.lda = 2048; S.ldb = 2048; S.G = G; S.c = bx;
            pg8::EpiStore E{MERGED, 1024};
            pg8::gemm_phase<pg8::EpiStore, pg8::PlainOrder, true, true>(lds, g, S, E, wave_s);
#else
            pg8::Gemm g{2048, 2048, 512}; pg8::MergeOrder S; S.br_ = (const char*)BR; S.wb_ = (const char*)WB; S.G = G; S.c = bx;
            pg8::EpiMerge E{GATE, MERGED};
            pg8::gemm_phase<pg8::EpiMerge, pg8::MergeOrder, true, true>(lds, g, S, E, wave_s);
#endif
            GRID_BARC(5);
        }
        if (IN(pb + 5)) { PH_VARS
            pg8::Gemm g{1024, 1024, 1024}; pg8::PlainOrder S; S.A = (const char*)MERGED; S.B = (const char*)WOUT; S.nM = 64; S.nN = 4; S.lda = 1024; S.ldb = 1024; S.G = G; S.c = bx;
            pg8::EpiRes E{layer == 0 ? x_ : (const float*)H, H};
            pg8::gemm_phase<pg8::EpiRes, pg8::PlainOrder, true, true>(lds, g, S, E, wave_s);
            GRID_BARC(6);
        }
        if (IN(pb + 6)) { PH_VARS
            {
                const int voff = G >= 256 ? G - 128 : 0;
                pg8::Gemm gv{1024, 1024, 256}; pg8::VWOOrder Sv; Sv.wo_ = (const char*)WO; Sv.v_ = (const char*)VT; Sv.G = G - voff; Sv.c = bx - voff;
                pg8::EpiStore Ev{VWO, 1024};
                pg8::gemm_phase<pg8::EpiStore, pg8::VWOOrder, false, false>(lds, gv, Sv, Ev, wave_s);
            }
            norm_rows(H, HN, T, gw, NGW, lane, NoPost{});
            GRID_BARC(7);
        }
        if (IN(pb + 8)) { PH_VARS
            pg8::Gemm g{1024, 1024, 1024}; pg8::ScoreOrder S; S.hn_ = (const char*)HN; S.qkw_ = (const char*)QKW; S.G = G; S.c = bx;
            pg8::EpiSoftmax E{PB, (PG8_LAS float*)xch};
            for (int sb = 0; sb < 256; sb += G) { S.base = sb; pg8::gemm_phase<pg8::EpiSoftmax, pg8::ScoreOrder, false, false>(lds, g, S, E, wave_s); }
            GRID_BARC(9);
        }
        if (IN(pb + 10)) { PH_VARS
            pg8::Gemm g{1024, 1024, 1024}; pg8::PVWOrder S; S.p_ = (const char*)PB; S.vwo_ = (const char*)VWO; S.G = G; S.c = bx;
            pg8::EpiRes E{H, H};
            pg8::gemm_phase<pg8::EpiRes, pg8::PVWOrder, true, true>(lds, g, S, E, wave_s);
            GRID_BARC(11);
        }
        if (layer == 0) {
            if (IN(pb + 11)) { PH_VARS
                norm_rows(H, HN, T, gw, NGW, lane, NoPost{});
                GRID_BARC(7);
            }
            if (IN(pb + 12)) { PH_VARS
                pg8::Gemm g{1024, 1024, 1024}; pg8::PlainOrder S; S.A = (const char*)HN; S.B = (const char*)W13; S.nM = 64; S.nN = 22; S.lda = 1024; S.ldb = 1024; S.G = G; S.c = bx;
                pg8::EpiSwiglu E{ACT, DFF, 1.0f};
                pg8::gemm_phase<pg8::EpiSwiglu, pg8::PlainOrder, true, true>(lds, g, S, E, wave_s);
                GRID_BARC(12);
            }
            if (IN(pb + 13)) { PH_VARS
                pg8::Gemm g{DFF, DFF, DFF}; pg8::PlainOrder S; S.A = (const char*)ACT; S.B = (const char*)W2T; S.nM = 64; S.nN = 4; S.lda = DFF; S.ldb = DFF; S.G = G; S.c = bx;
                pg8::EpiRes E{H, H};
                pg8::gemm_phase<pg8::EpiRes, pg8::PlainOrder, true, true>(lds, g, S, E, wave_s);
                GRID_BARC(13);
            }
            if (IN(pb + 14)) { PH_VARS
                for (int i = tid; i < 8192; i += 512) w8[i] = norm_mix[D + (i >> 3)] * w_in[(size_t)D * IN_TOTAL + (size_t)(i >> 3) * IN_TOTAL + O_DT + (i & 7)];
                __syncthreads();
                norm_rows(H, HN, T, gw, NGW, lane, [&](const int row, const float r, const f32x4 (&v)[4]) { float lg[8]; row_dot8(v, w8, lane, lg);
                    float mine = 0.f;
#pragma unroll
                    for (int e = 0; e < 8; ++e) if (lane == e) mine = lg[e];
                    if (lane < 8) DT[(size_t)row * 8 + lane] = softplusf_(r * mine + opqp(p.in[17])[8 + lane]);
                    { unsigned* h8 = (unsigned*)(HN8L1 + (size_t)row * 1024) + lane;
#pragma unroll
                      for (int j = 0; j < 4; ++j) { int p8 = 0; p8 = __builtin_amdgcn_cvt_pk_fp8_f32(v[j].x * r, v[j].y * r, p8, false); p8 = __builtin_amdgcn_cvt_pk_fp8_f32(v[j].z * r, v[j].w * r, p8, true); h8[64 * j] = (unsigned)p8; } } });
                __syncthreads();
                GRID_BARC(7);
            }
        } else {
            if (IN(pb + 11)) { PH_VARS
                for (int i = tid; i < 8192; i += 512) w8[i] = norm_ffn[D + (i >> 3)] * moe_router[i];
                LAS int* lcnt = (LAS int*)(lds + 40960); LAS int* lbase = lcnt + 8; LAS i32x4* lti = (LAS i32x4*)(lds + 41984);
                if (tid < 8) lcnt[tid] = 0;
                __syncthreads();
                { int it = 0;
                norm_rows(H, HN, T, gw, NGW, lane, [&](const int row, const float r, const f32x4 (&v)[4]) { float lg[8]; row_dot8(v, w8, lane, lg);
                    { unsigned* h8 = (unsigned*)(HN8 + (size_t)row * 1024) + lane;
#pragma unroll
                      for (int j = 0; j < 4; ++j) { int p8 = 0; p8 = __builtin_amdgcn_cvt_pk_fp8_f32(v[j].x * r, v[j].y * r, p8, false); p8 = __builtin_amdgcn_cvt_pk_fp8_f32(v[j].z * r, v[j].w * r, p8, true); h8[64 * j] = (unsigned)p8; } }
                    if (lane == 0) {
                        int i1 = 0; float v1 = lg[0];
#pragma unroll
                        for (int e = 1; e < 8; ++e) if (lg[e] > v1) { v1 = lg[e]; i1 = e; }
                        int i2 = 0; float v2 = -3.0e38f;
#pragma unroll
                        for (int e = 0; e < 8; ++e) if (e != i1 && lg[e] > v2) { v2 = lg[e]; i2 = e; }
                        const float w1 = 1.0f / (1.0f + expf(r * (v2 - v1))), w2 = 1.0f - w1;
                        const int r1 = __hip_atomic_fetch_add(lcnt + i1, 1, __ATOMIC_RELAXED, __HIP_MEMORY_SCOPE_WORKGROUP), r2 = __hip_atomic_fetch_add(lcnt + i2, 1, __ATOMIC_RELAXED, __HIP_MEMORY_SCOPE_WORKGROUP);
                        lti[wave * 32 + (it & 31)] = (i32x4){i1, i2, r1, r2}; TOPW[row] = (f32x2){w1, w2};
                    } ++it; }); }
                __syncthreads();
                if (tid < 8) lbase[tid] = atomicAdd(&CNT[tid], lcnt[tid]);
                __syncthreads();
                { int it = 0;
                for (int row = gw; row < T; row += NGW, ++it) if (lane == 0) { i32x4 ti = lti[wave * 32 + (it & 31)]; ti.z += lbase[ti.x]; ti.w += lbase[ti.y]; TOPI[row] = ti; } }
                __syncthreads();
                {
                    int rot = 0;
                    for (int e = 0; e < NE; ++e) {
                        CVT_LOOP8(16 * 112, 64.0f, 1024, MapW13 m{moe_w1 + (size_t)e * D * DFE, moe_w3 + (size_t)e * D * DFE, norm_ffn + D, (bf16*)((unsigned char*)W13E + (size_t)e * 2 * DFE * D), DFE, 2 * DFE});
                        CVT_LOOP8(56 * 16, 64.0f, DFE, MapPlain m{moe_w2 + (size_t)e * DFE * D, DFE, D, nullptr, 1.f, (bf16*)((unsigned char*)W2E + (size_t)e * D * DFE), DFE});
                    }
                }
                GRID_BARC(14);
            }
            int t1 = 0, t2 = 0, t3 = 0, t4 = 0, t5 = 0, t6 = 0, t7 = 0, ntiles = 0;
            if (lo <= pb + 14 && hi > pb + 12) {
                int acc = 0;
#pragma unroll
                for (int e = 0; e < 8; ++e) { const int c = __hip_atomic_load(&CNT[e], RLX_AGENT); acc += (c + 255) >> 8;
                    if (e == 0) t1 = acc; if (e == 1) t2 = acc; if (e == 2) t3 = acc; if (e == 3) t4 = acc; if (e == 4) t5 = acc; if (e == 5) t6 = acc; if (e == 6) t7 = acc; if (e == 7) ntiles = acc; }
            }
            if (IN(pb + 12)) { PH_VARS
                for (int row = gw; row < T; row += NGW) {
                    const i32x4 ti = TOPI[row];
                    const int e1 = ti.x, e2 = ti.y;
                    const int s1 = (e1 == 0 ? 0 : e1 == 1 ? t1 : e1 == 2 ? t2 : e1 == 3 ? t3 : e1 == 4 ? t4 : e1 == 5 ? t5 : e1 == 6 ? t6 : t7) * 256 + ti.z;
                    const int s2 = (e2 == 0 ? 0 : e2 == 1 ? t1 : e2 == 2 ? t2 : e2 == 3 ? t3 : e2 == 4 ? t4 : e2 == 5 ? t5 : e2 == 6 ? t6 : t7) * 256 + ti.w;
                    if (lane == 0) { SLOT[row] = (i32x2){s1, s2}; ROWOF[s1] = row; ROWOF[s2] = row; }
                }
                GRID_BARC(15);
            }
            if (IN(pb + 13)) { PH_VARS
                pg8::Gemm g{512, 512, 512}; pg8::MoeUpGather S; S.A = (const char*)HN8; S.B = (const char*)W13E; S.estride = (size_t)2 * DFE * D; S.lda = 512; S.ldb = 512; S.ntiles = ntiles; S.nN = 28; S.G = G; S.c = bx;
                S.t1 = t1; S.t2 = t2; S.t3 = t3; S.t4 = t4; S.t5 = t5; S.t6 = t6; S.t7 = t7;
                { LAS int* tab = (LAS int*)(lds + XCH_OFF); S.tab = tab;
                  for (int i = 0; i < 15; ++i) { pg8::Unit u; if (!S.next(i, u)) break; if (tid < 256) tab[i * 256 + tid] = ROWOF[u.pm * 256 + tid]; }
                  __syncthreads(); }
                pg8::EpiSwigluF8 E{(unsigned char*)ACTE, DFE, 1.0f / 64.0f, 2.0f};
                pg8::gemm_phase<pg8::EpiSwigluF8, pg8::MoeUpGather, false, true>(lds, g, S, E, wave_s);
                GRID_BARC(16);
            }
            if (IN(pb + 14)) { PH_VARS
                { pg8::Gemm g{DFE / 2, DFE / 2, DFE / 2}; pg8::MoeDownOrderF8 S; S.A = (const char*)ACTE; S.B = (const char*)W2E; S.estride = (size_t)D * DFE; S.lda = DFE / 2; S.ldb = DFE / 2; S.G = G; S.c = vcu;
                  S.t1 = t1; S.t2 = t2; S.t3 = t3; S.t4 = t4; S.t5 = t5; S.t6 = t6; S.t7 = t7;
                  pg8::EpiStoreS E{XS, 1024, 1.0f / 128.0f};
                  pg8::gemm_phase<pg8::EpiStoreS, pg8::MoeDownOrderF8, true, true>(lds, g, S, E, wave_s); }
                { pg8::Gemm g{DFE / 2, DFE / 2, 256}; pg8::MoeDownTailF8 S; S.A = (const char*)ACTE; S.B = (const char*)W2E; S.estride = (size_t)D * DFE; S.lda = DFE / 2; S.ldb = DFE / 2; S.ntiles = ntiles; S.G = G; S.c = vcu;
                  S.t1 = t1; S.t2 = t2; S.t3 = t3; S.t4 = t4; S.t5 = t5; S.t6 = t6; S.t7 = t7;
                  pg8::EpiPartF32S E{YPART, 1.0f / 128.0f};
                  pg8::gemm_phase<pg8::EpiPartF32S, pg8::MoeDownTailF8, true, true>(lds, g, S, E, wave_s); }
                GRID_BARC(17);
            }
            if (IN(pb + 15)) { PH_VARS
                const unsigned bad = __hip_atomic_load(ctl + CW_BAR + XB_TMO, RLX_AGENT);
                for (int row = gw; row < T; row += NGW) {
                    const i32x2 sl = SLOT[row]; const f32x2 tw = TOPW[row];
                    const f32x4* hr = (const f32x4*)(H + (size_t)row * D) + lane;
                    f32x4 v[4]; float ss = 0.f;
#pragma unroll
                    for (int j = 0; j < 4; ++j) v[j] = hr[64 * j];
#pragma unroll
                    for (int k = 0; k < 2; ++k) { const int s_ = k ? sl.y : sl.x; const float w_ = k ? tw.y : tw.x;
                        if (s_ < 32768) { const v2u* y = (const v2u*)(XS + (size_t)s_ * D) + lane;
#pragma unroll
                            for (int j = 0; j < 4; ++j) { const v2u a = y[64 * j]; v[j].x += w_ * bflo(a.x); v[j].y += w_ * bfhi(a.x); v[j].z += w_ * bflo(a.y); v[j].w += w_ * bfhi(a.y); } }
                        else { const f32x4* yp = (const f32x4*)(YPART + ((size_t)((s_ >> 8) - 128) * 7 * 256 + (s_ & 255)) * 1024) + lane;
                            for (int p7 = 0; p7 < 7; ++p7)
#pragma unroll
                                for (int j = 0; j < 4; ++j) v[j] += yp[(size_t)p7 * 256 * 256 + 64 * j] * w_; } }
#pragma unroll
                    for (int j = 0; j < 4; ++j) ss += (v[j].x * v[j].x + v[j].y * v[j].y) + (v[j].z * v[j].z + v[j].w * v[j].w);
                    float r = 1.0f / sqrtf(wave_sum(ss) * (1.0f / 1024.0f) + 1e-6f);
                    if (bad) r = __builtin_nanf("");
                    f32x4* orow = (f32x4*)(H + (size_t)row * D) + lane;
#pragma unroll
                    for (int j = 0; j < 4; ++j) { const f32x4 g4 = *((const f32x4*)norm_final + lane + 64 * j); orow[64 * j] = v[j] * r * g4; }
                }
            }
        }
        }
#ifdef MK_TPROBE
    if (IN(98)) { GRID_BAR(); PH_VARS
        const float tus = fmaxf((float)__hip_atomic_load(ctl + 20100, RLX_AGENT) * 0.01f, 1.0f);
        const float tp_v = __builtin_amdgcn_sqrtf(0.1f * __builtin_amdgcn_exp2f((1.0f / MK_TQ) * __builtin_rintf((float)MK_TQ * __builtin_amdgcn_logf(tus))));
        for (int i = gt; i < cf::T * cf::D / 4; i += NGT) ((f32x4*)H)[i] = (f32x4){tp_v, tp_v, tp_v, tp_v};
    }
#endif
#ifdef MK_DUMP
    if (IN(99)) { PH_VARS
        for (int row = gw; row < cf::T; row += NGW) {
#pragma unroll
            for (int j = 0; j < 16; ++j) { const int cc = lane + 64 * j; float v;
#if MK_DUMP == 1
                v = (cc < 512 ? bf1(HN[(size_t)row * 512 + cc]) : bf1(BR[(size_t)row * 2048 + cc])) + bf1(BR[(size_t)row * 2048 + cc + 1024]);
#elif MK_DUMP == 2
                v = bf1(PROJB[(size_t)row * cf::PJ + cc]) + bf1(PROJB[(size_t)row * cf::PJ + cc + 1024]) + bf1(PROJB[(size_t)row * cf::PJ + cc + 2048]) + bf1(PROJB[(size_t)row * cf::PJ + cc + 3072]) + bf1(GATE[(size_t)row * 4096 + cc]) + bf1(GATE[(size_t)row * 4096 + 3072 + cc]) + (cc < 768 ? bf1(PROJB[(size_t)row * cf::PJ + cc + 4096]) : 0.f);
#elif MK_DUMP == 5
                v = bf1(GATE[(size_t)row * 4096 + cc]) + bf1(GATE[(size_t)row * 4096 + 1024 + cc]) + bf1(GATE[(size_t)row * 4096 + 2048 + cc]) + bf1(GATE[(size_t)row * 4096 + 3072 + cc]);
#elif MK_DUMP == 7
                v = bf1(GATE[(size_t)row * 4096 + MK_GB * 1024 + cc]);
#elif MK_DUMP == 3
                v = bf1(BR[(size_t)row * 2048 + cc]) + bf1(BR[(size_t)row * 2048 + cc + 1024]);
#elif MK_DUMP == 4
                v = bf1(MERGED[(size_t)row * 1024 + cc]);
#endif
                H[(size_t)row * 1024 + cc] = v; }
        }
    }
#endif
#undef IN
#undef GRID_BAR
#undef ws
#undef ctl
#undef H
}

#undef PH_VARS
#undef ws
#undef ctl
#undef GRID_BAR
#undef IN
#undef x_
#undef mem_
#undef positions_
#undef norm_mix
#undef w_in
#undef b_gate
#undef w_branch
#undef w_out
#undef norm_xa
#undef norm_mem
#undef xa_wq
#undef xa_wk
#undef xa_wv
#undef xa_wo
#undef norm_ffn
#undef ffn_w1
#undef ffn_w3
#undef ffn_w2
#undef moe_router
#undef moe_w1
#undef moe_w3
#undef moe_w2
#undef norm_final
#undef H
#undef HN
#undef KVB
#undef COS
#undef SIN
#undef DT
#undef MNR
#undef PROJB
#undef GATE
#undef BR
#undef XBCC
#undef XLC
#undef MP
#undef MERGED
#undef XQ
#undef PB
#undef XO
#undef ACT
#undef W13E
#undef W2E
#undef XS
#undef ACTE
#undef YPART
#undef ROWOF
#undef HN8
#undef XS8
#undef HN8L1
#undef TOPI
#undef TOPW
#undef SLOT
#undef CNT
#undef W13
#undef W2T
#undef CVT_LOOP
#undef WLP
#undef WIN
#undef WGLU
#undef WB
#undef WOUT
#undef WQ
#undef WO
#undef KX
#undef VT
extern "C" void kernel_launch(void* const* d_in, const int* in_sizes, int n_in, void* d_out, int out_size, void* d_ws, size_t ws_size, hipStream_t stream) {
    static int grid = 0;
    if (grid == 0) {
        if (n_in != 46 || in_sizes[0] != cf::T * cf::D || out_size != cf::T * cf::D || ws_size < WS_NEED) { fprintf(stderr, "kernel_launch: unexpected shapes / workspace (n_in %d, in0 %d, out %d, ws %zu < %zu)\n", n_in, n_in > 0 ? in_sizes[0] : -1, out_size, ws_size, (size_t)WS_NEED); grid = -1; return; }
        int dev = 0, cus = 0, per_cu = 0;
        if (hipGetDevice(&dev) != hipSuccess || hipDeviceGetAttribute(&cus, hipDeviceAttributeMultiprocessorCount, dev) != hipSuccess) { grid = -1; return; }
        if (hipFuncSetAttribute((const void*)mega, hipFuncAttributeMaxDynamicSharedMemorySize, LDS_BYTES) != hipSuccess) { fprintf(stderr, "kernel_launch: hipFuncSetAttribute failed\n"); grid = -1; return; }
        if (hipOccupancyMaxActiveBlocksPerMultiprocessor(&per_cu, (const void*)mega, NWAVES * 64, LDS_BYTES) != hipSuccess || per_cu < 1) fprintf(stderr, "kernel_launch: occupancy query reports %d\n", per_cu);
        (void)hipGetLastError();
        grid = cus;
    }
    if (grid < 0) return;
    if (hipMemsetAsync((char*)d_ws + WS_CTL, 0, CTL_ZERO_BYTES, stream) != hipSuccess) return;
    Params a{};
    for (int i = 0; i < 46; ++i) a.in[i] = (const float*)d_in[i];
    a.out = (float*)d_out; a.ws = (unsigned char*)d_ws;
#ifdef MK_PER_PHASE
    for (int ph = 0; ph < MK_PER_PHASE; ++ph) { if (ph >= 16 && ph <= 20) continue; a.ph_lo = ph; a.ph_hi = ph + 1; hipLaunchKernelGGL(mega, dim3(grid), dim3(NWAVES * 64), LDS_BYTES, stream, a); }
#ifdef MK_DUMP
    a.ph_lo = 99; a.ph_hi = 100; hipLaunchKernelGGL(mega, dim3(grid), dim3(NWAVES * 64), LDS_BYTES, stream, a);
#endif
#elif defined(MK_SELFCHK)
    {
        using namespace nv;
        const float* x = (const float*)d_in[0]; char* wsb = (char*)d_ws;
        float* hn = (float*)wsb; float* PROJ = hn + (size_t)2048 * 1024; float* BRn = PROJ + (size_t)2048 * PW; float* TMP = BRn + (size_t)2048 * 2048; float* GLG = TMP + (size_t)2048 * 1024; float* MER = GLG + (size_t)2048 * 1024;
        float* ct = MER + (size_t)2048 * 1024; float* st = ct + (size_t)T * 32; float* hh = st + (size_t)T * 32;
        char* safe = wsb + (size_t)524 * 1048576; float* sBR = (float*)safe; float* sMER = sBR + (size_t)2048 * 2048; float* sH = sMER + (size_t)2048 * 1024; float* sPROJ = sH + (size_t)2048 * 1024; float* sGATE = sPROJ + (size_t)256 * PW; float* acc = sGATE + (size_t)256 * 4096;
        const float* Win = (const float*)d_in[4];
        hipLaunchKernelGGL(k_rope_tab, dim3((T * 32 + 255) / 256), dim3(256), 0, stream, (const int*)d_in[2], ct, st);
        hipLaunchKernelGGL(k_rmsnorm, dim3(2048 / 4), dim3(256), 0, stream, x, (const float*)d_in[3], hn, 2048);
        sgemm(stream, false, hn, D, Win, IN_TOTAL, PROJ, PW, 2048, PW, D);
        hipMemcpyAsync(sPROJ, PROJ, (size_t)256 * PW * 4, hipMemcpyDeviceToDevice, stream);
        hipLaunchKernelGGL(k_s5_scan, dim3(32), dim3(64), 0, stream, PROJ, BRn, (const float*)d_in[6], (const float*)d_in[7], (const float*)d_in[8], (const float*)d_in[9], (const float*)d_in[10], (const float*)d_in[11], (const float*)d_in[12], (const float*)d_in[13]);
        sgemm(stream, false, BRn, 2048, (const float*)d_in[14], 512, TMP, 512, 2048, 512, 512);
        hipLaunchKernelGGL(k_s5_gate, dim3((2048 * 512 + 255) / 256), dim3(256), 0, stream, BRn, TMP, 2048);
        hipLaunchKernelGGL(k_conv_inplace, dim3((768 + 255) / 256), dim3(256), 0, stream, PROJ, PW, OFF_XBC, 768, (const float*)d_in[15], (const float*)d_in[16], 1, 1);
        hipLaunchKernelGGL(k_ssd_scan, dim3(8), dim3(256), 0, stream, PROJ, BRn, (const float*)d_in[17], (const float*)d_in[18], (const float*)d_in[19]);
        hipLaunchKernelGGL(k_ssd_post, dim3(2048 / 4), dim3(256), 0, stream, BRn, PROJ, (const float*)d_in[20], 2048);
        hipLaunchKernelGGL(k_rope, dim3((2048 * 256 + 255) / 256), dim3(256), 0, stream, PROJ, ct, st, 0, 2048);
        hipLaunchKernelGGL(k_ret_scan, dim3(8), dim3(256), 0, stream, PROJ, BRn);
        hipLaunchKernelGGL(k_ret_post, dim3(2048 / 4), dim3(256), 0, stream, BRn, PROJ, (const float*)d_in[21], 2048);
        hipLaunchKernelGGL(k_conv_inplace, dim3((512 + 255) / 256), dim3(256), 0, stream, PROJ, PW, OFF_XL, 512, (const float*)d_in[22], (const float*)d_in[23], 0, 1);
        hipLaunchKernelGGL(k_lru_scan, dim3(8), dim3(64), 0, stream, PROJ, BRn, (const float*)d_in[24], (const float*)d_in[25], (const float*)d_in[26], (const float*)d_in[27], (const float*)d_in[28]);
        for (int k = 0; k < 4; ++k) {
            sgemm(stream, false, BRn + k * 512, 2048, (const float*)d_in[29] + (size_t)k * 512 * 1024, 1024, TMP, 1024, 2048, 1024, 512);
            sgemm(stream, false, hn, D, Win + OFF_GATE + k * 1024, IN_TOTAL, GLG, 1024, 2048, 1024, D);
            hipLaunchKernelGGL(k_dbg_gate, dim3((256 * 1024 + 255) / 256), dim3(256), 0, stream, sGATE + k * 1024, GLG, (const float*)d_in[5] + k * 1024);
            hipLaunchKernelGGL(k_gate_acc, dim3((2048 * 1024 + 255) / 256), dim3(256), 0, stream, MER, TMP, GLG, (const float*)d_in[5] + k * 1024, k == 0 ? 1 : 0, 2048);
        }
        hipMemcpyAsync(hh, x, (size_t)2048 * 1024 * 4, hipMemcpyDeviceToDevice, stream);
        sgemm(stream, true, MER, 1024, (const float*)d_in[30], D, hh, D, 2048, D, D);
        hipMemcpyAsync(sBR, BRn, (size_t)2048 * 2048 * 4, hipMemcpyDeviceToDevice, stream);
        hipMemcpyAsync(sMER, MER, (size_t)2048 * 1024 * 4, hipMemcpyDeviceToDevice, stream);
        hipMemcpyAsync(sH, hh, (size_t)2048 * 1024 * 4, hipMemcpyDeviceToDevice, stream);
        hipMemsetAsync((char*)d_ws + WS_CTL, 0, CTL_ZERO_BYTES, stream);
        a.ph_lo = 0; a.ph_hi = MK_SELFCHK;
        hipLaunchKernelGGL(mega, dim3(grid), dim3(NWAVES * 64), LDS_BYTES, stream, a);
        hipMemsetAsync(acc, 0, 256, stream);
        const unsigned short* PROJBp = (const unsigned short*)((char*)d_ws + R_PROJB); const unsigned short* GATEp = (const unsigned short*)((char*)d_ws + R_GATE); const unsigned short* BRp = (const unsigned short*)((char*)d_ws + R_BR); const unsigned short* MERp = (const unsigned short*)((char*)d_ws + R_MERGED);
        hipLaunchKernelGGL(k_dbg_cmp, dim3(256), dim3(256), 0, stream, sPROJ, PW, 0, (const void*)PROJBp, 4864, 0, 1, 256, 1792, acc + 0);
        hipLaunchKernelGGL(k_dbg_cmp, dim3(256), dim3(256), 0, stream, sPROJ, PW, 2824, (const void*)PROJBp, 4864, 2816, 1, 256, 1024, acc + 2);
        hipLaunchKernelGGL(k_dbg_cmp, dim3(256), dim3(256), 0, stream, sPROJ, PW, 3848, (const void*)PROJBp, 4864, 3840, 1, 256, 1024, acc + 4);
        for (int kk = 0; kk < 4; ++kk) hipLaunchKernelGGL(k_dbg_cmp, dim3(256), dim3(256), 0, stream, sGATE, 4096, kk * 1024, (const void*)GATEp, 4096, kk * 1024, 1, 256, 1024, acc + 6 + 2 * kk);
        if (MK_SELFCHK >= 5) for (int s = 0; s < 4; ++s) hipLaunchKernelGGL(k_dbg_cmp, dim3(256), dim3(256), 0, stream, sBR, 2048, s * 512, (const void*)BRp, 2048, s * 512, 1, 2048, 512, acc + 14 + 2 * s);
        if (MK_SELFCHK >= 6) hipLaunchKernelGGL(k_dbg_cmp, dim3(256), dim3(256), 0, stream, sMER, 1024, 0, (const void*)MERp, 1024, 0, 1, 2048, 1024, acc + 22);
        if (MK_SELFCHK >= 7) hipLaunchKernelGGL(k_dbg_cmp, dim3(256), dim3(256), 0, stream, sH, 1024, 0, (const void*)d_out, 1024, 0, 0, 2048, 1024, acc + 24);
        hipLaunchKernelGGL(k_dbg_report, dim3(1), dim3(1), 0, stream, acc, acc + 64);
        hipLaunchKernelGGL(k_dbg_fill, dim3(4096), dim3(256), 0, stream, (float*)d_out, acc + 64, (size_t)T * D);
        return;
    }
#elif defined(MK_HYBRID)
    a.ph_lo = 0; a.ph_hi = MK_HYBRID;
    hipLaunchKernelGGL(mega, dim3(grid), dim3(NWAVES * 64), LDS_BYTES, stream, a);
    nv::naive_from(MK_HYB_L, MK_HYB_S, d_in, d_out, d_ws, stream);
    return;
#else
    a.ph_lo = 0; a.ph_hi = 1000;
    hipLaunchKernelGGL(mega, dim3(grid), dim3(NWAVES * 64), LDS_BYTES, stream, a);
#endif
    const hipError_t le = hipPeekAtLastError();
    if (le != hipSuccess) fprintf(stderr, "kernel_launch: launch failed: %s\n", hipGetErrorName(le));
}
```

```cpp
#define MK_NMIXB 128
#define MK_GW0 768
#define MK_GW1 1024
#include <hip/hip_runtime.h>
#include <cstdio>
#include <cstdint>
#include <type_traits>
__device__ __forceinline__ int lane_id_fresh() { int l; asm volatile("v_mbcnt_lo_u32_b32 %0, -1, 0\n\tv_mbcnt_hi_u32_b32 %0, -1, %0" : "=v"(l)); return l; }
namespace pg8 {
#define PG8_LAS __attribute__((address_space(3)))
typedef unsigned short bf16_t;
typedef short bf16x8 __attribute__((ext_vector_type(8)));
typedef float f32x4 __attribute__((ext_vector_type(4)));
typedef float f32x2 __attribute__((ext_vector_type(2)));
typedef unsigned u32x4 __attribute__((ext_vector_type(4)));
typedef unsigned u32x2 __attribute__((ext_vector_type(2)));
constexpr int BM = 256, BK = 64, HALF = 128, HTB = HALF * BK * 2  , STAGE_BYTES = 8 * HTB, NXCD = 8, WGM = 8;
__host__ __device__ __forceinline__ int lds_byte(int r, int c) { const int st = (r >> 4) * 2 + (c >> 5), rr = r & 15, cc = c & 31, ob = rr * 64 + cc * 2; return st * 1024 + (ob ^ (((ob >> 9) & 1) << 5)); }
__host__ __device__ __forceinline__ void stage_rc(int b, int& R, int& C) { const int st = b / 1024, sb = b % 1024, swz = sb ^ (((sb >> 9) & 1) << 5); R = (st >> 1) * 16 + swz / 64; C = (st & 1) * 32 + (swz % 64) / 2; }
__host__ __device__ __forceinline__ int perm32(int rho) { const int n = rho >> 4, i = rho & 15; return 8 * (i >> 2) + 4 * n + (i & 3); }

struct Unit { int pm, pn, z; const char* a; const char* b; };
struct Gemm { int lda, ldb, K; };

__device__ __forceinline__ void tile_map(int L, int nM, int nN, int& pm, int& pn) {
    const int nwg = nM * nN; int wgid = L;
    { const int q = nwg / NXCD, r = nwg % NXCD, xcd = wgid % NXCD, off = wgid / NXCD; wgid = (xcd < r ? xcd * (q + 1) : r * (q + 1) + (xcd - r) * q) + off; }
    const int nig = WGM * nN, gid = wgid / nig, fm = gid * WGM, gsz = (nM - fm) < WGM ? (nM - fm) : WGM;
    pm = fm + ((wgid % nig) % gsz); pn = (wgid % nig) / gsz;
}
typedef __bf16 bf16x2_t __attribute__((ext_vector_type(2)));
typedef int i32x4_ __attribute__((ext_vector_type(4)));
typedef int i32x8_ __attribute__((ext_vector_type(8)));
__device__ __forceinline__ unsigned cvt_pk_bf16(float lo, float hi) { const f32x2 v = {lo, hi}; return __builtin_bit_cast(unsigned, __builtin_convertvector(v, bf16x2_t)); }
__device__ __forceinline__ float bf_lo(unsigned w) { return __uint_as_float(w << 16); }
__device__ __forceinline__ float bf_hi(unsigned w) { return __uint_as_float(w & 0xffff0000u); }
__device__ __forceinline__ float fast_sigmoid(float x) { return __builtin_amdgcn_rcpf(1.0f + __builtin_amdgcn_exp2f(-1.4426950408889634f * x)); }

struct NoHooks { static constexpr bool GATHER = false, F8 = false; __device__ __forceinline__ void a_ready(const Unit&) const {} __device__ __forceinline__ void done(const Unit&) const {} __device__ __forceinline__ int rowof(int, int) const { return 0; } };

typedef f32x4 AccT[2][2][4][2];
__device__ __forceinline__ u32x4 pack8(const f32x4 v0, const f32x4 v1) { u32x4 w; w.x = cvt_pk_bf16(v0[0], v0[1]); w.y = cvt_pk_bf16(v0[2], v0[3]); w.z = cvt_pk_bf16(v1[0], v1[1]); w.w = cvt_pk_bf16(v1[2], v1[3]); return w; }

struct EpiStore {
    static constexpr bool PERM = true, AFTER_DRAIN = false, KEEPS = false;
    bf16_t* O; int ldc;
    __device__ __forceinline__ void operator()(AccT& acc, const Unit& u, int wr, int wc, int fr, int fq) const {
        const int row0 = u.pm * BM + wr * 64 + fr, col0 = u.pn * BM + wc * 32 + 8 * fq;
#pragma unroll
        for (int ai = 0; ai < 2; ++ai)
#pragma unroll
            for (int m = 0; m < 4; ++m) { bf16_t* rowp = O + (size_t)(row0 + ai * HALF + m * 16) * ldc + col0;
#pragma unroll
                for (int bj = 0; bj < 2; ++bj) *(u32x4*)(rowp + bj * HALF) = pack8(acc[ai][bj][m][0], acc[ai][bj][m][1]); }
    }
};
struct EpiStoreS {
    static constexpr bool PERM = true, AFTER_DRAIN = false, KEEPS = false;
    bf16_t* O; int ldc; float sc;
    __device__ __forceinline__ void operator()(AccT& acc, const Unit& u, int wr, int wc, int fr, int fq) const {
        const int row0 = u.pm * BM + wr * 64 + fr, col0 = u.pn * BM + wc * 32 + 8 * fq;
#pragma unroll
        for (int ai = 0; ai < 2; ++ai)
#pragma unroll
            for (int m = 0; m < 4; ++m) { bf16_t* rowp = O + (size_t)(row0 + ai * HALF + m * 16) * ldc + col0;
#pragma unroll
                for (int bj = 0; bj < 2; ++bj) *(u32x4*)(rowp + bj * HALF) = pack8(acc[ai][bj][m][0] * sc, acc[ai][bj][m][1] * sc); }
    }
};
struct EpiKV {
    static constexpr bool PERM = true, AFTER_DRAIN = false, KEEPS = false;
    bf16_t* kvb;
    __device__ __forceinline__ void operator()(AccT& acc, const Unit& u, int wr, int wc, int fr, int fq) const {
        const int l = u.z >> 1, isv = u.z & 1;
        bf16_t* base = kvb + (size_t)l * 4194304 + (isv ? 2097152 : 0);
        const int ldc = 1024;
        const int row0 = u.pm * 256 + wr * 64 + fr, col0 = u.pn * 256 + wc * 32 + 8 * fq;
#pragma unroll
        for (int ai = 0; ai < 2; ++ai)
#pragma unroll
            for (int m = 0; m < 4; ++m) { bf16_t* rowp = base + (size_t)(row0 + ai * HALF + m * 16) * ldc + col0;
#pragma unroll
                for (int bj = 0; bj < 2; ++bj) *(u32x4*)(rowp + bj * HALF) = pack8(acc[ai][bj][m][0], acc[ai][bj][m][1]); }
    }
};
#ifdef MK_GATE_LOGIT
#define GATE_ACT(x) (x)
#else
#define GATE_ACT(x) fast_sigmoid(x)
#endif
struct EpiProj {
    static constexpr bool PERM = true, AFTER_DRAIN = false, KEEPS = false;
    bf16_t* projb; bf16_t* gate; const float* bgate; float sc;
    __device__ __forceinline__ void operator()(AccT& acc, const Unit& u, int wr, int wc, int fr, int fq) const {
        const int row0 = u.pm * BM + wr * 64 + fr;
        if (u.pn < 19) {
            const int col0 = u.pn * BM + wc * 32 + 8 * fq;
#pragma unroll
            for (int ai = 0; ai < 2; ++ai)
#pragma unroll
                for (int m = 0; m < 4; ++m) { bf16_t* rowp = projb + (size_t)(row0 + ai * HALF + m * 16) * 4864 + col0;
#pragma unroll
                    for (int bj = 0; bj < 2; ++bj) *(u32x4*)(rowp + bj * HALF) = pack8(acc[ai][bj][m][0] * sc, acc[ai][bj][m][1] * sc); }
        } else {
            const int col0 = (u.pn - 19) * BM + wc * 32 + 8 * fq;
            f32x4 bv[2][2];
#pragma unroll
            for (int bj = 0; bj < 2; ++bj)
#pragma unroll
                for (int n = 0; n < 2; ++n) bv[bj][n] = *(const f32x4*)(bgate + col0 + bj * HALF + 4 * n);
#pragma unroll
            for (int ai = 0; ai < 2; ++ai)
#pragma unroll
                for (int m = 0; m < 4; ++m) { bf16_t* rowp = gate + (size_t)(row0 + ai * HALF + m * 16) * 4096 + col0;
#pragma unroll
                    for (int bj = 0; bj < 2; ++bj) { f32x4 v0 = acc[ai][bj][m][0] * sc + bv[bj][0], v1 = acc[ai][bj][m][1] * sc + bv[bj][1];
#pragma unroll
                        for (int j = 0; j < 4; ++j) { v0[j] = GATE_ACT(v0[j]); v1[j] = GATE_ACT(v1[j]); }
                        *(u32x4*)(rowp + bj * HALF) = pack8(v0, v1); } }
        }
    }
};
struct EpiGlu {
    static constexpr bool PERM = true, AFTER_DRAIN = false, KEEPS = false;
    const bf16_t* ys; bf16_t* br;
    __device__ __forceinline__ void operator()(AccT& acc, const Unit& u, int wr, int wc, int fr, int fq) const {
        const int row0 = u.pm * BM + wr * 64 + fr, col0 = u.pn * BM + wc * 32 + 8 * fq;
#pragma unroll
        for (int ai = 0; ai < 2; ++ai)
#pragma unroll
            for (int m = 0; m < 4; ++m) { const size_t row = (size_t)(row0 + ai * HALF + m * 16);
#pragma unroll
                for (int bj = 0; bj < 2; ++bj) { const u32x4 yw = *(const u32x4*)(ys + row * 512 + col0 + bj * HALF);
                    f32x4 v0 = acc[ai][bj][m][0], v1 = acc[ai][bj][m][1];
                    v0[0] = bf_lo(yw.x) * fast_sigmoid(v0[0]); v0[1] = bf_hi(yw.x) * fast_sigmoid(v0[1]); v0[2] = bf_lo(yw.y) * fast_sigmoid(v0[2]); v0[3] = bf_hi(yw.y) * fast_sigmoid(v0[3]);
                    v1[0] = bf_lo(yw.z) * fast_sigmoid(v1[0]); v1[1] = bf_hi(yw.z) * fast_sigmoid(v1[1]); v1[2] = bf_lo(yw.w) * fast_sigmoid(v1[2]); v1[3] = bf_hi(yw.w) * fast_sigmoid(v1[3]);
                    *(u32x4*)(br + row * 2048 + col0 + bj * HALF) = pack8(v0, v1); } }
    }
};
struct EpiMerge {
    static constexpr bool PERM = true, AFTER_DRAIN = false, KEEPS = true;
    const bf16_t* gate; bf16_t* merged;
    __device__ __forceinline__ bool keep(const Unit& u) const { return u.z < 3; }
    __device__ __forceinline__ void operator()(AccT& acc, const Unit& u, int wr, int wc, int fr, int fq) const {
        const int row0 = u.pm * BM + wr * 64 + fr, col0 = u.pn * BM + wc * 32 + 8 * fq, k = u.z;
        if (k < 3) {
#pragma unroll
            for (int ai = 0; ai < 2; ++ai) { u32x4 gw[4][2], nw[4][2];
#pragma unroll
                for (int m = 0; m < 4; ++m)
#pragma unroll
                    for (int bj = 0; bj < 2; ++bj) { const bf16_t* gp = gate + (size_t)(row0 + ai * HALF + m * 16) * 4096 + k * 1024 + col0 + bj * HALF; gw[m][bj] = *(const u32x4*)gp; nw[m][bj] = *(const u32x4*)(gp + 1024); }
#pragma unroll
                for (int m = 0; m < 4; ++m)
#pragma unroll
                    for (int bj = 0; bj < 2; ++bj) { const u32x4 a = gw[m][bj], b = nw[m][bj];
                        const f32x4 g0 = (f32x4){bf_lo(a.x), bf_hi(a.x), bf_lo(a.y), bf_hi(a.y)}, g1 = (f32x4){bf_lo(a.z), bf_hi(a.z), bf_lo(a.w), bf_hi(a.w)};
                        const f32x4 n0 = (f32x4){bf_lo(b.x), bf_hi(b.x), bf_lo(b.y), bf_hi(b.y)}, n1 = (f32x4){bf_lo(b.z), bf_hi(b.z), bf_lo(b.w), bf_hi(b.w)};
                        f32x4 r0, r1;
#pragma unroll
                        for (int j = 0; j < 4; ++j) { r0[j] = fmaxf(g0[j], 1e-20f) * __builtin_amdgcn_rcpf(fmaxf(n0[j], 1e-20f)); r1[j] = fmaxf(g1[j], 1e-20f) * __builtin_amdgcn_rcpf(fmaxf(n1[j], 1e-20f)); }
                        acc[ai][bj][m][0] *= r0; acc[ai][bj][m][1] *= r1; }
                asm volatile("" ::: "memory"); }
        } else {
#pragma unroll
            for (int ai = 0; ai < 2; ++ai) { u32x4 gw[4][2];
#pragma unroll
                for (int m = 0; m < 4; ++m)
#pragma unroll
                    for (int bj = 0; bj < 2; ++bj) gw[m][bj] = *(const u32x4*)(gate + (size_t)(row0 + ai * HALF + m * 16) * 4096 + k * 1024 + col0 + bj * HALF);
#pragma unroll
                for (int m = 0; m < 4; ++m)
#pragma unroll
                    for (int bj = 0; bj < 2; ++bj) { const u32x4 a = gw[m][bj];
                        f32x4 g0 = (f32x4){bf_lo(a.x), bf_hi(a.x), bf_lo(a.y), bf_hi(a.y)}, g1 = (f32x4){bf_lo(a.z), bf_hi(a.z), bf_lo(a.w), bf_hi(a.w)};
#pragma unroll
                        for (int j = 0; j < 4; ++j) { g0[j] = fmaxf(g0[j], 1e-20f); g1[j] = fmaxf(g1[j], 1e-20f); }
                        *(u32x4*)(merged + (size_t)(row0 + ai * HALF + m * 16) * 1024 + col0 + bj * HALF) = pack8(acc[ai][bj][m][0] * g0, acc[ai][bj][m][1] * g1); }
                asm volatile("" ::: "memory"); }
        }
    }
};
struct EpiRes {
    static constexpr bool PERM = false, AFTER_DRAIN = false, KEEPS = false;
    const float* in; float* out;
    __device__ __forceinline__ void operator()(AccT& acc, const Unit& u, int wr, int wc, int fr, int fq) const {
        const int row0 = u.pm * BM + wr * 64 + fr, col0 = u.pn * BM + wc * 32 + 4 * fq;
#pragma unroll
        for (int ai = 0; ai < 2; ++ai)
#pragma unroll
            for (int m = 0; m < 4; ++m) { const size_t off = (size_t)(row0 + ai * HALF + m * 16) * 1024 + col0;
#pragma unroll
                for (int bj = 0; bj < 2; ++bj)
#pragma unroll
                    for (int n = 0; n < 2; ++n) { const f32x4 bs = *(const f32x4*)(in + off + bj * HALF + n * 16); *(f32x4*)(out + off + bj * HALF + n * 16) = bs + acc[ai][bj][m][n]; }
                if (m == 3) asm volatile("" ::: "memory"); }
    }
};
struct EpiSoftmax {
    static constexpr bool PERM = true, AFTER_DRAIN = true, KEEPS = false;
    bf16_t* P; PG8_LAS float* xch;
    __device__ __forceinline__ void fused(AccT& acc, const Unit& u, int wr, int wc, int fr, int fq, PG8_LAS unsigned char*, int, int) const {
        PG8_LAS float* RM = xch; PG8_LAS float* RS = xch + 1024;
#pragma unroll
        for (int ai = 0; ai < 2; ++ai)
#pragma unroll
            for (int m = 0; m < 4; ++m) { float mx = -3.0e38f;
#pragma unroll
                for (int bj = 0; bj < 2; ++bj)
#pragma unroll
                    for (int n = 0; n < 2; ++n) { const f32x4 x = acc[ai][bj][m][n]; mx = fmaxf(mx, fmaxf(fmaxf(x[0], x[1]), fmaxf(x[2], x[3]))); }
                mx = fmaxf(mx, __shfl_xor(mx, 16)); mx = fmaxf(mx, __shfl_xor(mx, 32));
                if (fq == 0) RM[(ai * HALF + wr * 64 + m * 16 + fr) * 4 + wc] = mx; }
        asm volatile("s_waitcnt lgkmcnt(0)" ::: "memory"); __builtin_amdgcn_s_barrier(); asm volatile("" ::: "memory");
#pragma unroll
        for (int ai = 0; ai < 2; ++ai)
#pragma unroll
            for (int m = 0; m < 4; ++m) { const int r = ai * HALF + wr * 64 + m * 16 + fr; const f32x4 q = *(const PG8_LAS f32x4*)(RM + r * 4);
                const float mx = fmaxf(fmaxf(q[0], q[1]), fmaxf(q[2], q[3])) * 1.4426950408889634f; float s = 0.f;
#pragma unroll
                for (int bj = 0; bj < 2; ++bj)
#pragma unroll
                    for (int n = 0; n < 2; ++n) { f32x4 x = acc[ai][bj][m][n];
#pragma unroll
                        for (int j = 0; j < 4; ++j) { x[j] = __builtin_amdgcn_exp2f(x[j] * 1.4426950408889634f - mx); s += x[j]; }
                        acc[ai][bj][m][n] = x; }
                s += __shfl_xor(s, 16); s += __shfl_xor(s, 32);
                if (fq == 0) RS[r * 4 + wc] = s; }
        asm volatile("s_waitcnt lgkmcnt(0)" ::: "memory"); __builtin_amdgcn_s_barrier(); asm volatile("" ::: "memory");
        const int row0 = u.pm * BM + wr * 64 + fr, col0 = u.pn * BM + wc * 32 + 8 * fq;
#pragma unroll
        for (int ai = 0; ai < 2; ++ai)
#pragma unroll
            for (int m = 0; m < 4; ++m) { const int r = ai * HALF + wr * 64 + m * 16 + fr; const f32x4 q = *(const PG8_LAS f32x4*)(RS + r * 4);
                const float inv = __builtin_amdgcn_rcpf((q[0] + q[1]) + (q[2] + q[3]));
                bf16_t* rowp = P + (size_t)(row0 + ai * HALF + m * 16) * 1024 + col0;
#pragma unroll
                for (int bj = 0; bj < 2; ++bj) *(u32x4*)(rowp + bj * HALF) = pack8(acc[ai][bj][m][0] * inv, acc[ai][bj][m][1] * inv); }
    }
};
struct EpiSwiglu {
    static constexpr bool PERM = true, AFTER_DRAIN = false, KEEPS = false;
    bf16_t* act; int ldc; float sc;
    __device__ __forceinline__ void operator()(AccT& acc, const Unit& u, int wr, int wc, int fr, int fq) const {
        const int row0 = u.pm * BM + wr * 64 + fr, col0 = u.pn * 128 + wc * 16 + 4 * fq;
#pragma unroll
        for (int ai = 0; ai < 2; ++ai)
#pragma unroll
            for (int m = 0; m < 4; ++m) { bf16_t* rowp = act + (size_t)(row0 + ai * HALF + m * 16) * ldc + col0;
#pragma unroll
                for (int bj = 0; bj < 2; ++bj) { const f32x4 a = acc[ai][bj][m][0] * sc, b = acc[ai][bj][m][1] * sc; f32x4 o;
#pragma unroll
                    for (int j = 0; j < 4; ++j) o[j] = a[j] * fast_sigmoid(a[j]) * b[j];
                    u32x2 w; w.x = cvt_pk_bf16(o[0], o[1]); w.y = cvt_pk_bf16(o[2], o[3]); *(u32x2*)(rowp + bj * 64) = w; } }
    }
};
struct EpiSwigluF8 {
    static constexpr bool PERM = true, AFTER_DRAIN = false, KEEPS = false;
    unsigned char* act; int ldc; float sc, so;
    __device__ __forceinline__ void operator()(AccT& acc, const Unit& u, int wr, int wc, int fr, int fq) const {
        const int row0 = u.pm * BM + wr * 64 + fr, col0 = u.pn * 128 + wc * 16 + 4 * fq;
#pragma unroll
        for (int ai = 0; ai < 2; ++ai)
#pragma unroll
            for (int m = 0; m < 4; ++m) { unsigned char* rowp = act + (size_t)(row0 + ai * HALF + m * 16) * ldc + col0;
#pragma unroll
                for (int bj = 0; bj < 2; ++bj) { const f32x4 a = acc[ai][bj][m][0] * sc, b = acc[ai][bj][m][1] * sc; f32x4 o;
#pragma unroll
                    for (int j = 0; j < 4; ++j) o[j] = a[j] * fast_sigmoid(a[j]) * b[j] * so;
                    int w = 0; w = __builtin_amdgcn_cvt_pk_fp8_f32(o[0], o[1], w, false); w = __builtin_amdgcn_cvt_pk_fp8_f32(o[2], o[3], w, true); *(unsigned*)(rowp + bj * 64) = (unsigned)w; } }
    }
};

struct PlainOrder : NoHooks {
    const char* A; const char* B; int nM, nN, lda, ldb, G, c;
    __device__ __forceinline__ bool next(int i, Unit& u) const { const int L = i * G + c; if (L >= nM * nN) return false; tile_map(L, nM, nN, u.pm, u.pn); u.z = 0;
        u.a = A + (size_t)u.pm * 256 * lda * 2; u.b = B + (size_t)u.pn * 256 * ldb * 2; return true; }
};
struct PlainOrderOff : NoHooks {
    const char* A; const char* B; int nM, nN, lda, ldb, G, c, pn0, L0, L1;
    __device__ __forceinline__ bool next(int i, Unit& u) const { const int L = L0 + i * G + c; if (L >= L1) return false; tile_map(L, nM, nN, u.pm, u.pn); u.pn += pn0; u.z = 0;
        u.a = A + (size_t)u.pm * 256 * lda * 2; u.b = B + (size_t)u.pn * 256 * ldb * 2; return true; }
};
struct PlainOrderOffF8 : NoHooks {   static constexpr bool F8 = true;
    const char* A; const char* B; int nM, nN, lda, ldb, G, c, pn0, L0, L1;
    __device__ __forceinline__ bool next(int i, Unit& u) const { const int L = L0 + i * G + c; if (L >= L1) return false; tile_map(L, nM, nN, u.pm, u.pn); u.pn += pn0; u.z = 0;
        u.a = A + (size_t)u.pm * 256 * lda * 2; u.b = B + (size_t)u.pn * 256 * ldb * 2; return true; }
};
struct MergeOrder : NoHooks {
    const char* br_; const char* wb_; int G, c;
    __device__ __forceinline__ bool next(int i, Unit& u) const { const int t = c + (i >> 2) * G; if (t >= 256) return false; const int k = i & 3; tile_map(t, 64, 4, u.pm, u.pn); u.z = k;
        u.a = br_ + ((size_t)u.pm * 256 * 2048 + k * 512) * 2; u.b = wb_ + ((size_t)u.pn * 256 * 2048 + k * 512) * 2; return true; }
};
struct KVOrder : NoHooks {
    const char* mnr_; const char* WKV0; const char* WKV1; int G, c;
    __device__ __forceinline__ bool next(int i, Unit& u) const { const int L = i * G + c; if (L >= 128) return false; const int kind = L >> 5, t = L & 31, isv = kind & 1;
        const char* W = (kind >> 1) ? WKV1 : WKV0; u.z = kind;
        if (!isv) { u.pm = t & 7; u.pn = t >> 3; u.a = mnr_ + (size_t)u.pm * 256 * 1024 * 2; u.b = W + (size_t)u.pn * 256 * 1024 * 2; }
        else { u.pm = t & 7; u.pn = t >> 3; u.a = mnr_ + (size_t)u.pm * 256 * 1024 * 2; u.b = W + (size_t)(1024 + u.pn * 256) * 1024 * 2; }
        return true; }
};
struct VWOOrder : NoHooks {
    const char* wo_; const char* v_; int G, c;
    __device__ __forceinline__ bool next(int i, Unit& u) const { if (c < 0) return false; const int L = i * G + c; if (L >= 128) return false; const int b = L >> 4, h = (L >> 2) & 3, nt = L & 3; u.pm = b * 4 + nt; u.pn = h; u.z = 0;
        u.a = wo_ + ((size_t)nt * 256 * 1024 + h * 256) * 2; u.b = v_ + ((size_t)b * 256 * 1024 + h * 256) * 2; return true; }
};
struct PVWOrder : NoHooks {
    const char* p_; const char* vwo_; int G, c;
    __device__ __forceinline__ bool next(int i, Unit& u) const { const int L = i * G + c; if (L >= 256) return false; tile_map(L, 64, 4, u.pm, u.pn); u.z = 0;
        u.a = p_ + (size_t)u.pm * 256 * 1024 * 2; u.b = vwo_ + ((size_t)(u.pm >> 3) * 1024 + u.pn * 256) * 1024 * 2; return true; }
};
struct QKWOrder : NoHooks {
    const char* kx_; const char* wqn_; int G, c;
    __device__ __forceinline__ bool next(int i, Unit& u) const { if (c < 0) return false; const int L = i * G + c; if (L >= 128) return false; const int bh = L >> 2; u.pm = bh; u.pn = L & 3; u.z = 0;
        u.a = kx_ + ((size_t)(bh >> 2) * 256 * 1024 + (bh & 3) * 256) * 2; u.b = wqn_ + ((size_t)u.pn * 256 * 1024 + (bh & 3) * 256) * 2; return true; }
};
struct ScoreOrder : NoHooks {
    const char* hn_; const char* qkw_; int G, c, base;
    __device__ __forceinline__ bool next(int i, Unit& u) const { const int L = base + c; if (i > 0 || L >= 256) return false; tile_map(L, 64, 4, u.pm, u.pn); u.z = 0;
        u.a = hn_ + (size_t)u.pm * 256 * 1024 * 2; u.b = qkw_ + (size_t)((u.pm >> 3) * 4 + u.pn) * 256 * 1024 * 2; return true; }
};
struct QKOrder : NoHooks {
    const char* xq_; const char* kx_; int G, c, base;
    __device__ __forceinline__ bool next(int i, Unit& u) const { const int L = base + c; if (i > 0 || L >= 256) return false; tile_map(L, 64, 4, u.pm, u.pn); u.z = 0;
        u.a = xq_ + ((size_t)u.pm * 256 * 1024 + u.pn * 256) * 2; u.b = kx_ + ((size_t)(u.pm >> 3) * 256 * 1024 + u.pn * 256) * 2; return true; }
};
struct PVOrder : NoHooks {
    const char* p_; const char* vt_; int G, c;
    __device__ __forceinline__ bool next(int i, Unit& u) const { const int L = i * G + c; if (L >= 256) return false; tile_map(L, 64, 4, u.pm, u.pn); u.z = 0;
        u.a = p_ + ((size_t)u.pm * 256 * 1024 + u.pn * 256) * 2; u.b = vt_ + ((size_t)(u.pm >> 3) * 1024 + u.pn * 256) * 256 * 2; return true; }
};
struct EpiPartF32 {
    static constexpr bool PERM = true, AFTER_DRAIN = false, KEEPS = false;
    float* P;
    __device__ __forceinline__ void operator()(AccT& acc, const Unit& u, int wr, int wc, int fr, int fq) const {
        const int row0 = u.z * BM + wr * 64 + fr, col0 = u.pn * BM + wc * 32 + 8 * fq;
#pragma unroll
        for (int ai = 0; ai < 2; ++ai)
#pragma unroll
            for (int m = 0; m < 4; ++m) { float* rowp = P + (size_t)(row0 + ai * HALF + m * 16) * 1024 + col0;
#pragma unroll
                for (int bj = 0; bj < 2; ++bj) { *(f32x4*)(rowp + bj * HALF) = acc[ai][bj][m][0]; *(f32x4*)(rowp + bj * HALF + 4) = acc[ai][bj][m][1]; } }
    }
};
struct EpiPartF32S {
    static constexpr bool PERM = true, AFTER_DRAIN = false, KEEPS = false;
    float* P; float sc;
    __device__ __forceinline__ void operator()(AccT& acc, const Unit& u, int wr, int wc, int fr, int fq) const {
        const int row0 = u.z * BM + wr * 64 + fr, col0 = u.pn * BM + wc * 32 + 8 * fq;
#pragma unroll
        for (int ai = 0; ai < 2; ++ai)
#pragma unroll
            for (int m = 0; m < 4; ++m) { float* rowp = P + (size_t)(row0 + ai * HALF + m * 16) * 1024 + col0;
#pragma unroll
                for (int bj = 0; bj < 2; ++bj) { *(f32x4*)(rowp + bj * HALF) = acc[ai][bj][m][0] * sc; *(f32x4*)(rowp + bj * HALF + 4) = acc[ai][bj][m][1] * sc; } }
    }
};
struct MoeUpGather : NoHooks {
    static constexpr bool GATHER = true, F8 = false;
    const char* A; const char* B; size_t estride; int lda, ldb, ntiles, nN, G, c; int t1, t2, t3, t4, t5, t6, t7; const PG8_LAS int* tab;
    __device__ __forceinline__ bool next(int i, Unit& u) const { const int L = i * G + c; if (L >= ntiles * nN) return false; tile_map(L, ntiles, nN, u.pm, u.pn);
        const int rt = u.pm; const int e = (rt >= t1) + (rt >= t2) + (rt >= t3) + (rt >= t4) + (rt >= t5) + (rt >= t6) + (rt >= t7); u.z = e;
        u.a = A; u.b = B + (size_t)e * estride + (size_t)u.pn * 256 * ldb * 2; return true; }
    __device__ __forceinline__ int rowof(int ord, int r) const { return tab[ord * 256 + r]; }
};
struct MoeUpF8 : NoHooks {
    static constexpr bool F8 = true;
    const char* A; const char* B; size_t estride; int lda, ldb, ntiles, nN, G, c; int t1, t2, t3, t4, t5, t6, t7;
    __device__ __forceinline__ bool next(int i, Unit& u) const { const int L = i * G + c; if (L >= ntiles * nN) return false; tile_map(L, ntiles, nN, u.pm, u.pn);
        const int rt = u.pm; const int e = (rt >= t1) + (rt >= t2) + (rt >= t3) + (rt >= t4) + (rt >= t5) + (rt >= t6) + (rt >= t7); u.z = e;
        u.a = A + (size_t)rt * 256 * lda * 2; u.b = B + (size_t)e * estride + (size_t)u.pn * 256 * ldb * 2; return true; }
};
struct MoeDownOrder : NoHooks {
    const char* A; const char* B; size_t estride; int lda, ldb, G, c; int t1, t2, t3, t4, t5, t6, t7;
    __device__ __forceinline__ bool next(int i, Unit& u) const { const int L = i * G + c; if (L >= 512) return false; u.pm = L >> 2; u.pn = L & 3;
        const int rt = u.pm; const int e = (rt >= t1) + (rt >= t2) + (rt >= t3) + (rt >= t4) + (rt >= t5) + (rt >= t6) + (rt >= t7); u.z = e;
        u.a = A + (size_t)rt * 256 * lda * 2; u.b = B + (size_t)e * estride + (size_t)u.pn * 256 * ldb * 2; return true; }
};
struct MoeDownOrderF8 : NoHooks {   static constexpr bool F8 = true;
    const char* A; const char* B; size_t estride; int lda, ldb, G, c; int t1, t2, t3, t4, t5, t6, t7;
    __device__ __forceinline__ bool next(int i, Unit& u) const { const int L = i * G + c; if (L >= 512) return false; u.pm = L >> 2; u.pn = L & 3;
        const int rt = u.pm; const int e = (rt >= t1) + (rt >= t2) + (rt >= t3) + (rt >= t4) + (rt >= t5) + (rt >= t6) + (rt >= t7); u.z = e;
        u.a = A + (size_t)rt * 256 * lda * 2; u.b = B + (size_t)e * estride + (size_t)u.pn * 256 * ldb * 2; return true; }
};
struct MoeDownTail : NoHooks {
    const char* A; const char* B; size_t estride; int lda, ldb, ntiles, G, c; int t1, t2, t3, t4, t5, t6, t7;
    __device__ __forceinline__ bool next(int i, Unit& u) const { const int v = i * G + c; if (v >= (ntiles - 128) * 28) return false; u.pn = v & 3; const int w = v >> 2, s = w % 7, jr = w / 7;
        const int rt = 128 + jr; u.pm = rt; const int e = (rt >= t1) + (rt >= t2) + (rt >= t3) + (rt >= t4) + (rt >= t5) + (rt >= t6) + (rt >= t7); u.z = jr * 7 + s;
        u.a = A + ((size_t)rt * 256 * lda + s * 512) * 2; u.b = B + (size_t)e * estride + ((size_t)u.pn * 256 * ldb + s * 512) * 2; return true; }
};
struct MoeDownTailF8 : NoHooks {   static constexpr bool F8 = true;
    const char* A; const char* B; size_t estride; int lda, ldb, ntiles, G, c; int t1, t2, t3, t4, t5, t6, t7;
    __device__ __forceinline__ bool next(int i, Unit& u) const { const int v = i * G + c; if (v >= (ntiles - 128) * 28) return false; u.pn = v & 3; const int w = v >> 2, s = w % 7, jr = w / 7;
        const int rt = 128 + jr; u.pm = rt; const int e = (rt >= t1) + (rt >= t2) + (rt >= t3) + (rt >= t4) + (rt >= t5) + (rt >= t6) + (rt >= t7); u.z = jr * 7 + s;
        u.a = A + ((size_t)rt * 256 * lda + s * 256) * 2; u.b = B + (size_t)e * estride + ((size_t)u.pn * 256 * ldb + s * 256) * 2; return true; }
};
struct MoeOrder : NoHooks {
    const char* A; const char* B; size_t estride; int lda, ldb, ntiles, nN, G, c; int t1, t2, t3, t4, t5, t6, t7;
    __device__ __forceinline__ bool next(int i, Unit& u) const { const int L = i * G + c; if (L >= ntiles * nN) return false; tile_map(L, ntiles, nN, u.pm, u.pn);
        const int rt = u.pm; const int e = (rt >= t1) + (rt >= t2) + (rt >= t3) + (rt >= t4) + (rt >= t5) + (rt >= t6) + (rt >= t7); u.z = e;
        u.a = A + (size_t)rt * 256 * lda * 2; u.b = B + (size_t)e * estride + (size_t)u.pn * 256 * ldb * 2; return true; }
};

template <class Epi, class Sched, bool ALIGN_EPI = false, bool SP2 = false>
__device__ __forceinline__ void gemm_phase(PG8_LAS unsigned char* lds, const Gemm g, const Sched& S, const Epi& E, const int wave_s) {
    int tid_ = wave_s * 64 + lane_id_fresh(); asm volatile("" : "+v"(tid_));
    const int tid = tid_, wid = __builtin_amdgcn_readfirstlane(tid >> 6), lane = tid & 63, wr = wid >> 2, wc = wid & 3, fr = lane & 15, fq = lane >> 4;
    const int K = g.K, nt = K / BK;
    unsigned voffA[2], voffB[2];
#pragma unroll
    for (int i = 0; i < 2; ++i) { int R, C; stage_rc(tid * 16 + i * 8192, R, C); const int Rb = Epi::PERM ? ((R & ~31) + perm32(R & 31)) : R;
        voffA[i] = (unsigned)(R * g.lda + C) * 2u; voffB[i] = (unsigned)(Rb * g.ldb + C) * 2u; }
    const size_t kstep = (size_t)(BK * 2);
    const size_t hstepA = (size_t)HALF * g.lda * 2, hstepB = (size_t)HALF * g.ldb * 2;
    const unsigned ldsw = (unsigned)wid * 1024u;
    const int aoff = lds_byte(wr * 64 + fr, fq * 8), boff = lds_byte(wc * 32 + fr, fq * 8);
#define PG8_SA(b, h) (((b) * 2 + (h)) * HTB)
#define PG8_SB(b, h) ((4 + (b) * 2 + (h)) * HTB)
#define PG8_UBASE(gbase) ([&]() -> const char* { if constexpr (Sched::F8) { const unsigned long long p_ = (unsigned long long)(gbase); \
        return (const char*)(((unsigned long long)(unsigned)__builtin_amdgcn_readfirstlane((int)(unsigned)(p_ >> 32)) << 32) | (unsigned long long)(unsigned)__builtin_amdgcn_readfirstlane((int)(unsigned)p_)); } else { return (const char*)(gbase); } }())
#define PG8_STAGE(bufoff, gbase, voff) do { const char* gb_ = PG8_UBASE(gbase); _Pragma("unroll") for (int _i = 0; _i < 2; ++_i) \
        __builtin_amdgcn_global_load_lds((const unsigned*)(gb_ + (voff)[_i]), (PG8_LAS unsigned*)(lds + (bufoff) + ldsw + _i * 8192), 16, 0, 0); } while (0)
#define PG8_LDA(dst, b, h) do { if constexpr (Sched::F8) { _Pragma("unroll") for (int m = 0; m < 4; ++m) dst##8[m] = PG8_CAT8(*(const PG8_LAS bf16x8*)(lds + PG8_SA(b, h) + aoff + m * 2048), *(const PG8_LAS bf16x8*)(lds + PG8_SA(b, h) + aoff + m * 2048 + 1024)); } \
    else { _Pragma("unroll") for (int m = 0; m < 4; ++m) _Pragma("unroll") for (int k = 0; k < 2; ++k) dst[m][k] = *(const PG8_LAS bf16x8*)(lds + PG8_SA(b, h) + aoff + m * 2048 + k * 1024); } } while (0)
#define PG8_LDB(dst, b, h) do { if constexpr (Sched::F8) { _Pragma("unroll") for (int n = 0; n < 2; ++n) dst##8[n] = PG8_CAT8(*(const PG8_LAS bf16x8*)(lds + PG8_SB(b, h) + boff + n * 2048), *(const PG8_LAS bf16x8*)(lds + PG8_SB(b, h) + boff + n * 2048 + 1024)); } \
    else { _Pragma("unroll") for (int n = 0; n < 2; ++n) _Pragma("unroll") for (int k = 0; k < 2; ++k) dst[n][k] = *(const PG8_LAS bf16x8*)(lds + PG8_SB(b, h) + boff + n * 2048 + k * 1024); } } while (0)
#define PG8_CAT8(x0, x1) __builtin_shufflevector(__builtin_bit_cast(i32x4_, (x0)), __builtin_bit_cast(i32x4_, (x1)), 0, 1, 2, 3, 4, 5, 6, 7)
#define PG8_MMA(ai, bj, At, Bt) do { __builtin_amdgcn_s_setprio(1); if constexpr (Sched::F8) { _Pragma("unroll") for (int m = 0; m < 4; ++m) _Pragma("unroll") for (int n = 0; n < 2; ++n) \
        asm volatile("v_mfma_scale_f32_16x16x128_f8f6f4 %0, %1, %2, %0, %3, %3 op_sel_hi:[0,0,0]" : "+v"(acc[ai][bj][m][n]) : "v"(Bt##8[n]), "v"(At##8[m]), "v"(sc7f_)); }     \
      else { _Pragma("unroll") for (int m = 0; m < 4; ++m) _Pragma("unroll") for (int n = 0; n < 2; ++n) _Pragma("unroll") for (int k = 0; k < 2; ++k) \
        acc[ai][bj][m][n] = __builtin_amdgcn_mfma_f32_16x16x32_bf16(Bt[n][k], At[m][k], acc[ai][bj][m][n], 0, 0, 0); } __builtin_amdgcn_s_setprio(0); } while (0)
#define PG8_WAIT_V(n) asm volatile("s_waitcnt vmcnt(" #n ")" ::: "memory")
#define PG8_WAIT_L(n) asm volatile("s_waitcnt lgkmcnt(" #n ")" ::: "memory")
#define PG8_BAR __builtin_amdgcn_s_barrier()
#define PG8_SCHED __builtin_amdgcn_sched_barrier(0)
    Unit cur, nxt; int ui = 0;
    if (!S.next(0, cur)) return;
    static_assert(!Sched::GATHER || SP2, "row-gathered A staging is written for the SP2 schedule only");
    unsigned vgc[2][2] = {{0u, 0u}, {0u, 0u}}, vgn[2][2] = {{0u, 0u}, {0u, 0u}}, vgs[2][2] = {{0u, 0u}, {0u, 0u}};
#define PG8_GLOAD(vg, ord) do { _Pragma("unroll") for (int h_ = 0; h_ < 2; ++h_) _Pragma("unroll") for (int i_ = 0; i_ < 2; ++i_) { int R_, C_; stage_rc(tid * 16 + i_ * 8192, R_, C_); \
        vg[h_][i_] = (unsigned)(S.rowof((ord), h_ * HALF + R_) * g.lda + C_) * 2u; } } while (0)
#define PG8_STAGE_A(b, h, base, vg) do { if constexpr (Sched::GATHER) { PG8_STAGE(PG8_SA(b, h), (base), vg[h]); } else { PG8_STAGE(PG8_SA(b, h), (base) + (h) * hstepA, voffA); } } while (0)
    if constexpr (Sched::GATHER) PG8_GLOAD(vgc, 0);
    f32x4 acc[2][2][4][2];
#pragma unroll
    for (int a = 0; a < 2; ++a)
#pragma unroll
        for (int b = 0; b < 2; ++b)
#pragma unroll
            for (int m = 0; m < 4; ++m)
#pragma unroll
                for (int n = 0; n < 2; ++n) acc[a][b][m][n] = (f32x4){0.f, 0.f, 0.f, 0.f};
    bf16x8 At[4][2], B0[2][2], B1[2][2];
    int sc7f_ = 0x7F7F7F7F; asm volatile("" : "+v"(sc7f_));
    i32x8_ At8[4], B08[2], B18[2];
    const char* cA = cur.a; const char* cB = cur.b;
    S.a_ready(cur);
    if constexpr (SP2) {
        PG8_STAGE(PG8_SB(0, 0), cB, voffB); PG8_STAGE(PG8_SB(0, 1), cB + hstepB, voffB); PG8_STAGE_A(0, 0, cA, vgc); PG8_STAGE_A(0, 1, cA, vgc);
        if (wr == 1) PG8_BAR;
        PG8_WAIT_V(2); PG8_BAR;
        PG8_STAGE(PG8_SB(1, 0), cB + kstep, voffB); PG8_STAGE_A(1, 0, cA + kstep, vgc); PG8_STAGE(PG8_SB(1, 1), cB + hstepB + kstep, voffB);
        PG8_WAIT_V(6); PG8_BAR;
    } else {
        PG8_STAGE(PG8_SB(0, 0), cB, voffB); PG8_STAGE(PG8_SA(0, 0), cA, voffA); PG8_STAGE(PG8_SB(0, 1), cB + hstepB, voffB); PG8_STAGE(PG8_SA(0, 1), cA + hstepA, voffA);
        if (wr == 1) PG8_BAR;
        PG8_WAIT_V(4); PG8_BAR;
        PG8_STAGE(PG8_SB(1, 0), cB + kstep, voffB); PG8_STAGE(PG8_SA(1, 0), cA + kstep, voffA); PG8_STAGE(PG8_SB(1, 1), cB + hstepB + kstep, voffB);
        PG8_WAIT_V(6); PG8_BAR;
    }
    for (;;) {
        const bool has_next = S.next(ui + 1, nxt);
        if constexpr (Sched::GATHER) { if (has_next) PG8_GLOAD(vgn, ui + 1); }
        const char* nA = has_next ? nxt.a : cA; const char* nB = has_next ? nxt.b : cB;
#pragma nounroll
        for (int t = 0; t < nt; t += 2) {
            const bool last = (t == nt - 2);
            const char* a1 = cA + (size_t)(t + 1) * kstep;
            const char* a2 = last ? nA : cA + (size_t)(t + 2) * kstep; const char* b2 = last ? nB : cB + (size_t)(t + 2) * kstep;
            const char* a3 = a2 + kstep; const char* b3 = b2 + kstep;
            if (last && has_next) S.a_ready(nxt);
            if constexpr (Sched::GATHER) { const bool nx_ = last && has_next; _Pragma("unroll") for (int h_ = 0; h_ < 2; ++h_) _Pragma("unroll") for (int i_ = 0; i_ < 2; ++i_) vgs[h_][i_] = nx_ ? vgn[h_][i_] : vgc[h_][i_]; }
            if constexpr (SP2) {
            PG8_LDB(B0, 0, 0); PG8_LDB(B1, 0, 1); PG8_SCHED; PG8_LDA(At, 0, 0); PG8_STAGE_A(1, 1, a1, vgc);
            PG8_WAIT_V(8); PG8_WAIT_L(0); PG8_BAR; PG8_MMA(0, 0, At, B0); PG8_MMA(0, 1, At, B1); PG8_BAR; PG8_SCHED;
            PG8_LDA(At, 0, 1); PG8_STAGE(PG8_SB(0, 0), b2, voffB); PG8_STAGE(PG8_SB(0, 1), b2 + hstepB, voffB); PG8_STAGE_A(0, 0, a2, vgs);
            PG8_WAIT_V(8); PG8_WAIT_L(0); PG8_BAR; PG8_MMA(1, 0, At, B0); PG8_MMA(1, 1, At, B1); PG8_BAR; PG8_SCHED;
            PG8_LDB(B0, 1, 0); PG8_LDB(B1, 1, 1); PG8_SCHED; PG8_LDA(At, 1, 0); PG8_STAGE_A(0, 1, a2, vgs);
            PG8_WAIT_V(8); PG8_WAIT_L(0); PG8_BAR; PG8_MMA(0, 0, At, B0); PG8_MMA(0, 1, At, B1); PG8_BAR; PG8_SCHED;
            PG8_LDA(At, 1, 1); PG8_STAGE(PG8_SB(1, 0), b3, voffB); PG8_STAGE(PG8_SB(1, 1), b3 + hstepB, voffB); PG8_STAGE_A(1, 0, a3, vgs);
            PG8_WAIT_V(8); PG8_WAIT_L(0); PG8_BAR; PG8_MMA(1, 0, At, B0); PG8_MMA(1, 1, At, B1); PG8_BAR; PG8_SCHED;
            } else {
            PG8_LDB(B0, 0, 0); PG8_SCHED; PG8_LDA(At, 0, 0); PG8_STAGE(PG8_SA(1, 1), a1 + hstepA, voffA);
            PG8_WAIT_L(8); PG8_BAR; PG8_WAIT_L(0); PG8_MMA(0, 0, At, B0); PG8_BAR; PG8_SCHED;
            PG8_LDB(B1, 0, 1); PG8_STAGE(PG8_SB(0, 0), b2, voffB);
            PG8_BAR; PG8_WAIT_L(0); PG8_MMA(0, 1, At, B1); PG8_BAR;
            PG8_LDA(At, 0, 1); PG8_STAGE(PG8_SA(0, 0), a2, voffA);
            PG8_BAR; PG8_WAIT_L(0); PG8_MMA(1, 0, At, B0); PG8_BAR; PG8_SCHED;
            PG8_STAGE(PG8_SB(0, 1), b2 + hstepB, voffB);
            PG8_WAIT_V(6); PG8_BAR; PG8_MMA(1, 1, At, B1); PG8_BAR;
            PG8_LDB(B0, 1, 0); PG8_SCHED; PG8_LDA(At, 1, 0); PG8_STAGE(PG8_SA(0, 1), a2 + hstepA, voffA);
            PG8_WAIT_L(8); PG8_BAR; PG8_WAIT_L(0); PG8_MMA(0, 0, At, B0); PG8_BAR; PG8_SCHED;
            PG8_LDB(B1, 1, 1); PG8_STAGE(PG8_SB(1, 0), b3, voffB);
            PG8_BAR; PG8_WAIT_L(0); PG8_MMA(0, 1, At, B1); PG8_BAR;
            PG8_LDA(At, 1, 1); PG8_STAGE(PG8_SA(1, 0), a3, voffA);
            PG8_BAR; PG8_WAIT_L(0); PG8_MMA(1, 0, At, B0); PG8_BAR; PG8_SCHED;
            PG8_STAGE(PG8_SB(1, 1), b3 + hstepB, voffB);
            PG8_WAIT_V(6); PG8_BAR; PG8_MMA(1, 1, At, B1); PG8_BAR;
            }
        }
        if constexpr (Sched::F8) asm volatile("s_nop 15\n\ts_nop 7" ::: "memory");
        if constexpr (ALIGN_EPI) { if (wr == 0) PG8_BAR; }
        if constexpr (!Epi::AFTER_DRAIN) { const int l2_ = lane_id_fresh(); E(acc, cur, wr, wc, l2_ & 15, l2_ >> 4); S.done(cur); }
        if (!has_next) break;
        bool zero_acc = true; if constexpr (Epi::KEEPS) zero_acc = !E.keep(cur);
        if (zero_acc) {
#pragma unroll
        for (int a = 0; a < 2; ++a)
#pragma unroll
            for (int b = 0; b < 2; ++b)
#pragma unroll
                for (int m = 0; m < 4; ++m)
#pragma unroll
                    for (int n = 0; n < 2; ++n) acc[a][b][m][n] = (f32x4){0.f, 0.f, 0.f, 0.f};
        }
        cur = nxt; cA = nA; cB = nB; ++ui;
        if constexpr (Sched::GATHER) { _Pragma("unroll") for (int h_ = 0; h_ < 2; ++h_) _Pragma("unroll") for (int i_ = 0; i_ < 2; ++i_) vgc[h_][i_] = vgn[h_][i_]; }
        if constexpr (ALIGN_EPI) { if (wr == 1) PG8_BAR; }
    }
    PG8_WAIT_V(0);
    if constexpr (!ALIGN_EPI) { if (wr == 0) PG8_BAR; }
    PG8_BAR;
    if constexpr (Epi::AFTER_DRAIN) { const int l3_ = lane_id_fresh(); E.fused(acc, cur, wr, wc, l3_ & 15, l3_ >> 4, lds, wid, l3_); S.done(cur); }
#undef PG8_SA
#undef PG8_SB
#undef PG8_STAGE
#undef PG8_UBASE
#undef PG8_STAGE_A
#undef PG8_GLOAD
#undef PG8_LDA
#undef PG8_LDB
#undef PG8_MMA
#undef PG8_CAT8
#undef PG8_WAIT_V
#undef PG8_WAIT_L
#undef PG8_BAR
#undef PG8_SCHED
}
}

#define GAS __attribute__((address_space(1)))
#define LAS __attribute__((address_space(3)))
typedef unsigned short bf16;
typedef unsigned v4u __attribute__((ext_vector_type(4)));
typedef short bf16x8 __attribute__((ext_vector_type(8)));
typedef unsigned v2u __attribute__((ext_vector_type(2)));
typedef float f32x4 __attribute__((ext_vector_type(4)));
typedef float f32x2 __attribute__((ext_vector_type(2)));
typedef int i32x4 __attribute__((ext_vector_type(4)));
typedef int i32x2 __attribute__((ext_vector_type(2)));
#define RLX_AGENT __ATOMIC_RELAXED, __HIP_MEMORY_SCOPE_AGENT
#define LDS_WAIT() asm volatile("s_waitcnt lgkmcnt(0)" ::: "memory")
#define VM_WAIT() asm volatile("s_waitcnt vmcnt(0)" ::: "memory")
__device__ __forceinline__ unsigned f2bf(float f) { unsigned u = __builtin_bit_cast(unsigned, f); return (u + 0x7fffu + ((u >> 16) & 1u)) >> 16; }
__device__ __forceinline__ unsigned pk2(float lo, float hi) { return f2bf(lo) | (f2bf(hi) << 16); }
__device__ __forceinline__ float bflo(unsigned w) { return __uint_as_float(w << 16); }
__device__ __forceinline__ float bfhi(unsigned w) { return __uint_as_float(w & 0xffff0000u); }
__device__ __forceinline__ float bf1(bf16 v) { return __uint_as_float((unsigned)v << 16); }

#define XB_TMO      128
#define XB_XCNT(j)  (256  + 64 * (j))
#define XB_XSUB(j)  (1280 + 64 * (j))
#define XB_XGEN(j)  (2304 + 64 * (j))
#define XB_TOP      3328
#define XB_TOPGEN   3392
#define XCD_BAR_WORDS 3456
#define XB_SPIN_CAP (1u << 18)

__device__ __forceinline__ unsigned xb_ld(unsigned* p)              { return __hip_atomic_load(p, __ATOMIC_RELAXED, __HIP_MEMORY_SCOPE_AGENT); }
__device__ __forceinline__ unsigned xb_add(unsigned* p, unsigned v) { return __hip_atomic_fetch_add(p, v, __ATOMIC_RELAXED, __HIP_MEMORY_SCOPE_AGENT); }
__device__ __forceinline__ unsigned xb_xcc_id() { return (unsigned)__builtin_amdgcn_s_getreg((3 << 11) | 20) & 0xFu; }
#define XB_SPIN(cond, bar) do { unsigned _sp = 0; while (cond) { __builtin_amdgcn_s_sleep(1); \
    if ((++_sp & 255u) == 0u) { if (xb_ld(&(bar)[XB_TMO])) break; if (_sp > XB_SPIN_CAP) { atomicAdd(&(bar)[XB_TMO], 1u); break; } } } } while (0)

struct XcdBarrier {
    unsigned* bar; unsigned x;
    volatile LAS unsigned* st;
};

__device__ __forceinline__ XcdBarrier xcd_barrier_post(unsigned* bar, volatile LAS unsigned* st, const int wave_s) {
    XcdBarrier b; b.bar = bar; b.x = xb_xcc_id(); b.st = st;
    if (wave_s == 0 && lane_id_fresh() == 0) (void)xb_add(&bar[XB_XCNT(b.x)], 1u);
    return b;
}
__device__ __forceinline__ void xcd_barrier_complete(unsigned* bar, unsigned x, unsigned& nloc, unsigned& nx) {
    const unsigned G = gridDim.x * gridDim.y * gridDim.z;
    unsigned sum, cnt, mine, sp = 0u;
    for (;;) {
        sum = 0u; cnt = 0u; mine = 0u;
#pragma unroll
        for (unsigned j = 0; j < 16; ++j) { const unsigned c = xb_ld(&bar[XB_XCNT(j)]); sum += c; cnt += (c > 0u) ? 1u : 0u; mine = (j == x) ? c : mine; }
        if (sum == G) break;
        __builtin_amdgcn_s_sleep(1);
        if ((++sp & 255u) == 0u) { if (xb_ld(&bar[XB_TMO])) break; if (sp > XB_SPIN_CAP) { atomicAdd(&bar[XB_TMO], 1u); break; } }
    }
    nloc = mine > 0u ? mine : 1u; nx = cnt > 0u ? cnt : 1u;
}

__device__ __forceinline__ void xcd_barrier(const XcdBarrier& b, const int wave_s) {
    asm volatile("s_waitcnt vmcnt(0)" ::: "memory");
    __syncthreads();
    if (wave_s == 0 && lane_id_fresh() == 0) {
        unsigned* bar = b.bar;
        __builtin_amdgcn_s_waitcnt(0);
        unsigned nloc = b.st[0], nx = b.st[1];
        if (nloc == 0u) { xcd_barrier_complete(bar, b.x, nloc, nx); b.st[0] = nloc; b.st[1] = nx; }
        const unsigned old = xb_add(&bar[XB_XSUB(b.x)], 1u);
        const unsigned gen = old / nloc;
        if (old + 1u == (gen + 1u) * nloc) {
            __builtin_amdgcn_fence(__ATOMIC_RELEASE, "agent");
            asm volatile("s_waitcnt vmcnt(0)" ::: "memory");
            const unsigned og = xb_add(&bar[XB_TOP], 1u);
            const unsigned tg = og / nx;
            if (og + 1u == (tg + 1u) * nx) xb_add(&bar[XB_TOPGEN], 1u);
            else XB_SPIN(xb_ld(&bar[XB_TOPGEN]) == tg, bar);
            __builtin_amdgcn_fence(__ATOMIC_ACQUIRE, "agent");
            xb_add(&bar[XB_XGEN(b.x)], 1u);
            asm volatile("s_waitcnt vmcnt(0)" ::: "memory");
        } else {
            XB_SPIN(xb_ld(&bar[XB_XGEN(b.x)]) == gen, bar);
            __builtin_amdgcn_fence(__ATOMIC_ACQUIRE, "agent");
            asm volatile("s_waitcnt vmcnt(0)" ::: "memory");
        }
    }
    __syncthreads();
}

constexpr int NWAVES = 8;
#ifndef MK_TAIL0
#define MK_TAIL0 0
#endif
#ifndef MK_TAIL1
#define MK_TAIL1 0
#endif
#ifndef MK_GW0
#define MK_GW0 1024
#endif
#ifndef MK_GW1
#define MK_GW1 1024
#endif
#ifndef MK_NMIXB
#define MK_NMIXB 96
#endif
namespace cf {
constexpr int D = 1024, NB = 8, L = 2048, T = NB * L, NMEM = 256, TM = NB * NMEM, IN_TOTAL = 8968, DFF = 2816, DFE = 3584, NE = 8;
constexpr int PJ = 4864;
constexpr int C_U = 0, C_Z = 512, C_XBC = 1024, C_Q = 1792, C_K = 2304, C_V = 2816, C_G = 3328, C_XL = 3840, C_GL = 4352;
constexpr int O_DT = 1792, O_GATE = 4872;
constexpr int MAXSLOT = 34816;
}
constexpr size_t MiB = 1u << 20;
constexpr size_t WS_CTL = 0, CTL_ZERO_BYTES = 1 * MiB;
constexpr size_t WS_TOPI = 1 * MiB, WS_TOPW = WS_TOPI + 256 * 1024, WS_SLOT = WS_TOPW + 128 * 1024;
constexpr size_t WS_HN = 2 * MiB, WS_KV = 34 * MiB, WS_TAB = 50 * MiB, WS_DT = 54 * MiB, WS_MNR = 55 * MiB, WS_W = 59 * MiB;
constexpr size_t WL_STRIDE = 32 * MiB, WL_WIN = 0, WL_GLU = 17 * MiB + 512 * 1024, WL_WB = 18 * MiB, WL_WOUT = 22 * MiB, WL_WQ = 24 * MiB, WL_WKV = 26 * MiB, WL_WO = 30 * MiB;
constexpr size_t WS_W13 = 123 * MiB, WS_W2 = 134 * MiB, WS_R = 140 * MiB;
constexpr size_t R_PROJB = WS_R, R_GATE = WS_R + 152 * MiB, R_BR = WS_R + 280 * MiB, R_XBCC = WS_R + 344 * MiB, R_XLC = WS_R + 368 * MiB, R_YS = WS_R + 384 * MiB, R_QKW = WS_R + 400 * MiB, R_END = WS_R + 416 * MiB;
constexpr size_t R_MP = WS_R, R_MERGED = WS_R + 64 * MiB;
constexpr size_t R_XQ = WS_R, R_P = WS_R + 32 * MiB, R_XO = WS_R + 64 * MiB;
constexpr size_t R_ACT = WS_R;
constexpr size_t M_W13E = 34 * MiB, M_W2E = 146 * MiB, M_XS = 202 * MiB, M_ACTE = 270 * MiB, M_END = 508 * MiB;
constexpr size_t WS_NEED = R_END > M_END ? R_END : M_END;
constexpr int CW_TMO = 0, CW_CODE = 1, CW_BAR = 4096, CW_CNT = 8192;
constexpr int RING_BYTES = 131072, LDSCTL_OFF = RING_BYTES, XCH_OFF = LDSCTL_OFF + 1024, LDS_BYTES = 147456;

struct Params { const float* in[46]; float* out; unsigned char* ws; int ph_lo, ph_hi; };

__device__ __forceinline__ int opq(int v) { asm volatile("" : "+s"(v)); return v; }
template <class Tp> __device__ __forceinline__ Tp* opqp(Tp* q) { return q + opq(0); }
#define DPPF_(v, ctrl, rm, bc) __builtin_bit_cast(float, __builtin_amdgcn_update_dpp(0, __builtin_bit_cast(int, (v)), (ctrl), (rm), 0xF, (bc)))
__device__ __forceinline__ float sum8(float v) {
    v += DPPF_(v, 0xB1, 0xF, true); v += DPPF_(v, 0x4E, 0xF, true); v += DPPF_(v, 0x141, 0xF, true); return v;
}
__device__ __forceinline__ float wave_sum(float v) {
    v = sum8(v); v += DPPF_(v, 0x140, 0xF, true); v += DPPF_(v, 0x142, 0xA, false); v += DPPF_(v, 0x143, 0xC, false);
    return __builtin_bit_cast(float, __builtin_amdgcn_readlane(__builtin_bit_cast(int, v), 63));
}
__device__ __forceinline__ float fexp_(float x) { return __builtin_amdgcn_exp2f(1.4426950408889634f * x); }
__device__ __forceinline__ float sigmoidf_(float x) { return __builtin_amdgcn_rcpf(1.0f + __builtin_amdgcn_exp2f(-1.4426950408889634f * x)); }
__device__ __forceinline__ float siluf_(float x) { return x * __builtin_amdgcn_rcpf(1.0f + __builtin_amdgcn_exp2f(-1.4426950408889634f * x)); }
__device__ __forceinline__ float gelu_tanh(float x) { const float u = 0.7978845608028654f * (x + 0.044715f * x * x * x); const float e = __builtin_amdgcn_exp2f(2.8853900817779268f * u); return x * (1.0f - __builtin_amdgcn_rcpf(e + 1.0f)); }
__device__ __forceinline__ float softplusf_(float x) { return x > 20.f ? x : log1pf(__expf(x)); }

struct MapPlain { const float* W; int K, N; const float* ks; float sc; bf16* WT; int ldo;
    __device__ __forceinline__ f32x4 load4(int k, int n0, int j4) const { return *(const f32x4*)(W + (size_t)k * N + n0 + 4 * j4); }
    __device__ __forceinline__ int nl(int j4) const { return 4 * j4; }
    __device__ __forceinline__ float scale(int k) const { return ks ? ks[k] * sc : sc; }
    __device__ __forceinline__ bf16* dst(int n) const { return WT + (size_t)n * ldo; } };
struct MapWin { const float* W; const float* ks; bf16* WT; int N;
    __device__ __forceinline__ f32x4 load4(int k, int n0, int j4) const { return *(const f32x4*)(W + (size_t)k * cf::IN_TOTAL + n0 + 4 * j4 + (n0 >= cf::O_DT ? 8 : 0)); }
    __device__ __forceinline__ int nl(int j4) const { return 4 * j4; }
    __device__ __forceinline__ float scale(int k) const { return ks[k]; }
    __device__ __forceinline__ bf16* dst(int n) const { return WT + (size_t)n * 1024; } };
struct MapW13 { const float* w1; const float* w3; const float* ks; bf16* WT; int F, N;
    __device__ __forceinline__ f32x4 load4(int k, int n0, int j4) const { const int gi = j4 >> 3, mat = (j4 >> 2) & 1, fi4 = j4 & 3; const ptrdiff_t dsel = mat ? (w3 - w1) : (ptrdiff_t)0;
        return *(const f32x4*)(w1 + dsel + (ptrdiff_t)((size_t)k * F + (n0 >> 1) + 16 * gi + 4 * fi4)); }
    __device__ __forceinline__ int nl(int j4) const { return 32 * (j4 >> 3) + 8 * (j4 & 3) + 4 * ((j4 >> 2) & 1); }
    __device__ __forceinline__ float scale(int k) const { return ks ? ks[k] : 1.0f; }
    __device__ __forceinline__ bf16* dst(int n) const { return WT + (size_t)n * 1024; } };
template <class Map> __device__ __forceinline__ void cvt_item8(const Map& mp, int item, LAS float* scr, int lane, const float wscale, const int pitch) {
    LAS unsigned char* T = (LAS unsigned char*)scr;
    const int nblk = mp.N / 64, kb = item / nblk, nb = item % nblk, k0 = 64 * kb, n0 = 64 * nb;
    f32x4 v[16];
#pragma unroll
    for (int it = 0; it < 16; ++it) { const int e = it * 64 + lane; v[it] = mp.load4(k0 + (e >> 4), n0, e & 15); }
#pragma unroll
    for (int it = 0; it < 16; ++it) { const int e = it * 64 + lane, k = e >> 4, nl = mp.nl(e & 15); const float sc = mp.scale(k0 + k) * wscale;
        int p = 0; p = __builtin_amdgcn_cvt_pk_fp8_f32(v[it][0] * sc, v[it][1] * sc, p, false); p = __builtin_amdgcn_cvt_pk_fp8_f32(v[it][2] * sc, v[it][3] * sc, p, true);
        T[(nl + 0) * 80 + k] = (unsigned char)(p & 0xff); T[(nl + 1) * 80 + k] = (unsigned char)((p >> 8) & 0xff); T[(nl + 2) * 80 + k] = (unsigned char)((p >> 16) & 0xff); T[(nl + 3) * 80 + k] = (unsigned char)((unsigned)p >> 24); }
    LDS_WAIT(); asm volatile("" ::: "memory");
#pragma unroll
    for (int it = 0; it < 4; ++it) { const int e = it * 64 + lane, nl = e >> 2, c4 = e & 3; const LAS unsigned* tp = (const LAS unsigned*)(T + nl * 80 + 16 * c4);
        v4u w; w.x = tp[0]; w.y = tp[1]; w.z = tp[2]; w.w = tp[3]; *(v4u*)((unsigned char*)mp.WT + (size_t)(n0 + nl) * pitch + k0 + 16 * c4) = w; }
    LDS_WAIT(); asm volatile("" ::: "memory");
}
template <class Map> __device__ __forceinline__ void cvt_item(const Map& mp, int item, LAS float* scr, int lane) {
    LAS bf16* T = (LAS bf16*)scr;
    const int nblk = mp.N / 64, kb = item / nblk, nb = item % nblk, k0 = 64 * kb, n0 = 64 * nb;
    f32x4 v[16];
#pragma unroll
    for (int it = 0; it < 16; ++it) { const int e = it * 64 + lane; v[it] = mp.load4(k0 + (e >> 4), n0, e & 15); }
#pragma unroll
    for (int it = 0; it < 16; ++it) { const int e = it * 64 + lane, k = e >> 4, nl = mp.nl(e & 15); const float sc = mp.scale(k0 + k);
        const unsigned p0 = pg8::cvt_pk_bf16(v[it][0] * sc, v[it][1] * sc), p1 = pg8::cvt_pk_bf16(v[it][2] * sc, v[it][3] * sc);
        T[(nl + 0) * 66 + k] = (bf16)(p0 & 0xffffu); T[(nl + 1) * 66 + k] = (bf16)(p0 >> 16); T[(nl + 2) * 66 + k] = (bf16)(p1 & 0xffffu); T[(nl + 3) * 66 + k] = (bf16)(p1 >> 16); }
    LDS_WAIT(); asm volatile("" ::: "memory");
#pragma unroll
    for (int it = 0; it < 8; ++it) { const int e = it * 64 + lane, nl = e >> 3, c8 = e & 7; const LAS unsigned* tp = (const LAS unsigned*)(T + nl * 66 + 8 * c8);
        v4u w; w.x = tp[0]; w.y = tp[1]; w.z = tp[2]; w.w = tp[3]; *(v4u*)(mp.dst(n0 + nl) + k0 + 8 * c8) = w; }
    LDS_WAIT(); asm volatile("" ::: "memory");
}

__device__ __forceinline__ float norm_row(const float* xrow, bf16* orow, int lane, f32x4 (&v)[4]) {
    const f32x4* xr = (const f32x4*)xrow + lane; float ss = 0.f;
#pragma unroll
    for (int j = 0; j < 4; ++j) { v[j] = xr[64 * j]; ss += (v[j].x * v[j].x + v[j].y * v[j].y) + (v[j].z * v[j].z + v[j].w * v[j].w); }
    const float r = 1.0f / sqrtf(wave_sum(ss) * (1.0f / 1024.0f) + 1e-6f);
    unsigned long long* o8 = (unsigned long long*)orow + lane;
#pragma unroll
    for (int j = 0; j < 4; ++j) o8[64 * j] = (unsigned long long)pk2(v[j].x * r, v[j].y * r) | ((unsigned long long)pk2(v[j].z * r, v[j].w * r) << 32);
    return r;
}
template <class Post> __device__ __forceinline__ void norm_rows(const float* X, bf16* O, const int nrows, const int gw, const int NGW, const int lane, Post post) {
    for (int r0 = gw; r0 < nrows; r0 += 4 * NGW) {
        f32x4 v0[4], v1[4], v2[4], v3[4];
        { const int q1 = r0 + NGW < nrows ? r0 + NGW : r0, q2 = r0 + 2 * NGW < nrows ? r0 + 2 * NGW : r0, q3 = r0 + 3 * NGW < nrows ? r0 + 3 * NGW : r0;
          const f32x4* x0 = (const f32x4*)(X + (size_t)r0 * 1024) + lane; const f32x4* x1 = (const f32x4*)(X + (size_t)q1 * 1024) + lane; const f32x4* x2 = (const f32x4*)(X + (size_t)q2 * 1024) + lane; const f32x4* x3 = (const f32x4*)(X + (size_t)q3 * 1024) + lane;
#pragma unroll
          for (int j = 0; j < 4; ++j) { v0[j] = x0[64 * j]; v1[j] = x1[64 * j]; v2[j] = x2[64 * j]; v3[j] = x3[64 * j]; } }
#define NR_ONE_(vv, row_) do { const int rw_ = (row_); if (rw_ < nrows) { float ss = 0.f; _Pragma("unroll") for (int j = 0; j < 4; ++j) ss += (vv[j].x * vv[j].x + vv[j].y * vv[j].y) + (vv[j].z * vv[j].z + vv[j].w * vv[j].w); \
            const float r = 1.0f / sqrtf(wave_sum(ss) * (1.0f / 1024.0f) + 1e-6f); unsigned long long* o8 = (unsigned long long*)(O + (size_t)rw_ * 1024) + lane; \
            _Pragma("unroll") for (int j = 0; j < 4; ++j) o8[64 * j] = (unsigned long long)pk2(vv[j].x * r, vv[j].y * r) | ((unsigned long long)pk2(vv[j].z * r, vv[j].w * r) << 32); \
            post(rw_, r, vv); } } while (0)
        NR_ONE_(v0, r0); NR_ONE_(v1, r0 + NGW); NR_ONE_(v2, r0 + 2 * NGW); NR_ONE_(v3, r0 + 3 * NGW);
#undef NR_ONE_
    }
}
struct NoPost { __device__ __forceinline__ void operator()(int, float, const f32x4 (&)[4]) const {} };
__device__ __forceinline__ void row_dot8(const f32x4 (&v)[4], const LAS float* w8, int lane, float (&lg)[8]) {
#pragma unroll
    for (int e = 0; e < 8; ++e) lg[e] = 0.f;
#pragma unroll
    for (int j = 0; j < 4; ++j)
#pragma unroll
        for (int q = 0; q < 4; ++q) { const int i = 256 * j + 4 * lane + q; const f32x4 wa = *(const LAS f32x4*)(w8 + i * 8), wb = *(const LAS f32x4*)(w8 + i * 8 + 4); const float x = v[j][q];
            lg[0] += x * wa.x; lg[1] += x * wa.y; lg[2] += x * wa.z; lg[3] += x * wa.w; lg[4] += x * wb.x; lg[5] += x * wb.y; lg[6] += x * wb.z; lg[7] += x * wb.w; }
#pragma unroll
    for (int e = 0; e < 8; ++e) lg[e] = wave_sum(lg[e]);
}


#define MFMA16(a, b, c) __builtin_amdgcn_mfma_f32_16x16x32_bf16((a), (b), (c), 0, 0, 0)
__device__ __forceinline__ float bfs(short v) { return __uint_as_float(((unsigned)(unsigned short)v) << 16); }
__device__ __forceinline__ float ex2(float x) { return __builtin_amdgcn_exp2f(x); }
__device__ __forceinline__ bf16x8 pack8f(const f32x4 a, const f32x4 b) { v4u w; w.x = pg8::cvt_pk_bf16(a[0], a[1]); w.y = pg8::cvt_pk_bf16(a[2], a[3]); w.z = pg8::cvt_pk_bf16(b[0], b[1]); w.w = pg8::cvt_pk_bf16(b[2], b[3]); return __builtin_bit_cast(bf16x8, w); }
__device__ __forceinline__ v2u pack4f(const f32x4 a) { v2u w; w.x = pg8::cvt_pk_bf16(a[0], a[1]); w.y = pg8::cvt_pk_bf16(a[2], a[3]); return w; }

struct LaChunk { float dtl, vsc; bf16x8 Qf[2][2], Kf[2][2], vv0, vv1; v2u xs[2][2]; };
__device__ __forceinline__ void la_load(LaChunk& ck, const int t0, const bf16* Q, const int qp, const bf16* K, const int kp, const bf16* V, const int vp, const float* dtp, const bool skip, const int lane) {
    const int n16 = lane & 15, q = lane >> 4, vrow = lane >> 1, vcol = (lane & 1) * 16;
    ck.dtl = dtp ? dtp[(size_t)(t0 + (lane & 31)) * 8] : 0.f; ck.vsc = dtp ? dtp[(size_t)(t0 + vrow) * 8] : 1.0f;
#pragma unroll
    for (int j = 0; j < 2; ++j)
#pragma unroll
        for (int ks = 0; ks < 2; ++ks) { ck.Qf[j][ks] = *(const bf16x8*)(Q + (size_t)(t0 + 16 * j + n16) * qp + 32 * ks + 8 * q); ck.Kf[j][ks] = *(const bf16x8*)(K + (size_t)(t0 + 16 * j + n16) * kp + 32 * ks + 8 * q); }
    ck.vv0 = *(const bf16x8*)(V + (size_t)(t0 + vrow) * vp + vcol); ck.vv1 = *(const bf16x8*)(V + (size_t)(t0 + vrow) * vp + vcol + 8);
#pragma unroll
    for (int t = 0; t < 2; ++t)
#pragma unroll
        for (int j = 0; j < 2; ++j) ck.xs[t][j] = skip ? *(const v2u*)(V + (size_t)(t0 + 16 * j + n16) * vp + 16 * t + 4 * q) : (v2u){0u, 0u};
}
__device__ __forceinline__ void linattn_unit(const bf16* Q, const int qp, const bf16* K, const int kp, const bf16* V, const int vp, const float* dtp, const float dcoef, const float dskip,
                                             bf16* out, const int op, LAS unsigned char* sl, const int lane) {
    const int n16 = lane & 15, q = lane >> 4;
    LAS bf16* Vt = (LAS bf16*)sl;
    LAS bf16* Kt = Vt + 32 * 32;
    LAS bf16* St = Kt + 64 * 32;
    LAS float* la = (LAS float*)(St + 32 * 64);
    for (int i = lane; i < 32 * 64 / 2; i += 64) ((LAS unsigned*)St)[i] = 0u;
    f32x4 Sacc[4][2];
#pragma unroll
    for (int i = 0; i < 4; ++i) { Sacc[i][0] = (f32x4){0.f, 0.f, 0.f, 0.f}; Sacc[i][1] = (f32x4){0.f, 0.f, 0.f, 0.f}; }
    const f32x4 z4 = (f32x4){0.f, 0.f, 0.f, 0.f};
    const int posn = 8 * (n16 >> 2) + (n16 & 3);
    const int vrow = lane >> 1, vcol = (lane & 1) * 16, vpos = 8 * ((vrow & 15) >> 2) + 4 * (vrow >> 4) + (vrow & 3);
    const bool skip = dskip != 0.f;
    { const unsigned dm_ = *(const unsigned*)Q; asm volatile("" :: "v"(dm_)); const unsigned dl_ = ((LAS unsigned*)St)[lane]; asm volatile("" :: "v"(dl_)); }
    LaChunk nx; la_load(nx, 0, Q, qp, K, kp, V, vp, dtp, skip, lane);
    asm volatile("" : "+v"(nx.Qf[0][0]), "+v"(nx.Qf[0][1]), "+v"(nx.Qf[1][0]), "+v"(nx.Qf[1][1]), "+v"(nx.Kf[0][0]), "+v"(nx.Kf[0][1]), "+v"(nx.Kf[1][0]), "+v"(nx.Kf[1][1]), "+v"(nx.vv0), "+v"(nx.vv1) :: "memory");
    for (int c = 0; c < cf::L / 32; ++c) {
        const int t0 = c * 32;
        const LaChunk ck = nx;
        if (c + 1 < cf::L / 32) la_load(nx, t0 + 32, Q, qp, K, kp, V, vp, dtp, skip, lane);
        float xl = dtp ? ck.dtl * dcoef : dcoef;
#pragma unroll
        for (int off = 1; off < 32; off <<= 1) { const float y = __shfl_up(xl, off); if ((lane & 31) >= off) xl += y; }
        if (lane < 32) la[lane] = xl;
        const float a_end = __shfl(xl, 31);
        const f32x4 as0 = *(const LAS f32x4*)(la + 4 * q), as1 = *(const LAS f32x4*)(la + 16 + 4 * q); const float al0 = la[n16], al1 = la[16 + n16];
        f32x4 s00 = MFMA16(ck.Kf[0][0], ck.Qf[0][0], z4); s00 = MFMA16(ck.Kf[0][1], ck.Qf[0][1], s00);
        f32x4 s01 = MFMA16(ck.Kf[0][0], ck.Qf[1][0], z4); s01 = MFMA16(ck.Kf[0][1], ck.Qf[1][1], s01);
        f32x4 s11 = MFMA16(ck.Kf[1][0], ck.Qf[1][0], z4); s11 = MFMA16(ck.Kf[1][1], ck.Qf[1][1], s11);
#pragma unroll
        for (int r = 0; r < 4; ++r) { const bool ok = n16 >= 4 * q + r;
            s00[r] = ok ? s00[r] * ex2(al0 - as0[r]) : 0.f; s01[r] = s01[r] * ex2(al1 - as0[r]); s11[r] = ok ? s11[r] * ex2(al1 - as1[r]) : 0.f; }
        const bf16x8 Pf0 = pack8f(s00, z4), Pf1 = pack8f(s01, s11);
        const float w0 = ex2(a_end - al0), w1 = ex2(a_end - al1);
#pragma unroll
        for (int i = 0; i < 2; ++i)
#pragma unroll
            for (int ks = 0; ks < 2; ++ks)
#pragma unroll
                for (int jj = 0; jj < 8; jj += 2) { const float wv = i ? w1 : w0; const unsigned pw = pg8::cvt_pk_bf16(bfs(ck.Kf[i][ks][jj]) * wv, bfs(ck.Kf[i][ks][jj + 1]) * wv); const int d = 32 * ks + 8 * q + jj;
                    Kt[d * 32 + posn + 4 * i] = (bf16)(pw & 0xffffu); Kt[(d + 1) * 32 + posn + 4 * i] = (bf16)(pw >> 16); }
#pragma unroll
        for (int jj = 0; jj < 8; jj += 2) { const unsigned pa = pg8::cvt_pk_bf16(bfs(ck.vv0[jj]) * ck.vsc, bfs(ck.vv0[jj + 1]) * ck.vsc), pb = pg8::cvt_pk_bf16(bfs(ck.vv1[jj]) * ck.vsc, bfs(ck.vv1[jj + 1]) * ck.vsc);
            Vt[(vcol + jj) * 32 + vpos] = (bf16)(pa & 0xffffu); Vt[(vcol + jj + 1) * 32 + vpos] = (bf16)(pa >> 16); Vt[(vcol + 8 + jj) * 32 + vpos] = (bf16)(pb & 0xffffu); Vt[(vcol + 9 + jj) * 32 + vpos] = (bf16)(pb >> 16); }
        bf16x8 Vf[2], Sf[2][2];
#pragma unroll
        for (int t = 0; t < 2; ++t) { Vf[t] = *(const LAS bf16x8*)(Vt + (16 * t + n16) * 32 + 8 * q); Sf[t][0] = *(const LAS bf16x8*)(St + (16 * t + n16) * 64 + 8 * q); Sf[t][1] = *(const LAS bf16x8*)(St + (16 * t + n16) * 64 + 32 + 8 * q); }
        const float ea0 = ex2(al0), ea1 = ex2(al1);
#pragma unroll
        for (int t = 0; t < 2; ++t)
#pragma unroll
            for (int j = 0; j < 2; ++j) {
                f32x4 y = MFMA16(Vf[t], j ? Pf1 : Pf0, z4);
                f32x4 cr = MFMA16(Sf[t][0], ck.Qf[j][0], z4); cr = MFMA16(Sf[t][1], ck.Qf[j][1], cr);
                y += cr * (j ? ea1 : ea0);
                const size_t row = (size_t)(t0 + 16 * j + n16);
                if (skip) { const v2u xw = ck.xs[t][j]; y[0] += dskip * bflo(xw.x); y[1] += dskip * bfhi(xw.x); y[2] += dskip * bflo(xw.y); y[3] += dskip * bfhi(xw.y); }
                *(v2u*)(out + row * op + 16 * t + 4 * q) = pack4f(y);
            }
        const float dec = ex2(a_end);
#pragma unroll
        for (int dt = 0; dt < 4; ++dt) { const bf16x8 Ktf = *(const LAS bf16x8*)(Kt + (16 * dt + n16) * 32 + 8 * q);
#pragma unroll
            for (int et = 0; et < 2; ++et) { Sacc[dt][et] = MFMA16(Ktf, Vf[et], Sacc[dt][et] * dec); *(LAS v2u*)(St + (16 * et + n16) * 64 + 16 * dt + 4 * q) = pack4f(Sacc[dt][et]); } }
    }
}

__device__ __forceinline__ void s5_unit(const bf16* U, bf16* Y, const float* lam_re, const float* lam_im, const float* b_re, const float* b_im, const float* c_re, const float* c_im, const float* dsk, const float step,
                                        LAS unsigned char* sl, const int lane) {
    const int n16 = lane & 15, q = lane >> 4;
    LAS float* BU = (LAS float*)sl;
    LAS bf16* SI = (LAS bf16*)(sl + 8192);
    float ar, ai;
    { const float lr = lam_re[lane], li = lam_im[lane], mag = expf(lr * step); ar = mag * cosf(li * step); ai = mag * sinf(li * step); }
    bf16x8 Bbf[8], Ccf[4];
#pragma unroll
    for (int tl = 0; tl < 8; ++tl) {
        const int idx = 16 * tl + n16, st = idx & 63; float v[8];
        const float lr = lam_re[st], li = lam_im[st], mag = expf(lr * step), sar = mag * cosf(li * step), sai = mag * sinf(li * step), inv = 1.0f / (lr * lr + li * li);
        const float cr = ((sar - 1.0f) * lr + sai * li) * inv, ci = (sai * lr - (sar - 1.0f) * li) * inv;
#pragma unroll
        for (int jj = 0; jj < 8; ++jj) { float x = 0.f; if (q < 2) { const float br_ = b_re[st * 16 + 8 * q + jj], bi_ = b_im[st * 16 + 8 * q + jj]; x = idx < 64 ? cr * br_ - ci * bi_ : cr * bi_ + ci * br_; } v[jj] = x; }
        Bbf[tl] = pack8f((f32x4){v[0], v[1], v[2], v[3]}, (f32x4){v[4], v[5], v[6], v[7]});
    }
#pragma unroll
    for (int ks = 0; ks < 4; ++ks) {
        float v[8];
#pragma unroll
        for (int jj = 0; jj < 8; ++jj) { const int idx = 32 * ks + 8 * q + jj; v[jj] = idx < 64 ? c_re[n16 * 64 + idx] : -c_im[n16 * 64 + idx - 64]; }
        Ccf[ks] = pack8f((f32x4){v[0], v[1], v[2], v[3]}, (f32x4){v[4], v[5], v[6], v[7]});
    }
    const f32x4 dk = *(const f32x4*)(dsk + 4 * q);
    const f32x4 z4 = (f32x4){0.f, 0.f, 0.f, 0.f};
    const bf16x8 zf = (bf16x8){0, 0, 0, 0, 0, 0, 0, 0};
    float sr = 0.f, si = 0.f;
    bf16x8 nUf[2]; v2u nuw[2];
#pragma unroll
    for (int mt = 0; mt < 2; ++mt) { const bf16* urow = U + (size_t)(16 * mt + n16) * cf::PJ; nUf[mt] = q < 2 ? *(const bf16x8*)(urow + 8 * q) : zf; nuw[mt] = *(const v2u*)(urow + 4 * q); }
    for (int c = 0; c < cf::L / 32; ++c) {
        bf16x8 Uf[2]; v2u uw[2];
#pragma unroll
        for (int mt = 0; mt < 2; ++mt) { Uf[mt] = nUf[mt]; uw[mt] = nuw[mt]; }
        if (c + 1 < cf::L / 32) {
#pragma unroll
            for (int mt = 0; mt < 2; ++mt) { const bf16* urow = U + (size_t)((c + 1) * 32 + 16 * mt + n16) * cf::PJ; nUf[mt] = q < 2 ? *(const bf16x8*)(urow + 8 * q) : zf; nuw[mt] = *(const v2u*)(urow + 4 * q); } }
#pragma unroll
        for (int mt = 0; mt < 2; ++mt) {
            f32x4 d8[8];
#pragma unroll
            for (int tl = 0; tl < 8; ++tl) d8[tl] = MFMA16(Uf[mt], Bbf[tl], z4);
            asm volatile("" : "+v"(d8[0]), "+v"(d8[1]), "+v"(d8[2]), "+v"(d8[3]), "+v"(d8[4]), "+v"(d8[5]), "+v"(d8[6]), "+v"(d8[7]));
#pragma unroll
            for (int tl = 0; tl < 8; ++tl) {
#pragma unroll
                for (int r = 0; r < 4; ++r) BU[(4 * q + r) * 128 + 16 * tl + n16] = d8[tl][r]; }
#pragma unroll
            for (int t = 0; t < 16; ++t) { const float bre = BU[t * 128 + lane], bim = BU[t * 128 + 64 + lane];
                const float nr = ar * sr - ai * si + bre, ni = ar * si + ai * sr + bim; sr = nr; si = ni;
                const unsigned pw = pg8::cvt_pk_bf16(sr, si); SI[(16 * mt + t) * 128 + lane] = (bf16)(pw & 0xffffu); SI[(16 * mt + t) * 128 + 64 + lane] = (bf16)(pw >> 16); }
        }
        f32x4 yy[2] = {z4, z4};
#pragma unroll
        for (int ks = 0; ks < 4; ++ks) { const bf16x8 Sf0 = *(const LAS bf16x8*)(SI + n16 * 128 + 32 * ks + 8 * q), Sf1 = *(const LAS bf16x8*)(SI + (16 + n16) * 128 + 32 * ks + 8 * q);
            yy[0] = MFMA16(Ccf[ks], Sf0, yy[0]); yy[1] = MFMA16(Ccf[ks], Sf1, yy[1]); }
#pragma unroll
        for (int mt = 0; mt < 2; ++mt) {
            f32x4 y = yy[mt];
            y[0] = gelu_tanh(y[0] + dk[0] * bflo(uw[mt].x)); y[1] = gelu_tanh(y[1] + dk[1] * bfhi(uw[mt].x)); y[2] = gelu_tanh(y[2] + dk[2] * bflo(uw[mt].y)); y[3] = gelu_tanh(y[3] + dk[3] * bfhi(uw[mt].y));
            *(v2u*)(Y + (size_t)(c * 32 + 16 * mt + n16) * 512 + 4 * q) = pack4f(y);
        }
    }
}

struct LruChunk { bf16x8 X[2][2], Gf[2]; };
__device__ __forceinline__ void lru_load(LruChunk& ck, const int t0, const bf16* XC, const bf16* GLb, const int ksel, const int lane) {
    const int n16 = lane & 15, q = lane >> 4;
#pragma unroll
    for (int mt = 0; mt < 2; ++mt) { const size_t row = (size_t)(t0 + 8 * (n16 >> 2) + 4 * mt + (n16 & 3));
        ck.X[mt][0] = *(const bf16x8*)(XC + row * 512 + 8 * q); ck.X[mt][1] = *(const bf16x8*)(XC + row * 512 + 32 + 8 * q); ck.Gf[mt] = *(const bf16x8*)(GLb + row * cf::PJ + 32 * ksel + 8 * q); }
}
__device__ __forceinline__ void lru_unit(const bf16* XC  , const bf16* GLb  , bf16* out  ,
                                         const float* wa  , const float* wx, const float ba, const float bx, const float sp, const int jq, const int lane) {
    const int n16 = lane & 15, q = lane >> 4, ksel = jq >> 1;
    bf16x8 Waf[2], Wxf[2], Idf;
#pragma unroll
    for (int ks = 0; ks < 2; ++ks) { float va[8], vx[8];
#pragma unroll
        for (int jj = 0; jj < 8; ++jj) { const int i = 32 * ks + 8 * q + jj; va[jj] = wa[i * 64 + jq * 16 + n16]; vx[jj] = wx[i * 64 + jq * 16 + n16]; }
        Waf[ks] = pack8f((f32x4){va[0], va[1], va[2], va[3]}, (f32x4){va[4], va[5], va[6], va[7]}); Wxf[ks] = pack8f((f32x4){vx[0], vx[1], vx[2], vx[3]}, (f32x4){vx[4], vx[5], vx[6], vx[7]}); }
    { float vi[8];
#pragma unroll
      for (int jj = 0; jj < 8; ++jj) vi[jj] = (8 * q + jj == (jq & 1) * 16 + n16) ? 1.0f : 0.f;
      Idf = pack8f((f32x4){vi[0], vi[1], vi[2], vi[3]}, (f32x4){vi[4], vi[5], vi[6], vi[7]}); }
    const f32x4 z4 = (f32x4){0.f, 0.f, 0.f, 0.f};
    float hprev = 0.f;
    LruChunk nx; lru_load(nx, 0, XC, GLb, ksel, lane);
    for (int c = 0; c < cf::L / 32; ++c) {
        const int t0 = c * 32;
        const LruChunk ck = nx;
        if (c + 1 < cf::L / 32) lru_load(nx, t0 + 32, XC, GLb, ksel, lane);
        float a[8], bb[8], gv[8];
        float A = 1.0f, B = 0.f;
#pragma unroll
        for (int mt = 0; mt < 2; ++mt) {
            f32x4 ra = MFMA16(ck.X[mt][0], Waf[0], z4); ra = MFMA16(ck.X[mt][1], Waf[1], ra);
            f32x4 ri = MFMA16(ck.X[mt][0], Wxf[0], z4); ri = MFMA16(ck.X[mt][1], Wxf[1], ri);
            const f32x4 xc = MFMA16(ksel ? ck.X[mt][1] : ck.X[mt][0], Idf, z4), gl = MFMA16(ck.Gf[mt], Idf, z4);
#pragma unroll
            for (int r = 0; r < 4; ++r) { const int k = 4 * mt + r;
                const float rr = sigmoidf_(ra[r] + ba), ii = sigmoidf_(ri[r] + bx), la_ = -8.0f * rr * sp; a[k] = fexp_(la_);
                bb[k] = __builtin_amdgcn_sqrtf(fmaxf(1.0f - a[k] * a[k], 0.f)) * ii * xc[r]; gv[k] = gl[r];
                B = a[k] * B + bb[k]; A *= a[k]; }
        }
        { const float Au = __shfl_up(A, 16), Bu = __shfl_up(B, 16); if (q >= 1) { B = A * Bu + B; A = A * Au; } }
        { const float Au = __shfl_up(A, 32), Bu = __shfl_up(B, 32); if (q >= 2) { B = A * Bu + B; A = A * Au; } }
        float Ae = __shfl_up(A, 16), Be = __shfl_up(B, 16); if (q == 0) { Ae = 1.0f; Be = 0.f; }
        float h = Ae * hprev + Be;
#pragma unroll
        for (int k = 0; k < 8; ++k) { h = a[k] * h + bb[k]; out[(size_t)(t0 + 8 * q + k) * 2048 + n16] = (bf16)f2bf(h * gelu_tanh(gv[k])); }
        hprev = __shfl(h, 48 + n16);
    }
}

#define PH_VARS int tid_ = wave_s * 64 + lane_id_fresh(); asm volatile("" : "+v"(tid_)); const int tid = tid_, lane = tid & 63, wave = __builtin_amdgcn_readfirstlane(tid >> 6); \
    const int G = opq((int)gridDim.x), bx = opq((int)blockIdx.x), vcu = (G % 8 == 0) ? (bx % 8) * (G / 8) + bx / 8 : bx; \
    const int gw = vcu * NWAVES + wave, NGW = G * NWAVES, gt = vcu * 512 + tid, NGT = G * 512; \
    LAS float* scr = (LAS float*)(lds + wave * 16384); LAS float* w8 = (LAS float*)lds; LAS float* xch = (LAS float*)(lds + XCH_OFF); \
    (void)lane; (void)gw; (void)NGW; (void)gt; (void)NGT; (void)scr; (void)w8; (void)xch; (void)bx;
#define ws (opqp(p.ws))
#define ctl ((unsigned*)(ws + WS_CTL))
#define GRID_BAR() do { if (single) { XcdBarrier b2_ = bar; b2_.bar = ctl + CW_BAR; xcd_barrier(b2_, wave_s); } } while (0)
#ifdef MK_TPROBE
#define GRID_BARC(c) do { GRID_BAR(); if (single && blockIdx.x == 0 && wave_s == 0 && lane_id_fresh() == 0) { unsigned long long* tl_ = (unsigned long long*)(ctl + 20000); const unsigned long long now_ = wall_clock64(); \
    if ((MK_TPROBE >> (c)) & 1) { unsigned* ac_ = ctl + 20100; *ac_ += (unsigned)(now_ - tl_[0]); } tl_[0] = now_; } } while (0)
#else
#define GRID_BARC(c) GRID_BAR()
#endif
#define IN(k) (lo <= (k) && (k) < hi)
#define x_ (opqp(p.in[0]))
#define mem_ (opqp(p.in[1]))
#define positions_ ((const int*)opqp(p.in[2]))
#define norm_mix (opqp(p.in[3]))
#define w_in (opqp(p.in[4]))
#define b_gate (opqp(p.in[5]))
#define w_branch (opqp(p.in[29]))
#define w_out (opqp(p.in[30]))
#define norm_xa (opqp(p.in[31]))
#define norm_mem (opqp(p.in[32]))
#define xa_wq (opqp(p.in[33]))
#define xa_wk (opqp(p.in[34]))
#define xa_wv (opqp(p.in[35]))
#define xa_wo (opqp(p.in[36]))
#define norm_ffn (opqp(p.in[37]))
#define ffn_w1 (opqp(p.in[38]))
#define ffn_w3 (opqp(p.in[39]))
#define ffn_w2 (opqp(p.in[40]))
#define moe_router (opqp(p.in[41]))
#define moe_w1 (opqp(p.in[42]))
#define moe_w3 (opqp(p.in[43]))
#define moe_w2 (opqp(p.in[44]))
#define norm_final (opqp(p.in[45]))
#define H (opqp(p.out))
#define HN ((bf16*)(ws + WS_HN))
#define KVB ((bf16*)(ws + WS_KV))
#define COS ((float*)(ws + WS_TAB))
#define SIN (COS + (size_t)T * 32)
#define DT ((float*)(ws + WS_DT))
#define MNR ((bf16*)(ws + WS_MNR))
#define PROJB ((bf16*)(ws + R_PROJB))
#define GATE ((bf16*)(ws + R_GATE))
#define BR ((bf16*)(ws + R_BR))
#define XBCC ((bf16*)(ws + R_XBCC))
#define XLC ((bf16*)(ws + R_XLC))
#define YSB ((bf16*)(ws + R_YS))
#define QKW ((bf16*)(ws + R_QKW))
#define MP ((float*)(ws + R_MP))
#define MERGED ((bf16*)(ws + R_MERGED))
#define XQ ((bf16*)(ws + R_XQ))
#define VWO ((bf16*)(ws + R_XQ))
#define PB ((bf16*)(ws + R_P))
#define XO ((bf16*)(ws + R_XO))
#define ACT ((bf16*)(ws + R_ACT))
#define W13E ((bf16*)(ws + M_W13E))
#define W2E ((bf16*)(ws + M_W2E))
#define XS ((bf16*)(ws + M_XS))
#define ACTE ((bf16*)(ws + M_ACTE))
#define YPART ((float*)(ws + M_W13E))
#define TOPI ((i32x4*)(ws + WS_TOPI))
#define TOPW ((f32x2*)(ws + WS_TOPW))
#define SLOT ((i32x2*)(ws + WS_SLOT))
#define HN8L1 ((unsigned char*)(ws + WS_W))
#define XS8 ((unsigned char*)(ws + M_XS))
#define HN8 ((unsigned char*)(ws + M_XS + 36 * MiB))
#define ROWOF ((int*)(ws + WS_CTL + 512 * 1024))
#define CNT ((int*)(ctl + CW_CNT))
#define W13 ((bf16*)(ws + WS_W13))
#define W2T ((bf16*)(ws + WS_W2))
#define CVT_LOOP(NITEMS, ...) do { for (int it = (gw + NGW - rot % NGW) % NGW; it < (NITEMS); it += NGW) { __VA_ARGS__; cvt_item(m, it, scr, lane); } rot += (NITEMS); } while (0)
#define CVT_LOOP8(NITEMS, WSC, PITCH, ...) do { for (int it = (gw + NGW - rot % NGW) % NGW; it < (NITEMS); it += NGW) { __VA_ARGS__; cvt_item8(m, it, scr, lane, (WSC), (PITCH)); } rot += (NITEMS); } while (0)

__global__ void __launch_bounds__(NWAVES * 64, 2) mega(Params p) {
    using namespace cf;
    extern __shared__ __attribute__((aligned(16))) unsigned char lds_raw[];
    LAS unsigned char* lds = (LAS unsigned char*)lds_raw;
    const int wave_s = __builtin_amdgcn_readfirstlane((int)threadIdx.x >> 6);
    for (int u = threadIdx.x; u < (LDS_BYTES - LDSCTL_OFF) / 4; u += NWAVES * 64) ((LAS unsigned*)(lds + LDSCTL_OFF))[u] = 0u;
    __syncthreads();
    const bool single = (p.ph_hi - p.ph_lo) > 1;
    XcdBarrier bar; bar.bar = ctl + CW_BAR; bar.x = 0; bar.st = (volatile LAS unsigned*)(lds + LDSCTL_OFF) + 8;
    if (single) bar = xcd_barrier_post(ctl + CW_BAR, (volatile LAS unsigned*)(lds + LDSCTL_OFF) + 8, wave_s);
#ifdef MK_TPROBE
    if (blockIdx.x == 0 && wave_s == 0 && lane_id_fresh() == 0) ((unsigned long long*)(ctl + 20000))[0] = wall_clock64();
#endif
    const int lo = p.ph_lo, hi = p.ph_hi;


    if (IN(0)) { PH_VARS
        {
            int rot = 0;
            {
                unsigned char* wl = ws + WS_W;
                { for (int it = (gw + NGW - rot % NGW) % NGW; it < 16 * 140; it += NGW) { if (it % 140 < 76) { MapWin m{w_in, norm_mix, (bf16*)(wl + WL_WIN), 8960}; cvt_item(m, it, scr, lane); }
                    else { MapWin m{w_in, norm_mix, (bf16*)(wl + WL_WIN + (size_t)4864 * 2048 - (size_t)4864 * 1024), 8960}; cvt_item8(m, it, scr, lane, 64.0f, 1024); } } rot += 16 * 140; }
                CVT_LOOP(8 * 8, MapPlain m{opqp(p.in[14]), 512, 512, nullptr, 1.f, (bf16*)(wl + WL_GLU), 512});
                for (int k = 0; k < 4; ++k) CVT_LOOP(8 * 16, MapPlain m{w_branch + (size_t)k * 512 * 1024, 512, 1024, nullptr, 1.f, (bf16*)(wl + WL_WB) + k * 512, 2048});
                CVT_LOOP(16 * 16, MapPlain m{w_out, D, D, nullptr, 1.f, (bf16*)(wl + WL_WOUT), D});
                for (int l = 0; l < 2; ++l) { unsigned char* wk = ws + WS_W + (size_t)l * WL_STRIDE;
                    CVT_LOOP(16 * 16, MapPlain m{xa_wk + (size_t)l * D * D, D, D, norm_mem + l * D, 1.f, (bf16*)(wk + WL_WKV), D});
                    CVT_LOOP(16 * 16, MapPlain m{xa_wv + (size_t)l * D * D, D, D, norm_mem + l * D, 1.f, (bf16*)(wk + WL_WKV) + (size_t)D * D, D}); }
            }
        }
        for (int i = gt; i < T * 32; i += NGT) { const int row = i >> 5, f = i & 31; const float inv_freq = (float)exp(-(double)f / 32.0 * 9.210340371976184); const float ang = (float)positions_[row] * inv_freq;
            COS[i] = (float)cos((double)ang); SIN[i] = (float)sin((double)ang); }
        norm_rows(mem_, MNR, TM, gw, NGW, lane, NoPost{});
        __syncthreads();
        for (int i = tid; i < 8192; i += 512) w8[i] = norm_mix[i >> 3] * w_in[(size_t)(i >> 3) * IN_TOTAL + O_DT + (i & 7)];
        __syncthreads();
        norm_rows(x_, HN, T, gw, NGW, lane, [&](const int row, const float r, const f32x4 (&v)[4]) { float lg[8]; row_dot8(v, w8, lane, lg);
            float mine = 0.f;
#pragma unroll
            for (int e = 0; e < 8; ++e) if (lane == e) mine = lg[e];
            if (lane < 8) DT[(size_t)row * 8 + lane] = softplusf_(r * mine + opqp(p.in[17])[lane]);
            { unsigned* h8 = (unsigned*)((unsigned char*)H + (size_t)row * 1024) + lane;
#pragma unroll
              for (int j = 0; j < 4; ++j) { int p8 = 0; p8 = __builtin_amdgcn_cvt_pk_fp8_f32(v[j].x * r, v[j].y * r, p8, false); p8 = __builtin_amdgcn_cvt_pk_fp8_f32(v[j].z * r, v[j].w * r, p8, true); h8[64 * j] = (unsigned)p8; } } });
        GRID_BARC(0);
    }


    { constexpr int layer = 0;
        const int pb = 1 + layer * 20;
#define WLP (ws + WS_W + (size_t)layer * WL_STRIDE)
#define WIN ((const bf16*)(WLP + WL_WIN))
#define WGLU ((const bf16*)(WLP + WL_GLU))
#define WB ((const bf16*)(WLP + WL_WB))
#define WOUT ((const bf16*)(WLP + WL_WOUT))
#define WQ ((const bf16*)(WLP + WL_WQ))
#define WO ((const bf16*)(WLP + WL_WO))
#define KX (KVB + (size_t)layer * 4194304)
#define VT (KX + 2097152)
        if (IN(pb + 0)) { PH_VARS
            pg8::Gemm g{1024, 1024, 1024}; pg8::PlainOrder S; S.A = (const char*)HN; S.B = (const char*)WIN; S.nM = 64; S.nN = 19; S.lda = 1024; S.ldb = 1024; S.G = G; S.c = bx;
            pg8::EpiProj E{PROJB, GATE, b_gate + layer * 4096, 1.0f};
            pg8::gemm_phase<pg8::EpiProj, pg8::PlainOrder, true, true>(lds, g, S, E, wave_s);
            GRID_BARC(1);
        }
        if (IN(pb + 1)) { PH_VARS
            const float* cw = opqp(p.in[15]) + layer * 4 * 768; const float* cb = opqp(p.in[16]) + layer * 768; const float* lw = opqp(p.in[22]) + layer * 4 * 512; const float* lb = opqp(p.in[23]) + layer * 512;
            for (int it = gt; it < T * 224; it += NGT) {
                const int row = it / 224, j = it % 224, t = row & (L - 1);
                if (j < 160) {
                    const bool isx = j < 96; const int c0 = isx ? j * 8 : (j - 96) * 8, C = isx ? 768 : 512; const float* w = isx ? cw : lw; const float* bb = isx ? cb : lb;
                    const bf16* src = PROJB + (size_t)row * PJ + (isx ? C_XBC : C_XL) + c0;
                    float acc[8];
#pragma unroll
                    for (int q = 0; q < 8; ++q) acc[q] = bb[c0 + q];
#pragma unroll
                    for (int tap = 0; tap < 4; ++tap) { if (t - 3 + tap >= 0) { const v4u xv = *(const v4u*)(src - (ptrdiff_t)(3 - tap) * PJ); const float* wt = w + tap * C + c0;
                        acc[0] += wt[0] * bflo(xv.x); acc[1] += wt[1] * bfhi(xv.x); acc[2] += wt[2] * bflo(xv.y); acc[3] += wt[3] * bfhi(xv.y);
                        acc[4] += wt[4] * bflo(xv.z); acc[5] += wt[5] * bfhi(xv.z); acc[6] += wt[6] * bflo(xv.w); acc[7] += wt[7] * bfhi(xv.w); } }
                    if (isx) {
#pragma unroll
                        for (int q = 0; q < 8; ++q) acc[q] = siluf_(acc[q]); }
                    v4u o; o.x = pk2(acc[0], acc[1]); o.y = pk2(acc[2], acc[3]); o.z = pk2(acc[4], acc[5]); o.w = pk2(acc[6], acc[7]);
                    *(v4u*)((isx ? XBCC + (size_t)row * 768 : XLC + (size_t)row * 512) + c0) = o;
                } else {
                    const bool isk = j >= 192; const int jj = isk ? j - 192 : j - 160, h = jj >> 2, i0 = (jj & 3) * 8; const float sc = isk ? 0.125f : 1.0f;
                    bf16* q1 = PROJB + (size_t)row * PJ + (isk ? C_K : C_Q) + h * 64 + i0; bf16* q2 = q1 + 32;
                    const v4u a = *(const v4u*)q1, b = *(const v4u*)q2;
                    const f32x4 c0v = *(const f32x4*)(COS + (size_t)row * 32 + i0), c1v = *(const f32x4*)(COS + (size_t)row * 32 + i0 + 4), s0v = *(const f32x4*)(SIN + (size_t)row * 32 + i0), s1v = *(const f32x4*)(SIN + (size_t)row * 32 + i0 + 4);
                    const float x1[8] = {bflo(a.x), bfhi(a.x), bflo(a.y), bfhi(a.y), bflo(a.z), bfhi(a.z), bflo(a.w), bfhi(a.w)};
                    const float x2[8] = {bflo(b.x), bfhi(b.x), bflo(b.y), bfhi(b.y), bflo(b.z), bfhi(b.z), bflo(b.w), bfhi(b.w)};
                    const float cc[8] = {c0v.x, c0v.y, c0v.z, c0v.w, c1v.x, c1v.y, c1v.z, c1v.w}, ss[8] = {s0v.x, s0v.y, s0v.z, s0v.w, s1v.x, s1v.y, s1v.z, s1v.w};
                    float o1[8], o2[8];
#pragma unroll
                    for (int q = 0; q < 8; ++q) { o1[q] = (x1[q] * cc[q] - x2[q] * ss[q]) * sc; o2[q] = (x2[q] * cc[q] + x1[q] * ss[q]) * sc; }
                    v4u w1; w1.x = pk2(o1[0], o1[1]); w1.y = pk2(o1[2], o1[3]); w1.z = pk2(o1[4], o1[5]); w1.w = pk2(o1[6], o1[7]);
                    v4u w2; w2.x = pk2(o2[0], o2[1]); w2.y = pk2(o2[2], o2[3]); w2.z = pk2(o2[4], o2[5]); w2.w = pk2(o2[6], o2[7]);
                    *(v4u*)q1 = w1; *(v4u*)q2 = w2;
                }
            }
            GRID_BARC(2);
        }
        if (IN(pb + 2)) { PH_VARS
            bf16* YS = YSB;
#ifdef MK_NAIVE_MIX
            for (int wu = gw; wu < 832; wu += NGW) {
                if (wu < 256) {
                    const int un = wu >> 2, sub = wu & 3, b = un >> 3, hh = un & 7, g = hh >> 2, pp = sub * 16 + (lane >> 2), nq = lane & 3;
                    const float Aa = -__expf(opqp(p.in[18])[layer * 8 + hh]), Dk = opqp(p.in[19])[layer * 8 + hh];
                    float S[16];
#pragma unroll
                    for (int j = 0; j < 16; ++j) S[j] = 0.f;
                    for (int t = 0; t < L; ++t) {
                        const size_t row = (size_t)b * L + t; const bf16* xr = XBCC + row * 768;
                        const float dtv = DT[row * 8 + hh], xv = bf1(xr[hh * 64 + pp]);
                        const v4u b0 = *(const v4u*)(xr + 512 + g * 64 + nq * 16), b1 = *(const v4u*)(xr + 512 + g * 64 + nq * 16 + 8), c0 = *(const v4u*)(xr + 640 + g * 64 + nq * 16), c1 = *(const v4u*)(xr + 640 + g * 64 + nq * 16 + 8);
                        const float Bv[16] = {bflo(b0.x), bfhi(b0.x), bflo(b0.y), bfhi(b0.y), bflo(b0.z), bfhi(b0.z), bflo(b0.w), bfhi(b0.w), bflo(b1.x), bfhi(b1.x), bflo(b1.y), bfhi(b1.y), bflo(b1.z), bfhi(b1.z), bflo(b1.w), bfhi(b1.w)};
                        const float Cv[16] = {bflo(c0.x), bfhi(c0.x), bflo(c0.y), bfhi(c0.y), bflo(c0.z), bfhi(c0.z), bflo(c0.w), bfhi(c0.w), bflo(c1.x), bfhi(c1.x), bflo(c1.y), bfhi(c1.y), bflo(c1.z), bfhi(c1.z), bflo(c1.w), bfhi(c1.w)};
                        const float da = __expf(dtv * Aa), xdt = xv * dtv; float acc = 0.f;
#pragma unroll
                        for (int j = 0; j < 16; ++j) { S[j] = da * S[j] + xdt * Bv[j]; acc += Cv[j] * S[j]; }
                        acc += __shfl_xor(acc, 1); acc += __shfl_xor(acc, 2);
                        if (nq == 0) BR[row * 2048 + 512 + hh * 64 + pp] = (bf16)f2bf(acc + Dk * xv);
                    }
                } else if (wu < 512) {
                    const int un = (wu - 256) >> 2, sub = wu & 3, b = un >> 3, hh = un & 7, e = sub * 16 + (lane >> 2), dq = lane & 3;
                    const float gamma = 1.0f - exp2f(-5.0f - (float)hh);
                    float S[16];
#pragma unroll
                    for (int j = 0; j < 16; ++j) S[j] = 0.f;
                    for (int t = 0; t < L; ++t) {
                        const size_t row = (size_t)b * L + t; const bf16* pr = PROJB + row * PJ;
                        const float vv = bf1(pr[C_V + hh * 64 + e]);
                        const v4u k0 = *(const v4u*)(pr + C_K + hh * 64 + dq * 16), k1 = *(const v4u*)(pr + C_K + hh * 64 + dq * 16 + 8), q0 = *(const v4u*)(pr + C_Q + hh * 64 + dq * 16), q1 = *(const v4u*)(pr + C_Q + hh * 64 + dq * 16 + 8);
                        const float Kv[16] = {bflo(k0.x), bfhi(k0.x), bflo(k0.y), bfhi(k0.y), bflo(k0.z), bfhi(k0.z), bflo(k0.w), bfhi(k0.w), bflo(k1.x), bfhi(k1.x), bflo(k1.y), bfhi(k1.y), bflo(k1.z), bfhi(k1.z), bflo(k1.w), bfhi(k1.w)};
                        const float Qv[16] = {bflo(q0.x), bfhi(q0.x), bflo(q0.y), bfhi(q0.y), bflo(q0.z), bfhi(q0.z), bflo(q0.w), bfhi(q0.w), bflo(q1.x), bfhi(q1.x), bflo(q1.y), bfhi(q1.y), bflo(q1.z), bfhi(q1.z), bflo(q1.w), bfhi(q1.w)};
                        float acc = 0.f;
#pragma unroll
                        for (int j = 0; j < 16; ++j) { S[j] = gamma * S[j] + Kv[j] * vv; acc += Qv[j] * S[j]; }
                        acc += __shfl_xor(acc, 1); acc += __shfl_xor(acc, 2);
                        if (dq == 0) BR[row * 2048 + 1024 + hh * 64 + e] = (bf16)f2bf(acc);
                    }
                } else if (wu < 768) {
                    const int un = wu - 512, b = un >> 5, g = un & 31, n = lane;
                    const float* lam_re = opqp(p.in[6]) + layer * 2048; const float* lam_im = opqp(p.in[7]) + layer * 2048; const float* b_re = opqp(p.in[8]) + layer * 32768; const float* b_im = opqp(p.in[9]) + layer * 32768;
                    const float* c_re = opqp(p.in[10]) + layer * 32768; const float* c_im = opqp(p.in[11]) + layer * 32768; const float* dsk = opqp(p.in[12]) + layer * 512;
                    const float lr = lam_re[g * 64 + n], li = lam_im[g * 64 + n], step = expf(opqp(p.in[13])[layer * 32 + g]);
                    const float mag = expf(lr * step), ar = mag * cosf(li * step), ai = mag * sinf(li * step);
                    const float inv = 1.0f / (lr * lr + li * li);
                    const float cr = ((ar - 1.0f) * lr + ai * li) * inv, ci = (ai * lr - (ar - 1.0f) * li) * inv;
                    float bbr[16], bbi[16], cre[16], cim[16];
#pragma unroll
                    for (int h = 0; h < 16; ++h) { const float br_ = b_re[(g * 64 + n) * 16 + h], bi_ = b_im[(g * 64 + n) * 16 + h];
                        bbr[h] = cr * br_ - ci * bi_; bbi[h] = cr * bi_ + ci * br_; cre[h] = c_re[(g * 16 + h) * 64 + n]; cim[h] = c_im[(g * 16 + h) * 64 + n]; }
                    const float dmine = dsk[g * 16 + (n & 15)];
                    float sr = 0.f, si = 0.f;
                    for (int t = 0; t < L; ++t) {
                        const size_t row = (size_t)b * L + t; const bf16* up = PROJB + row * PJ + C_U + g * 16;
                        const v4u u0 = *(const v4u*)up, u1 = *(const v4u*)(up + 8);
                        const float u[16] = {bflo(u0.x), bfhi(u0.x), bflo(u0.y), bfhi(u0.y), bflo(u0.z), bfhi(u0.z), bflo(u0.w), bfhi(u0.w), bflo(u1.x), bfhi(u1.x), bflo(u1.y), bfhi(u1.y), bflo(u1.z), bfhi(u1.z), bflo(u1.w), bfhi(u1.w)};
                        float bur = 0.f, bui = 0.f;
#pragma unroll
                        for (int h = 0; h < 16; ++h) { bur += u[h] * bbr[h]; bui += u[h] * bbi[h]; }
                        const float nr = ar * sr - ai * si + bur, ni = ar * si + ai * sr + bui; sr = nr; si = ni;
                        float mine = 0.f, umine = 0.f;
#pragma unroll
                        for (int h = 0; h < 16; ++h) { const float y = wave_sum(sr * cre[h] - si * cim[h]); if (n == h) { mine = y; umine = u[h]; } }
                        if (n < 16) YS[row * 512 + g * 16 + n] = (bf16)f2bf(gelu_tanh(mine + dmine * umine));
                    }
                } else {
                    const int un = wu - 768, b = un >> 3, blk = un & 7, j = lane;
                    LAS bf16* wA = (LAS bf16*)scr; LAS bf16* wX = wA + 4096;
                    for (int i = 0; i < 64; ++i) { wA[i * 64 + j] = (bf16)f2bf(opqp(p.in[24])[layer * 32768 + (blk * 64 + i) * 64 + j]); wX[i * 64 + j] = (bf16)f2bf(opqp(p.in[26])[layer * 32768 + (blk * 64 + i) * 64 + j]); }
                    LDS_WAIT();
                    const float bA = opqp(p.in[25])[layer * 512 + blk * 64 + j], bX = opqp(p.in[27])[layer * 512 + blk * 64 + j], sp = softplusf_(-opqp(p.in[28])[layer * 512 + blk * 64 + j]);
                    float hs = 0.f;
                    for (int t = 0; t < L; ++t) {
                        const size_t row = (size_t)b * L + t;
                        const float xc = bf1(XLC[row * 512 + blk * 64 + j]);
                        float ra = bA, ri = bX;
#pragma unroll
                        for (int i = 0; i < 64; ++i) { const float xi = __shfl(xc, i); ra += xi * bf1(wA[i * 64 + j]); ri += xi * bf1(wX[i * 64 + j]); }
                        const float r = sigmoidf_(ra), ig = sigmoidf_(ri);
                        const float log_a = -8.0f * r * sp, a = __expf(log_a);
                        const float mult = sqrtf(fmaxf(-expm1f(2.0f * log_a), 0.f));
                        hs = a * hs + mult * ig * xc;
                        BR[row * 2048 + 1536 + blk * 64 + j] = (bf16)f2bf(hs * gelu_tanh(bf1(PROJB[row * PJ + C_GL + blk * 64 + j])));
                    }
                }
            }
#else
            const int NMIXB = G >= 192 ? MK_NMIXB : G / 2;
            if (vcu >= NMIXB) {
                if (layer == 0) {
                    { const int gw = (vcu - NMIXB) * NWAVES + wave, NGW = (G - NMIXB) * NWAVES; int rot = 0;
                      CVT_LOOP(16 * 16, MapPlain m{xa_wo, D, D, nullptr, 1.f, (bf16*)(ws + WS_W + WL_WO), D});
                      CVT_LOOP(16 * 88, MapW13 m{ffn_w1, ffn_w3, norm_ffn, W13, DFF, 2 * DFF});
                      CVT_LOOP(44 * 16, MapPlain m{ffn_w2, DFF, D, nullptr, 1.f, W2T, DFF});
                      { unsigned char* wl = ws + WS_W + WL_STRIDE;
                        { for (int it = (gw + NGW - rot % NGW) % NGW; it < 16 * 140; it += NGW) { if (it % 140 < 76) { MapWin m{w_in + (size_t)D * IN_TOTAL, norm_mix + D, (bf16*)(wl + WL_WIN), 8960}; cvt_item(m, it, scr, lane); }
                            else { MapWin m{w_in + (size_t)D * IN_TOTAL, norm_mix + D, (bf16*)(wl + WL_WIN + (size_t)4864 * 2048 - (size_t)4864 * 1024), 8960}; cvt_item8(m, it, scr, lane, 64.0f, 1024); } } rot += 16 * 140; }
                        CVT_LOOP(8 * 8, MapPlain m{opqp(p.in[14]) + (size_t)512 * 512, 512, 512, nullptr, 1.f, (bf16*)(wl + WL_GLU), 512});
                        for (int k = 0; k < 4; ++k) CVT_LOOP(8 * 16, MapPlain m{w_branch + ((size_t)4 + k) * 512 * 1024, 512, 1024, nullptr, 1.f, (bf16*)(wl + WL_WB) + k * 512, 2048});
                        CVT_LOOP(16 * 16, MapPlain m{w_out + (size_t)D * D, D, D, nullptr, 1.f, (bf16*)(wl + WL_WOUT), D});
                        CVT_LOOP(16 * 16, MapPlain m{xa_wo + (size_t)D * D, D, D, nullptr, 1.f, (bf16*)(wl + WL_WO), D}); } }
                    for (int ll = 0; ll < 2; ++ll) {
                        const float* wq = xa_wq + (size_t)ll * D * D; const float* nx = norm_xa + ll * D; bf16* dq = (bf16*)(ws + WS_W + (size_t)ll * WL_STRIDE + WL_WQ);
                        for (int i8 = ((vcu - NMIXB) * NWAVES + wave) * 64 + lane; i8 < D * D / 8; i8 += (G - NMIXB) * NWAVES * 64) { const float sc = nx[i8 >> 7] * 0.0625f;
                            const f32x4 v0 = *(const f32x4*)(wq + (size_t)i8 * 8), v1 = *(const f32x4*)(wq + (size_t)i8 * 8 + 4);
                            v4u o; o.x = pg8::cvt_pk_bf16(v0[0] * sc, v0[1] * sc); o.y = pg8::cvt_pk_bf16(v0[2] * sc, v0[3] * sc); o.z = pg8::cvt_pk_bf16(v1[0] * sc, v1[1] * sc); o.w = pg8::cvt_pk_bf16(v1[2] * sc, v1[3] * sc);
                            *(v4u*)(dq + (size_t)i8 * 8) = o; } }
                    __syncthreads();
                    pg8::Gemm g{1024, 1024, 1024}; pg8::KVOrder S; S.mnr_ = (const char*)MNR; S.WKV0 = (const char*)(ws + WS_W + WL_WKV); S.WKV1 = (const char*)(ws + WS_W + WL_STRIDE + WL_WKV); S.G = G - NMIXB; S.c = vcu - NMIXB;
                    pg8::EpiKV E{KVB};
                    pg8::gemm_phase<pg8::EpiKV, pg8::KVOrder, true, true>(lds, g, S, E, wave_s);
                }
                using POF = std::conditional<true, pg8::PlainOrderOffF8, pg8::PlainOrderOff>::type; constexpr int ldw = 512; constexpr float psc = 1.0f / 64.0f;
                pg8::Gemm g{ldw, ldw, ldw}; POF S; S.A = layer == 1 ? (const char*)HN8L1 : (const char*)H; S.B = (const char*)WIN + (size_t)4864 * 2048 - (size_t)4864 * 1024;     S.nM = 64; S.nN = 16; S.lda = ldw; S.ldb = ldw; S.G = G - NMIXB; S.c = vcu - NMIXB; S.pn0 = 19; S.L0 = 0; S.L1 = (layer == 0 ? MK_GW0 : MK_GW1) - (layer == 0 ? MK_TAIL0 : MK_TAIL1);
                pg8::EpiProj E{PROJB, GATE, b_gate + layer * 4096, psc};
                pg8::gemm_phase<pg8::EpiProj, POF, true, true>(lds, g, S, E, wave_s);
            } else
            for (int wu = wave * NMIXB + vcu; wu < 768; wu += NMIXB * NWAVES) {
#ifdef MK_MIXONLY
                if ((wu < 256 ? 0 : wu < 512 ? 1 : 2) != MK_MIXONLY) continue;
#endif
                LAS unsigned char* sl = (LAS unsigned char*)scr; const int ln_ = lane_id_fresh();
                if (wu < 256) {
                    const int ty = wu >> 7, uu = wu & 127, b = uu >> 4, hh = (uu >> 1) & 7, eh = uu & 1; const size_t r0 = (size_t)b * L;
                    if (ty == 0) { const int g = hh >> 2; const float Aa = -__expf(opqp(p.in[18])[layer * 8 + hh]);
                        linattn_unit(XBCC + r0 * 768 + 640 + g * 64, 768, XBCC + r0 * 768 + 512 + g * 64, 768, XBCC + r0 * 768 + hh * 64 + eh * 32, 768, DT + r0 * 8 + hh, Aa * 1.4426950408889634f, opqp(p.in[19])[layer * 8 + hh],
                                     BR + r0 * 2048 + 512 + hh * 64 + eh * 32, 2048, sl, ln_); }
                    else { const float lg = log2f(1.0f - exp2f(-5.0f - (float)hh));
                        linattn_unit(PROJB + r0 * PJ + C_Q + hh * 64, PJ, PROJB + r0 * PJ + C_K + hh * 64, PJ, PROJB + r0 * PJ + C_V + hh * 64 + eh * 32, PJ, nullptr, lg, 0.f,
                                     BR + r0 * 2048 + 1024 + hh * 64 + eh * 32, 2048, sl, ln_); }
                } else if (wu < 512) {
                    const int un = wu - 256, b = un >> 5, g = un & 31; const size_t r0 = (size_t)b * L;
                    s5_unit(PROJB + r0 * PJ + C_U + g * 16, YS + r0 * 512 + g * 16, opqp(p.in[6]) + layer * 2048 + g * 64, opqp(p.in[7]) + layer * 2048 + g * 64, opqp(p.in[8]) + layer * 32768 + g * 1024, opqp(p.in[9]) + layer * 32768 + g * 1024,
                            opqp(p.in[10]) + layer * 32768 + g * 1024, opqp(p.in[11]) + layer * 32768 + g * 1024, opqp(p.in[12]) + layer * 512 + g * 16, expf(opqp(p.in[13])[layer * 32 + g]), sl, ln_);
                } else {
                    const int un = wu - 512, b = un >> 5, blk = (un >> 2) & 7, jq = un & 3, ch = blk * 64 + jq * 16 + (ln_ & 15); const size_t r0 = (size_t)b * L;
                    lru_unit(XLC + r0 * 512 + blk * 64, PROJB + r0 * PJ + C_GL + blk * 64, BR + r0 * 2048 + 1536 + blk * 64 + jq * 16, opqp(p.in[24]) + layer * 32768 + blk * 4096, opqp(p.in[26]) + layer * 32768 + blk * 4096,
                             opqp(p.in[25])[layer * 512 + ch], opqp(p.in[27])[layer * 512 + ch], softplusf_(-opqp(p.in[28])[layer * 512 + ch]), jq, ln_);
                }
            }
            if (vcu < NMIXB && (layer == 0 ? MK_TAIL0 : MK_TAIL1) > 0) {
                __syncthreads();
                pg8::Gemm g{1024, 1024, 1024}; pg8::PlainOrderOff S; S.A = (const char*)HN; S.B = (const char*)WIN; S.nM = 64; S.nN = 16; S.lda = 1024; S.ldb = 1024; S.G = NMIXB; S.c = vcu; S.pn0 = 19; S.L0 = (layer == 0 ? MK_GW0 : MK_GW1) - (layer == 0 ? MK_TAIL0 : MK_TAIL1); S.L1 = (layer == 0 ? MK_GW0 : MK_GW1);
                pg8::EpiProj E{PROJB, GATE, b_gate + layer * 4096, 1.0f};
                pg8::gemm_phase<pg8::EpiProj, pg8::PlainOrderOff, true, true>(lds, g, S, E, wave_s);
            }
#endif
            GRID_BARC(3);
        }
        if (IN(pb + 3)) { PH_VARS
            const float* snw = opqp(p.in[20]) + layer * 512; const float* rnw = opqp(p.in[21]) + layer * 512;
            for (int row = gw; row < T; row += NGW) {
                bf16* y = BR + (size_t)row * 2048; const bf16* pr = PROJB + (size_t)row * PJ;
                {
                    const v4u yw = *(const v4u*)(y + 512 + 8 * lane), zw = *(const v4u*)(pr + C_Z + 8 * lane);
                    float v[8] = {bflo(yw.x), bfhi(yw.x), bflo(yw.y), bfhi(yw.y), bflo(yw.z), bfhi(yw.z), bflo(yw.w), bfhi(yw.w)};
                    const float z[8] = {bflo(zw.x), bfhi(zw.x), bflo(zw.y), bfhi(zw.y), bflo(zw.z), bfhi(zw.z), bflo(zw.w), bfhi(zw.w)};
                    float ss = 0.f;
#pragma unroll
                    for (int q = 0; q < 8; ++q) { v[q] *= siluf_(z[q]); ss += v[q] * v[q]; }
                    const float r = 1.0f / sqrtf(wave_sum(ss) * (1.0f / 512.0f) + 1e-6f);
#pragma unroll
                    for (int q = 0; q < 8; ++q) v[q] *= r * snw[8 * lane + q];
                    v4u o; o.x = pk2(v[0], v[1]); o.y = pk2(v[2], v[3]); o.z = pk2(v[4], v[5]); o.w = pk2(v[6], v[7]);
                    *(v4u*)(y + 512 + 8 * lane) = o;
                }
                {
                    const v4u yw = *(const v4u*)(y + 1024 + 8 * lane), gw_ = *(const v4u*)(pr + C_G + 8 * lane);
                    float v[8] = {bflo(yw.x), bfhi(yw.x), bflo(yw.y), bfhi(yw.y), bflo(yw.z), bfhi(yw.z), bflo(yw.w), bfhi(yw.w)};
                    const float gg[8] = {bflo(gw_.x), bfhi(gw_.x), bflo(gw_.y), bfhi(gw_.y), bflo(gw_.z), bfhi(gw_.z), bflo(gw_.w), bfhi(gw_.w)};
                    float s = 0.f;
#pragma unroll
                    for (int q = 0; q < 8; ++q) s += v[q];
                    s = sum8(s);
                    const float mu = s * (1.0f / 64.0f); float q2 = 0.f;
#pragma unroll
                    for (int q = 0; q < 8; ++q) { v[q] -= mu; q2 += v[q] * v[q]; }
                    q2 = sum8(q2);
                    const float rs = 1.0f / sqrtf(q2 * (1.0f / 64.0f) + 1e-6f);
#pragma unroll
                    for (int q = 0; q < 8; ++q) v[q] = siluf_(gg[q]) * (v[q] * rs * rnw[8 * lane + q]);
                    v4u o; o.x = pk2(v[0], v[1]); o.y = pk2(v[2], v[3]); o.z = pk2(v[4], v[5]); o.w = pk2(v[6], v[7]);
                    *(v4u*)(y + 1024 + 8 * lane) = o;
                }
            }
            pg8::Gemm g{512, 512, 512}; pg8::PlainOrder S; S.A = (const char*)YSB; S.B = (const char*)WGLU; S.nM = 64; S.nN = 2; S.lda = 512; S.ldb = 512; S.G = G; S.c = bx;
            pg8::EpiGlu E{YSB, BR};
            pg8::gemm_phase<pg8::EpiGlu, pg8::PlainOrder, true, true>(lds, g, S, E, wave_s);
            {
                const int qoff = G >= 256 ? 128 : 0;
                pg8::Gemm gq{1024, 1024, 256}; pg8::QKWOrder Sq; Sq.kx_ = (const char*)KX; Sq.wqn_ = (const char*)WQ; Sq.G = G - qoff; Sq.c = bx - qoff;
                pg8::EpiStore Eq{QKW, 1024};
                pg8::gemm_phase<pg8::EpiStore, pg8::QKWOrder, false, false>(lds, gq, Sq, Eq, wave_s);
            }
            if ((layer == 0 ? MK_GW0 : MK_GW1) < 1024) {
                using POF2 = std::conditional<true, pg8::PlainOrderOffF8, pg8::PlainOrderOff>::type; constexpr int ldw2 = 512; constexpr float psc2 = 1.0f / 64.0f;
                pg8::Gemm g2{ldw2, ldw2, ldw2}; POF2 S2; S2.A = layer == 1 ? (const char*)HN8L1 : (const char*)H; S2.B = (const char*)WIN + (size_t)4864 * 2048 - (size_t)4864 * 1024; S2.nM = 64; S2.nN = 16; S2.lda = ldw2; S2.ldb = ldw2; S2.G = G; S2.c = vcu; S2.pn0 = 19; S2.L0 = (layer == 0 ? MK_GW0 : MK_GW1); S2.L1 = 1024;
                pg8::EpiProj E2{PROJB, GATE, b_gate + layer * 4096, psc2};
                pg8::gemm_phase<pg8::EpiProj, POF2, true, true>(lds, g2, S2, E2, wave_s);
            }
            GRID_BARC(4);
        }
        if (IN(pb + 4)) { PH_VARS
#ifdef MK_EXP_A
            pg8::Gemm g{2048, 2048, 2048}; pg8::PlainOrder S; S.A = (const char*)BR; S.B = (const char*)WB; S.nM = 64; S.nN = 4; S.lda = 2048; S.ldb = 2048; S.G = G; S.c = bx;
            pg8::EpiStore E{MERGED, 1024};
            pg8::gemm_phase<pg8::EpiStore, pg8::PlainOrder, true, true>(lds, g, S, E, wave_s);
#else
            pg8::Gemm g{2048, 2048, 512}; pg8::MergeOrder S; S.br_ = (const char*)BR; S.wb_ = (const char*)WB; S.G = G; S.c = bx;
            pg8::EpiMerge E{GATE, MERGED};
            pg8::gemm_phase<pg8::EpiMerge, pg8::MergeOrder, true, true>(lds, g, S, E, wave_s);
#endif
            GRID_BARC(5);
        }
        if (IN(pb + 5)) { PH_VARS
            pg8::Gemm g{1024, 1024, 1024}; pg8::PlainOrder S; S.A = (const char*)MERGED; S.B = (const char*)WOUT; S.nM = 64; S.nN = 4; S.lda = 1024; S.ldb = 1024; S.G = G; S.c = bx;
            pg8::EpiRes E{layer == 0 ? x_ : (const float*)H, H};
            pg8::gemm_phase<pg8::EpiRes, pg8::PlainOrder, true, true>(lds, g, S, E, wave_s);
            GRID_BARC(6);
        }
        if (IN(pb + 6)) { PH_VARS
            {
                const int voff = G >= 256 ? G - 128 : 0;
                pg8::Gemm gv{1024, 1024, 256}; pg8::VWOOrder Sv; Sv.wo_ = (const char*)WO; Sv.v_ = (const char*)VT; Sv.G = G - voff; Sv.c = bx - voff;
                pg8::EpiStore Ev{VWO, 1024};
                pg8::gemm_phase<pg8::EpiStore, pg8::VWOOrder, false, false>(lds, gv, Sv, Ev, wave_s);
            }
            norm_rows(H, HN, T, gw, NGW, lane, NoPost{});
            GRID_BARC(7);
        }
        if (IN(pb + 8)) { PH_VARS
            pg8::Gemm g{1024, 1024, 1024}; pg8::ScoreOrder S; S.hn_ = (const char*)HN; S.qkw_ = (const char*)QKW; S.G = G; S.c = bx;
            pg8::EpiSoftmax E{PB, (PG8_LAS float*)xch};
            for (int sb = 0; sb < 256; sb += G) { S.base = sb; pg8::gemm_phase<pg8::EpiSoftmax, pg8::ScoreOrder, false, false>(lds, g, S, E, wave_s); }
            GRID_BARC(9);
        }
        if (IN(pb + 10)) { PH_VARS
            pg8::Gemm g{1024, 1024, 1024}; pg8::PVWOrder S; S.p_ = (const char*)PB; S.vwo_ = (const char*)VWO; S.G = G; S.c = bx;
            pg8::EpiRes E{H, H};
            pg8::gemm_phase<pg8::EpiRes, pg8::PVWOrder, true, true>(lds, g, S, E, wave_s);
            GRID_BARC(11);
        }
        if (layer == 0) {
            if (IN(pb + 11)) { PH_VARS
                norm_rows(H, HN, T, gw, NGW, lane, NoPost{});
                GRID_BARC(7);
            }
            if (IN(pb + 12)) { PH_VARS
                pg8::Gemm g{1024, 1024, 1024}; pg8::PlainOrder S; S.A = (const char*)HN; S.B = (const char*)W13; S.nM = 64; S.nN = 22; S.lda = 1024; S.ldb = 1024; S.G = G; S.c = bx;
                pg8::EpiSwiglu E{ACT, DFF, 1.0f};
                pg8::gemm_phase<pg8::EpiSwiglu, pg8::PlainOrder, true, true>(lds, g, S, E, wave_s);
                GRID_BARC(12);
            }
            if (IN(pb + 13)) { PH_VARS
                pg8::Gemm g{DFF, DFF, DFF}; pg8::PlainOrder S; S.A = (const char*)ACT; S.B = (const char*)W2T; S.nM = 64; S.nN = 4; S.lda = DFF; S.ldb = DFF; S.G = G; S.c = bx;
                pg8::EpiRes E{H, H};
                pg8::gemm_phase<pg8::EpiRes, pg8::PlainOrder, true, true>(lds, g, S, E, wave_s);
                GRID_BARC(13);
            }
            if (IN(pb + 14)) { PH_VARS
                for (int i = tid; i < 8192; i += 512) w8[i] = norm_mix[D + (i >> 3)] * w_in[(size_t)D * IN_TOTAL + (size_t)(i >> 3) * IN_TOTAL + O_DT + (i & 7)];
                __syncthreads();
                norm_rows(H, HN, T, gw, NGW, lane, [&](const int row, const float r, const f32x4 (&v)[4]) { float lg[8]; row_dot8(v, w8, lane, lg);
                    float mine = 0.f;
#pragma unroll
                    for (int e = 0; e < 8; ++e) if (lane == e) mine = lg[e];
                    if (lane < 8) DT[(size_t)row * 8 + lane] = softplusf_(r * mine + opqp(p.in[17])[8 + lane]);
                    { unsigned* h8 = (unsigned*)(HN8L1 + (size_t)row * 1024) + lane;
#pragma unroll
                      for (int j = 0; j < 4; ++j) { int p8 = 0; p8 = __builtin_amdgcn_cvt_pk_fp8_f32(v[j].x * r, v[j].y * r, p8, false); p8 = __builtin_amdgcn_cvt_pk_fp8_f32(v[j].z * r, v[j].w * r, p8, true); h8[64 * j] = (unsigned)p8; } } });
                __syncthreads();
                GRID_BARC(7);
            }
        } else {
            if (IN(pb + 11)) { PH_VARS
                for (int i = tid; i < 8192; i += 512) w8[i] = norm_ffn[D + (i >> 3)] * moe_router[i];
                LAS int* lcnt = (LAS int*)(lds + 40960); LAS int* lbase = lcnt + 8; LAS i32x4* lti = (LAS i32x4*)(lds + 41984);
                if (tid < 8) lcnt[tid] = 0;
                __syncthreads();
                { int it = 0;
                norm_rows(H, HN, T, gw, NGW, lane, [&](const int row, const float r, const f32x4 (&v)[4]) { float lg[8]; row_dot8(v, w8, lane, lg);
                    { unsigned* h8 = (unsigned*)(HN8 + (size_t)row * 1024) + lane;
#pragma unroll
                      for (int j = 0; j < 4; ++j) { int p8 = 0; p8 = __builtin_amdgcn_cvt_pk_fp8_f32(v[j].x * r, v[j].y * r, p8, false); p8 = __builtin_amdgcn_cvt_pk_fp8_f32(v[j].z * r, v[j].w * r, p8, true); h8[64 * j] = (unsigned)p8; } }
                    if (lane == 0) {
                        int i1 = 0; float v1 = lg[0];
#pragma unroll
                        for (int e = 1; e < 8; ++e) if (lg[e] > v1) { v1 = lg[e]; i1 = e; }
                        int i2 = 0; float v2 = -3.0e38f;
#pragma unroll
                        for (int e = 0; e < 8; ++e) if (e != i1 && lg[e] > v2) { v2 = lg[e]; i2 = e; }
                        const float w1 = 1.0f / (1.0f + expf(r * (v2 - v1))), w2 = 1.0f - w1;
                        const int r1 = __hip_atomic_fetch_add(lcnt + i1, 1, __ATOMIC_RELAXED, __HIP_MEMORY_SCOPE_WORKGROUP), r2 = __hip_atomic_fetch_add(lcnt + i2, 1, __ATOMIC_RELAXED, __HIP_MEMORY_SCOPE_WORKGROUP);
                        lti[wave * 32 + (it & 31)] = (i32x4){i1, i2, r1, r2}; TOPW[row] = (f32x2){w1, w2};
                    } ++it; }); }
                __syncthreads();
                if (tid < 8) lbase[tid] = atomicAdd(&CNT[tid], lcnt[tid]);
                __syncthreads();
                { int it = 0;
                for (int row = gw; row < T; row += NGW, ++it) if (lane == 0) { i32x4 ti = lti[wave * 32 + (it & 31)]; ti.z += lbase[ti.x]; ti.w += lbase[ti.y]; TOPI[row] = ti; } }
                __syncthreads();
                {
                    int rot = 0;
                    for (int e = 0; e < NE; ++e) {
                        CVT_LOOP8(16 * 112, 64.0f, 1024, MapW13 m{moe_w1 + (size_t)e * D * DFE, moe_w3 + (size_t)e * D * DFE, norm_ffn + D, (bf16*)((unsigned char*)W13E + (size_t)e * 2 * DFE * D), DFE, 2 * DFE});
                        CVT_LOOP8(56 * 16, 64.0f, DFE, MapPlain m{moe_w2 + (size_t)e * DFE * D, DFE, D, nullptr, 1.f, (bf16*)((unsigned char*)W2E + (size_t)e * D * DFE), DFE});
                    }
                }
                GRID_BARC(14);
            }
            int t1 = 0, t2 = 0, t3 = 0, t4 = 0, t5 = 0, t6 = 0, t7 = 0, ntiles = 0;
            if (lo <= pb + 14 && hi > pb + 12) {
                int acc = 0;
#pragma unroll
                for (int e = 0; e < 8; ++e) { const int c = __hip_atomic_load(&CNT[e], RLX_AGENT); acc += (c + 255) >> 8;
                    if (e == 0) t1 = acc; if (e == 1) t2 = acc; if (e == 2) t3 = acc; if (e == 3) t4 = acc; if (e == 4) t5 = acc; if (e == 5) t6 = acc; if (e == 6) t7 = acc; if (e == 7) ntiles = acc; }
            }
            if (IN(pb + 12)) { PH_VARS
                for (int row = gw; row < T; row += NGW) {
                    const i32x4 ti = TOPI[row];
                    const int e1 = ti.x, e2 = ti.y;
                    const int s1 = (e1 == 0 ? 0 : e1 == 1 ? t1 : e1 == 2 ? t2 : e1 == 3 ? t3 : e1 == 4 ? t4 : e1 == 5 ? t5 : e1 == 6 ? t6 : t7) * 256 + ti.z;
                    const int s2 = (e2 == 0 ? 0 : e2 == 1 ? t1 : e2 == 2 ? t2 : e2 == 3 ? t3 : e2 == 4 ? t4 : e2 == 5 ? t5 : e2 == 6 ? t6 : t7) * 256 + ti.w;
                    { const v4u a8 = *((const v4u*)(HN8 + (size_t)row * 1024) + lane); *((v4u*)(XS8 + (size_t)s1 * 1024) + lane) = a8; *((v4u*)(XS8 + (size_t)s2 * 1024) + lane) = a8; }
                    if (lane == 0) SLOT[row] = (i32x2){s1, s2};
                }
                GRID_BARC(15);
            }
            if (IN(pb + 13)) { PH_VARS
                pg8::Gemm g{512, 512, 512}; pg8::MoeUpF8 S; S.A = (const char*)XS8; S.B = (const char*)W13E; S.estride = (size_t)2 * DFE * D; S.lda = 512; S.ldb = 512; S.ntiles = ntiles; S.nN = 28; S.G = G; S.c = bx;
                S.t1 = t1; S.t2 = t2; S.t3 = t3; S.t4 = t4; S.t5 = t5; S.t6 = t6; S.t7 = t7;
                pg8::EpiSwigluF8 E{(unsigned char*)ACTE, DFE, 1.0f / 64.0f, 2.0f};
                pg8::gemm_phase<pg8::EpiSwigluF8, pg8::MoeUpF8, false, true>(lds, g, S, E, wave_s);
                GRID_BARC(16);
            }
            if (IN(pb + 14)) { PH_VARS
                { pg8::Gemm g{DFE / 2, DFE / 2, DFE / 2}; pg8::MoeDownOrderF8 S; S.A = (const char*)ACTE; S.B = (const char*)W2E; S.estride = (size_t)D * DFE; S.lda = DFE / 2; S.ldb = DFE / 2; S.G = G; S.c = vcu;
                  S.t1 = t1; S.t2 = t2; S.t3 = t3; S.t4 = t4; S.t5 = t5; S.t6 = t6; S.t7 = t7;
                  pg8::EpiStoreS E{XS, 1024, 1.0f / 128.0f};
                  pg8::gemm_phase<pg8::EpiStoreS, pg8::MoeDownOrderF8, true, true>(lds, g, S, E, wave_s); }
                { pg8::Gemm g{DFE / 2, DFE / 2, 256}; pg8::MoeDownTailF8 S; S.A = (const char*)ACTE; S.B = (const char*)W2E; S.estride = (size_t)D * DFE; S.lda = DFE / 2; S.ldb = DFE / 2; S.ntiles = ntiles; S.G = G; S.c = vcu;
                  S.t1 = t1; S.t2 = t2; S.t3 = t3; S.t4 = t4; S.t5 = t5; S.t6 = t6; S.t7 = t7;
                  pg8::EpiPartF32S E{YPART, 1.0f / 128.0f};
                  pg8::gemm_phase<pg8::EpiPartF32S, pg8::MoeDownTailF8, true, true>(lds, g, S, E, wave_s); }
                GRID_BARC(17);
            }
            if (IN(pb + 15)) { PH_VARS
                const unsigned bad = __hip_atomic_load(ctl + CW_BAR + XB_TMO, RLX_AGENT);
                for (int row = gw; row < T; row += NGW) {
                    const i32x2 sl = SLOT[row]; const f32x2 tw = TOPW[row];
                    const f32x4* hr = (const f32x4*)(H + (size_t)row * D) + lane;
                    f32x4 v[4]; float ss = 0.f;
#pragma unroll
                    for (int j = 0; j < 4; ++j) v[j] = hr[64 * j];
#pragma unroll
                    for (int k = 0; k < 2; ++k) { const int s_ = k ? sl.y : sl.x; const float w_ = k ? tw.y : tw.x;
                        if (s_ < 32768) { const v2u* y = (const v2u*)(XS + (size_t)s_ * D) + lane;
#pragma unroll
                            for (int j = 0; j < 4; ++j) { const v2u a = y[64 * j]; v[j].x += w_ * bflo(a.x); v[j].y += w_ * bfhi(a.x); v[j].z += w_ * bflo(a.y); v[j].w += w_ * bfhi(a.y); } }
                        else { const f32x4* yp = (const f32x4*)(YPART + ((size_t)((s_ >> 8) - 128) * 7 * 256 + (s_ & 255)) * 1024) + lane;
                            for (int p7 = 0; p7 < 7; ++p7)
#pragma unroll
                                for (int j = 0; j < 4; ++j) v[j] += yp[(size_t)p7 * 256 * 256 + 64 * j] * w_; } }
#pragma unroll
                    for (int j = 0; j < 4; ++j) ss += (v[j].x * v[j].x + v[j].y * v[j].y) + (v[j].z * v[j].z + v[j].w * v[j].w);
                    float r = 1.0f / sqrtf(wave_sum(ss) * (1.0f / 1024.0f) + 1e-6f);
                    if (bad) r = __builtin_nanf("");
                    f32x4* orow = (f32x4*)(H + (size_t)row * D) + lane;
#pragma unroll
                    for (int j = 0; j < 4; ++j) { const f32x4 g4 = *((const f32x4*)norm_final + lane + 64 * j); orow[64 * j] = v[j] * r * g4; }
                }
            }
        }
        }
    { constexpr int layer = 1;
        const int pb = 1 + layer * 20;
#define WLP (ws + WS_W + (size_t)layer * WL_STRIDE)
#define WIN ((const bf16*)(WLP + WL_WIN))
#define WGLU ((const bf16*)(WLP + WL_GLU))
#define WB ((const bf16*)(WLP + WL_WB))
#define WOUT ((const bf16*)(WLP + WL_WOUT))
#define WQ ((const bf16*)(WLP + WL_WQ))
#define WO ((const bf16*)(WLP + WL_WO))
#define KX (KVB + (size_t)layer * 4194304)
#define VT (KX + 2097152)
        if (IN(pb + 0)) { PH_VARS
            pg8::Gemm g{1024, 1024, 1024}; pg8::PlainOrder S; S.A = (const char*)HN; S.B = (const char*)WIN; S.nM = 64; S.nN = 19; S.lda = 1024; S.ldb = 1024; S.G = G; S.c = bx;
            pg8::EpiProj E{PROJB, GATE, b_gate + layer * 4096, 1.0f};
            pg8::gemm_phase<pg8::EpiProj, pg8::PlainOrder, true, true>(lds, g, S, E, wave_s);
            GRID_BARC(1);
        }
        if (IN(pb + 1)) { PH_VARS
            const float* cw = opqp(p.in[15]) + layer * 4 * 768; const float* cb = opqp(p.in[16]) + layer * 768; const float* lw = opqp(p.in[22]) + layer * 4 * 512; const float* lb = opqp(p.in[23]) + layer * 512;
            for (int it = gt; it < T * 224; it += NGT) {
                const int row = it / 224, j = it % 224, t = row & (L - 1);
                if (j < 160) {
                    const bool isx = j < 96; const int c0 = isx ? j * 8 : (j - 96) * 8, C = isx ? 768 : 512; const float* w = isx ? cw : lw; const float* bb = isx ? cb : lb;
                    const bf16* src = PROJB + (size_t)row * PJ + (isx ? C_XBC : C_XL) + c0;
                    float acc[8];
#pragma unroll
                    for (int q = 0; q < 8; ++q) acc[q] = bb[c0 + q];
#pragma unroll
                    for (int tap = 0; tap < 4; ++tap) { if (t - 3 + tap >= 0) { const v4u xv = *(const v4u*)(src - (ptrdiff_t)(3 - tap) * PJ); const float* wt = w + tap * C + c0;
                        acc[0] += wt[0] * bflo(xv.x); acc[1] += wt[1] * bfhi(xv.x); acc[2] += wt[2] * bflo(xv.y); acc[3] += wt[3] * bfhi(xv.y);
                        acc[4] += wt[4] * bflo(xv.z); acc[5] += wt[5] * bfhi(xv.z); acc[6] += wt[6] * bflo(xv.w); acc[7] += wt[7] * bfhi(xv.w); } }
                    if (isx) {
#pragma unroll
                        for (int q = 0; q < 8; ++q) acc[q] = siluf_(acc[q]); }
                    v4u o; o.x = pk2(acc[0], acc[1]); o.y = pk2(acc[2], acc[3]); o.z = pk2(acc[4], acc[5]); o.w = pk2(acc[6], acc[7]);
                    *(v4u*)((isx ? XBCC + (size_t)row * 768 : XLC + (size_t)row * 512) + c0) = o;
                } else {
                    const bool isk = j >= 192; const int jj = isk ? j - 192 : j - 160, h = jj >> 2, i0 = (jj & 3) * 8; const float sc = isk ? 0.125f : 1.0f;
                    bf16* q1 = PROJB + (size_t)row * PJ + (isk ? C_K : C_Q) + h * 64 + i0; bf16* q2 = q1 + 32;
                    const v4u a = *(const v4u*)q1, b = *(const v4u*)q2;
                    const f32x4 c0v = *(const f32x4*)(COS + (size_t)row * 32 + i0), c1v = *(const f32x4*)(COS + (size_t)row * 32 + i0 + 4), s0v = *(const f32x4*)(SIN + (size_t)row * 32 + i0), s1v = *(const f32x4*)(SIN + (size_t)row * 32 + i0 + 4);
                    const float x1[8] = {bflo(a.x), bfhi(a.x), bflo(a.y), bfhi(a.y), bflo(a.z), bfhi(a.z), bflo(a.w), bfhi(a.w)};
                    const float x2[8] = {bflo(b.x), bfhi(b.x), bflo(b.y), bfhi(b.y), bflo(b.z), bfhi(b.z), bflo(b.w), bfhi(b.w)};
                    const float cc[8] = {c0v.x, c0v.y, c0v.z, c0v.w, c1v.x, c1v.y, c1v.z, c1v.w}, ss[8] = {s0v.x, s0v.y, s0v.z, s0v.w, s1v.x, s1v.y, s1v.z, s1v.w};
                    float o1[8], o2[8];
#pragma unroll
                    for (int q = 0; q < 8; ++q) { o1[q] = (x1[q] * cc[q] - x2[q] * ss[q]) * sc; o2[q] = (x2[q] * cc[q] + x1[q] * ss[q]) * sc; }
                    v4u w1; w1.x = pk2(o1[0], o1[1]); w1.y = pk2(o1[2], o1[3]); w1.z = pk2(o1[4], o1[5]); w1.w = pk2(o1[6], o1[7]);
                    v4u w2; w2.x = pk2(o2[0], o2[1]); w2.y = pk2(o2[2], o2[3]); w2.z = pk2(o2[4], o2[5]); w2.w = pk2(o2[6], o2[7]);
                    *(v4u*)q1 = w1; *(v4u*)q2 = w2;
                }
            }
            GRID_BARC(2);
        }
        if (IN(pb + 2)) { PH_VARS
            bf16* YS = YSB;
#ifdef MK_NAIVE_MIX
            for (int wu = gw; wu < 832; wu += NGW) {
                if (wu < 256) {
                    const int un = wu >> 2, sub = wu & 3, b = un >> 3, hh = un & 7, g = hh >> 2, pp = sub * 16 + (lane >> 2), nq = lane & 3;
                    const float Aa = -__expf(opqp(p.in[18])[layer * 8 + hh]), Dk = opqp(p.in[19])[layer * 8 + hh];
                    float S[16];
#pragma unroll
                    for (int j = 0; j < 16; ++j) S[j] = 0.f;
                    for (int t = 0; t < L; ++t) {
                        const size_t row = (size_t)b * L + t; const bf16* xr = XBCC + row * 768;
                        const float dtv = DT[row * 8 + hh], xv = bf1(xr[hh * 64 + pp]);
                        const v4u b0 = *(const v4u*)(xr + 512 + g * 64 + nq * 16), b1 = *(const v4u*)(xr + 512 + g * 64 + nq * 16 + 8), c0 = *(const v4u*)(xr + 640 + g * 64 + nq * 16), c1 = *(const v4u*)(xr + 640 + g * 64 + nq * 16 + 8);
                        const float Bv[16] = {bflo(b0.x), bfhi(b0.x), bflo(b0.y), bfhi(b0.y), bflo(b0.z), bfhi(b0.z), bflo(b0.w), bfhi(b0.w), bflo(b1.x), bfhi(b1.x), bflo(b1.y), bfhi(b1.y), bflo(b1.z), bfhi(b1.z), bflo(b1.w), bfhi(b1.w)};
                        const float Cv[16] = {bflo(c0.x), bfhi(c0.x), bflo(c0.y), bfhi(c0.y), bflo(c0.z), bfhi(c0.z), bflo(c0.w), bfhi(c0.w), bflo(c1.x), bfhi(c1.x), bflo(c1.y), bfhi(c1.y), bflo(c1.z), bfhi(c1.z), bflo(c1.w), bfhi(c1.w)};
                        const float da = __expf(dtv * Aa), xdt = xv * dtv; float acc = 0.f;
#pragma unroll
                        for (int j = 0; j < 16; ++j) { S[j] = da * S[j] + xdt * Bv[j]; acc += Cv[j] * S[j]; }
                        acc += __shfl_xor(acc, 1); acc += __shfl_xor(acc, 2);
                        if (nq == 0) BR[row * 2048 + 512 + hh * 64 + pp] = (bf16)f2bf(acc + Dk * xv);
                    }
                } else if (wu < 512) {
                    const int un = (wu - 256) >> 2, sub = wu & 3, b = un >> 3, hh = un & 7, e = sub * 16 + (lane >> 2), dq = lane & 3;
                    const float gamma = 1.0f - exp2f(-5.0f - (float)hh);
                    float S[16];
#pragma unroll
                    for (int j = 0; j < 16; ++j) S[j] = 0.f;
                    for (int t = 0; t < L; ++t) {
                        const size_t row = (size_t)b * L + t; const bf16* pr = PROJB + row * PJ;
                        const float vv = bf1(pr[C_V + hh * 64 + e]);
                        const v4u k0 = *(const v4u*)(pr + C_K + hh * 64 + dq * 16), k1 = *(const v4u*)(pr + C_K + hh * 64 + dq * 16 + 8), q0 = *(const v4u*)(pr + C_Q + hh * 64 + dq * 16), q1 = *(const v4u*)(pr + C_Q + hh * 64 + dq * 16 + 8);
                        const float Kv[16] = {bflo(k0.x), bfhi(k0.x), bflo(k0.y), bfhi(k0.y), bflo(k0.z), bfhi(k0.z), bflo(k0.w), bfhi(k0.w), bflo(k1.x), bfhi(k1.x), bflo(k1.y), bfhi(k1.y), bflo(k1.z), bfhi(k1.z), bflo(k1.w), bfhi(k1.w)};
                        const float Qv[16] = {bflo(q0.x), bfhi(q0.x), bflo(q0.y), bfhi(q0.y), bflo(q0.z), bfhi(q0.z), bflo(q0.w), bfhi(q0.w), bflo(q1.x), bfhi(q1.x), bflo(q1.y), bfhi(q1.y), bflo(q1.z), bfhi(q1.z), bflo(q1.w), bfhi(q1.w)};
                        float acc = 0.f;
#pragma unroll
                        for (int j = 0; j < 16; ++j) { S[j] = gamma * S[j] + Kv[j] * vv; acc += Qv[j] * S[j]; }
                        acc += __shfl_xor(acc, 1); acc += __shfl_xor(acc, 2);
                        if (dq == 0) BR[row * 2048 + 1024 + hh * 64 + e] = (bf16)f2bf(acc);
                    }
                } else if (wu < 768) {
                    const int un = wu - 512, b = un >> 5, g = un & 31, n = lane;
                    const float* lam_re = opqp(p.in[6]) + layer * 2048; const float* lam_im = opqp(p.in[7]) + layer * 2048; const float* b_re = opqp(p.in[8]) + layer * 32768; const float* b_im = opqp(p.in[9]) + layer * 32768;
                    const float* c_re = opqp(p.in[10]) + layer * 32768; const float* c_im = opqp(p.in[11]) + layer * 32768; const float* dsk = opqp(p.in[12]) + layer * 512;
                    const float lr = lam_re[g * 64 + n], li = lam_im[g * 64 + n], step = expf(opqp(p.in[13])[layer * 32 + g]);
                    const float mag = expf(lr * step), ar = mag * cosf(li * step), ai = mag * sinf(li * step);
                    const float inv = 1.0f / (lr * lr + li * li);
                    const float cr = ((ar - 1.0f) * lr + ai * li) * inv, ci = (ai * lr - (ar - 1.0f) * li) * inv;
                    float bbr[16], bbi[16], cre[16], cim[16];
#pragma unroll
                    for (int h = 0; h < 16; ++h) { const float br_ = b_re[(g * 64 + n) * 16 + h], bi_ = b_im[(g * 64 + n) * 16 + h];
                        bbr[h] = cr * br_ - ci * bi_; bbi[h] = cr * bi_ + ci * br_; cre[h] = c_re[(g * 16 + h) * 64 + n]; cim[h] = c_im[(g * 16 + h) * 64 + n]; }
                    const float dmine = dsk[g * 16 + (n & 15)];
                    float sr = 0.f, si = 0.f;
                    for (int t = 0; t < L; ++t) {
                        const size_t row = (size_t)b * L + t; const bf16* up = PROJB + row * PJ + C_U + g * 16;
                        const v4u u0 = *(const v4u*)up, u1 = *(const v4u*)(up + 8);
                        const float u[16] = {bflo(u0.x), bfhi(u0.x), bflo(u0.y), bfhi(u0.y), bflo(u0.z), bfhi(u0.z), bflo(u0.w), bfhi(u0.w), bflo(u1.x), bfhi(u1.x), bflo(u1.y), bfhi(u1.y), bflo(u1.z), bfhi(u1.z), bflo(u1.w), bfhi(u1.w)};
                        float bur = 0.f, bui = 0.f;
#pragma unroll
                        for (int h = 0; h < 16; ++h) { bur += u[h] * bbr[h]; bui += u[h] * bbi[h]; }
                        const float nr = ar * sr - ai * si + bur, ni = ar * si + ai * sr + bui; sr = nr; si = ni;
                        float mine = 0.f, umine = 0.f;
#pragma unroll
                        for (int h = 0; h < 16; ++h) { const float y = wave_sum(sr * cre[h] - si * cim[h]); if (n == h) { mine = y; umine = u[h]; } }
                        if (n < 16) YS[row * 512 + g * 16 + n] = (bf16)f2bf(gelu_tanh(mine + dmine * umine));
                    }
                } else {
                    const int un = wu - 768, b = un >> 3, blk = un & 7, j = lane;
                    LAS bf16* wA = (LAS bf16*)scr; LAS bf16* wX = wA + 4096;
                    for (int i = 0; i < 64; ++i) { wA[i * 64 + j] = (bf16)f2bf(opqp(p.in[24])[layer * 32768 + (blk * 64 + i) * 64 + j]); wX[i * 64 + j] = (bf16)f2bf(opqp(p.in[26])[layer * 32768 + (blk * 64 + i) * 64 + j]); }
                    LDS_WAIT();
                    const float bA = opqp(p.in[25])[layer * 512 + blk * 64 + j], bX = opqp(p.in[27])[layer * 512 + blk * 64 + j], sp = softplusf_(-opqp(p.in[28])[layer * 512 + blk * 64 + j]);
                    float hs = 0.f;
                    for (int t = 0; t < L; ++t) {
                        const size_t row = (size_t)b * L + t;
                        const float xc = bf1(XLC[row * 512 + blk * 64 + j]);
                        float ra = bA, ri = bX;
#pragma unroll
                        for (int i = 0; i < 64; ++i) { const float xi = __shfl(xc, i); ra += xi * bf1(wA[i * 64 + j]); ri += xi * bf1(wX[i * 64 + j]); }
                        const float r = sigmoidf_(ra), ig = sigmoidf_(ri);
                        const float log_a = -8.0f * r * sp, a = __expf(log_a);
                        const float mult = sqrtf(fmaxf(-expm1f(2.0f * log_a), 0.f));
                        hs = a * hs + mult * ig * xc;
                        BR[row * 2048 + 1536 + blk * 64 + j] = (bf16)f2bf(hs * gelu_tanh(bf1(PROJB[row * PJ + C_GL + blk * 64 + j])));
                    }
                }
            }
#else
            const int NMIXB = G >= 192 ? MK_NMIXB : G / 2;
            if (vcu >= NMIXB) {
                if (layer == 0) {
                    { const int gw = (vcu - NMIXB) * NWAVES + wave, NGW = (G - NMIXB) * NWAVES; int rot = 0;
                      CVT_LOOP(16 * 16, MapPlain m{xa_wo, D, D, nullptr, 1.f, (bf16*)(ws + WS_W + WL_WO), D});
                      CVT_LOOP(16 * 88, MapW13 m{ffn_w1, ffn_w3, norm_ffn, W13, DFF, 2 * DFF});
                      CVT_LOOP(44 * 16, MapPlain m{ffn_w2, DFF, D, nullptr, 1.f, W2T, DFF});
                      { unsigned char* wl = ws + WS_W + WL_STRIDE;
                        { for (int it = (gw + NGW - rot % NGW) % NGW; it < 16 * 140; it += NGW) { if (it % 140 < 76) { MapWin m{w_in + (size_t)D * IN_TOTAL, norm_mix + D, (bf16*)(wl + WL_WIN), 8960}; cvt_item(m, it, scr, lane); }
                            else { MapWin m{w_in + (size_t)D * IN_TOTAL, norm_mix + D, (bf16*)(wl + WL_WIN + (size_t)4864 * 2048 - (size_t)4864 * 1024), 8960}; cvt_item8(m, it, scr, lane, 64.0f, 1024); } } rot += 16 * 140; }
                        CVT_LOOP(8 * 8, MapPlain m{opqp(p.in[14]) + (size_t)512 * 512, 512, 512, nullptr, 1.f, (bf16*)(wl + WL_GLU), 512});
                        for (int k = 0; k < 4; ++k) CVT_LOOP(8 * 16, MapPlain m{w_branch + ((size_t)4 + k) * 512 * 1024, 512, 1024, nullptr, 1.f, (bf16*)(wl + WL_WB) + k * 512, 2048});
                        CVT_LOOP(16 * 16, MapPlain m{w_out + (size_t)D * D, D, D, nullptr, 1.f, (bf16*)(wl + WL_WOUT), D});
                        CVT_LOOP(16 * 16, MapPlain m{xa_wo + (size_t)D * D, D, D, nullptr, 1.f, (bf16*)(wl + WL_WO), D}); } }
                    for (int ll = 0; ll < 2; ++ll) {
                        const float* wq = xa_wq + (size_t)ll * D * D; const float* nx = norm_xa + ll * D; bf16* dq = (bf16*)(ws + WS_W + (size_t)ll * WL_STRIDE + WL_WQ);
                        for (int i8 = ((vcu - NMIXB) * NWAVES + wave) * 64 + lane; i8 < D * D / 8; i8 += (G - NMIXB) * NWAVES * 64) { const float sc = nx[i8 >> 7] * 0.0625f;
                            const f32x4 v0 = *(const f32x4*)(wq + (size_t)i8 * 8), v1 = *(const f32x4*)(wq + (size_t)i8 * 8 + 4);
                            v4u o; o.x = pg8::cvt_pk_bf16(v0[0] * sc, v0[1] * sc); o.y = pg8::cvt_pk_bf16(v0[2] * sc, v0[3] * sc); o.z = pg8::cvt_pk_bf16(v1[0] * sc, v1[1] * sc); o.w = pg8::cvt_pk_bf16(v1[2] * sc, v1[3] * sc);
                            *(v4u*)(dq + (size_t)i8 * 8) = o; } }
                    __syncthreads();
                    pg8::Gemm g{1024, 1024, 1024}; pg8::KVOrder S; S.mnr_ = (const char*)MNR; S.WKV0 = (const char*)(ws + WS_W + WL_WKV); S.WKV1 = (const char*)(ws + WS_W + WL_STRIDE + WL_WKV); S.G = G - NMIXB; S.c = vcu - NMIXB;
                    pg8::EpiKV E{KVB};
                    pg8::gemm_phase<pg8::EpiKV, pg8::KVOrder, true, true>(lds, g, S, E, wave_s);
                }
                using POF = std::conditional<true, pg8::PlainOrderOffF8, pg8::PlainOrderOff>::type; constexpr int ldw = 512; constexpr float psc = 1.0f / 64.0f;
                pg8::Gemm g{ldw, ldw, ldw}; POF S; S.A = layer == 1 ? (const char*)HN8L1 : (const char*)H; S.B = (const char*)WIN + (size_t)4864 * 2048 - (size_t)4864 * 1024;     S.nM = 64; S.nN = 16; S.lda = ldw; S.ldb = ldw; S.G = G - NMIXB; S.c = vcu - NMIXB; S.pn0 = 19; S.L0 = 0; S.L1 = (layer == 0 ? MK_GW0 : MK_GW1) - (layer == 0 ? MK_TAIL0 : MK_TAIL1);
                pg8::EpiProj E{PROJB, GATE, b_gate + layer * 4096, psc};
                pg8::gemm_phase<pg8::EpiProj, POF, true, true>(lds, g, S, E, wave_s);
            } else
            for (int wu = wave * NMIXB + vcu; wu < 768; wu += NMIXB * NWAVES) {
#ifdef MK_MIXONLY
                if ((wu < 256 ? 0 : wu < 512 ? 1 : 2) != MK_MIXONLY) continue;
#endif
                LAS unsigned char* sl = (LAS unsigned char*)scr; const int ln_ = lane_id_fresh();
                if (wu < 256) {
                    const int ty = wu >> 7, uu = wu & 127, b = uu >> 4, hh = (uu >> 1) & 7, eh = uu & 1; const size_t r0 = (size_t)b * L;
                    if (ty == 0) { const int g = hh >> 2; const float Aa = -__expf(opqp(p.in[18])[layer * 8 + hh]);
                        linattn_unit(XBCC + r0 * 768 + 640 + g * 64, 768, XBCC + r0 * 768 + 512 + g * 64, 768, XBCC + r0 * 768 + hh * 64 + eh * 32, 768, DT + r0 * 8 + hh, Aa * 1.4426950408889634f, opqp(p.in[19])[layer * 8 + hh],
                                     BR + r0 * 2048 + 512 + hh * 64 + eh * 32, 2048, sl, ln_); }
                    else { const float lg = log2f(1.0f - exp2f(-5.0f - (float)hh));
                        linattn_unit(PROJB + r0 * PJ + C_Q + hh * 64, PJ, PROJB + r0 * PJ + C_K + hh * 64, PJ, PROJB + r0 * PJ + C_V + hh * 64 + eh * 32, PJ, nullptr, lg, 0.f,
                                     BR + r0 * 2048 + 1024 + hh * 64 + eh * 32, 2048, sl, ln_); }
                } else if (wu < 512) {
                    const int un = wu - 256, b = un >> 5, g = un & 31; const size_t r0 = (size_t)b * L;
                    s5_unit(PROJB + r0 * PJ + C_U + g * 16, YS + r0 * 512 + g * 16, opqp(p.in[6]) + layer * 2048 + g * 64, opqp(p.in[7]) + layer * 2048 + g * 64, opqp(p.in[8]) + layer * 32768 + g * 1024, opqp(p.in[9]) + layer * 32768 + g * 1024,
                            opqp(p.in[10]) + layer * 32768 + g * 1024, opqp(p.in[11]) + layer * 32768 + g * 1024, opqp(p.in[12]) + layer * 512 + g * 16, expf(opqp(p.in[13])[layer * 32 + g]), sl, ln_);
                } else {
                    const int un = wu - 512, b = un >> 5, blk = (un >> 2) & 7, jq = un & 3, ch = blk * 64 + jq * 16 + (ln_ & 15); const size_t r0 = (size_t)b * L;
                    lru_unit(XLC + r0 * 512 + blk * 64, PROJB + r0 * PJ + C_GL + blk * 64, BR + r0 * 2048 + 1536 + blk * 64 + jq * 16, opqp(p.in[24]) + layer * 32768 + blk * 4096, opqp(p.in[26]) + layer * 32768 + blk * 4096,
                             opqp(p.in[25])[layer * 512 + ch], opqp(p.in[27])[layer * 512 + ch], softplusf_(-opqp(p.in[28])[layer * 512 + ch]), jq, ln_);
                }
            }
            if (vcu < NMIXB && (layer == 0 ? MK_TAIL0 : MK_TAIL1) > 0) {
                __syncthreads();
                pg8::Gemm g{1024, 1024, 1024}; pg8::PlainOrderOff S; S.A = (const char*)HN; S.B = (const char*)WIN; S.nM = 64; S.nN = 16; S.lda = 1024; S.ldb = 1024; S.G = NMIXB; S.c = vcu; S.pn0 = 19; S.L0 = (layer == 0 ? MK_GW0 : MK_GW1) - (layer == 0 ? MK_TAIL0 : MK_TAIL1); S.L1 = (layer == 0 ? MK_GW0 : MK_GW1);
                pg8::EpiProj E{PROJB, GATE, b_gate + layer * 4096, 1.0f};
                pg8::gemm_phase<pg8::EpiProj, pg8::PlainOrderOff, true, true>(lds, g, S, E, wave_s);
            }
#endif
            GRID_BARC(3);
        }
        if (IN(pb + 3)) { PH_VARS
            const float* snw = opqp(p.in[20]) + layer * 512; const float* rnw = opqp(p.in[21]) + layer * 512;
            for (int row = gw; row < T; row += NGW) {
                bf16* y = BR + (size_t)row * 2048; const bf16* pr = PROJB + (size_t)row * PJ;
                {
                    const v4u yw = *(const v4u*)(y + 512 + 8 * lane), zw = *(const v4u*)(pr + C_Z + 8 * lane);
                    float v[8] = {bflo(yw.x), bfhi(yw.x), bflo(yw.y), bfhi(yw.y), bflo(yw.z), bfhi(yw.z), bflo(yw.w), bfhi(yw.w)};
                    const float z[8] = {bflo(zw.x), bfhi(zw.x), bflo(zw.y), bfhi(zw.y), bflo(zw.z), bfhi(zw.z), bflo(zw.w), bfhi(zw.w)};
                    float ss = 0.f;
#pragma unroll
                    for (int q = 0; q < 8; ++q) { v[q] *= siluf_(z[q]); ss += v[q] * v[q]; }
                    const float r = 1.0f / sqrtf(wave_sum(ss) * (1.0f / 512.0f) + 1e-6f);
#pragma unroll
                    for (int q = 0; q < 8; ++q) v[q] *= r * snw[8 * lane + q];
                    v4u o; o.x = pk2(v[0], v[1]); o.y = pk2(v[2], v[3]); o.z = pk2(v[4], v[5]); o.w = pk2(v[6], v[7]);
                    *(v4u*)(y + 512 + 8 * lane) = o;
                }
                {
                    const v4u yw = *(const v4u*)(y + 1024 + 8 * lane), gw_ = *(const v4u*)(pr + C_G + 8 * lane);
                    float v[8] = {bflo(yw.x), bfhi(yw.x), bflo(yw.y), bfhi(yw.y), bflo(yw.z), bfhi(yw.z), bflo(yw.w), bfhi(yw.w)};
                    const float gg[8] = {bflo(gw_.x), bfhi(gw_.x), bflo(gw_.y), bfhi(gw_.y), bflo(gw_.z), bfhi(gw_.z), bflo(gw_.w), bfhi(gw_.w)};
                    float s = 0.f;
#pragma unroll
                    for (int q = 0; q < 8; ++q) s += v[q];
                    s = sum8(s);
                    const float mu = s * (1.0f / 64.0f); float q2 = 0.f;
#pragma unroll
                    for (int q = 0; q < 8; ++q) { v[q] -= mu; q2 += v[q] * v[q]; }
                    q2 = sum8(q2);
                    const float rs = 1.0f / sqrtf(q2 * (1.0f / 64.0f) + 1e-6f);
#pragma unroll
                    for (int q = 0; q < 8; ++q) v[q] = siluf_(gg[q]) * (v[q] * rs * rnw[8 * lane + q]);
                    v4u o; o.x = pk2(v[0], v[1]); o.y = pk2(v[2], v[3]); o.z = pk2(v[4], v[5]); o.w = pk2(v[6], v[7]);
                    *(v4u*)(y + 1024 + 8 * lane) = o;
                }
            }
            pg8::Gemm g{512, 512, 512}; pg8::PlainOrder S; S.A = (const char*)YSB; S.B = (const char*)WGLU; S.nM = 64; S.nN = 2; S.lda = 512; S.ldb = 512; S.G = G; S.c = bx;
            pg8::EpiGlu E{YSB, BR};
            pg8::gemm_phase<pg8::EpiGlu, pg8::PlainOrder, true, true>(lds, g, S, E, wave_s);
            {
                const int qoff = G >= 256 ? 128 : 0;
                pg8::Gemm gq{1024, 1024, 256}; pg8::QKWOrder Sq; Sq.kx_ = (const char*)KX; Sq.wqn_ = (const char*)WQ; Sq.G = G - qoff; Sq.c = bx - qoff;
                pg8::EpiStore Eq{QKW, 1024};
                pg8::gemm_phase<pg8::EpiStore, pg8::QKWOrder, false, false>(lds, gq, Sq, Eq, wave_s);
            }
            if ((layer == 0 ? MK_GW0 : MK_GW1) < 1024) {
                using POF2 = std::conditional<true, pg8::PlainOrderOffF8, pg8::PlainOrderOff>::type; constexpr int ldw2 = 512; constexpr float psc2 = 1.0f / 64.0f;
                pg8::Gemm g2{ldw2, ldw2, ldw2}; POF2 S2; S2.A = layer == 1 ? (const char*)HN8L1 : (const char*)H; S2.B = (const char*)WIN + (size_t)4864 * 2048 - (size_t)4864 * 1024; S2.nM = 64; S2.nN = 16; S2.lda = ldw2; S2.ldb = ldw2; S2.G = G; S2.c = vcu; S2.pn0 = 19; S2.L0 = (layer == 0 ? MK_GW0 : MK_GW1); S2.L1 = 1024;
                pg8::EpiProj E2{PROJB, GATE, b_gate + layer * 4096, psc2};
                pg8::gemm_phase<pg8::EpiProj, POF2, true, true>(lds, g2, S2, E2, wave_s);
            }
            GRID_BARC(4);
        }
        if (IN(pb + 4)) { PH_VARS
#ifdef MK_EXP_A
            pg8::Gemm g{2048, 2048, 2048}; pg8::PlainOrder S; S.A = (const char*)BR; S.B = (const char*)WB; S.nM = 64; S.nN = 4; S.lda = 2048; S.ldb = 2048; S.G = G; S.c = bx;
            pg8::EpiStore E{MERGED, 1024};
            pg8::gemm_phase<pg8::EpiStore, pg8::PlainOrder, true, true>(lds, g, S, E, wave_s);
#else
            pg8::Gemm g{2048, 2048, 512}; pg8::MergeOrder S; S.br_ = (const char*)BR; S.wb_ = (const char*)WB; S.G = G; S.c = bx;
            pg8::EpiMerge E{GATE, MERGED};
            pg8::gemm_phase<pg8::EpiMerge, pg8::MergeOrder, true, true>(lds, g, S, E, wave_s);
#endif
            GRID_BARC(5);
        }
        if (IN(pb + 5)) { PH_VARS
            pg8::Gemm g{1024, 1024, 1024}; pg8::PlainOrder S; S.A = (const char*)MERGED; S.B = (const char*)WOUT; S.nM = 64; S.nN = 4; S.lda = 1024; S.ldb = 1024; S.G = G; S.c = bx;
            pg8::EpiRes E{layer == 0 ? x_ : (const float*)H, H};
            pg8::gemm_phase<pg8::EpiRes, pg8::PlainOrder, true, true>(lds, g, S, E, wave_s);
            GRID_BARC(6);
        }
        if (IN(pb + 6)) { PH_VARS
            {
                const int voff = G >= 256 ? G - 128 : 0;
                pg8::Gemm gv{1024, 1024, 256}; pg8::VWOOrder Sv; Sv.wo_ = (const char*)WO; Sv.v_ = (const char*)VT; Sv.G = G - voff; Sv.c = bx - voff;
                pg8::EpiStore Ev{VWO, 1024};
                pg8::gemm_phase<pg8::EpiStore, pg8::VWOOrder, false, false>(lds, gv, Sv, Ev, wave_s);
            }
            norm_rows(H, HN, T, gw, NGW, lane, NoPost{});
            GRID_BARC(7);
        }
        if (IN(pb + 8)) { PH_VARS
            pg8::Gemm g{1024, 1024, 1024}; pg8::ScoreOrder S; S.hn_ = (const char*)HN; S.qkw_ = (const char*)QKW; S.G = G; S.c = bx;
            pg8::EpiSoftmax E{PB, (PG8_LAS float*)xch};
            for (int sb = 0; sb < 256; sb += G) { S.base = sb; pg8::gemm_phase<pg8::EpiSoftmax, pg8::ScoreOrder, false, false>(lds, g, S, E, wave_s); }
            GRID_BARC(9);
        }
        if (IN(pb + 10)) { PH_VARS
            pg8::Gemm g{1024, 1024, 1024}; pg8::PVWOrder S; S.p_ = (const char*)PB; S.vwo_ = (const char*)VWO; S.G = G; S.c = bx;
            pg8::EpiRes E{H, H};
            pg8::gemm_phase<pg8::EpiRes, pg8::PVWOrder, true, true>(lds, g, S, E, wave_s);
            GRID_BARC(11);
        }
        if (layer == 0) {
            if (IN(pb + 11)) { PH_VARS
                norm_rows(H, HN, T, gw, NGW, lane, NoPost{});
                GRID_BARC(7);
            }
            if (IN(pb + 12)) { PH_VARS
                pg8::Gemm g{1024, 1024, 1024}; pg8::PlainOrder S; S.A = (const char*)HN; S.B = (const char*)W13; S.nM = 64; S.nN = 22; S.lda = 1024; S.ldb = 1024; S.G = G; S.c = bx;
                pg8::EpiSwiglu E{ACT, DFF, 1.0f};
                pg8::gemm_phase<pg8::EpiSwiglu, pg8::PlainOrder, true, true>(lds, g, S, E, wave_s);
                GRID_BARC(12);
            }
            if (IN(pb + 13)) { PH_VARS
                pg8::Gemm g{DFF, DFF, DFF}; pg8::PlainOrder S; S.A = (const char*)ACT; S.B = (const char*)W2T; S.nM = 64; S.nN = 4; S.lda = DFF; S.ldb = DFF; S.G = G; S.c = bx;
                pg8::EpiRes E{H, H};
                pg8::gemm_phase<pg8::EpiRes, pg8::PlainOrder, true, true>(lds, g, S, E, wave_s);
                GRID_BARC(13);
            }
            if (IN(pb + 14)) { PH_VARS
                for (int i = tid; i < 8192; i += 512) w8[i] = norm_mix[D + (i >> 3)] * w_in[(size_t)D * IN_TOTAL + (size_t)(i >> 3) * IN_TOTAL + O_DT + (i & 7)];
                __syncthreads();
                norm_rows(H, HN, T, gw, NGW, lane, [&](const int row, const float r, const f32x4 (&v)[4]) { float lg[8]; row_dot8(v, w8, lane, lg);
                    float mine = 0.f;
#pragma unroll
                    for (int e = 0; e < 8; ++e) if (lane == e) mine = lg[e];
                    if (lane < 8) DT[(size_t)row * 8 + lane] = softplusf_(r * mine + opqp(p.in[17])[8 + lane]);
                    { unsigned* h8 = (unsigned*)(HN8L1 + (size_t)row * 1024) + lane;
#pragma unroll
                      for (int j = 0; j < 4; ++j) { int p8 = 0; p8 = __builtin_amdgcn_cvt_pk_fp8_f32(v[j].x * r, v[j].y * r, p8, false); p8 = __builtin_amdgcn_cvt_pk_fp8_f32(v[j].z * r, v[j].w * r, p8, true); h8[64 * j] = (unsigned)p8; } } });
                __syncthreads();
                GRID_BARC(7);
            }
        } else {
            if (IN(pb + 11)) { PH_VARS
                for (int i = tid; i < 8192; i += 512) w8[i] = norm_ffn[D + (i >> 3)] * moe_router[i];
                LAS int* lcnt = (LAS int*)(lds + 40960); LAS int* lbase = lcnt + 8; LAS i32x4* lti = (LAS i32x4*)(lds + 41984);
                if (tid < 8) lcnt[tid] = 0;
                __syncthreads();
                { int it = 0;
                norm_rows(H, HN, T, gw, NGW, lane, [&](const int row, const float r, const f32x4 (&v)[4]) { float lg[8]; row_dot8(v, w8, lane, lg);
                    { unsigned* h8 = (unsigned*)(HN8 + (size_t)row * 1024) + lane;
#pragma unroll
                      for (int j = 0; j < 4; ++j) { int p8 = 0; p8 = __builtin_amdgcn_cvt_pk_fp8_f32(v[j].x * r, v[j].y * r, p8, false); p8 = __builtin_amdgcn_cvt_pk_fp8_f32(v[j].z * r, v[j].w * r, p8, true); h8[64 * j] = (unsigned)p8; } }
                    if (lane == 0) {
                        int i1 = 0; float v1 = lg[0];
#pragma unroll
                        for (int e = 1; e < 8; ++e) if (lg[e] > v1) { v1 = lg[e]; i1 = e; }
                        int i2 = 0; float v2 = -3.0e38f;
#pragma unroll
                        for (int e = 0; e < 8; ++e) if (e != i1 && lg[e] > v2) { v2 = lg[e]; i2 = e; }
                        const float w1 = 1.0f / (1.0f + expf(r * (v2 - v1))), w2 = 1.0f - w1;
                        const int r1 = __hip_atomic_fetch_add(lcnt + i1, 1, __ATOMIC_RELAXED, __HIP_MEMORY_SCOPE_WORKGROUP), r2 = __hip_atomic_fetch_add(lcnt + i2, 1, __ATOMIC_RELAXED, __HIP_MEMORY_SCOPE_WORKGROUP);
                        lti[wave * 32 + (it & 31)] = (i32x4){i1, i2, r1, r2}; TOPW[row] = (f32x2){w1, w2};
                    } ++it; }); }
                __syncthreads();
                if (tid < 8) lbase[tid] = atomicAdd(&CNT[tid], lcnt[tid]);
                __syncthreads();
                { int it = 0;
                for (int row = gw; row < T; row += NGW, ++it) if (lane == 0) { i32x4 ti = lti[wave * 32 + (it & 31)]; ti.z += lbase[ti.x]; ti.w += lbase[ti.y]; TOPI[row] = ti; } }
                __syncthreads();
                {
                    int rot = 0;
                    for (int e = 0; e < NE; ++e) {
                        CVT_LOOP8(16 * 112, 64.0f, 1024, MapW13 m{moe_w1 + (size_t)e * D * DFE, moe_w3 + (size_t)e * D * DFE, norm_ffn + D, (bf16*)((unsigned char*)W13E + (size_t)e * 2 * DFE * D), DFE, 2 * DFE});
                        CVT_LOOP8(56 * 16, 64.0f, DFE, MapPlain m{moe_w2 + (size_t)e * DFE * D, DFE, D, nullptr, 1.f, (bf16*)((unsigned char*)W2E + (size_t)e * D * DFE), DFE});
                    }
                }
                GRID_BARC(14);
            }
            int t1 = 0, t2 = 0, t3 = 0, t4 = 0, t5 = 0, t6 = 0, t7 = 0, ntiles = 0;
            if (lo <= pb + 14 && hi > pb + 12) {
                int acc = 0;
#pragma unroll
                for (int e = 0; e < 8; ++e) { const int c = __hip_atomic_load(&CNT[e], RLX_AGENT); acc += (c + 255) >> 8;
                    if (e == 0) t1 = acc; if (e == 1) t2 = acc; if (e == 2) t3 = acc; if (e == 3) t4 = acc; if (e == 4) t5 = acc; if (e == 5) t6 = acc; if (e == 6) t7 = acc; if (e == 7) ntiles = acc; }
            }
            if (IN(pb + 12)) { PH_VARS
                for (int row = gw; row < T; row += NGW) {
                    const i32x4 ti = TOPI[row];
                    const int e1 = ti.x, e2 = ti.y;
                    const int s1 = (e1 == 0 ? 0 : e1 == 1 ? t1 : e1 == 2 ? t2 : e1 == 3 ? t3 : e1 == 4 ? t4 : e1 == 5 ? t5 : e1 == 6 ? t6 : t7) * 256 + ti.z;
                    const int s2 = (e2 == 0 ? 0 : e2 == 1 ? t1 : e2 == 2 ? t2 : e2 == 3 ? t3 : e2 == 4 ? t4 : e2 == 5 ? t5 : e2 == 6 ? t6 : t7) * 256 + ti.w;
                    { const v4u a8 = *((const v4u*)(HN8 + (size_t)row * 1024) + lane); *((v4u*)(XS8 + (size_t)s1 * 1024) + lane) = a8; *((v4u*)(XS8 + (size_t)s2 * 1024) + lane) = a8; }
                    if (lane == 0) SLOT[row] = (i32x2){s1, s2};
                }
                GRID_BARC(15);
            }
            if (IN(pb + 13)) { PH_VARS
                pg8::Gemm g{512, 512, 512}; pg8::MoeUpF8 S; S.A = (const char*)XS8; S.B = (const char*)W13E; S.estride = (size_t)2 * DFE * D; S.lda = 512; S.ldb = 512; S.ntiles = ntiles; S.nN = 28; S.G = G; S.c = bx;
                S.t1 = t1; S.t2 = t2; S.t3 = t3; S.t4 = t4; S.t5 = t5; S.t6 = t6; S.t7 = t7;
                pg8::EpiSwigluF8 E{(unsigned char*)ACTE, DFE, 1.0f / 64.0f, 2.0f};
                pg8::gemm_phase<pg8::EpiSwigluF8, pg8::MoeUpF8, false, true>(lds, g, S, E, wave_s);
                GRID_BARC(16);
            }
            if (IN(pb + 14)) { PH_VARS
                { pg8::Gemm g{DFE / 2, DFE / 2, DFE / 2}; pg8::MoeDownOrderF8 S; S.A = (const char*)ACTE; S.B = (const char*)W2E; S.estride = (size_t)D * DFE; S.lda = DFE / 2; S.ldb = DFE / 2; S.G = G; S.c = vcu;
                  S.t1 = t1; S.t2 = t2; S.t3 = t3; S.t4 = t4; S.t5 = t5; S.t6 = t6; S.t7 = t7;
                  pg8::EpiStoreS E{XS, 1024, 1.0f / 128.0f};
                  pg8::gemm_phase<pg8::EpiStoreS, pg8::MoeDownOrderF8, true, true>(lds, g, S, E, wave_s); }
                { pg8::Gemm g{DFE / 2, DFE / 2, 256}; pg8::MoeDownTailF8 S; S.A = (const char*)ACTE; S.B = (const char*)W2E; S.estride = (size_t)D * DFE; S.lda = DFE / 2; S.ldb = DFE / 2; S.ntiles = ntiles; S.G = G; S.c = vcu;
                  S.t1 = t1; S.t2 = t2; S.t3 = t3; S.t4 = t4; S.t5 = t5; S.t6 = t6; S.t7 = t7;
                  pg8::EpiPartF32S E{YPART, 1.0f / 128.0f};
                  pg8::gemm_phase<pg8::EpiPartF32S, pg8::MoeDownTailF8, true, true>(lds, g, S, E, wave_s); }
                GRID_BARC(17);
            }
            if (IN(pb + 15)) { PH_VARS
                const unsigned bad = __hip_atomic_load(ctl + CW_BAR + XB_TMO, RLX_AGENT);
                for (int row = gw; row < T; row += NGW) {
                    const i32x2 sl = SLOT[row]; const f32x2 tw = TOPW[row];
                    const f32x4* hr = (const f32x4*)(H + (size_t)row * D) + lane;
                    f32x4 v[4]; float ss = 0.f;
#pragma unroll
                    for (int j = 0; j < 4; ++j) v[j] = hr[64 * j];
#pragma unroll
                    for (int k = 0; k < 2; ++k) { const int s_ = k ? sl.y : sl.x; const float w_ = k ? tw.y : tw.x;
                        if (s_ < 32768) { const v2u* y = (const v2u*)(XS + (size_t)s_ * D) + lane;
#pragma unroll
                            for (int j = 0; j < 4; ++j) { const v2u a = y[64 * j]; v[j].x += w_ * bflo(a.x); v[j].y += w_ * bfhi(a.x); v[j].z += w_ * bflo(a.y); v[j].w += w_ * bfhi(a.y); } }
                        else { const f32x4* yp = (const f32x4*)(YPART + ((size_t)((s_ >> 8) - 128) * 7 * 256 + (s_ & 255)) * 1024) + lane;
                            for (int p7 = 0; p7 < 7; ++p7)
#pragma unroll
                                for (int j = 0; j < 4; ++j) v[j] += yp[(size_t)p7 * 256 * 256 + 64 * j] * w_; } }
#pragma unroll
                    for (int j = 0; j < 4; ++j) ss += (v[j].x * v[j].x + v[j].y * v[j].y) + (v[j].z * v[j].z + v[j].w * v[j].w);
                    float r = 1.0f / sqrtf(wave_sum(ss) * (1.0f / 1024.0f) + 1e-6f);
                    if (bad) r = __builtin_nanf("");
                    f32x4* orow = (f32x4*)(H + (size_t)row * D) + lane;
#pragma unroll
                    for (int j = 0; j < 4; ++j) { const f32x4 g4 = *((const f32x4*)norm_final + lane + 64 * j); orow[64 * j] = v[j] * r * g4; }
                }
            }
        }
        }
#ifdef MK_TPROBE
    if (IN(98)) { GRID_BAR(); PH_VARS
        const float tus = fmaxf((float)__hip_atomic_load(ctl + 20100, RLX_AGENT) * 0.01f, 1.0f);
        const float tp_v = __builtin_amdgcn_sqrtf(0.1f * __builtin_amdgcn_exp2f((1.0f / MK_TQ) * __builtin_rintf((float)MK_TQ * __builtin_amdgcn_logf(tus))));
        for (int i = gt; i < cf::T * cf::D / 4; i += NGT) ((f32x4*)H)[i] = (f32x4){tp_v, tp_v, tp_v, tp_v};
    }
#endif
#ifdef MK_DUMP
    if (IN(99)) { PH_VARS
        for (int row = gw; row < cf::T; row += NGW) {
#pragma unroll
            for (int j = 0; j < 16; ++j) { const int cc = lane + 64 * j; float v;
#if MK_DUMP == 1
                v = (cc < 512 ? bf1(HN[(size_t)row * 512 + cc]) : bf1(BR[(size_t)row * 2048 + cc])) + bf1(BR[(size_t)row * 2048 + cc + 1024]);
#elif MK_DUMP == 2
                v = bf1(PROJB[(size_t)row * cf::PJ + cc]) + bf1(PROJB[(size_t)row * cf::PJ + cc + 1024]) + bf1(PROJB[(size_t)row * cf::PJ + cc + 2048]) + bf1(PROJB[(size_t)row * cf::PJ + cc + 3072]) + bf1(GATE[(size_t)row * 4096 + cc]) + bf1(GATE[(size_t)row * 4096 + 3072 + cc]) + (cc < 768 ? bf1(PROJB[(size_t)row * cf::PJ + cc + 4096]) : 0.f);
#elif MK_DUMP == 5
                v = bf1(GATE[(size_t)row * 4096 + cc]) + bf1(GATE[(size_t)row * 4096 + 1024 + cc]) + bf1(GATE[(size_t)row * 4096 + 2048 + cc]) + bf1(GATE[(size_t)row * 4096 + 3072 + cc]);
#elif MK_DUMP == 7
                v = bf1(GATE[(size_t)row * 4096 + MK_GB * 1024 + cc]);
#elif MK_DUMP == 3
                v = bf1(BR[(size_t)row * 2048 + cc]) + bf1(BR[(size_t)row * 2048 + cc + 1024]);
#elif MK_DUMP == 4
                v = bf1(MERGED[(size_t)row * 1024 + cc]);
#endif
                H[(size_t)row * 1024 + cc] = v; }
        }
    }
#endif
#undef IN
#undef GRID_BAR
#undef ws
#undef ctl
#undef H
}

#undef PH_VARS
#undef ws
#undef ctl
#undef GRID_BAR
#undef IN
#undef x_
#undef mem_
#undef positions_
#undef norm_mix
#undef w_in
#undef b_gate
#undef w_branch
#undef w_out
#undef norm_xa
#undef norm_mem
#undef xa_wq
#undef xa_wk
#undef xa_wv
#undef xa_wo
#undef norm_ffn
#undef ffn_w1
#undef ffn_w3
#undef ffn_w2
#undef moe_router
#undef moe_w1
#undef moe_w3
#undef moe_w2
#undef norm_final
#undef H
#undef HN
#undef KVB
#undef COS
#undef SIN
#undef DT
#undef MNR
#undef PROJB
#undef GATE
#undef BR
#undef XBCC
#undef XLC
#undef MP
#undef MERGED
#undef XQ
#undef PB
#undef XO
#undef ACT
#undef W13E
#undef W2E
#undef XS
#undef ACTE
#undef YPART
#undef ROWOF
#undef HN8
#undef XS8
#undef HN8L1
#undef TOPI
#undef TOPW
#undef SLOT
#undef CNT
#undef W13
#undef W2T
#undef CVT_LOOP
#undef WLP
#undef WIN
#undef WGLU
#undef WB
#undef WOUT
#undef WQ
#undef WO
#undef KX
#undef VT
extern "C" void kernel_launch(void* const* d_in, const int* in_sizes, int n_in, void* d_out, int out_size, void* d_ws, size_t ws_size, hipStream_t stream) {
    static int grid = 0;
    if (grid == 0) {
        if (n_in != 46 || in_sizes[0] != cf::T * cf::D || out_size != cf::T * cf::D || ws_size < WS_NEED) { fprintf(stderr, "kernel_launch: unexpected shapes / workspace (n_in %d, in0 %d, out %d, ws %zu < %zu)\n", n_in, n_in > 0 ? in_sizes[0] : -1, out_size, ws_size, (size_t)WS_NEED); grid = -1; return; }
        int dev = 0, cus = 0, per_cu = 0;
        if (hipGetDevice(&dev) != hipSuccess || hipDeviceGetAttribute(&cus, hipDeviceAttributeMultiprocessorCount, dev) != hipSuccess) { grid = -1; return; }
        if (hipFuncSetAttribute((const void*)mega, hipFuncAttributeMaxDynamicSharedMemorySize, LDS_BYTES) != hipSuccess) { fprintf(stderr, "kernel_launch: hipFuncSetAttribute failed\n"); grid = -1; return; }
        if (hipOccupancyMaxActiveBlocksPerMultiprocessor(&per_cu, (const void*)mega, NWAVES * 64, LDS_BYTES) != hipSuccess || per_cu < 1) fprintf(stderr, "kernel_launch: occupancy query reports %d\n", per_cu);
        (void)hipGetLastError();
        grid = cus;
    }
    if (grid < 0) return;
    if (hipMemsetAsync((char*)d_ws + WS_CTL, 0, CTL_ZERO_BYTES, stream) != hipSuccess) return;
    Params a{};
    for (int i = 0; i < 46; ++i) a.in[i] = (const float*)d_in[i];
    a.out = (float*)d_out; a.ws = (unsigned char*)d_ws;
#ifdef MK_PER_PHASE
    for (int ph = 0; ph < MK_PER_PHASE; ++ph) { if (ph >= 16 && ph <= 20) continue; a.ph_lo = ph; a.ph_hi = ph + 1; hipLaunchKernelGGL(mega, dim3(grid), dim3(NWAVES * 64), LDS_BYTES, stream, a); }
#ifdef MK_DUMP
    a.ph_lo = 99; a.ph_hi = 100; hipLaunchKernelGGL(mega, dim3(grid), dim3(NWAVES * 64), LDS_BYTES, stream, a);
#endif
#elif defined(MK_SELFCHK)
    {
        using namespace nv;
        const float* x = (const float*)d_in[0]; char* wsb = (char*)d_ws;
        float* hn = (float*)wsb; float* PROJ = hn + (size_t)2048 * 1024; float* BRn = PROJ + (size_t)2048 * PW; float* TMP = BRn + (size_t)2048 * 2048; float* GLG = TMP + (size_t)2048 * 1024; float* MER = GLG + (size_t)2048 * 1024;
        float* ct = MER + (size_t)2048 * 1024; float* st = ct + (size_t)T * 32; float* hh = st + (size_t)T * 32;
        char* safe = wsb + (size_t)524 * 1048576; float* sBR = (float*)safe; float* sMER = sBR + (size_t)2048 * 2048; float* sH = sMER + (size_t)2048 * 1024; float* sPROJ = sH + (size_t)2048 * 1024; float* sGATE = sPROJ + (size_t)256 * PW; float* acc = sGATE + (size_t)256 * 4096;
        const float* Win = (const float*)d_in[4];
        hipLaunchKernelGGL(k_rope_tab, dim3((T * 32 + 255) / 256), dim3(256), 0, stream, (const int*)d_in[2], ct, st);
        hipLaunchKernelGGL(k_rmsnorm, dim3(2048 / 4), dim3(256), 0, stream, x, (const float*)d_in[3], hn, 2048);
        sgemm(stream, false, hn, D, Win, IN_TOTAL, PROJ, PW, 2048, PW, D);
        hipMemcpyAsync(sPROJ, PROJ, (size_t)256 * PW * 4, hipMemcpyDeviceToDevice, stream);
        hipLaunchKernelGGL(k_s5_scan, dim3(32), dim3(64), 0, stream, PROJ, BRn, (const float*)d_in[6], (const float*)d_in[7], (const float*)d_in[8], (const float*)d_in[9], (const float*)d_in[10], (const float*)d_in[11], (const float*)d_in[12], (const float*)d_in[13]);
        sgemm(stream, false, BRn, 2048, (const float*)d_in[14], 512, TMP, 512, 2048, 512, 512);
        hipLaunchKernelGGL(k_s5_gate, dim3((2048 * 512 + 255) / 256), dim3(256), 0, stream, BRn, TMP, 2048);
        hipLaunchKernelGGL(k_conv_inplace, dim3((768 + 255) / 256), dim3(256), 0, stream, PROJ, PW, OFF_XBC, 768, (const float*)d_in[15], (const float*)d_in[16], 1, 1);
        hipLaunchKernelGGL(k_ssd_scan, dim3(8), dim3(256), 0, stream, PROJ, BRn, (const float*)d_in[17], (const float*)d_in[18], (const float*)d_in[19]);
        hipLaunchKernelGGL(k_ssd_post, dim3(2048 / 4), dim3(256), 0, stream, BRn, PROJ, (const float*)d_in[20], 2048);
        hipLaunchKernelGGL(k_rope, dim3((2048 * 256 + 255) / 256), dim3(256), 0, stream, PROJ, ct, st, 0, 2048);
        hipLaunchKernelGGL(k_ret_scan, dim3(8), dim3(256), 0, stream, PROJ, BRn);
        hipLaunchKernelGGL(k_ret_post, dim3(2048 / 4), dim3(256), 0, stream, BRn, PROJ, (const float*)d_in[21], 2048);
        hipLaunchKernelGGL(k_conv_inplace, dim3((512 + 255) / 256), dim3(256), 0, stream, PROJ, PW, OFF_XL, 512, (const float*)d_in[22], (const float*)d_in[23], 0, 1);
        hipLaunchKernelGGL(k_lru_scan, dim3(8), dim3(64), 0, stream, PROJ, BRn, (const float*)d_in[24], (const float*)d_in[25], (const float*)d_in[26], (const float*)d_in[27], (const float*)d_in[28]);
        for (int k = 0; k < 4; ++k) {
            sgemm(stream, false, BRn + k * 512, 2048, (const float*)d_in[29] + (size_t)k * 512 * 1024, 1024, TMP, 1024, 2048, 1024, 512);
            sgemm(stream, false, hn, D, Win + OFF_GATE + k * 1024, IN_TOTAL, GLG, 1024, 2048, 1024, D);
            hipLaunchKernelGGL(k_dbg_gate, dim3((256 * 1024 + 255) / 256), dim3(256), 0, stream, sGATE + k * 1024, GLG, (const float*)d_in[5] + k * 1024);
            hipLaunchKernelGGL(k_gate_acc, dim3((2048 * 1024 + 255) / 256), dim3(256), 0, stream, MER, TMP, GLG, (const float*)d_in[5] + k * 1024, k == 0 ? 1 : 0, 2048);
        }
        hipMemcpyAsync(hh, x, (size_t)2048 * 1024 * 4, hipMemcpyDeviceToDevice, stream);
        sgemm(stream, true, MER, 1024, (const float*)d_in[30], D, hh, D, 2048, D, D);
        hipMemcpyAsync(sBR, BRn, (size_t)2048 * 2048 * 4, hipMemcpyDeviceToDevice, stream);
        hipMemcpyAsync(sMER, MER, (size_t)2048 * 1024 * 4, hipMemcpyDeviceToDevice, stream);
        hipMemcpyAsync(sH, hh, (size_t)2048 * 1024 * 4, hipMemcpyDeviceToDevice, stream);
        hipMemsetAsync((char*)d_ws + WS_CTL, 0, CTL_ZERO_BYTES, stream);
        a.ph_lo = 0; a.ph_hi = MK_SELFCHK;
        hipLaunchKernelGGL(mega, dim3(grid), dim3(NWAVES * 64), LDS_BYTES, stream, a);
        hipMemsetAsync(acc, 0, 256, stream);
        const unsigned short* PROJBp = (const unsigned short*)((char*)d_ws + R_PROJB); const unsigned short* GATEp = (const unsigned short*)((char*)d_ws + R_GATE); const unsigned short* BRp = (const unsigned short*)((char*)d_ws + R_BR); const unsigned short* MERp = (const unsigned short*)((char*)d_ws + R_MERGED);
        hipLaunchKernelGGL(k_dbg_cmp, dim3(256), dim3(256), 0, stream, sPROJ, PW, 0, (const void*)PROJBp, 4864, 0, 1, 256, 1792, acc + 0);
        hipLaunchKernelGGL(k_dbg_cmp, dim3(256), dim3(256), 0, stream, sPROJ, PW, 2824, (const void*)PROJBp, 4864, 2816, 1, 256, 1024, acc + 2);
        hipLaunchKernelGGL(k_dbg_cmp, dim3(256), dim3(256), 0, stream, sPROJ, PW, 3848, (const void*)PROJBp, 4864, 3840, 1, 256, 1024, acc + 4);
        for (int kk = 0; kk < 4; ++kk) hipLaunchKernelGGL(k_dbg_cmp, dim3(256), dim3(256), 0, stream, sGATE, 4096, kk * 1024, (const void*)GATEp, 4096, kk * 1024, 1, 256, 1024, acc + 6 + 2 * kk);
        if (MK_SELFCHK >= 5) for (int s = 0; s < 4; ++s) hipLaunchKernelGGL(k_dbg_cmp, dim3(256), dim3(256), 0, stream, sBR, 2048, s * 512, (const void*)BRp, 2048, s * 512, 1, 2048, 512, acc + 14 + 2 * s);
        if (MK_SELFCHK >= 6) hipLaunchKernelGGL(k_dbg_cmp, dim3(256), dim3(256), 0, stream, sMER, 1024, 0, (const void*)MERp, 1024, 0, 1, 2048, 1024, acc + 22);
        if (MK_SELFCHK >= 7) hipLaunchKernelGGL(k_dbg_cmp, dim3(256), dim3(256), 0, stream, sH, 1024, 0, (const void*)d_out, 1024, 0, 0, 2048, 1024, acc + 24);
        hipLaunchKernelGGL(k_dbg_report, dim3(1), dim3(1), 0, stream, acc, acc + 64);
        hipLaunchKernelGGL(k_dbg_fill, dim3(4096), dim3(256), 0, stream, (float*)d_out, acc + 64, (size_t)T * D);
        return;
    }
#elif defined(MK_HYBRID)
    a.ph_lo = 0; a.ph_hi = MK_HYBRID;
    hipLaunchKernelGGL(mega, dim3(grid), dim3(NWAVES * 64), LDS_BYTES, stream, a);
    nv::naive_from(MK_HYB_L, MK_HYB_S, d_in, d_out, d_ws, stream);
    return;
#else
    a.ph_lo = 0; a.ph_hi = 1000;
    hipLaunchKernelGGL(mega, dim3(grid), dim3(NWAVES * 64), LDS_BYTES, stream, a);
#endif
    const hipError_t le = hipPeekAtLastError();
    if (le != hipSuccess) fprintf(stderr, "kernel_launch: launch failed: %s\n", hipGetErrorName(le));
}
```

```cpp
#define MK_NMIXB 128
#define MK_GW0 1024
#define MK_GW1 1024
#include <hip/hip_runtime.h>
#include <cstdio>
#include <cstdint>
#include <type_traits>
__device__ __forceinline__ int lane_id_fresh() { int l; asm volatile("v_mbcnt_lo_u32_b32 %0, -1, 0\n\tv_mbcnt_hi_u32_b32 %0, -1, %0" : "=v"(l)); return l; }
namespace pg8 {
#define PG8_LAS __attribute__((address_space(3)))
typedef unsigned short bf16_t;
typedef short bf16x8 __attribute__((ext_vector_type(8)));
typedef float f32x4 __attribute__((ext_vector_type(4)));
typedef float f32x2 __attribute__((ext_vector_type(2)));
typedef unsigned u32x4 __attribute__((ext_vector_type(4)));
typedef unsigned u32x2 __attribute__((ext_vector_type(2)));
constexpr int BM = 256, BK = 64, HALF = 128, HTB = HALF * BK * 2  , STAGE_BYTES = 8 * HTB, NXCD = 8, WGM = 8;
__host__ __device__ __forceinline__ int lds_byte(int r, int c) { const int st = (r >> 4) * 2 + (c >> 5), rr = r & 15, cc = c & 31, ob = rr * 64 + cc * 2; return st * 1024 + (ob ^ (((ob >> 9) & 1) << 5)); }
__host__ __device__ __forceinline__ void stage_rc(int b, int& R, int& C) { const int st = b / 1024, sb = b % 1024, swz = sb ^ (((sb >> 9) & 1) << 5); R = (st >> 1) * 16 + swz / 64; C = (st & 1) * 32 + (swz % 64) / 2; }
__host__ __device__ __forceinline__ int perm32(int rho) { const int n = rho >> 4, i = rho & 15; return 8 * (i >> 2) + 4 * n + (i & 3); }

struct Unit { int pm, pn, z; const char* a; const char* b; };
struct Gemm { int lda, ldb, K; };

__device__ __forceinline__ void tile_map(int L, int nM, int nN, int& pm, int& pn) {
    const int nwg = nM * nN; int wgid = L;
    { const int q = nwg / NXCD, r = nwg % NXCD, xcd = wgid % NXCD, off = wgid / NXCD; wgid = (xcd < r ? xcd * (q + 1) : r * (q + 1) + (xcd - r) * q) + off; }
    const int nig = WGM * nN, gid = wgid / nig, fm = gid * WGM, gsz = (nM - fm) < WGM ? (nM - fm) : WGM;
    pm = fm + ((wgid % nig) % gsz); pn = (wgid % nig) / gsz;
}
typedef __bf16 bf16x2_t __attribute__((ext_vector_type(2)));
typedef int i32x4_ __attribute__((ext_vector_type(4)));
typedef int i32x8_ __attribute__((ext_vector_type(8)));
__device__ __forceinline__ unsigned cvt_pk_bf16(float lo, float hi) { const f32x2 v = {lo, hi}; return __builtin_bit_cast(unsigned, __builtin_convertvector(v, bf16x2_t)); }
__device__ __forceinline__ float bf_lo(unsigned w) { return __uint_as_float(w << 16); }
__device__ __forceinline__ float bf_hi(unsigned w) { return __uint_as_float(w & 0xffff0000u); }
__device__ __forceinline__ float fast_sigmoid(float x) { return __builtin_amdgcn_rcpf(1.0f + __builtin_amdgcn_exp2f(-1.4426950408889634f * x)); }

struct NoHooks { static constexpr bool GATHER = false, F8 = false; __device__ __forceinline__ void a_ready(const Unit&) const {} __device__ __forceinline__ void done(const Unit&) const {} __device__ __forceinline__ int rowof(int, int) const { return 0; } };

typedef f32x4 AccT[2][2][4][2];
__device__ __forceinline__ u32x4 pack8(const f32x4 v0, const f32x4 v1) { u32x4 w; w.x = cvt_pk_bf16(v0[0], v0[1]); w.y = cvt_pk_bf16(v0[2], v0[3]); w.z = cvt_pk_bf16(v1[0], v1[1]); w.w = cvt_pk_bf16(v1[2], v1[3]); return w; }

struct EpiStore {
    static constexpr bool PERM = true, AFTER_DRAIN = false, KEEPS = false;
    bf16_t* O; int ldc;
    __device__ __forceinline__ void operator()(AccT& acc, const Unit& u, int wr, int wc, int fr, int fq) const {
        const int row0 = u.pm * BM + wr * 64 + fr, col0 = u.pn * BM + wc * 32 + 8 * fq;
#pragma unroll
        for (int ai = 0; ai < 2; ++ai)
#pragma unroll
            for (int m = 0; m < 4; ++m) { bf16_t* rowp = O + (size_t)(row0 + ai * HALF + m * 16) * ldc + col0;
#pragma unroll
                for (int bj = 0; bj < 2; ++bj) *(u32x4*)(rowp + bj * HALF) = pack8(acc[ai][bj][m][0], acc[ai][bj][m][1]); }
    }
};
struct EpiStoreS {
    static constexpr bool PERM = true, AFTER_DRAIN = false, KEEPS = false;
    bf16_t* O; int ldc; float sc;
    __device__ __forceinline__ void operator()(AccT& acc, const Unit& u, int wr, int wc, int fr, int fq) const {
        const int row0 = u.pm * BM + wr * 64 + fr, col0 = u.pn * BM + wc * 32 + 8 * fq;
#pragma unroll
        for (int ai = 0; ai < 2; ++ai)
#pragma unroll
            for (int m = 0; m < 4; ++m) { bf16_t* rowp = O + (size_t)(row0 + ai * HALF + m * 16) * ldc + col0;
#pragma unroll
                for (int bj = 0; bj < 2; ++bj) *(u32x4*)(rowp + bj * HALF) = pack8(acc[ai][bj][m][0] * sc, acc[ai][bj][m][1] * sc); }
    }
};
struct EpiKV {
    static constexpr bool PERM = true, AFTER_DRAIN = false, KEEPS = false;
    bf16_t* kvb;
    __device__ __forceinline__ void operator()(AccT& acc, const Unit& u, int wr, int wc, int fr, int fq) const {
        const int l = u.z >> 1, isv = u.z & 1;
        bf16_t* base = kvb + (size_t)l * 4194304 + (isv ? 2097152 : 0);
        const int ldc = 1024;
        const int row0 = u.pm * 256 + wr * 64 + fr, col0 = u.pn * 256 + wc * 32 + 8 * fq;
#pragma unroll
        for (int ai = 0; ai < 2; ++ai)
#pragma unroll
            for (int m = 0; m < 4; ++m) { bf16_t* rowp = base + (size_t)(row0 + ai * HALF + m * 16) * ldc + col0;
#pragma unroll
                for (int bj = 0; bj < 2; ++bj) *(u32x4*)(rowp + bj * HALF) = pack8(acc[ai][bj][m][0], acc[ai][bj][m][1]); }
    }
};
#ifdef MK_GATE_LOGIT
#define GATE_ACT(x) (x)
#else
#define GATE_ACT(x) fast_sigmoid(x)
#endif
struct EpiProj {
    static constexpr bool PERM = true, AFTER_DRAIN = false, KEEPS = false;
    bf16_t* projb; bf16_t* gate; const float* bgate; float sc;
    __device__ __forceinline__ void operator()(AccT& acc, const Unit& u, int wr, int wc, int fr, int fq) const {
        const int row0 = u.pm * BM + wr * 64 + fr;
        if (u.pn < 19) {
            const int col0 = u.pn * BM + wc * 32 + 8 * fq;
#pragma unroll
            for (int ai = 0; ai < 2; ++ai)
#pragma unroll
                for (int m = 0; m < 4; ++m) { bf16_t* rowp = projb + (size_t)(row0 + ai * HALF + m * 16) * 4864 + col0;
#pragma unroll
                    for (int bj = 0; bj < 2; ++bj) *(u32x4*)(rowp + bj * HALF) = pack8(acc[ai][bj][m][0] * sc, acc[ai][bj][m][1] * sc); }
        } else {
            const int col0 = (u.pn - 19) * BM + wc * 32 + 8 * fq;
            f32x4 bv[2][2];
#pragma unroll
            for (int bj = 0; bj < 2; ++bj)
#pragma unroll
                for (int n = 0; n < 2; ++n) bv[bj][n] = *(const f32x4*)(bgate + col0 + bj * HALF + 4 * n);
#pragma unroll
            for (int ai = 0; ai < 2; ++ai)
#pragma unroll
                for (int m = 0; m < 4; ++m) { bf16_t* rowp = gate + (size_t)(row0 + ai * HALF + m * 16) * 4096 + col0;
#pragma unroll
                    for (int bj = 0; bj < 2; ++bj) { f32x4 v0 = acc[ai][bj][m][0] * sc + bv[bj][0], v1 = acc[ai][bj][m][1] * sc + bv[bj][1];
#pragma unroll
                        for (int j = 0; j < 4; ++j) { v0[j] = GATE_ACT(v0[j]); v1[j] = GATE_ACT(v1[j]); }
                        *(u32x4*)(rowp + bj * HALF) = pack8(v0, v1); } }
        }
    }
};
struct EpiGlu {
    static constexpr bool PERM = true, AFTER_DRAIN = false, KEEPS = false;
    const bf16_t* ys; bf16_t* br;
    __device__ __forceinline__ void operator()(AccT& acc, const Unit& u, int wr, int wc, int fr, int fq) const {
        const int row0 = u.pm * BM + wr * 64 + fr, col0 = u.pn * BM + wc * 32 + 8 * fq;
#pragma unroll
        for (int ai = 0; ai < 2; ++ai)
#pragma unroll
            for (int m = 0; m < 4; ++m) { const size_t row = (size_t)(row0 + ai * HALF + m * 16);
#pragma unroll
                for (int bj = 0; bj < 2; ++bj) { const u32x4 yw = *(const u32x4*)(ys + row * 512 + col0 + bj * HALF);
                    f32x4 v0 = acc[ai][bj][m][0], v1 = acc[ai][bj][m][1];
                    v0[0] = bf_lo(yw.x) * fast_sigmoid(v0[0]); v0[1] = bf_hi(yw.x) * fast_sigmoid(v0[1]); v0[2] = bf_lo(yw.y) * fast_sigmoid(v0[2]); v0[3] = bf_hi(yw.y) * fast_sigmoid(v0[3]);
                    v1[0] = bf_lo(yw.z) * fast_sigmoid(v1[0]); v1[1] = bf_hi(yw.z) * fast_sigmoid(v1[1]); v1[2] = bf_lo(yw.w) * fast_sigmoid(v1[2]); v1[3] = bf_hi(yw.w) * fast_sigmoid(v1[3]);
                    *(u32x4*)(br + row * 2048 + col0 + bj * HALF) = pack8(v0, v1); } }
    }
};
struct EpiMerge {
    static constexpr bool PERM = true, AFTER_DRAIN = false, KEEPS = true;
    const bf16_t* gate; bf16_t* merged;
    __device__ __forceinline__ bool keep(const Unit& u) const { return u.z < 3; }
    __device__ __forceinline__ void operator()(AccT& acc, const Unit& u, int wr, int wc, int fr, int fq) const {
        const int row0 = u.pm * BM + wr * 64 + fr, col0 = u.pn * BM + wc * 32 + 8 * fq, k = u.z;
        if (k < 3) {
#pragma unroll
            for (int ai = 0; ai < 2; ++ai) { u32x4 gw[4][2], nw[4][2];
#pragma unroll
                for (int m = 0; m < 4; ++m)
#pragma unroll
                    for (int bj = 0; bj < 2; ++bj) { const bf16_t* gp = gate + (size_t)(row0 + ai * HALF + m * 16) * 4096 + k * 1024 + col0 + bj * HALF; gw[m][bj] = *(const u32x4*)gp; nw[m][bj] = *(const u32x4*)(gp + 1024); }
#pragma unroll
                for (int m = 0; m < 4; ++m)
#pragma unroll
                    for (int bj = 0; bj < 2; ++bj) { const u32x4 a = gw[m][bj], b = nw[m][bj];
                        const f32x4 g0 = (f32x4){bf_lo(a.x), bf_hi(a.x), bf_lo(a.y), bf_hi(a.y)}, g1 = (f32x4){bf_lo(a.z), bf_hi(a.z), bf_lo(a.w), bf_hi(a.w)};
                        const f32x4 n0 = (f32x4){bf_lo(b.x), bf_hi(b.x), bf_lo(b.y), bf_hi(b.y)}, n1 = (f32x4){bf_lo(b.z), bf_hi(b.z), bf_lo(b.w), bf_hi(b.w)};
                        f32x4 r0, r1;
#pragma unroll
                        for (int j = 0; j < 4; ++j) { r0[j] = fmaxf(g0[j], 1e-20f) * __builtin_amdgcn_rcpf(fmaxf(n0[j], 1e-20f)); r1[j] = fmaxf(g1[j], 1e-20f) * __builtin_amdgcn_rcpf(fmaxf(n1[j], 1e-20f)); }
                        acc[ai][bj][m][0] *= r0; acc[ai][bj][m][1] *= r1; }
                asm volatile("" ::: "memory"); }
        } else {
#pragma unroll
            for (int ai = 0; ai < 2; ++ai) { u32x4 gw[4][2];
#pragma unroll
                for (int m = 0; m < 4; ++m)
#pragma unroll
                    for (int bj = 0; bj < 2; ++bj) gw[m][bj] = *(const u32x4*)(gate + (size_t)(row0 + ai * HALF + m * 16) * 4096 + k * 1024 + col0 + bj * HALF);
#pragma unroll
                for (int m = 0; m < 4; ++m)
#pragma unroll
                    for (int bj = 0; bj < 2; ++bj) { const u32x4 a = gw[m][bj];
                        f32x4 g0 = (f32x4){bf_lo(a.x), bf_hi(a.x), bf_lo(a.y), bf_hi(a.y)}, g1 = (f32x4){bf_lo(a.z), bf_hi(a.z), bf_lo(a.w), bf_hi(a.w)};
#pragma unroll
                        for (int j = 0; j < 4; ++j) { g0[j] = fmaxf(g0[j], 1e-20f); g1[j] = fmaxf(g1[j], 1e-20f); }
                        *(u32x4*)(merged + (size_t)(row0 + ai * HALF + m * 16) * 1024 + col0 + bj * HALF) = pack8(acc[ai][bj][m][0] * g0, acc[ai][bj][m][1] * g1); }
                asm volatile("" ::: "memory"); }
        }
    }
};
struct EpiRes {
    static constexpr bool PERM = false, AFTER_DRAIN = false, KEEPS = false;
    const float* in; float* out;
    __device__ __forceinline__ void operator()(AccT& acc, const Unit& u, int wr, int wc, int fr, int fq) const {
        const int row0 = u.pm * BM + wr * 64 + fr, col0 = u.pn * BM + wc * 32 + 4 * fq;
#pragma unroll
        for (int ai = 0; ai < 2; ++ai)
#pragma unroll
            for (int m = 0; m < 4; ++m) { const size_t off = (size_t)(row0 + ai * HALF + m * 16) * 1024 + col0;
#pragma unroll
                for (int bj = 0; bj < 2; ++bj)
#pragma unroll
                    for (int n = 0; n < 2; ++n) { const f32x4 bs = *(const f32x4*)(in + off + bj * HALF + n * 16); *(f32x4*)(out + off + bj * HALF + n * 16) = bs + acc[ai][bj][m][n]; }
                if (m == 3) asm volatile("" ::: "memory"); }
    }
};
struct EpiSoftmax {
    static constexpr bool PERM = true, AFTER_DRAIN = true, KEEPS = false;
    bf16_t* P; PG8_LAS float* xch;
    __device__ __forceinline__ void fused(AccT& acc, const Unit& u, int wr, int wc, int fr, int fq, PG8_LAS unsigned char*, int, int) const {
        PG8_LAS float* RM = xch; PG8_LAS float* RS = xch + 1024;
#pragma unroll
        for (int ai = 0; ai < 2; ++ai)
#pragma unroll
            for (int m = 0; m < 4; ++m) { float mx = -3.0e38f;
#pragma unroll
                for (int bj = 0; bj < 2; ++bj)
#pragma unroll
                    for (int n = 0; n < 2; ++n) { const f32x4 x = acc[ai][bj][m][n]; mx = fmaxf(mx, fmaxf(fmaxf(x[0], x[1]), fmaxf(x[2], x[3]))); }
                mx = fmaxf(mx, __shfl_xor(mx, 16)); mx = fmaxf(mx, __shfl_xor(mx, 32));
                if (fq == 0) RM[(ai * HALF + wr * 64 + m * 16 + fr) * 4 + wc] = mx; }
        asm volatile("s_waitcnt lgkmcnt(0)" ::: "memory"); __builtin_amdgcn_s_barrier(); asm volatile("" ::: "memory");
#pragma unroll
        for (int ai = 0; ai < 2; ++ai)
#pragma unroll
            for (int m = 0; m < 4; ++m) { const int r = ai * HALF + wr * 64 + m * 16 + fr; const f32x4 q = *(const PG8_LAS f32x4*)(RM + r * 4);
                const float mx = fmaxf(fmaxf(q[0], q[1]), fmaxf(q[2], q[3])) * 1.4426950408889634f; float s = 0.f;
#pragma unroll
                for (int bj = 0; bj < 2; ++bj)
#pragma unroll
                    for (int n = 0; n < 2; ++n) { f32x4 x = acc[ai][bj][m][n];
#pragma unroll
                        for (int j = 0; j < 4; ++j) { x[j] = __builtin_amdgcn_exp2f(x[j] * 1.4426950408889634f - mx); s += x[j]; }
                        acc[ai][bj][m][n] = x; }
                s += __shfl_xor(s, 16); s += __shfl_xor(s, 32);
                if (fq == 0) RS[r * 4 + wc] = s; }
        asm volatile("s_waitcnt lgkmcnt(0)" ::: "memory"); __builtin_amdgcn_s_barrier(); asm volatile("" ::: "memory");
        const int row0 = u.pm * BM + wr * 64 + fr, col0 = u.pn * BM + wc * 32 + 8 * fq;
#pragma unroll
        for (int ai = 0; ai < 2; ++ai)
#pragma unroll
            for (int m = 0; m < 4; ++m) { const int r = ai * HALF + wr * 64 + m * 16 + fr; const f32x4 q = *(const PG8_LAS f32x4*)(RS + r * 4);
                const float inv = __builtin_amdgcn_rcpf((q[0] + q[1]) + (q[2] + q[3]));
                bf16_t* rowp = P + (size_t)(row0 + ai * HALF + m * 16) * 1024 + col0;
#pragma unroll
                for (int bj = 0; bj < 2; ++bj) *(u32x4*)(rowp + bj * HALF) = pack8(acc[ai][bj][m][0] * inv, acc[ai][bj][m][1] * inv); }
    }
};
struct EpiSwiglu {
    static constexpr bool PERM = true, AFTER_DRAIN = false, KEEPS = false;
    bf16_t* act; int ldc; float sc;
    __device__ __forceinline__ void operator()(AccT& acc, const Unit& u, int wr, int wc, int fr, int fq) const {
        const int row0 = u.pm * BM + wr * 64 + fr, col0 = u.pn * 128 + wc * 16 + 4 * fq;
#pragma unroll
        for (int ai = 0; ai < 2; ++ai)
#pragma unroll
            for (int m = 0; m < 4; ++m) { bf16_t* rowp = act + (size_t)(row0 + ai * HALF + m * 16) * ldc + col0;
#pragma unroll
                for (int bj = 0; bj < 2; ++bj) { const f32x4 a = acc[ai][bj][m][0] * sc, b = acc[ai][bj][m][1] * sc; f32x4 o;
#pragma unroll
                    for (int j = 0; j < 4; ++j) o[j] = a[j] * fast_sigmoid(a[j]) * b[j];
                    u32x2 w; w.x = cvt_pk_bf16(o[0], o[1]); w.y = cvt_pk_bf16(o[2], o[3]); *(u32x2*)(rowp + bj * 64) = w; } }
    }
};
struct EpiSwigluF8 {
    static constexpr bool PERM = true, AFTER_DRAIN = false, KEEPS = false;
    unsigned char* act; int ldc; float sc, so;
    __device__ __forceinline__ void operator()(AccT& acc, const Unit& u, int wr, int wc, int fr, int fq) const {
        const int row0 = u.pm * BM + wr * 64 + fr, col0 = u.pn * 128 + wc * 16 + 4 * fq;
#pragma unroll
        for (int ai = 0; ai < 2; ++ai)
#pragma unroll
            for (int m = 0; m < 4; ++m) { unsigned char* rowp = act + (size_t)(row0 + ai * HALF + m * 16) * ldc + col0;
#pragma unroll
                for (int bj = 0; bj < 2; ++bj) { const f32x4 a = acc[ai][bj][m][0] * sc, b = acc[ai][bj][m][1] * sc; f32x4 o;
#pragma unroll
                    for (int j = 0; j < 4; ++j) o[j] = a[j] * fast_sigmoid(a[j]) * b[j] * so;
                    int w = 0; w = __builtin_amdgcn_cvt_pk_fp8_f32(o[0], o[1], w, false); w = __builtin_amdgcn_cvt_pk_fp8_f32(o[2], o[3], w, true); *(unsigned*)(rowp + bj * 64) = (unsigned)w; } }
    }
};

struct PlainOrder : NoHooks {
    const char* A; const char* B; int nM, nN, lda, ldb, G, c;
    __device__ __forceinline__ bool next(int i, Unit& u) const { const int L = i * G + c; if (L >= nM * nN) return false; tile_map(L, nM, nN, u.pm, u.pn); u.z = 0;
        u.a = A + (size_t)u.pm * 256 * lda * 2; u.b = B + (size_t)u.pn * 256 * ldb * 2; return true; }
};
struct PlainOrderOff : NoHooks {
    const char* A; const char* B; int nM, nN, lda, ldb, G, c, pn0, L0, L1;
    __device__ __forceinline__ bool next(int i, Unit& u) const { const int L = L0 + i * G + c; if (L >= L1) return false; tile_map(L, nM, nN, u.pm, u.pn); u.pn += pn0; u.z = 0;
        u.a = A + (size_t)u.pm * 256 * lda * 2; u.b = B + (size_t)u.pn * 256 * ldb * 2; return true; }
};
struct PlainOrderOffF8 : NoHooks {   static constexpr bool F8 = true;
    const char* A; const char* B; int nM, nN, lda, ldb, G, c, pn0, L0, L1;
    __device__ __forceinline__ bool next(int i, Unit& u) const { const int L = L0 + i * G + c; if (L >= L1) return false; tile_map(L, nM, nN, u.pm, u.pn); u.pn += pn0; u.z = 0;
        u.a = A + (size_t)u.pm * 256 * lda * 2; u.b = B + (size_t)u.pn * 256 * ldb * 2; return true; }
};
struct MergeOrder : NoHooks {
    const char* br_; const char* wb_; int G, c;
    __device__ __forceinline__ bool next(int i, Unit& u) const { const int t = c + (i >> 2) * G; if (t >= 256) return false; const int k = i & 3; tile_map(t, 64, 4, u.pm, u.pn); u.z = k;
        u.a = br_ + ((size_t)u.pm * 256 * 2048 + k * 512) * 2; u.b = wb_ + ((size_t)u.pn * 256 * 2048 + k * 512) * 2; return true; }
};
struct KVOrder : NoHooks {
    const char* mnr_; const char* WKV0; const char* WKV1; int G, c;
    __device__ __forceinline__ bool next(int i, Unit& u) const { const int L = i * G + c; if (L >= 128) return false; const int kind = L >> 5, t = L & 31, isv = kind & 1;
        const char* W = (kind >> 1) ? WKV1 : WKV0; u.z = kind;
        if (!isv) { u.pm = t & 7; u.pn = t >> 3; u.a = mnr_ + (size_t)u.pm * 256 * 1024 * 2; u.b = W + (size_t)u.pn * 256 * 1024 * 2; }
        else { u.pm = t & 7; u.pn = t >> 3; u.a = mnr_ + (size_t)u.pm * 256 * 1024 * 2; u.b = W + (size_t)(1024 + u.pn * 256) * 1024 * 2; }
        return true; }
};
struct VWOOrder : NoHooks {
    const char* wo_; const char* v_; int G, c;
    __device__ __forceinline__ bool next(int i, Unit& u) const { if (c < 0) return false; const int L = i * G + c; if (L >= 128) return false; const int b = L >> 4, h = (L >> 2) & 3, nt = L & 3; u.pm = b * 4 + nt; u.pn = h; u.z = 0;
        u.a = wo_ + ((size_t)nt * 256 * 1024 + h * 256) * 2; u.b = v_ + ((size_t)b * 256 * 1024 + h * 256) * 2; return true; }
};
struct PVWOrder : NoHooks {
    const char* p_; const char* vwo_; int G, c;
    __device__ __forceinline__ bool next(int i, Unit& u) const { const int L = i * G + c; if (L >= 256) return false; tile_map(L, 64, 4, u.pm, u.pn); u.z = 0;
        u.a = p_ + (size_t)u.pm * 256 * 1024 * 2; u.b = vwo_ + ((size_t)(u.pm >> 3) * 1024 + u.pn * 256) * 1024 * 2; return true; }
};
struct QKWOrder : NoHooks {
    const char* kx_; const char* wqn_; int G, c;
    __device__ __forceinline__ bool next(int i, Unit& u) const { if (c < 0) return false; const int L = i * G + c; if (L >= 128) return false; const int bh = L >> 2; u.pm = bh; u.pn = L & 3; u.z = 0;
        u.a = kx_ + ((size_t)(bh >> 2) * 256 * 1024 + (bh & 3) * 256) * 2; u.b = wqn_ + ((size_t)u.pn * 256 * 1024 + (bh & 3) * 256) * 2; return true; }
};
struct ScoreOrder : NoHooks {
    const char* hn_; const char* qkw_; int G, c, base;
    __device__ __forceinline__ bool next(int i, Unit& u) const { const int L = base + c; if (i > 0 || L >= 256) return false; tile_map(L, 64, 4, u.pm, u.pn); u.z = 0;
        u.a = hn_ + (size_t)u.pm * 256 * 1024 * 2; u.b = qkw_ + (size_t)((u.pm >> 3) * 4 + u.pn) * 256 * 1024 * 2; return true; }
};
struct QKOrder : NoHooks {
    const char* xq_; const char* kx_; int G, c, base;
    __device__ __forceinline__ bool next(int i, Unit& u) const { const int L = base + c; if (i > 0 || L >= 256) return false; tile_map(L, 64, 4, u.pm, u.pn); u.z = 0;
        u.a = xq_ + ((size_t)u.pm * 256 * 1024 + u.pn * 256) * 2; u.b = kx_ + ((size_t)(u.pm >> 3) * 256 * 1024 + u.pn * 256) * 2; return true; }
};
struct PVOrder : NoHooks {
    const char* p_; const char* vt_; int G, c;
    __device__ __forceinline__ bool next(int i, Unit& u) const { const int L = i * G + c; if (L >= 256) return false; tile_map(L, 64, 4, u.pm, u.pn); u.z = 0;
        u.a = p_ + ((size_t)u.pm * 256 * 1024 + u.pn * 256) * 2; u.b = vt_ + ((size_t)(u.pm >> 3) * 1024 + u.pn * 256) * 256 * 2; return true; }
};
struct EpiPartF32 {
    static constexpr bool PERM = true, AFTER_DRAIN = false, KEEPS = false;
    float* P;
    __device__ __forceinline__ void operator()(AccT& acc, const Unit& u, int wr, int wc, int fr, int fq) const {
        const int row0 = u.z * BM + wr * 64 + fr, col0 = u.pn * BM + wc * 32 + 8 * fq;
#pragma unroll
        for (int ai = 0; ai < 2; ++ai)
#pragma unroll
            for (int m = 0; m < 4; ++m) { float* rowp = P + (size_t)(row0 + ai * HALF + m * 16) * 1024 + col0;
#pragma unroll
                for (int bj = 0; bj < 2; ++bj) { *(f32x4*)(rowp + bj * HALF) = acc[ai][bj][m][0]; *(f32x4*)(rowp + bj * HALF + 4) = acc[ai][bj][m][1]; } }
    }
};
struct EpiPartF32S {
    static constexpr bool PERM = true, AFTER_DRAIN = false, KEEPS = false;
    float* P; float sc;
    __device__ __forceinline__ void operator()(AccT& acc, const Unit& u, int wr, int wc, int fr, int fq) const {
        const int row0 = u.z * BM + wr * 64 + fr, col0 = u.pn * BM + wc * 32 + 8 * fq;
#pragma unroll
        for (int ai = 0; ai < 2; ++ai)
#pragma unroll
            for (int m = 0; m < 4; ++m) { float* rowp = P + (size_t)(row0 + ai * HALF + m * 16) * 1024 + col0;
#pragma unroll
                for (int bj = 0; bj < 2; ++bj) { *(f32x4*)(rowp + bj * HALF) = acc[ai][bj][m][0] * sc; *(f32x4*)(rowp + bj * HALF + 4) = acc[ai][bj][m][1] * sc; } }
    }
};
struct MoeUpGather : NoHooks {
    static constexpr bool GATHER = true, F8 = false;
    const char* A; const char* B; size_t estride; int lda, ldb, ntiles, nN, G, c; int t1, t2, t3, t4, t5, t6, t7; const PG8_LAS int* tab;
    __device__ __forceinline__ bool next(int i, Unit& u) const { const int L = i * G + c; if (L >= ntiles * nN) return false; tile_map(L, ntiles, nN, u.pm, u.pn);
        const int rt = u.pm; const int e = (rt >= t1) + (rt >= t2) + (rt >= t3) + (rt >= t4) + (rt >= t5) + (rt >= t6) + (rt >= t7); u.z = e;
        u.a = A; u.b = B + (size_t)e * estride + (size_t)u.pn * 256 * ldb * 2; return true; }
    __device__ __forceinline__ int rowof(int ord, int r) const { return tab[ord * 256 + r]; }
};
struct MoeUpF8 : NoHooks {
    static constexpr bool F8 = true;
    const char* A; const char* B; size_t estride; int lda, ldb, ntiles, nN, G, c; int t1, t2, t3, t4, t5, t6, t7;
    __device__ __forceinline__ bool next(int i, Unit& u) const { const int L = i * G + c; if (L >= ntiles * nN) return false; tile_map(L, ntiles, nN, u.pm, u.pn);
        const int rt = u.pm; const int e = (rt >= t1) + (rt >= t2) + (rt >= t3) + (rt >= t4) + (rt >= t5) + (rt >= t6) + (rt >= t7); u.z = e;
        u.a = A + (size_t)rt * 256 * lda * 2; u.b = B + (size_t)e * estride + (size_t)u.pn * 256 * ldb * 2; return true; }
};
struct MoeDownOrder : NoHooks {
    const char* A; const char* B; size_t estride; int lda, ldb, G, c; int t1, t2, t3, t4, t5, t6, t7;
    __device__ __forceinline__ bool next(int i, Unit& u) const { const int L = i * G + c; if (L >= 512) return false; u.pm = L >> 2; u.pn = L & 3;
        const int rt = u.pm; const int e = (rt >= t1) + (rt >= t2) + (rt >= t3) + (rt >= t4) + (rt >= t5) + (rt >= t6) + (rt >= t7); u.z = e;
        u.a = A + (size_t)rt * 256 * lda * 2; u.b = B + (size_t)e * estride + (size_t)u.pn * 256 * ldb * 2; return true; }
};
struct MoeDownOrderF8 : NoHooks {   static constexpr bool F8 = true;
    const char* A; const char* B; size_t estride; int lda, ldb, G, c; int t1, t2, t3, t4, t5, t6, t7;
    __device__ __forceinline__ bool next(int i, Unit& u) const { const int L = i * G + c; if (L >= 512) return false; u.pm = L >> 2; u.pn = L & 3;
        const int rt = u.pm; const int e = (rt >= t1) + (rt >= t2) + (rt >= t3) + (rt >= t4) + (rt >= t5) + (rt >= t6) + (rt >= t7); u.z = e;
        u.a = A + (size_t)rt * 256 * lda * 2; u.b = B + (size_t)e * estride + (size_t)u.pn * 256 * ldb * 2; return true; }
};
struct MoeDownTail : NoHooks {
    const char* A; const char* B; size_t estride; int lda, ldb, ntiles, G, c; int t1, t2, t3, t4, t5, t6, t7;
    __device__ __forceinline__ bool next(int i, Unit& u) const { const int v = i * G + c; if (v >= (ntiles - 128) * 28) return false; u.pn = v & 3; const int w = v >> 2, s = w % 7, jr = w / 7;
        const int rt = 128 + jr; u.pm = rt; const int e = (rt >= t1) + (rt >= t2) + (rt >= t3) + (rt >= t4) + (rt >= t5) + (rt >= t6) + (rt >= t7); u.z = jr * 7 + s;
        u.a = A + ((size_t)rt * 256 * lda + s * 512) * 2; u.b = B + (size_t)e * estride + ((size_t)u.pn * 256 * ldb + s * 512) * 2; return true; }
};
struct MoeDownTailF8 : NoHooks {   static constexpr bool F8 = true;
    const char* A; const char* B; size_t estride; int lda, ldb, ntiles, G, c; int t1, t2, t3, t4, t5, t6, t7;
    __device__ __forceinline__ bool next(int i, Unit& u) const { const int v = i * G + c; if (v >= (ntiles - 128) * 28) return false; u.pn = v & 3; const int w = v >> 2, s = w % 7, jr = w / 7;
        const int rt = 128 + jr; u.pm = rt; const int e = (rt >= t1) + (rt >= t2) + (rt >= t3) + (rt >= t4) + (rt >= t5) + (rt >= t6) + (rt >= t7); u.z = jr * 7 + s;
        u.a = A + ((size_t)rt * 256 * lda + s * 256) * 2; u.b = B + (size_t)e * estride + ((size_t)u.pn * 256 * ldb + s * 256) * 2; return true; }
};
struct MoeOrder : NoHooks {
    const char* A; const char* B; size_t estride; int lda, ldb, ntiles, nN, G, c; int t1, t2, t3, t4, t5, t6, t7;
    __device__ __forceinline__ bool next(int i, Unit& u) const { const int L = i * G + c; if (L >= ntiles * nN) return false; tile_map(L, ntiles, nN, u.pm, u.pn);
        const int rt = u.pm; const int e = (rt >= t1) + (rt >= t2) + (rt >= t3) + (rt >= t4) + (rt >= t5) + (rt >= t6) + (rt >= t7); u.z = e;
        u.a = A + (size_t)rt * 256 * lda * 2; u.b = B + (size_t)e * estride + (size_t)u.pn * 256 * ldb * 2; return true; }
};

template <class Epi, class Sched, bool ALIGN_EPI = false, bool SP2 = false>
__device__ __forceinline__ void gemm_phase(PG8_LAS unsigned char* lds, const Gemm g, const Sched& S, const Epi& E, const int wave_s) {
    int tid_ = wave_s * 64 + lane_id_fresh(); asm volatile("" : "+v"(tid_));
    const int tid = tid_, wid = __builtin_amdgcn_readfirstlane(tid >> 6), lane = tid & 63, wr = wid >> 2, wc = wid & 3, fr = lane & 15, fq = lane >> 4;
    const int K = g.K, nt = K / BK;
    unsigned voffA[2], voffB[2];
#pragma unroll
    for (int i = 0; i < 2; ++i) { int R, C; stage_rc(tid * 16 + i * 8192, R, C); const int Rb = Epi::PERM ? ((R & ~31) + perm32(R & 31)) : R;
        voffA[i] = (unsigned)(R * g.lda + C) * 2u; voffB[i] = (unsigned)(Rb * g.ldb + C) * 2u; }
    const size_t kstep = (size_t)(BK * 2);
    const size_t hstepA = (size_t)HALF * g.lda * 2, hstepB = (size_t)HALF * g.ldb * 2;
    const unsigned ldsw = (unsigned)wid * 1024u;
    const int aoff = lds_byte(wr * 64 + fr, fq * 8), boff = lds_byte(wc * 32 + fr, fq * 8);
#define PG8_SA(b, h) (((b) * 2 + (h)) * HTB)
#define PG8_SB(b, h) ((4 + (b) * 2 + (h)) * HTB)
#define PG8_UBASE(gbase) ([&]() -> const char* { if constexpr (Sched::F8) { const unsigned long long p_ = (unsigned long long)(gbase); \
        return (const char*)(((unsigned long long)(unsigned)__builtin_amdgcn_readfirstlane((int)(unsigned)(p_ >> 32)) << 32) | (unsigned long long)(unsigned)__builtin_amdgcn_readfirstlane((int)(unsigned)p_)); } else { return (const char*)(gbase); } }())
#define PG8_STAGE(bufoff, gbase, voff) do { const char* gb_ = PG8_UBASE(gbase); _Pragma("unroll") for (int _i = 0; _i < 2; ++_i) \
        __builtin_amdgcn_global_load_lds((const unsigned*)(gb_ + (voff)[_i]), (PG8_LAS unsigned*)(lds + (bufoff) + ldsw + _i * 8192), 16, 0, 0); } while (0)
#define PG8_LDA(dst, b, h) do { if constexpr (Sched::F8) { _Pragma("unroll") for (int m = 0; m < 4; ++m) dst##8[m] = PG8_CAT8(*(const PG8_LAS bf16x8*)(lds + PG8_SA(b, h) + aoff + m * 2048), *(const PG8_LAS bf16x8*)(lds + PG8_SA(b, h) + aoff + m * 2048 + 1024)); } \
    else { _Pragma("unroll") for (int m = 0; m < 4; ++m) _Pragma("unroll") for (int k = 0; k < 2; ++k) dst[m][k] = *(const PG8_LAS bf16x8*)(lds + PG8_SA(b, h) + aoff + m * 2048 + k * 1024); } } while (0)
#define PG8_LDB(dst, b, h) do { if constexpr (Sched::F8) { _Pragma("unroll") for (int n = 0; n < 2; ++n) dst##8[n] = PG8_CAT8(*(const PG8_LAS bf16x8*)(lds + PG8_SB(b, h) + boff + n * 2048), *(const PG8_LAS bf16x8*)(lds + PG8_SB(b, h) + boff + n * 2048 + 1024)); } \
    else { _Pragma("unroll") for (int n = 0; n < 2; ++n) _Pragma("unroll") for (int k = 0; k < 2; ++k) dst[n][k] = *(const PG8_LAS bf16x8*)(lds + PG8_SB(b, h) + boff + n * 2048 + k * 1024); } } while (0)
#define PG8_CAT8(x0, x1) __builtin_shufflevector(__builtin_bit_cast(i32x4_, (x0)), __builtin_bit_cast(i32x4_, (x1)), 0, 1, 2, 3, 4, 5, 6, 7)
#define PG8_MMA(ai, bj, At, Bt) do { __builtin_amdgcn_s_setprio(1); if constexpr (Sched::F8) { _Pragma("unroll") for (int m = 0; m < 4; ++m) _Pragma("unroll") for (int n = 0; n < 2; ++n) \
        asm volatile("v_mfma_scale_f32_16x16x128_f8f6f4 %0, %1, %2, %0, %3, %3 op_sel_hi:[0,0,0]" : "+v"(acc[ai][bj][m][n]) : "v"(Bt##8[n]), "v"(At##8[m]), "v"(sc7f_)); }     \
      else { _Pragma("unroll") for (int m = 0; m < 4; ++m) _Pragma("unroll") for (int n = 0; n < 2; ++n) _Pragma("unroll") for (int k = 0; k < 2; ++k) \
        acc[ai][bj][m][n] = __builtin_amdgcn_mfma_f32_16x16x32_bf16(Bt[n][k], At[m][k], acc[ai][bj][m][n], 0, 0, 0); } __builtin_amdgcn_s_setprio(0); } while (0)
#define PG8_WAIT_V(n) asm volatile("s_waitcnt vmcnt(" #n ")" ::: "memory")
#define PG8_WAIT_L(n) asm volatile("s_waitcnt lgkmcnt(" #n ")" ::: "memory")
#define PG8_BAR __builtin_amdgcn_s_barrier()
#define PG8_SCHED __builtin_amdgcn_sched_barrier(0)
    Unit cur, nxt; int ui = 0;
    if (!S.next(0, cur)) return;
    static_assert(!Sched::GATHER || SP2, "row-gathered A staging is written for the SP2 schedule only");
    unsigned vgc[2][2] = {{0u, 0u}, {0u, 0u}}, vgn[2][2] = {{0u, 0u}, {0u, 0u}}, vgs[2][2] = {{0u, 0u}, {0u, 0u}};
#define PG8_GLOAD(vg, ord) do { _Pragma("unroll") for (int h_ = 0; h_ < 2; ++h_) _Pragma("unroll") for (int i_ = 0; i_ < 2; ++i_) { int R_, C_; stage_rc(tid * 16 + i_ * 8192, R_, C_); \
        vg[h_][i_] = (unsigned)(S.rowof((ord), h_ * HALF + R_) * g.lda + C_) * 2u; } } while (0)
#define PG8_STAGE_A(b, h, base, vg) do { if constexpr (Sched::GATHER) { PG8_STAGE(PG8_SA(b, h), (base), vg[h]); } else { PG8_STAGE(PG8_SA(b, h), (base) + (h) * hstepA, voffA); } } while (0)
    if constexpr (Sched::GATHER) PG8_GLOAD(vgc, 0);
    f32x4 acc[2][2][4][2];
#pragma unroll
    for (int a = 0; a < 2; ++a)
#pragma unroll
        for (int b = 0; b < 2; ++b)
#pragma unroll
            for (int m = 0; m < 4; ++m)
#pragma unroll
                for (int n = 0; n < 2; ++n) acc[a][b][m][n] = (f32x4){0.f, 0.f, 0.f, 0.f};
    bf16x8 At[4][2], B0[2][2], B1[2][2];
    int sc7f_ = 0x7F7F7F7F; asm volatile("" : "+v"(sc7f_));
    i32x8_ At8[4], B08[2], B18[2];
    const char* cA = cur.a; const char* cB = cur.b;
    S.a_ready(cur);
    if constexpr (SP2) {
        PG8_STAGE(PG8_SB(0, 0), cB, voffB); PG8_STAGE(PG8_SB(0, 1), cB + hstepB, voffB); PG8_STAGE_A(0, 0, cA, vgc); PG8_STAGE_A(0, 1, cA, vgc);
        if (wr == 1) PG8_BAR;
        PG8_WAIT_V(2); PG8_BAR;
        PG8_STAGE(PG8_SB(1, 0), cB + kstep, voffB); PG8_STAGE_A(1, 0, cA + kstep, vgc); PG8_STAGE(PG8_SB(1, 1), cB + hstepB + kstep, voffB);
        PG8_WAIT_V(6); PG8_BAR;
    } else {
        PG8_STAGE(PG8_SB(0, 0), cB, voffB); PG8_STAGE(PG8_SA(0, 0), cA, voffA); PG8_STAGE(PG8_SB(0, 1), cB + hstepB, voffB); PG8_STAGE(PG8_SA(0, 1), cA + hstepA, voffA);
        if (wr == 1) PG8_BAR;
        PG8_WAIT_V(4); PG8_BAR;
        PG8_STAGE(PG8_SB(1, 0), cB + kstep, voffB); PG8_STAGE(PG8_SA(1, 0), cA + kstep, voffA); PG8_STAGE(PG8_SB(1, 1), cB + hstepB + kstep, voffB);
        PG8_WAIT_V(6); PG8_BAR;
    }
    for (;;) {
        const bool has_next = S.next(ui + 1, nxt);
        if constexpr (Sched::GATHER) { if (has_next) PG8_GLOAD(vgn, ui + 1); }
        const char* nA = has_next ? nxt.a : cA; const char* nB = has_next ? nxt.b : cB;
#pragma nounroll
        for (int t = 0; t < nt; t += 2) {
            const bool last = (t == nt - 2);
            const char* a1 = cA + (size_t)(t + 1) * kstep;
            const char* a2 = last ? nA : cA + (size_t)(t + 2) * kstep; const char* b2 = last ? nB : cB + (size_t)(t + 2) * kstep;
            const char* a3 = a2 + kstep; const char* b3 = b2 + kstep;
            if (last && has_next) S.a_ready(nxt);
            if constexpr (Sched::GATHER) { const bool nx_ = last && has_next; _Pragma("unroll") for (int h_ = 0; h_ < 2; ++h_) _Pragma("unroll") for (int i_ = 0; i_ < 2; ++i_) vgs[h_][i_] = nx_ ? vgn[h_][i_] : vgc[h_][i_]; }
            if constexpr (SP2) {
            PG8_LDB(B0, 0, 0); PG8_LDB(B1, 0, 1); PG8_SCHED; PG8_LDA(At, 0, 0); PG8_STAGE_A(1, 1, a1, vgc);
            PG8_WAIT_V(8); PG8_WAIT_L(0); PG8_BAR; PG8_MMA(0, 0, At, B0); PG8_MMA(0, 1, At, B1); PG8_BAR; PG8_SCHED;
            PG8_LDA(At, 0, 1); PG8_STAGE(PG8_SB(0, 0), b2, voffB); PG8_STAGE(PG8_SB(0, 1), b2 + hstepB, voffB); PG8_STAGE_A(0, 0, a2, vgs);
            PG8_WAIT_V(8); PG8_WAIT_L(0); PG8_BAR; PG8_MMA(1, 0, At, B0); PG8_MMA(1, 1, At, B1); PG8_BAR; PG8_SCHED;
            PG8_LDB(B0, 1, 0); PG8_LDB(B1, 1, 1); PG8_SCHED; PG8_LDA(At, 1, 0); PG8_STAGE_A(0, 1, a2, vgs);
            PG8_WAIT_V(8); PG8_WAIT_L(0); PG8_BAR; PG8_MMA(0, 0, At, B0); PG8_MMA(0, 1, At, B1); PG8_BAR; PG8_SCHED;
            PG8_LDA(At, 1, 1); PG8_STAGE(PG8_SB(1, 0), b3, voffB); PG8_STAGE(PG8_SB(1, 1), b3 + hstepB, voffB); PG8_STAGE_A(1, 0, a3, vgs);
            PG8_WAIT_V(8); PG8_WAIT_L(0); PG8_BAR; PG8_MMA(1, 0, At, B0); PG8_MMA(1, 1, At, B1); PG8_BAR; PG8_SCHED;
            } else {
            PG8_LDB(B0, 0, 0); PG8_SCHED; PG8_LDA(At, 0, 0); PG8_STAGE(PG8_SA(1, 1), a1 + hstepA, voffA);
            PG8_WAIT_L(8); PG8_BAR; PG8_WAIT_L(0); PG8_MMA(0, 0, At, B0); PG8_BAR; PG8_SCHED;
            PG8_LDB(B1, 0, 1); PG8_STAGE(PG8_SB(0, 0), b2, voffB);
            PG8_BAR; PG8_WAIT_L(0); PG8_MMA(0, 1, At, B1); PG8_BAR;
            PG8_LDA(At, 0, 1); PG8_STAGE(PG8_SA(0, 0), a2, voffA);
            PG8_BAR; PG8_WAIT_L(0); PG8_MMA(1, 0, At, B0); PG8_BAR; PG8_SCHED;
            PG8_STAGE(PG8_SB(0, 1), b2 + hstepB, voffB);
            PG8_WAIT_V(6); PG8_BAR; PG8_MMA(1, 1, At, B1); PG8_BAR;
            PG8_LDB(B0, 1, 0); PG8_SCHED; PG8_LDA(At, 1, 0); PG8_STAGE(PG8_SA(0, 1), a2 + hstepA, voffA);
            PG8_WAIT_L(8); PG8_BAR; PG8_WAIT_L(0); PG8_MMA(0, 0, At, B0); PG8_BAR; PG8_SCHED;
            PG8_LDB(B1, 1, 1); PG8_STAGE(PG8_SB(1, 0), b3, voffB);
            PG8_BAR; PG8_WAIT_L(0); PG8_MMA(0, 1, At, B1); PG8_BAR;
            PG8_LDA(At, 1, 1); PG8_STAGE(PG8_SA(1, 0), a3, voffA);
            PG8_BAR; PG8_WAIT_L(0); PG8_MMA(1, 0, At, B0); PG8_BAR; PG8_SCHED;
            PG8_STAGE(PG8_SB(1, 1), b3 + hstepB, voffB);
            PG8_WAIT_V(6); PG8_BAR; PG8_MMA(1, 1, At, B1); PG8_BAR;
            }
        }
        if constexpr (Sched::F8) asm volatile("s_nop 15\n\ts_nop 7" ::: "memory");
        if constexpr (ALIGN_EPI) { if (wr == 0) PG8_BAR; }
        if constexpr (!Epi::AFTER_DRAIN) { const int l2_ = lane_id_fresh(); E(acc, cur, wr, wc, l2_ & 15, l2_ >> 4); S.done(cur); }
        if (!has_next) break;
        bool zero_acc = true; if constexpr (Epi::KEEPS) zero_acc = !E.keep(cur);
        if (zero_acc) {
#pragma unroll
        for (int a = 0; a < 2; ++a)
#pragma unroll
            for (int b = 0; b < 2; ++b)
#pragma unroll
                for (int m = 0; m < 4; ++m)
#pragma unroll
                    for (int n = 0; n < 2; ++n) acc[a][b][m][n] = (f32x4){0.f, 0.f, 0.f, 0.f};
        }
        cur = nxt; cA = nA; cB = nB; ++ui;
        if constexpr (Sched::GATHER) { _Pragma("unroll") for (int h_ = 0; h_ < 2; ++h_) _Pragma("unroll") for (int i_ = 0; i_ < 2; ++i_) vgc[h_][i_] = vgn[h_][i_]; }
        if constexpr (ALIGN_EPI) { if (wr == 1) PG8_BAR; }
    }
    PG8_WAIT_V(0);
    if constexpr (!ALIGN_EPI) { if (wr == 0) PG8_BAR; }
    PG8_BAR;
    if constexpr (Epi::AFTER_DRAIN) { const int l3_ = lane_id_fresh(); E.fused(acc, cur, wr, wc, l3_ & 15, l3_ >> 4, lds, wid, l3_); S.done(cur); }
#undef PG8_SA
#undef PG8_SB
#undef PG8_STAGE
#undef PG8_UBASE
#undef PG8_STAGE_A
#undef PG8_GLOAD
#undef PG8_LDA
#undef PG8_LDB
#undef PG8_MMA
#undef PG8_CAT8
#undef PG8_WAIT_V
#undef PG8_WAIT_L
#undef PG8_BAR
#undef PG8_SCHED
}
}

#define GAS __attribute__((address_space(1)))
#define LAS __attribute__((address_space(3)))
typedef unsigned short bf16;
typedef unsigned v4u __attribute__((ext_vector_type(4)));
typedef short bf16x8 __attribute__((ext_vector_type(8)));
typedef unsigned v2u __attribute__((ext_vector_type(2)));
typedef float f32x4 __attribute__((ext_vector_type(4)));
typedef float f32x2 __attribute__((ext_vector_type(2)));
typedef int i32x4 __attribute__((ext_vector_type(4)));
typedef int i32x2 __attribute__((ext_vector_type(2)));
#define RLX_AGENT __ATOMIC_RELAXED, __HIP_MEMORY_SCOPE_AGENT
#define LDS_WAIT() asm volatile("s_waitcnt lgkmcnt(0)" ::: "memory")
#define VM_WAIT() asm volatile("s_waitcnt vmcnt(0)" ::: "memory")
__device__ __forceinline__ unsigned f2bf(float f) { unsigned u = __builtin_bit_cast(unsigned, f); return (u + 0x7fffu + ((u >> 16) & 1u)) >> 16; }
__device__ __forceinline__ unsigned pk2(float lo, float hi) { return f2bf(lo) | (f2bf(hi) << 16); }
__device__ __forceinline__ float bflo(unsigned w) { return __uint_as_float(w << 16); }
__device__ __forceinline__ float bfhi(unsigned w) { return __uint_as_float(w & 0xffff0000u); }
__device__ __forceinline__ float bf1(bf16 v) { return __uint_as_float((unsigned)v << 16); }

#define XB_TMO      128
#define XB_XCNT(j)  (256  + 64 * (j))
#define XB_XSUB(j)  (1280 + 64 * (j))
#define XB_XGEN(j)  (2304 + 64 * (j))
#define XB_TOP      3328
#define XB_TOPGEN   3392
#define XCD_BAR_WORDS 3456
#define XB_SPIN_CAP (1u << 18)

__device__ __forceinline__ unsigned xb_ld(unsigned* p)              { return __hip_atomic_load(p, __ATOMIC_RELAXED, __HIP_MEMORY_SCOPE_AGENT); }
__device__ __forceinline__ unsigned xb_add(unsigned* p, unsigned v) { return __hip_atomic_fetch_add(p, v, __ATOMIC_RELAXED, __HIP_MEMORY_SCOPE_AGENT); }
__device__ __forceinline__ unsigned xb_xcc_id() { return (unsigned)__builtin_amdgcn_s_getreg((3 << 11) | 20) & 0xFu; }
#define XB_SPIN(cond, bar) do { unsigned _sp = 0; while (cond) { __builtin_amdgcn_s_sleep(1); \
    if ((++_sp & 255u) == 0u) { if (xb_ld(&(bar)[XB_TMO])) break; if (_sp > XB_SPIN_CAP) { atomicAdd(&(bar)[XB_TMO], 1u); break; } } } } while (0)

struct XcdBarrier {
    unsigned* bar; unsigned x;
    volatile LAS unsigned* st;
};

__device__ __forceinline__ XcdBarrier xcd_barrier_post(unsigned* bar, volatile LAS unsigned* st, const int wave_s) {
    XcdBarrier b; b.bar = bar; b.x = xb_xcc_id(); b.st = st;
    if (wave_s == 0 && lane_id_fresh() == 0) (void)xb_add(&bar[XB_XCNT(b.x)], 1u);
    return b;
}
__device__ __forceinline__ void xcd_barrier_complete(unsigned* bar, unsigned x, unsigned& nloc, unsigned& nx) {
    const unsigned G = gridDim.x * gridDim.y * gridDim.z;
    unsigned sum, cnt, mine, sp = 0u;
    for (;;) {
        sum = 0u; cnt = 0u; mine = 0u;
#pragma unroll
        for (unsigned j = 0; j < 16; ++j) { const unsigned c = xb_ld(&bar[XB_XCNT(j)]); sum += c; cnt += (c > 0u) ? 1u : 0u; mine = (j == x) ? c : mine; }
        if (sum == G) break;
        __builtin_amdgcn_s_sleep(1);
        if ((++sp & 255u) == 0u) { if (xb_ld(&bar[XB_TMO])) break; if (sp > XB_SPIN_CAP) { atomicAdd(&bar[XB_TMO], 1u); break; } }
    }
    nloc = mine > 0u ? mine : 1u; nx = cnt > 0u ? cnt : 1u;
}

__device__ __forceinline__ void xcd_barrier(const XcdBarrier& b, const int wave_s) {
    asm volatile("s_waitcnt vmcnt(0)" ::: "memory");
    __syncthreads();
    if (wave_s == 0 && lane_id_fresh() == 0) {
        unsigned* bar = b.bar;
        __builtin_amdgcn_s_waitcnt(0);
        unsigned nloc = b.st[0], nx = b.st[1];
        if (nloc == 0u) { xcd_barrier_complete(bar, b.x, nloc, nx); b.st[0] = nloc; b.st[1] = nx; }
        const unsigned old = xb_add(&bar[XB_XSUB(b.x)], 1u);
        const unsigned gen = old / nloc;
        if (old + 1u == (gen + 1u) * nloc) {
            __builtin_amdgcn_fence(__ATOMIC_RELEASE, "agent");
            asm volatile("s_waitcnt vmcnt(0)" ::: "memory");
            const unsigned og = xb_add(&bar[XB_TOP], 1u);
            const unsigned tg = og / nx;
            if (og + 1u == (tg + 1u) * nx) xb_add(&bar[XB_TOPGEN], 1u);
            else XB_SPIN(xb_ld(&bar[XB_TOPGEN]) == tg, bar);
            __builtin_amdgcn_fence(__ATOMIC_ACQUIRE, "agent");
            xb_add(&bar[XB_XGEN(b.x)], 1u);
            asm volatile("s_waitcnt vmcnt(0)" ::: "memory");
        } else {
            XB_SPIN(xb_ld(&bar[XB_XGEN(b.x)]) == gen, bar);
            __builtin_amdgcn_fence(__ATOMIC_ACQUIRE, "agent");
            asm volatile("s_waitcnt vmcnt(0)" ::: "memory");
        }
    }
    __syncthreads();
}

constexpr int NWAVES = 8;
#ifndef MK_TAIL0
#define MK_TAIL0 0
#endif
#ifndef MK_TAIL1
#define MK_TAIL1 0
#endif
#ifndef MK_GW0
#define MK_GW0 1024
#endif
#ifndef MK_GW1
#define MK_GW1 1024
#endif
#ifndef MK_NMIXB
#define MK_NMIXB 96
#endif
namespace cf {
constexpr int D = 1024, NB = 8, L = 2048, T = NB * L, NMEM = 256, TM = NB * NMEM, IN_TOTAL = 8968, DFF = 2816, DFE = 3584, NE = 8;
constexpr int PJ = 4864;
constexpr int C_U = 0, C_Z = 512, C_XBC = 1024, C_Q = 1792, C_K = 2304, C_V = 2816, C_G = 3328, C_XL = 3840, C_GL = 4352;
constexpr int O_DT = 1792, O_GATE = 4872;
constexpr int MAXSLOT = 34816;
}
constexpr size_t MiB = 1u << 20;
constexpr size_t WS_CTL = 0, CTL_ZERO_BYTES = 1 * MiB;
constexpr size_t WS_TOPI = 1 * MiB, WS_TOPW = WS_TOPI + 256 * 1024, WS_SLOT = WS_TOPW + 128 * 1024;
constexpr size_t WS_HN = 2 * MiB, WS_KV = 34 * MiB, WS_TAB = 50 * MiB, WS_DT = 54 * MiB, WS_MNR = 55 * MiB, WS_W = 59 * MiB;
constexpr size_t WL_STRIDE = 32 * MiB, WL_WIN = 0, WL_GLU = 17 * MiB + 512 * 1024, WL_WB = 18 * MiB, WL_WOUT = 22 * MiB, WL_WQ = 24 * MiB, WL_WKV = 26 * MiB, WL_WO = 30 * MiB;
constexpr size_t WS_W13 = 123 * MiB, WS_W2 = 134 * MiB, WS_R = 140 * MiB;
constexpr size_t R_PROJB = WS_R, R_GATE = WS_R + 152 * MiB, R_BR = WS_R + 280 * MiB, R_XBCC = WS_R + 344 * MiB, R_XLC = WS_R + 368 * MiB, R_YS = WS_R + 384 * MiB, R_QKW = WS_R + 400 * MiB, R_END = WS_R + 416 * MiB;
constexpr size_t R_MP = WS_R, R_MERGED = WS_R + 64 * MiB;
constexpr size_t R_XQ = WS_R, R_P = WS_R + 32 * MiB, R_XO = WS_R + 64 * MiB;
constexpr size_t R_ACT = WS_R;
constexpr size_t M_W13E = 34 * MiB, M_W2E = 146 * MiB, M_XS = 202 * MiB, M_ACTE = 270 * MiB, M_END = 508 * MiB;
constexpr size_t WS_NEED = R_END > M_END ? R_END : M_END;
constexpr int CW_TMO = 0, CW_CODE = 1, CW_BAR = 4096, CW_CNT = 8192;
constexpr int RING_BYTES = 131072, LDSCTL_OFF = RING_BYTES, XCH_OFF = LDSCTL_OFF + 1024, LDS_BYTES = 147456;

struct Params { const float* in[46]; float* out; unsigned char* ws; int ph_lo, ph_hi; };

__device__ __forceinline__ int opq(int v) { asm volatile("" : "+s"(v)); return v; }
template <class Tp> __device__ __forceinline__ Tp* opqp(Tp* q) { return q + opq(0); }
#define DPPF_(v, ctrl, rm, bc) __builtin_bit_cast(float, __builtin_amdgcn_update_dpp(0, __builtin_bit_cast(int, (v)), (ctrl), (rm), 0xF, (bc)))
__device__ __forceinline__ float sum8(float v) {
    v += DPPF_(v, 0xB1, 0xF, true); v += DPPF_(v, 0x4E, 0xF, true); v += DPPF_(v, 0x141, 0xF, true); return v;
}
__device__ __forceinline__ float wave_sum(float v) {
    v = sum8(v); v += DPPF_(v, 0x140, 0xF, true); v += DPPF_(v, 0x142, 0xA, false); v += DPPF_(v, 0x143, 0xC, false);
    return __builtin_bit_cast(float, __builtin_amdgcn_readlane(__builtin_bit_cast(int, v), 63));
}
__device__ __forceinline__ float fexp_(float x) { return __builtin_amdgcn_exp2f(1.4426950408889634f * x); }
__device__ __forceinline__ float sigmoidf_(float x) { return __builtin_amdgcn_rcpf(1.0f + __builtin_amdgcn_exp2f(-1.4426950408889634f * x)); }
__device__ __forceinline__ float siluf_(float x) { return x * __builtin_amdgcn_rcpf(1.0f + __builtin_amdgcn_exp2f(-1.4426950408889634f * x)); }
__device__ __forceinline__ float gelu_tanh(float x) { const float u = 0.7978845608028654f * (x + 0.044715f * x * x * x); const float e = __builtin_amdgcn_exp2f(2.8853900817779268f * u); return x * (1.0f - __builtin_amdgcn_rcpf(e + 1.0f)); }
__device__ __forceinline__ float softplusf_(float x) { return x > 20.f ? x : log1pf(__expf(x)); }

struct MapPlain { const float* W; int K, N; const float* ks; float sc; bf16* WT; int ldo;
    __device__ __forceinline__ f32x4 load4(int k, int n0, int j4) const { return *(const f32x4*)(W + (size_t)k * N + n0 + 4 * j4); }
    __device__ __forceinline__ int nl(int j4) const { return 4 * j4; }
    __device__ __forceinline__ float scale(int k) const { return ks ? ks[k] * sc : sc; }
    __device__ __forceinline__ bf16* dst(int n) const { return WT + (size_t)n * ldo; } };
struct MapWin { const float* W; const float* ks; bf16* WT; int N;
    __device__ __forceinline__ f32x4 load4(int k, int n0, int j4) const { return *(const f32x4*)(W + (size_t)k * cf::IN_TOTAL + n0 + 4 * j4 + (n0 >= cf::O_DT ? 8 : 0)); }
    __device__ __forceinline__ int nl(int j4) const { return 4 * j4; }
    __device__ __forceinline__ float scale(int k) const { return ks[k]; }
    __device__ __forceinline__ bf16* dst(int n) const { return WT + (size_t)n * 1024; } };
struct MapW13 { const float* w1; const float* w3; const float* ks; bf16* WT; int F, N;
    __device__ __forceinline__ f32x4 load4(int k, int n0, int j4) const { const int gi = j4 >> 3, mat = (j4 >> 2) & 1, fi4 = j4 & 3; const ptrdiff_t dsel = mat ? (w3 - w1) : (ptrdiff_t)0;
        return *(const f32x4*)(w1 + dsel + (ptrdiff_t)((size_t)k * F + (n0 >> 1) + 16 * gi + 4 * fi4)); }
    __device__ __forceinline__ int nl(int j4) const { return 32 * (j4 >> 3) + 8 * (j4 & 3) + 4 * ((j4 >> 2) & 1); }
    __device__ __forceinline__ float scale(int k) const { return ks ? ks[k] : 1.0f; }
    __device__ __forceinline__ bf16* dst(int n) const { return WT + (size_t)n * 1024; } };
template <class Map> __device__ __forceinline__ void cvt_item8(const Map& mp, int item, LAS float* scr, int lane, const float wscale, const int pitch) {
    LAS unsigned char* T = (LAS unsigned char*)scr;
    const int nblk = mp.N / 64, kb = item / nblk, nb = item % nblk, k0 = 64 * kb, n0 = 64 * nb;
    f32x4 v[16];
#pragma unroll
    for (int it = 0; it < 16; ++it) { const int e = it * 64 + lane; v[it] = mp.load4(k0 + (e >> 4), n0, e & 15); }
#pragma unroll
    for (int it = 0; it < 16; ++it) { const int e = it * 64 + lane, k = e >> 4, nl = mp.nl(e & 15); const float sc = mp.scale(k0 + k) * wscale;
        int p = 0; p = __builtin_amdgcn_cvt_pk_fp8_f32(v[it][0] * sc, v[it][1] * sc, p, false); p = __builtin_amdgcn_cvt_pk_fp8_f32(v[it][2] * sc, v[it][3] * sc, p, true);
        T[(nl + 0) * 80 + k] = (unsigned char)(p & 0xff); T[(nl + 1) * 80 + k] = (unsigned char)((p >> 8) & 0xff); T[(nl + 2) * 80 + k] = (unsigned char)((p >> 16) & 0xff); T[(nl + 3) * 80 + k] = (unsigned char)((unsigned)p >> 24); }
    LDS_WAIT(); asm volatile("" ::: "memory");
#pragma unroll
    for (int it = 0; it < 4; ++it) { const int e = it * 64 + lane, nl = e >> 2, c4 = e & 3; const LAS unsigned* tp = (const LAS unsigned*)(T + nl * 80 + 16 * c4);
        v4u w; w.x = tp[0]; w.y = tp[1]; w.z = tp[2]; w.w = tp[3]; *(v4u*)((unsigned char*)mp.WT + (size_t)(n0 + nl) * pitch + k0 + 16 * c4) = w; }
    LDS_WAIT(); asm volatile("" ::: "memory");
}
template <class Map> __device__ __forceinline__ void cvt_item(const Map& mp, int item, LAS float* scr, int lane) {
    LAS bf16* T = (LAS bf16*)scr;
    const int nblk = mp.N / 64, kb = item / nblk, nb = item % nblk, k0 = 64 * kb, n0 = 64 * nb;
    f32x4 v[16];
#pragma unroll
    for (int it = 0; it < 16; ++it) { const int e = it * 64 + lane; v[it] = mp.load4(k0 + (e >> 4), n0, e & 15); }
#pragma unroll
    for (int it = 0; it < 16; ++it) { const int e = it * 64 + lane, k = e >> 4, nl = mp.nl(e & 15); const float sc = mp.scale(k0 + k);
        const unsigned p0 = pg8::cvt_pk_bf16(v[it][0] * sc, v[it][1] * sc), p1 = pg8::cvt_pk_bf16(v[it][2] * sc, v[it][3] * sc);
        T[(nl + 0) * 66 + k] = (bf16)(p0 & 0xffffu); T[(nl + 1) * 66 + k] = (bf16)(p0 >> 16); T[(nl + 2) * 66 + k] = (bf16)(p1 & 0xffffu); T[(nl + 3) * 66 + k] = (bf16)(p1 >> 16); }
    LDS_WAIT(); asm volatile("" ::: "memory");
#pragma unroll
    for (int it = 0; it < 8; ++it) { const int e = it * 64 + lane, nl = e >> 3, c8 = e & 7; const LAS unsigned* tp = (const LAS unsigned*)(T + nl * 66 + 8 * c8);
        v4u w; w.x = tp[0]; w.y = tp[1]; w.z = tp[2]; w.w = tp[3]; *(v4u*)(mp.dst(n0 + nl) + k0 + 8 * c8) = w; }
    LDS_WAIT(); asm volatile("" ::: "memory");
}

__device__ __forceinline__ float norm_row(const float* xrow, bf16* orow, int lane, f32x4 (&v)[4]) {
    const f32x4* xr = (const f32x4*)xrow + lane; float ss = 0.f;
#pragma unroll
    for (int j = 0; j < 4; ++j) { v[j] = xr[64 * j]; ss += (v[j].x * v[j].x + v[j].y * v[j].y) + (v[j].z * v[j].z + v[j].w * v[j].w); }
    const float r = 1.0f / sqrtf(wave_sum(ss) * (1.0f / 1024.0f) + 1e-6f);
    unsigned long long* o8 = (unsigned long long*)orow + lane;
#pragma unroll
    for (int j = 0; j < 4; ++j) o8[64 * j] = (unsigned long long)pk2(v[j].x * r, v[j].y * r) | ((unsigned long long)pk2(v[j].z * r, v[j].w * r) << 32);
    return r;
}
template <class Post> __device__ __forceinline__ void norm_rows(const float* X, bf16* O, const int nrows, const int gw, const int NGW, const int lane, Post post) {
    for (int r0 = gw; r0 < nrows; r0 += 4 * NGW) {
        f32x4 v0[4], v1[4], v2[4], v3[4];
        { const int q1 = r0 + NGW < nrows ? r0 + NGW : r0, q2 = r0 + 2 * NGW < nrows ? r0 + 2 * NGW : r0, q3 = r0 + 3 * NGW < nrows ? r0 + 3 * NGW : r0;
          const f32x4* x0 = (const f32x4*)(X + (size_t)r0 * 1024) + lane; const f32x4* x1 = (const f32x4*)(X + (size_t)q1 * 1024) + lane; const f32x4* x2 = (const f32x4*)(X + (size_t)q2 * 1024) + lane; const f32x4* x3 = (const f32x4*)(X + (size_t)q3 * 1024) + lane;
#pragma unroll
          for (int j = 0; j < 4; ++j) { v0[j] = x0[64 * j]; v1[j] = x1[64 * j]; v2[j] = x2[64 * j]; v3[j] = x3[64 * j]; } }
#define NR_ONE_(vv, row_) do { const int rw_ = (row_); if (rw_ < nrows) { float ss = 0.f; _Pragma("unroll") for (int j = 0; j < 4; ++j) ss += (vv[j].x * vv[j].x + vv[j].y * vv[j].y) + (vv[j].z * vv[j].z + vv[j].w * vv[j].w); \
            const float r = 1.0f / sqrtf(wave_sum(ss) * (1.0f / 1024.0f) + 1e-6f); unsigned long long* o8 = (unsigned long long*)(O + (size_t)rw_ * 1024) + lane; \
            _Pragma("unroll") for (int j = 0; j < 4; ++j) o8[64 * j] = (unsigned long long)pk2(vv[j].x * r, vv[j].y * r) | ((unsigned long long)pk2(vv[j].z * r, vv[j].w * r) << 32); \
            post(rw_, r, vv); } } while (0)
        NR_ONE_(v0, r0); NR_ONE_(v1, r0 + NGW); NR_ONE_(v2, r0 + 2 * NGW); NR_ONE_(v3, r0 + 3 * NGW);
#undef NR_ONE_
    }
}
struct NoPost { __device__ __forceinline__ void operator()(int, float, const f32x4 (&)[4]) const {} };
__device__ __forceinline__ void row_dot8(const f32x4 (&v)[4], const LAS float* w8, int lane, float (&lg)[8]) {
#pragma unroll
    for (int e = 0; e < 8; ++e) lg[e] = 0.f;
#pragma unroll
    for (int j = 0; j < 4; ++j)
#pragma unroll
        for (int q = 0; q < 4; ++q) { const int i = 256 * j + 4 * lane + q; const f32x4 wa = *(const LAS f32x4*)(w8 + i * 8), wb = *(const LAS f32x4*)(w8 + i * 8 + 4); const float x = v[j][q];
            lg[0] += x * wa.x; lg[1] += x * wa.y; lg[2] += x * wa.z; lg[3] += x * wa.w; lg[4] += x * wb.x; lg[5] += x * wb.y; lg[6] += x * wb.z; lg[7] += x * wb.w; }
#pragma unroll
    for (int e = 0; e < 8; ++e) lg[e] = wave_sum(lg[e]);
}


#define MFMA16(a, b, c) __builtin_amdgcn_mfma_f32_16x16x32_bf16((a), (b), (c), 0, 0, 0)
__device__ __forceinline__ float bfs(short v) { return __uint_as_float(((unsigned)(unsigned short)v) << 16); }
__device__ __forceinline__ float ex2(float x) { return __builtin_amdgcn_exp2f(x); }
__device__ __forceinline__ bf16x8 pack8f(const f32x4 a, const f32x4 b) { v4u w; w.x = pg8::cvt_pk_bf16(a[0], a[1]); w.y = pg8::cvt_pk_bf16(a[2], a[3]); w.z = pg8::cvt_pk_bf16(b[0], b[1]); w.w = pg8::cvt_pk_bf16(b[2], b[3]); return __builtin_bit_cast(bf16x8, w); }
__device__ __forceinline__ v2u pack4f(const f32x4 a) { v2u w; w.x = pg8::cvt_pk_bf16(a[0], a[1]); w.y = pg8::cvt_pk_bf16(a[2], a[3]); return w; }

struct LaChunk { float dtl, vsc; bf16x8 Qf[2][2], Kf[2][2], vv0, vv1; v2u xs[2][2]; };
__device__ __forceinline__ void la_load(LaChunk& ck, const int t0, const bf16* Q, const int qp, const bf16* K, const int kp, const bf16* V, const int vp, const float* dtp, const bool skip, const int lane) {
    const int n16 = lane & 15, q = lane >> 4, vrow = lane >> 1, vcol = (lane & 1) * 16;
    ck.dtl = dtp ? dtp[(size_t)(t0 + (lane & 31)) * 8] : 0.f; ck.vsc = dtp ? dtp[(size_t)(t0 + vrow) * 8] : 1.0f;
#pragma unroll
    for (int j = 0; j < 2; ++j)
#pragma unroll
        for (int ks = 0; ks < 2; ++ks) { ck.Qf[j][ks] = *(const bf16x8*)(Q + (size_t)(t0 + 16 * j + n16) * qp + 32 * ks + 8 * q); ck.Kf[j][ks] = *(const bf16x8*)(K + (size_t)(t0 + 16 * j + n16) * kp + 32 * ks + 8 * q); }
    ck.vv0 = *(const bf16x8*)(V + (size_t)(t0 + vrow) * vp + vcol); ck.vv1 = *(const bf16x8*)(V + (size_t)(t0 + vrow) * vp + vcol + 8);
#pragma unroll
    for (int t = 0; t < 2; ++t)
#pragma unroll
        for (int j = 0; j < 2; ++j) ck.xs[t][j] = skip ? *(const v2u*)(V + (size_t)(t0 + 16 * j + n16) * vp + 16 * t + 4 * q) : (v2u){0u, 0u};
}
__device__ __forceinline__ void linattn_unit(const bf16* Q, const int qp, const bf16* K, const int kp, const bf16* V, const int vp, const float* dtp, const float dcoef, const float dskip,
                                             bf16* out, const int op, LAS unsigned char* sl, const int lane) {
    const int n16 = lane & 15, q = lane >> 4;
    LAS bf16* Vt = (LAS bf16*)sl;
    LAS bf16* Kt = Vt + 32 * 32;
    LAS bf16* St = Kt + 64 * 32;
    LAS float* la = (LAS float*)(St + 32 * 64);
    for (int i = lane; i < 32 * 64 / 2; i += 64) ((LAS unsigned*)St)[i] = 0u;
    f32x4 Sacc[4][2];
#pragma unroll
    for (int i = 0; i < 4; ++i) { Sacc[i][0] = (f32x4){0.f, 0.f, 0.f, 0.f}; Sacc[i][1] = (f32x4){0.f, 0.f, 0.f, 0.f}; }
    const f32x4 z4 = (f32x4){0.f, 0.f, 0.f, 0.f};
    const int posn = 8 * (n16 >> 2) + (n16 & 3);
    const int vrow = lane >> 1, vcol = (lane & 1) * 16, vpos = 8 * ((vrow & 15) >> 2) + 4 * (vrow >> 4) + (vrow & 3);
    const bool skip = dskip != 0.f;
    { const unsigned dm_ = *(const unsigned*)Q; asm volatile("" :: "v"(dm_)); const unsigned dl_ = ((LAS unsigned*)St)[lane]; asm volatile("" :: "v"(dl_)); }
    LaChunk nx; la_load(nx, 0, Q, qp, K, kp, V, vp, dtp, skip, lane);
    asm volatile("" : "+v"(nx.Qf[0][0]), "+v"(nx.Qf[0][1]), "+v"(nx.Qf[1][0]), "+v"(nx.Qf[1][1]), "+v"(nx.Kf[0][0]), "+v"(nx.Kf[0][1]), "+v"(nx.Kf[1][0]), "+v"(nx.Kf[1][1]), "+v"(nx.vv0), "+v"(nx.vv1) :: "memory");
    for (int c = 0; c < cf::L / 32; ++c) {
        const int t0 = c * 32;
        const LaChunk ck = nx;
        if (c + 1 < cf::L / 32) la_load(nx, t0 + 32, Q, qp, K, kp, V, vp, dtp, skip, lane);
        float xl = dtp ? ck.dtl * dcoef : dcoef;
#pragma unroll
        for (int off = 1; off < 32; off <<= 1) { const float y = __shfl_up(xl, off); if ((lane & 31) >= off) xl += y; }
        if (lane < 32) la[lane] = xl;
        const float a_end = __shfl(xl, 31);
        const f32x4 as0 = *(const LAS f32x4*)(la + 4 * q), as1 = *(const LAS f32x4*)(la + 16 + 4 * q); const float al0 = la[n16], al1 = la[16 + n16];
        f32x4 s00 = MFMA16(ck.Kf[0][0], ck.Qf[0][0], z4); s00 = MFMA16(ck.Kf[0][1], ck.Qf[0][1], s00);
        f32x4 s01 = MFMA16(ck.Kf[0][0], ck.Qf[1][0], z4); s01 = MFMA16(ck.Kf[0][1], ck.Qf[1][1], s01);
        f32x4 s11 = MFMA16(ck.Kf[1][0], ck.Qf[1][0], z4); s11 = MFMA16(ck.Kf[1][1], ck.Qf[1][1], s11);
#pragma unroll
        for (int r = 0; r < 4; ++r) { const bool ok = n16 >= 4 * q + r;
            s00[r] = ok ? s00[r] * ex2(al0 - as0[r]) : 0.f; s01[r] = s01[r] * ex2(al1 - as0[r]); s11[r] = ok ? s11[r] * ex2(al1 - as1[r]) : 0.f; }
        const bf16x8 Pf0 = pack8f(s00, z4), Pf1 = pack8f(s01, s11);
        const float w0 = ex2(a_end - al0), w1 = ex2(a_end - al1);
#pragma unroll
        for (int i = 0; i < 2; ++i)
#pragma unroll
            for (int ks = 0; ks < 2; ++ks)
#pragma unroll
                for (int jj = 0; jj < 8; jj += 2) { const float wv = i ? w1 : w0; const unsigned pw = pg8::cvt_pk_bf16(bfs(ck.Kf[i][ks][jj]) * wv, bfs(ck.Kf[i][ks][jj + 1]) * wv); const int d = 32 * ks + 8 * q + jj;
                    Kt[d * 32 + posn + 4 * i] = (bf16)(pw & 0xffffu); Kt[(d + 1) * 32 + posn + 4 * i] = (bf16)(pw >> 16); }
#pragma unroll
        for (int jj = 0; jj < 8; jj += 2) { const unsigned pa = pg8::cvt_pk_bf16(bfs(ck.vv0[jj]) * ck.vsc, bfs(ck.vv0[jj + 1]) * ck.vsc), pb = pg8::cvt_pk_bf16(bfs(ck.vv1[jj]) * ck.vsc, bfs(ck.vv1[jj + 1]) * ck.vsc);
            Vt[(vcol + jj) * 32 + vpos] = (bf16)(pa & 0xffffu); Vt[(vcol + jj + 1) * 32 + vpos] = (bf16)(pa >> 16); Vt[(vcol + 8 + jj) * 32 + vpos] = (bf16)(pb & 0xffffu); Vt[(vcol + 9 + jj) * 32 + vpos] = (bf16)(pb >> 16); }
        bf16x8 Vf[2], Sf[2][2];
#pragma unroll
        for (int t = 0; t < 2; ++t) { Vf[t] = *(const LAS bf16x8*)(Vt + (16 * t + n16) * 32 + 8 * q); Sf[t][0] = *(const LAS bf16x8*)(St + (16 * t + n16) * 64 + 8 * q); Sf[t][1] = *(const LAS bf16x8*)(St + (16 * t + n16) * 64 + 32 + 8 * q); }
        const float ea0 = ex2(al0), ea1 = ex2(al1);
#pragma unroll
        for (int t = 0; t < 2; ++t)
#pragma unroll
            for (int j = 0; j < 2; ++j) {
                f32x4 y = MFMA16(Vf[t], j ? Pf1 : Pf0, z4);
                f32x4 cr = MFMA16(Sf[t][0], ck.Qf[j][0], z4); cr = MFMA16(Sf[t][1], ck.Qf[j][1], cr);
                y += cr * (j ? ea1 : ea0);
                const size_t row = (size_t)(t0 + 16 * j + n16);
                if (skip) { const v2u xw = ck.xs[t][j]; y[0] += dskip * bflo(xw.x); y[1] += dskip * bfhi(xw.x); y[2] += dskip * bflo(xw.y); y[3] += dskip * bfhi(xw.y); }
                *(v2u*)(out + row * op + 16 * t + 4 * q) = pack4f(y);
            }
        const float dec = ex2(a_end);
#pragma unroll
        for (int dt = 0; dt < 4; ++dt) { const bf16x8 Ktf = *(const LAS bf16x8*)(Kt + (16 * dt + n16) * 32 + 8 * q);
#pragma unroll
            for (int et = 0; et < 2; ++et) { Sacc[dt][et] = MFMA16(Ktf, Vf[et], Sacc[dt][et] * dec); *(LAS v2u*)(St + (16 * et + n16) * 64 + 16 * dt + 4 * q) = pack4f(Sacc[dt][et]); } }
    }
}

__device__ __forceinline__ void s5_unit(const bf16* U, bf16* Y, const float* lam_re, const float* lam_im, const float* b_re, const float* b_im, const float* c_re, const float* c_im, const float* dsk, const float step,
                                        LAS unsigned char* sl, const int lane) {
    const int n16 = lane & 15, q = lane >> 4;
    LAS float* BU = (LAS float*)sl;
    LAS bf16* SI = (LAS bf16*)(sl + 8192);
    float ar, ai;
    { const float lr = lam_re[lane], li = lam_im[lane], mag = expf(lr * step); ar = mag * cosf(li * step); ai = mag * sinf(li * step); }
    bf16x8 Bbf[8], Ccf[4];
#pragma unroll
    for (int tl = 0; tl < 8; ++tl) {
        const int idx = 16 * tl + n16, st = idx & 63; float v[8];
        const float lr = lam_re[st], li = lam_im[st], mag = expf(lr * step), sar = mag * cosf(li * step), sai = mag * sinf(li * step), inv = 1.0f / (lr * lr + li * li);
        const float cr = ((sar - 1.0f) * lr + sai * li) * inv, ci = (sai * lr - (sar - 1.0f) * li) * inv;
#pragma unroll
        for (int jj = 0; jj < 8; ++jj) { float x = 0.f; if (q < 2) { const float br_ = b_re[st * 16 + 8 * q + jj], bi_ = b_im[st * 16 + 8 * q + jj]; x = idx < 64 ? cr * br_ - ci * bi_ : cr * bi_ + ci * br_; } v[jj] = x; }
        Bbf[tl] = pack8f((f32x4){v[0], v[1], v[2], v[3]}, (f32x4){v[4], v[5], v[6], v[7]});
    }
#pragma unroll
    for (int ks = 0; ks < 4; ++ks) {
        float v[8];
#pragma unroll
        for (int jj = 0; jj < 8; ++jj) { const int idx = 32 * ks + 8 * q + jj; v[jj] = idx < 64 ? c_re[n16 * 64 + idx] : -c_im[n16 * 64 + idx - 64]; }
        Ccf[ks] = pack8f((f32x4){v[0], v[1], v[2], v[3]}, (f32x4){v[4], v[5], v[6], v[7]});
    }
    const f32x4 dk = *(const f32x4*)(dsk + 4 * q);
    const f32x4 z4 = (f32x4){0.f, 0.f, 0.f, 0.f};
    const bf16x8 zf = (bf16x8){0, 0, 0, 0, 0, 0, 0, 0};
    float sr = 0.f, si = 0.f;
    bf16x8 nUf[2]; v2u nuw[2];
#pragma unroll
    for (int mt = 0; mt < 2; ++mt) { const bf16* urow = U + (size_t)(16 * mt + n16) * cf::PJ; nUf[mt] = q < 2 ? *(const bf16x8*)(urow + 8 * q) : zf; nuw[mt] = *(const v2u*)(urow + 4 * q); }
    for (int c = 0; c < cf::L / 32; ++c) {
        bf16x8 Uf[2]; v2u uw[2];
#pragma unroll
        for (int mt = 0; mt < 2; ++mt) { Uf[mt] = nUf[mt]; uw[mt] = nuw[mt]; }
        if (c + 1 < cf::L / 32) {
#pragma unroll
            for (int mt = 0; mt < 2; ++mt) { const bf16* urow = U + (size_t)((c + 1) * 32 + 16 * mt + n16) * cf::PJ; nUf[mt] = q < 2 ? *(const bf16x8*)(urow + 8 * q) : zf; nuw[mt] = *(const v2u*)(urow + 4 * q); } }
#pragma unroll
        for (int mt = 0; mt < 2; ++mt) {
            f32x4 d8[8];
#pragma unroll
            for (int tl = 0; tl < 8; ++tl) d8[tl] = MFMA16(Uf[mt], Bbf[tl], z4);
            asm volatile("" : "+v"(d8[0]), "+v"(d8[1]), "+v"(d8[2]), "+v"(d8[3]), "+v"(d8[4]), "+v"(d8[5]), "+v"(d8[6]), "+v"(d8[7]));
#pragma unroll
            for (int tl = 0; tl < 8; ++tl) {
#pragma unroll
                for (int r = 0; r < 4; ++r) BU[(4 * q + r) * 128 + 16 * tl + n16] = d8[tl][r]; }
#pragma unroll
            for (int t = 0; t < 16; ++t) { const float bre = BU[t * 128 + lane], bim = BU[t * 128 + 64 + lane];
                const float nr = ar * sr - ai * si + bre, ni = ar * si + ai * sr + bim; sr = nr; si = ni;
                const unsigned pw = pg8::cvt_pk_bf16(sr, si); SI[(16 * mt + t) * 128 + lane] = (bf16)(pw & 0xffffu); SI[(16 * mt + t) * 128 + 64 + lane] = (bf16)(pw >> 16); }
        }
        f32x4 yy[2] = {z4, z4};
#pragma unroll
        for (int ks = 0; ks < 4; ++ks) { const bf16x8 Sf0 = *(const LAS bf16x8*)(SI + n16 * 128 + 32 * ks + 8 * q), Sf1 = *(const LAS bf16x8*)(SI + (16 + n16) * 128 + 32 * ks + 8 * q);
            yy[0] = MFMA16(Ccf[ks], Sf0, yy[0]); yy[1] = MFMA16(Ccf[ks], Sf1, yy[1]); }
#pragma unroll
        for (int mt = 0; mt < 2; ++mt) {
            f32x4 y = yy[mt];
            y[0] = gelu_tanh(y[0] + dk[0] * bflo(uw[mt].x)); y[1] = gelu_tanh(y[1] + dk[1] * bfhi(uw[mt].x)); y[2] = gelu_tanh(y[2] + dk[2] * bflo(uw[mt].y)); y[3] = gelu_tanh(y[3] + dk[3] * bfhi(uw[mt].y));
            *(v2u*)(Y + (size_t)(c * 32 + 16 * mt + n16) * 512 + 4 * q) = pack4f(y);
        }
    }
}

struct LruChunk { bf16x8 X[2][2], Gf[2]; };
__device__ __forceinline__ void lru_load(LruChunk& ck, const int t0, const bf16* XC, const bf16* GLb, const int ksel, const int lane) {
    const int n16 = lane & 15, q = lane >> 4;
#pragma unroll
    for (int mt = 0; mt < 2; ++mt) { const size_t row = (size_t)(t0 + 8 * (n16 >> 2) + 4 * mt + (n16 & 3));
        ck.X[mt][0] = *(const bf16x8*)(XC + row * 512 + 8 * q); ck.X[mt][1] = *(const bf16x8*)(XC + row * 512 + 32 + 8 * q); ck.Gf[mt] = *(const bf16x8*)(GLb + row * cf::PJ + 32 * ksel + 8 * q); }
}
__device__ __forceinline__ void lru_unit(const bf16* XC  , const bf16* GLb  , bf16* out  ,
                                         const float* wa  , const float* wx, const float ba, const float bx, const float sp, const int jq, const int lane) {
    const int n16 = lane & 15, q = lane >> 4, ksel = jq >> 1;
    bf16x8 Waf[2], Wxf[2], Idf;
#pragma unroll
    for (int ks = 0; ks < 2; ++ks) { float va[8], vx[8];
#pragma unroll
        for (int jj = 0; jj < 8; ++jj) { const int i = 32 * ks + 8 * q + jj; va[jj] = wa[i * 64 + jq * 16 + n16]; vx[jj] = wx[i * 64 + jq * 16 + n16]; }
        Waf[ks] = pack8f((f32x4){va[0], va[1], va[2], va[3]}, (f32x4){va[4], va[5], va[6], va[7]}); Wxf[ks] = pack8f((f32x4){vx[0], vx[1], vx[2], vx[3]}, (f32x4){vx[4], vx[5], vx[6], vx[7]}); }
    { float vi[8];
#pragma unroll
      for (int jj = 0; jj < 8; ++jj) vi[jj] = (8 * q + jj == (jq & 1) * 16 + n16) ? 1.0f : 0.f;
      Idf = pack8f((f32x4){vi[0], vi[1], vi[2], vi[3]}, (f32x4){vi[4], vi[5], vi[6], vi[7]}); }
    const f32x4 z4 = (f32x4){0.f, 0.f, 0.f, 0.f};
    float hprev = 0.f;
    LruChunk nx; lru_load(nx, 0, XC, GLb, ksel, lane);
    for (int c = 0; c < cf::L / 32; ++c) {
        const int t0 = c * 32;
        const LruChunk ck = nx;
        if (c + 1 < cf::L / 32) lru_load(nx, t0 + 32, XC, GLb, ksel, lane);
        float a[8], bb[8], gv[8];
        float A = 1.0f, B = 0.f;
#pragma unroll
        for (int mt = 0; mt < 2; ++mt) {
            f32x4 ra = MFMA16(ck.X[mt][0], Waf[0], z4); ra = MFMA16(ck.X[mt][1], Waf[1], ra);
            f32x4 ri = MFMA16(ck.X[mt][0], Wxf[0], z4); ri = MFMA16(ck.X[mt][1], Wxf[1], ri);
            const f32x4 xc = MFMA16(ksel ? ck.X[mt][1] : ck.X[mt][0], Idf, z4), gl = MFMA16(ck.Gf[mt], Idf, z4);
#pragma unroll
            for (int r = 0; r < 4; ++r) { const int k = 4 * mt + r;
                const float rr = sigmoidf_(ra[r] + ba), ii = sigmoidf_(ri[r] + bx), la_ = -8.0f * rr * sp; a[k] = fexp_(la_);
                bb[k] = __builtin_amdgcn_sqrtf(fmaxf(1.0f - a[k] * a[k], 0.f)) * ii * xc[r]; gv[k] = gl[r];
                B = a[k] * B + bb[k]; A *= a[k]; }
        }
        { const float Au = __shfl_up(A, 16), Bu = __shfl_up(B, 16); if (q >= 1) { B = A * Bu + B; A = A * Au; } }
        { const float Au = __shfl_up(A, 32), Bu = __shfl_up(B, 32); if (q >= 2) { B = A * Bu + B; A = A * Au; } }
        float Ae = __shfl_up(A, 16), Be = __shfl_up(B, 16); if (q == 0) { Ae = 1.0f; Be = 0.f; }
        float h = Ae * hprev + Be;
#pragma unroll
        for (int k = 0; k < 8; ++k) { h = a[k] * h + bb[k]; out[(size_t)(t0 + 8 * q + k) * 2048 + n16] = (bf16)f2bf(h * gelu_tanh(gv[k])); }
        hprev = __shfl(h, 48 + n16);
    }
}

#define PH_VARS int tid_ = wave_s * 64 + lane_id_fresh(); asm volatile("" : "+v"(tid_)); const int tid = tid_, lane = tid & 63, wave = __builtin_amdgcn_readfirstlane(tid >> 6); \
    const int G = opq((int)gridDim.x), bx = opq((int)blockIdx.x), vcu = (G % 8 == 0) ? (bx % 8) * (G / 8) + bx / 8 : bx; \
    const int gw = vcu * NWAVES + wave, NGW = G * NWAVES, gt = vcu * 512 + tid, NGT = G * 512; \
    LAS float* scr = (LAS float*)(lds + wave * 16384); LAS float* w8 = (LAS float*)lds; LAS float* xch = (LAS float*)(lds + XCH_OFF); \
    (void)lane; (void)gw; (void)NGW; (void)gt; (void)NGT; (void)scr; (void)w8; (void)xch; (void)bx;
#define ws (opqp(p.ws))
#define ctl ((unsigned*)(ws + WS_CTL))
#define GRID_BAR() do { if (single) { XcdBarrier b2_ = bar; b2_.bar = ctl + CW_BAR; xcd_barrier(b2_, wave_s); } } while (0)
#ifdef MK_TPROBE
#define GRID_BARC(c) do { GRID_BAR(); if (single && blockIdx.x == 0 && wave_s == 0 && lane_id_fresh() == 0) { unsigned long long* tl_ = (unsigned long long*)(ctl + 20000); const unsigned long long now_ = wall_clock64(); \
    if ((MK_TPROBE >> (c)) & 1) { unsigned* ac_ = ctl + 20100; *ac_ += (unsigned)(now_ - tl_[0]); } tl_[0] = now_; } } while (0)
#else
#define GRID_BARC(c) GRID_BAR()
#endif
#define IN(k) (lo <= (k) && (k) < hi)
#define x_ (opqp(p.in[0]))
#define mem_ (opqp(p.in[1]))
#define positions_ ((const int*)opqp(p.in[2]))
#define norm_mix (opqp(p.in[3]))
#define w_in (opqp(p.in[4]))
#define b_gate (opqp(p.in[5]))
#define w_branch (opqp(p.in[29]))
#define w_out (opqp(p.in[30]))
#define norm_xa (opqp(p.in[31]))
#define norm_mem (opqp(p.in[32]))
#define xa_wq (opqp(p.in[33]))
#define xa_wk (opqp(p.in[34]))
#define xa_wv (opqp(p.in[35]))
#define xa_wo (opqp(p.in[36]))
#define norm_ffn (opqp(p.in[37]))
#define ffn_w1 (opqp(p.in[38]))
#define ffn_w3 (opqp(p.in[39]))
#define ffn_w2 (opqp(p.in[40]))
#define moe_router (opqp(p.in[41]))
#define moe_w1 (opqp(p.in[42]))
#define moe_w3 (opqp(p.in[43]))
#define moe_w2 (opqp(p.in[44]))
#define norm_final (opqp(p.in[45]))
#define H (opqp(p.out))
#define HN ((bf16*)(ws + WS_HN))
#define KVB ((bf16*)(ws + WS_KV))
#define COS ((float*)(ws + WS_TAB))
#define SIN (COS + (size_t)T * 32)
#define DT ((float*)(ws + WS_DT))
#define MNR ((bf16*)(ws + WS_MNR))
#define PROJB ((bf16*)(ws + R_PROJB))
#define GATE ((bf16*)(ws + R_GATE))
#define BR ((bf16*)(ws + R_BR))
#define XBCC ((bf16*)(ws + R_XBCC))
#define XLC ((bf16*)(ws + R_XLC))
#define YSB ((bf16*)(ws + R_YS))
#define QKW ((bf16*)(ws + R_QKW))
#define MP ((float*)(ws + R_MP))
#define MERGED ((bf16*)(ws + R_MERGED))
#define XQ ((bf16*)(ws + R_XQ))
#define VWO ((bf16*)(ws + R_XQ))
#define PB ((bf16*)(ws + R_P))
#define XO ((bf16*)(ws + R_XO))
#define ACT ((bf16*)(ws + R_ACT))
#define W13E ((bf16*)(ws + M_W13E))
#define W2E ((bf16*)(ws + M_W2E))
#define XS ((bf16*)(ws + M_XS))
#define ACTE ((bf16*)(ws + M_ACTE))
#define YPART ((float*)(ws + M_W13E))
#define TOPI ((i32x4*)(ws + WS_TOPI))
#define TOPW ((f32x2*)(ws + WS_TOPW))
#define SLOT ((i32x2*)(ws + WS_SLOT))
#define HN8L1 ((unsigned char*)(ws + WS_W))
#define XS8 ((unsigned char*)(ws + M_XS))
#define HN8 ((unsigned char*)(ws + M_XS + 36 * MiB))
#define ROWOF ((int*)(ws + WS_CTL + 512 * 1024))
#define CNT ((int*)(ctl + CW_CNT))
#define W13 ((bf16*)(ws + WS_W13))
#define W2T ((bf16*)(ws + WS_W2))
#define CVT_LOOP(NITEMS, ...) do { for (int it = (gw + NGW - rot % NGW) % NGW; it < (NITEMS); it += NGW) { __VA_ARGS__; cvt_item(m, it, scr, lane); } rot += (NITEMS); } while (0)
#define CVT_LOOP8(NITEMS, WSC, PITCH, ...) do { for (int it = (gw + NGW - rot % NGW) % NGW; it < (NITEMS); it += NGW) { __VA_ARGS__; cvt_item8(m, it, scr, lane, (WSC), (PITCH)); } rot += (NITEMS); } while (0)

__global__ void __launch_bounds__(NWAVES * 64, 2) mega(Params p) {
    using namespace cf;
    extern __shared__ __attribute__((aligned(16))) unsigned char lds_raw[];
    LAS unsigned char* lds = (LAS unsigned char*)lds_raw;
    const int wave_s = __builtin_amdgcn_readfirstlane((int)threadIdx.x >> 6);
    for (int u = threadIdx.x; u < (LDS_BYTES - LDSCTL_OFF) / 4; u += NWAVES * 64) ((LAS unsigned*)(lds + LDSCTL_OFF))[u] = 0u;
    __syncthreads();
    const bool single = (p.ph_hi - p.ph_lo) > 1;
    XcdBarrier bar; bar.bar = ctl + CW_BAR; bar.x = 0; bar.st = (volatile LAS unsigned*)(lds + LDSCTL_OFF) + 8;
    if (single) bar = xcd_barrier_post(ctl + CW_BAR, (volatile LAS unsigned*)(lds + LDSCTL_OFF) + 8, wave_s);
#ifdef MK_TPROBE
    if (blockIdx.x == 0 && wave_s == 0 && lane_id_fresh() == 0) ((unsigned long long*)(ctl + 20000))[0] = wall_clock64();
#endif
    const int lo = p.ph_lo, hi = p.ph_hi;


    if (IN(0)) { PH_VARS
        {
            int rot = 0;
            {
                unsigned char* wl = ws + WS_W;
                { for (int it = (gw + NGW - rot % NGW) % NGW; it < 16 * 140; it += NGW) { if (it % 140 < 76) { MapWin m{w_in, norm_mix, (bf16*)(wl + WL_WIN), 8960}; cvt_item(m, it, scr, lane); }
                    else { MapWin m{w_in, norm_mix, (bf16*)(wl + WL_WIN + (size_t)4864 * 2048 - (size_t)4864 * 1024), 8960}; cvt_item8(m, it, scr, lane, 64.0f, 1024); } } rot += 16 * 140; }
                CVT_LOOP(8 * 8, MapPlain m{opqp(p.in[14]), 512, 512, nullptr, 1.f, (bf16*)(wl + WL_GLU), 512});
                for (int k = 0; k < 4; ++k) CVT_LOOP(8 * 16, MapPlain m{w_branch + (size_t)k * 512 * 1024, 512, 1024, nullptr, 1.f, (bf16*)(wl + WL_WB) + k * 512, 2048});
                CVT_LOOP(16 * 16, MapPlain m{w_out, D, D, nullptr, 1.f, (bf16*)(wl + WL_WOUT), D});
                for (int l = 0; l < 2; ++l) { unsigned char* wk = ws + WS_W + (size_t)l * WL_STRIDE;
                    CVT_LOOP(16 * 16, MapPlain m{xa_wk + (size_t)l * D * D, D, D, norm_mem + l * D, 1.f, (bf16*)(wk + WL_WKV), D});
                    CVT_LOOP(16 * 16, MapPlain m{xa_wv + (size_t)l * D * D, D, D, norm_mem + l * D, 1.f, (bf16*)(wk + WL_WKV) + (size_t)D * D, D}); }
            }
        }
        for (int i = gt; i < T * 32; i += NGT) { const int row = i >> 5, f = i & 31; const float inv_freq = (float)exp(-(double)f / 32.0 * 9.210340371976184); const float ang = (float)positions_[row] * inv_freq;
            COS[i] = (float)cos((double)ang); SIN[i] = (float)sin((double)ang); }
        norm_rows(mem_, MNR, TM, gw, NGW, lane, NoPost{});
        __syncthreads();
        for (int i = tid; i < 8192; i += 512) w8[i] = norm_mix[i >> 3] * w_in[(size_t)(i >> 3) * IN_TOTAL + O_DT + (i & 7)];
        __syncthreads();
        norm_rows(x_, HN, T, gw, NGW, lane, [&](const int row, const float r, const f32x4 (&v)[4]) { float lg[8]; row_dot8(v, w8, lane, lg);
            float mine = 0.f;
#pragma unroll
            for (int e = 0; e < 8; ++e) if (lane == e) mine = lg[e];
            if (lane < 8) DT[(size_t)row * 8 + lane] = softplusf_(r * mine + opqp(p.in[17])[lane]);
            { unsigned* h8 = (unsigned*)((unsigned char*)H + (size_t)row * 1024) + lane;
#pragma unroll
              for (int j = 0; j < 4; ++j) { int p8 = 0; p8 = __builtin_amdgcn_cvt_pk_fp8_f32(v[j].x * r, v[j].y * r, p8, false); p8 = __builtin_amdgcn_cvt_pk_fp8_f32(v[j].z * r, v[j].w * r, p8, true); h8[64 * j] = (unsigned)p8; } } });
        GRID_BARC(0);
    }


    { constexpr int layer = 0;
        const int pb = 1 + layer * 20;
#define WLP (ws + WS_W + (size_t)layer * WL_STRIDE)
#define WIN ((const bf16*)(WLP + WL_WIN))
#define WGLU ((const bf16*)(WLP + WL_GLU))
#define WB ((const bf16*)(WLP + WL_WB))
#define WOUT ((const bf16*)(WLP + WL_WOUT))
#define WQ ((const bf16*)(WLP + WL_WQ))
#define WO ((const bf16*)(WLP + WL_WO))
#define KX (KVB + (size_t)layer * 4194304)
#define VT (KX + 2097152)
        if (IN(pb + 0)) { PH_VARS
            pg8::Gemm g{1024, 1024, 1024}; pg8::PlainOrder S; S.A = (const char*)HN; S.B = (const char*)WIN; S.nM = 64; S.nN = 19; S.lda = 1024; S.ldb = 1024; S.G = G; S.c = bx;
            pg8::EpiProj E{PROJB, GATE, b_gate + layer * 4096, 1.0f};
            pg8::gemm_phase<pg8::EpiProj, pg8::PlainOrder, true, true>(lds, g, S, E, wave_s);
            GRID_BARC(1);
        }
        if (IN(pb + 1)) { PH_VARS
            const float* cw = opqp(p.in[15]) + layer * 4 * 768; const float* cb = opqp(p.in[16]) + layer * 768; const float* lw = opqp(p.in[22]) + layer * 4 * 512; const float* lb = opqp(p.in[23]) + layer * 512;
            for (int it = gt; it < T * 224; it += NGT) {
                const int row = it / 224, j = it % 224, t = row & (L - 1);
                if (j < 160) {
                    const bool isx = j < 96; const int c0 = isx ? j * 8 : (j - 96) * 8, C = isx ? 768 : 512; const float* w = isx ? cw : lw; const float* bb = isx ? cb : lb;
                    const bf16* src = PROJB + (size_t)row * PJ + (isx ? C_XBC : C_XL) + c0;
                    float acc[8];
#pragma unroll
                    for (int q = 0; q < 8; ++q) acc[q] = bb[c0 + q];
#pragma unroll
                    for (int tap = 0; tap < 4; ++tap) { if (t - 3 + tap >= 0) { const v4u xv = *(const v4u*)(src - (ptrdiff_t)(3 - tap) * PJ); const float* wt = w + tap * C + c0;
                        acc[0] += wt[0] * bflo(xv.x); acc[1] += wt[1] * bfhi(xv.x); acc[2] += wt[2] * bflo(xv.y); acc[3] += wt[3] * bfhi(xv.y);
                        acc[4] += wt[4] * bflo(xv.z); acc[5] += wt[5] * bfhi(xv.z); acc[6] += wt[6] * bflo(xv.w); acc[7] += wt[7] * bfhi(xv.w); } }
                    if (isx) {
#pragma unroll
                        for (int q = 0; q < 8; ++q) acc[q] = siluf_(acc[q]); }
                    v4u o; o.x = pk2(acc[0], acc[1]); o.y = pk2(acc[2], acc[3]); o.z = pk2(acc[4], acc[5]); o.w = pk2(acc[6], acc[7]);
                    *(v4u*)((isx ? XBCC + (size_t)row * 768 : XLC + (size_t)row * 512) + c0) = o;
                } else {
                    const bool isk = j >= 192; const int jj = isk ? j - 192 : j - 160, h = jj >> 2, i0 = (jj & 3) * 8; const float sc = isk ? 0.125f : 1.0f;
                    bf16* q1 = PROJB + (size_t)row * PJ + (isk ? C_K : C_Q) + h * 64 + i0; bf16* q2 = q1 + 32;
                    const v4u a = *(const v4u*)q1, b = *(const v4u*)q2;
                    const f32x4 c0v = *(const f32x4*)(COS + (size_t)row * 32 + i0), c1v = *(const f32x4*)(COS + (size_t)row * 32 + i0 + 4), s0v = *(const f32x4*)(SIN + (size_t)row * 32 + i0), s1v = *(const f32x4*)(SIN + (size_t)row * 32 + i0 + 4);
                    const float x1[8] = {bflo(a.x), bfhi(a.x), bflo(a.y), bfhi(a.y), bflo(a.z), bfhi(a.z), bflo(a.w), bfhi(a.w)};
                    const float x2[8] = {bflo(b.x), bfhi(b.x), bflo(b.y), bfhi(b.y), bflo(b.z), bfhi(b.z), bflo(b.w), bfhi(b.w)};
                    const float cc[8] = {c0v.x, c0v.y, c0v.z, c0v.w, c1v.x, c1v.y, c1v.z, c1v.w}, ss[8] = {s0v.x, s0v.y, s0v.z, s0v.w, s1v.x, s1v.y, s1v.z, s1v.w};
                    float o1[8], o2[8];
#pragma unroll
                    for (int q = 0; q < 8; ++q) { o1[q] = (x1[q] * cc[q] - x2[q] * ss[q]) * sc; o2[q] = (x2[q] * cc[q] + x1[q] * ss[q]) * sc; }
                    v4u w1; w1.x = pk2(o1[0], o1[1]); w1.y = pk2(o1[2], o1[3]); w1.z = pk2(o1[4], o1[5]); w1.w = pk2(o1[6], o1[7]);
                    v4u w2; w2.x = pk2(o2[0], o2[1]); w2.y = pk2(o2[2], o2[3]); w2.z = pk2(o2[4], o2[5]); w2.w = pk2(o2[6], o2[7]);
                    *(v4u*)q1 = w1; *(v4u*)q2 = w2;
                }
            }
            GRID_BARC(2);
        }
        if (IN(pb + 2)) { PH_VARS
            bf16* YS = YSB;
#ifdef MK_NAIVE_MIX
            for (int wu = gw; wu < 832; wu += NGW) {
                if (wu < 256) {
                    const int un = wu >> 2, sub = wu & 3, b = un >> 3, hh = un & 7, g = hh >> 2, pp = sub * 16 + (lane >> 2), nq = lane & 3;
                    const float Aa = -__expf(opqp(p.in[18])[layer * 8 + hh]), Dk = opqp(p.in[19])[layer * 8 + hh];
                    float S[16];
#pragma unroll
                    for (int j = 0; j < 16; ++j) S[j] = 0.f;
                    for (int t = 0; t < L; ++t) {
                        const size_t row = (size_t)b * L + t; const bf16* xr = XBCC + row * 768;
                        const float dtv = DT[row * 8 + hh], xv = bf1(xr[hh * 64 + pp]);
                        const v4u b0 = *(const v4u*)(xr + 512 + g * 64 + nq * 16), b1 = *(const v4u*)(xr + 512 + g * 64 + nq * 16 + 8), c0 = *(const v4u*)(xr + 640 + g * 64 + nq * 16), c1 = *(const v4u*)(xr + 640 + g * 64 + nq * 16 + 8);
                        const float Bv[16] = {bflo(b0.x), bfhi(b0.x), bflo(b0.y), bfhi(b0.y), bflo(b0.z), bfhi(b0.z), bflo(b0.w), bfhi(b0.w), bflo(b1.x), bfhi(b1.x), bflo(b1.y), bfhi(b1.y), bflo(b1.z), bfhi(b1.z), bflo(b1.w), bfhi(b1.w)};
                        const float Cv[16] = {bflo(c0.x), bfhi(c0.x), bflo(c0.y), bfhi(c0.y), bflo(c0.z), bfhi(c0.z), bflo(c0.w), bfhi(c0.w), bflo(c1.x), bfhi(c1.x), bflo(c1.y), bfhi(c1.y), bflo(c1.z), bfhi(c1.z), bflo(c1.w), bfhi(c1.w)};
                        const float da = __expf(dtv * Aa), xdt = xv * dtv; float acc = 0.f;
#pragma unroll
                        for (int j = 0; j < 16; ++j) { S[j] = da * S[j] + xdt * Bv[j]; acc += Cv[j] * S[j]; }
                        acc += __shfl_xor(acc, 1); acc += __shfl_xor(acc, 2);
                        if (nq == 0) BR[row * 2048 + 512 + hh * 64 + pp] = (bf16)f2bf(acc + Dk * xv);
                    }
                } else if (wu < 512) {
                    const int un = (wu - 256) >> 2, sub = wu & 3, b = un >> 3, hh = un & 7, e = sub * 16 + (lane >> 2), dq = lane & 3;
                    const float gamma = 1.0f - exp2f(-5.0f - (float)hh);
                    float S[16];
#pragma unroll
                    for (int j = 0; j < 16; ++j) S[j] = 0.f;
                    for (int t = 0; t < L; ++t) {
                        const size_t row = (size_t)b * L + t; const bf16* pr = PROJB + row * PJ;
                        const float vv = bf1(pr[C_V + hh * 64 + e]);
                        const v4u k0 = *(const v4u*)(pr + C_K + hh * 64 + dq * 16), k1 = *(const v4u*)(pr + C_K + hh * 64 + dq * 16 + 8), q0 = *(const v4u*)(pr + C_Q + hh * 64 + dq * 16), q1 = *(const v4u*)(pr + C_Q + hh * 64 + dq * 16 + 8);
                        const float Kv[16] = {bflo(k0.x), bfhi(k0.x), bflo(k0.y), bfhi(k0.y), bflo(k0.z), bfhi(k0.z), bflo(k0.w), bfhi(k0.w), bflo(k1.x), bfhi(k1.x), bflo(k1.y), bfhi(k1.y), bflo(k1.z), bfhi(k1.z), bflo(k1.w), bfhi(k1.w)};
                        const float Qv[16] = {bflo(q0.x), bfhi(q0.x), bflo(q0.y), bfhi(q0.y), bflo(q0.z), bfhi(q0.z), bflo(q0.w), bfhi(q0.w), bflo(q1.x), bfhi(q1.x), bflo(q1.y), bfhi(q1.y), bflo(q1.z), bfhi(q1.z), bflo(q1.w), bfhi(q1.w)};
                        float acc = 0.f;
#pragma unroll
                        for (int j = 0; j < 16; ++j) { S[j] = gamma * S[j] + Kv[j] * vv; acc += Qv[j] * S[j]; }
                        acc += __shfl_xor(acc, 1); acc += __shfl_xor(acc, 2);
                        if (dq == 0) BR[row * 2048 + 1024 + hh * 64 + e] = (bf16)f2bf(acc);
                    }
                } else if (wu < 768) {
                    const int un = wu - 512, b = un >> 5, g = un & 31, n = lane;
                    const float* lam_re = opqp(p.in[6]) + layer * 2048; const float* lam_im = opqp(p.in[7]) + layer * 2048; const float* b_re = opqp(p.in[8]) + layer * 32768; const float* b_im = opqp(p.in[9]) + layer * 32768;
                    const float* c_re = opqp(p.in[10]) + layer * 32768; const float* c_im = opqp(p.in[11]) + layer * 32768; const float* dsk = opqp(p.in[12]) + layer * 512;
                    const float lr = lam_re[g * 64 + n], li = lam_im[g * 64 + n], step = expf(opqp(p.in[13])[layer * 32 + g]);
                    const float mag = expf(lr * step), ar = mag * cosf(li * step), ai = mag * sinf(li * step);
                    const float inv = 1.0f / (lr * lr + li * li);
                    const float cr = ((ar - 1.0f) * lr + ai * li) * inv, ci = (ai * lr - (ar - 1.0f) * li) * inv;
                    float bbr[16], bbi[16], cre[16], cim[16];
#pragma unroll
                    for (int h = 0; h < 16; ++h) { const float br_ = b_re[(g * 64 + n) * 16 + h], bi_ = b_im[(g * 64 + n) * 16 + h];
                        bbr[h] = cr * br_ - ci * bi_; bbi[h] = cr * bi_ + ci * br_; cre[h] = c_re[(g * 16 + h) * 64 + n]; cim[h] = c_im[(g * 16 + h) * 64 + n]; }
                    const float dmine = dsk[g * 16 + (n & 15)];
                    float sr = 0.f, si = 0.f;
                    for (int t = 0; t < L; ++t) {
                        const size_t row = (size_t)b * L + t; const bf16* up = PROJB + row * PJ + C_U + g * 16;
                        const v4u u0 = *(const v4u*)up, u1 = *(const v4u*)(up + 8);
                        const float u[16] = {bflo(u0.x), bfhi(u0.x), bflo(u0.y), bfhi(u0.y), bflo(u0.z), bfhi(u0.z), bflo(u0.w), bfhi(u0.w), bflo(u1.x), bfhi(u1.x), bflo(u1.y), bfhi(u1.y), bflo(u1.z), bfhi(u1.z), bflo(u1.w), bfhi(u1.w)};
                        float bur = 0.f, bui = 0.f;
#pragma unroll
                        for (int h = 0; h < 16; ++h) { bur += u[h] * bbr[h]; bui += u[h] * bbi[h]; }
                        const float nr = ar * sr - ai * si + bur, ni = ar * si + ai * sr + bui; sr = nr; si = ni;
                        float mine = 0.f, umine = 0.f;
#pragma unroll
                        for (int h = 0; h < 16; ++h) { const float y = wave_sum(sr * cre[h] - si * cim[h]); if (n == h) { mine = y; umine = u[h]; } }
                        if (n < 16) YS[row * 512 + g * 16 + n] = (bf16)f2bf(gelu_tanh(mine + dmine * umine));
                    }
                } else {
                    const int un = wu - 768, b = un >> 3, blk = un & 7, j = lane;
                    LAS bf16* wA = (LAS bf16*)scr; LAS bf16* wX = wA + 4096;
                    for (int i = 0; i < 64; ++i) { wA[i * 64 + j] = (bf16)f2bf(opqp(p.in[24])[layer * 32768 + (blk * 64 + i) * 64 + j]); wX[i * 64 + j] = (bf16)f2bf(opqp(p.in[26])[layer * 32768 + (blk * 64 + i) * 64 + j]); }
                    LDS_WAIT();
                    const float bA = opqp(p.in[25])[layer * 512 + blk * 64 + j], bX = opqp(p.in[27])[layer * 512 + blk * 64 + j], sp = softplusf_(-opqp(p.in[28])[layer * 512 + blk * 64 + j]);
                    float hs = 0.f;
                    for (int t = 0; t < L; ++t) {
                        const size_t row = (size_t)b * L + t;
                        const float xc = bf1(XLC[row * 512 + blk * 64 + j]);
                        float ra = bA, ri = bX;
#pragma unroll
                        for (int i = 0; i < 64; ++i) { const float xi = __shfl(xc, i); ra += xi * bf1(wA[i * 64 + j]); ri += xi * bf1(wX[i * 64 + j]); }
                        const float r = sigmoidf_(ra), ig = sigmoidf_(ri);
                        const float log_a = -8.0f * r * sp, a = __expf(log_a);
                        const float mult = sqrtf(fmaxf(-expm1f(2.0f * log_a), 0.f));
                        hs = a * hs + mult * ig * xc;
                        BR[row * 2048 + 1536 + blk * 64 + j] = (bf16)f2bf(hs * gelu_tanh(bf1(PROJB[row * PJ + C_GL + blk * 64 + j])));
                    }
                }
            }
#else
            const int NMIXB = G >= 192 ? MK_NMIXB : G / 2;
            if (vcu >= NMIXB) {
                if (layer == 0) {
                    { const int gw = (vcu - NMIXB) * NWAVES + wave, NGW = (G - NMIXB) * NWAVES; int rot = 0;
                      CVT_LOOP(16 * 16, MapPlain m{xa_wo, D, D, nullptr, 1.f, (bf16*)(ws + WS_W + WL_WO), D});
                      CVT_LOOP(16 * 88, MapW13 m{ffn_w1, ffn_w3, norm_ffn, W13, DFF, 2 * DFF});
                      CVT_LOOP(44 * 16, MapPlain m{ffn_w2, DFF, D, nullptr, 1.f, W2T, DFF});
                      { unsigned char* wl = ws + WS_W + WL_STRIDE;
                        { for (int it = (gw + NGW - rot % NGW) % NGW; it < 16 * 140; it += NGW) { if (it % 140 < 76) { MapWin m{w_in + (size_t)D * IN_TOTAL, norm_mix + D, (bf16*)(wl + WL_WIN), 8960}; cvt_item(m, it, scr, lane); }
                            else { MapWin m{w_in + (size_t)D * IN_TOTAL, norm_mix + D, (bf16*)(wl + WL_WIN + (size_t)4864 * 2048 - (size_t)4864 * 1024), 8960}; cvt_item8(m, it, scr, lane, 64.0f, 1024); } } rot += 16 * 140; }
                        CVT_LOOP(8 * 8, MapPlain m{opqp(p.in[14]) + (size_t)512 * 512, 512, 512, nullptr, 1.f, (bf16*)(wl + WL_GLU), 512});
                        for (int k = 0; k < 4; ++k) CVT_LOOP(8 * 16, MapPlain m{w_branch + ((size_t)4 + k) * 512 * 1024, 512, 1024, nullptr, 1.f, (bf16*)(wl + WL_WB) + k * 512, 2048});
                        CVT_LOOP(16 * 16, MapPlain m{w_out + (size_t)D * D, D, D, nullptr, 1.f, (bf16*)(wl + WL_WOUT), D});
                        CVT_LOOP(16 * 16, MapPlain m{xa_wo + (size_t)D * D, D, D, nullptr, 1.f, (bf16*)(wl + WL_WO), D}); } }
                    for (int ll = 0; ll < 2; ++ll) {
                        const float* wq = xa_wq + (size_t)ll * D * D; const float* nx = norm_xa + ll * D; bf16* dq = (bf16*)(ws + WS_W + (size_t)ll * WL_STRIDE + WL_WQ);
                        for (int i8 = ((vcu - NMIXB) * NWAVES + wave) * 64 + lane; i8 < D * D / 8; i8 += (G - NMIXB) * NWAVES * 64) { const float sc = nx[i8 >> 7] * 0.0625f;
                            const f32x4 v0 = *(const f32x4*)(wq + (size_t)i8 * 8), v1 = *(const f32x4*)(wq + (size_t)i8 * 8 + 4);
                            v4u o; o.x = pg8::cvt_pk_bf16(v0[0] * sc, v0[1] * sc); o.y = pg8::cvt_pk_bf16(v0[2] * sc, v0[3] * sc); o.z = pg8::cvt_pk_bf16(v1[0] * sc, v1[1] * sc); o.w = pg8::cvt_pk_bf16(v1[2] * sc, v1[3] * sc);
                            *(v4u*)(dq + (size_t)i8 * 8) = o; } }
                    __syncthreads();
                    pg8::Gemm g{1024, 1024, 1024}; pg8::KVOrder S; S.mnr_ = (const char*)MNR; S.WKV0 = (const char*)(ws + WS_W + WL_WKV); S.WKV1 = (const char*)(ws + WS_W + WL_STRIDE + WL_WKV); S.G = G - NMIXB; S.c = vcu - NMIXB;
                    pg8::EpiKV E{KVB};
                    pg8::gemm_phase<pg8::EpiKV, pg8::KVOrder, true, true>(lds, g, S, E, wave_s);
                }
                using POF = std::conditional<true, pg8::PlainOrderOffF8, pg8::PlainOrderOff>::type; constexpr int ldw = 512; constexpr float psc = 1.0f / 64.0f;
                pg8::Gemm g{ldw, ldw, ldw}; POF S; S.A = layer == 1 ? (const char*)HN8L1 : (const char*)H; S.B = (const char*)WIN + (size_t)4864 * 2048 - (size_t)4864 * 1024;     S.nM = 64; S.nN = 16; S.lda = ldw; S.ldb = ldw; S.G = G - NMIXB; S.c = vcu - NMIXB; S.pn0 = 19; S.L0 = 0; S.L1 = (layer == 0 ? MK_GW0 : MK_GW1) - (layer == 0 ? MK_TAIL0 : MK_TAIL1);
                pg8::EpiProj E{PROJB, GATE, b_gate + layer * 4096, psc};
                pg8::gemm_phase<pg8::EpiProj, POF, true, true>(lds, g, S, E, wave_s);
            } else
            for (int wu = wave * NMIXB + vcu; wu < 768; wu += NMIXB * NWAVES) {
#ifdef MK_MIXONLY
                if ((wu < 256 ? 0 : wu < 512 ? 1 : 2) != MK_MIXONLY) continue;
#endif
                LAS unsigned char* sl = (LAS unsigned char*)scr; const int ln_ = lane_id_fresh();
                if (wu < 256) {
                    const int ty = wu >> 7, uu = wu & 127, b = uu >> 4, hh = (uu >> 1) & 7, eh = uu & 1; const size_t r0 = (size_t)b * L;
                    if (ty == 0) { const int g = hh >> 2; const float Aa = -__expf(opqp(p.in[18])[layer * 8 + hh]);
                        linattn_unit(XBCC + r0 * 768 + 640 + g * 64, 768, XBCC + r0 * 768 + 512 + g * 64, 768, XBCC + r0 * 768 + hh * 64 + eh * 32, 768, DT + r0 * 8 + hh, Aa * 1.4426950408889634f, opqp(p.in[19])[layer * 8 + hh],
                                     BR + r0 * 2048 + 512 + hh * 64 + eh * 32, 2048, sl, ln_); }
                    else { const float lg = log2f(1.0f - exp2f(-5.0f - (float)hh));
                        linattn_unit(PROJB + r0 * PJ + C_Q + hh * 64, PJ, PROJB + r0 * PJ + C_K + hh * 64, PJ, PROJB + r0 * PJ + C_V + hh * 64 + eh * 32, PJ, nullptr, lg, 0.f,
                                     BR + r0 * 2048 + 1024 + hh * 64 + eh * 32, 2048, sl, ln_); }
                } else if (wu < 512) {
                    const int un = wu - 256, b = un >> 5, g = un & 31; const size_t r0 = (size_t)b * L;
                    s5_unit(PROJB + r0 * PJ + C_U + g * 16, YS + r0 * 512 + g * 16, opqp(p.in[6]) + layer * 2048 + g * 64, opqp(p.in[7]) + layer * 2048 + g * 64, opqp(p.in[8]) + layer * 32768 + g * 1024, opqp(p.in[9]) + layer * 32768 + g * 1024,
                            opqp(p.in[10]) + layer * 32768 + g * 1024, opqp(p.in[11]) + layer * 32768 + g * 1024, opqp(p.in[12]) + layer * 512 + g * 16, expf(opqp(p.in[13])[layer * 32 + g]), sl, ln_);
                } else {
                    const int un = wu - 512, b = un >> 5, blk = (un >> 2) & 7, jq = un & 3, ch = blk * 64 + jq * 16 + (ln_ & 15); const size_t r0 = (size_t)b * L;
                    lru_unit(XLC + r0 * 512 + blk * 64, PROJB + r0 * PJ + C_GL + blk * 64, BR + r0 * 2048 + 1536 + blk * 64 + jq * 16, opqp(p.in[24]) + layer * 32768 + blk * 4096, opqp(p.in[26]) + layer * 32768 + blk * 4096,
                             opqp(p.in[25])[layer * 512 + ch], opqp(p.in[27])[layer * 512 + ch], softplusf_(-opqp(p.in[28])[layer * 512 + ch]), jq, ln_);
                }
            }
            if (vcu < NMIXB && (layer == 0 ? MK_TAIL0 : MK_TAIL1) > 0) {
                __syncthreads();
                pg8::Gemm g{1024, 1024, 1024}; pg8::PlainOrderOff S; S.A = (const char*)HN; S.B = (const char*)WIN; S.nM = 64; S.nN = 16; S.lda = 1024; S.ldb = 1024; S.G = NMIXB; S.c = vcu; S.pn0 = 19; S.L0 = (layer == 0 ? MK_GW0 : MK_GW1) - (layer == 0 ? MK_TAIL0 : MK_TAIL1); S.L1 = (layer == 0 ? MK_GW0 : MK_GW1);
                pg8::EpiProj E{PROJB, GATE, b_gate + layer * 4096, 1.0f};
                pg8::gemm_phase<pg8::EpiProj, pg8::PlainOrderOff, true, true>(lds, g, S, E, wave_s);
            }
#endif
            GRID_BARC(3);
        }
        if (IN(pb + 3)) { PH_VARS
            const float* snw = opqp(p.in[20]) + layer * 512; const float* rnw = opqp(p.in[21]) + layer * 512;
            for (int row = gw; row < T; row += NGW) {
                bf16* y = BR + (size_t)row * 2048; const bf16* pr = PROJB + (size_t)row * PJ;
                {
                    const v4u yw = *(const v4u*)(y + 512 + 8 * lane), zw = *(const v4u*)(pr + C_Z + 8 * lane);
                    float v[8] = {bflo(yw.x), bfhi(yw.x), bflo(yw.y), bfhi(yw.y), bflo(yw.z), bfhi(yw.z), bflo(yw.w), bfhi(yw.w)};
                    const float z[8] = {bflo(zw.x), bfhi(zw.x), bflo(zw.y), bfhi(zw.y), bflo(zw.z), bfhi(zw.z), bflo(zw.w), bfhi(zw.w)};
                    float ss = 0.f;
#pragma unroll
                    for (int q = 0; q < 8; ++q) { v[q] *= siluf_(z[q]); ss += v[q] * v[q]; }
                    const float r = 1.0f / sqrtf(wave_sum(ss) * (1.0f / 512.0f) + 1e-6f);
#pragma unroll
                    for (int q = 0; q < 8; ++q) v[q] *= r * snw[8 * lane + q];
                    v4u o; o.x = pk2(v[0], v[1]); o.y = pk2(v[2], v[3]); o.z = pk2(v[4], v[5]); o.w = pk2(v[6], v[7]);
                    *(v4u*)(y + 512 + 8 * lane) = o;
                }
                {
                    const v4u yw = *(const v4u*)(y + 1024 + 8 * lane), gw_ = *(const v4u*)(pr + C_G + 8 * lane);
                    float v[8] = {bflo(yw.x), bfhi(yw.x), bflo(yw.y), bfhi(yw.y), bflo(yw.z), bfhi(yw.z), bflo(yw.w), bfhi(yw.w)};
                    const float gg[8] = {bflo(gw_.x), bfhi(gw_.x), bflo(gw_.y), bfhi(gw_.y), bflo(gw_.z), bfhi(gw_.z), bflo(gw_.w), bfhi(gw_.w)};
                    float s = 0.f;
#pragma unroll
                    for (int q = 0; q < 8; ++q) s += v[q];
                    s = sum8(s);
                    const float mu = s * (1.0f / 64.0f); float q2 = 0.f;
#pragma unroll
                    for (int q = 0; q < 8; ++q) { v[q] -= mu; q2 += v[q] * v[q]; }
                    q2 = sum8(q2);
                    const float rs = 1.0f / sqrtf(q2 * (1.0f / 64.0f) + 1e-6f);
#pragma unroll
                    for (int q = 0; q < 8; ++q) v[q] = siluf_(gg[q]) * (v[q] * rs * rnw[8 * lane + q]);
                    v4u o; o.x = pk2(v[0], v[1]); o.y = pk2(v[2], v[3]); o.z = pk2(v[4], v[5]); o.w = pk2(v[6], v[7]);
                    *(v4u*)(y + 1024 + 8 * lane) = o;
                }
            }
            pg8::Gemm g{512, 512, 512}; pg8::PlainOrder S; S.A = (const char*)YSB; S.B = (const char*)WGLU; S.nM = 64; S.nN = 2; S.lda = 512; S.ldb = 512; S.G = G; S.c = bx;
            pg8::EpiGlu E{YSB, BR};
            pg8::gemm_phase<pg8::EpiGlu, pg8::PlainOrder, true, true>(lds, g, S, E, wave_s);
            {
                const int qoff = G >= 256 ? 128 : 0;
                pg8::Gemm gq{1024, 1024, 256}; pg8::QKWOrder Sq; Sq.kx_ = (const char*)KX; Sq.wqn_ = (const char*)WQ; Sq.G = G - qoff; Sq.c = bx - qoff;
                pg8::EpiStore Eq{QKW, 1024};
                pg8::gemm_phase<pg8::EpiStore, pg8::QKWOrder, false, false>(lds, gq, Sq, Eq, wave_s);
            }
            if ((layer == 0 ? MK_GW0 : MK_GW1) < 1024) {
                using POF2 = std::conditional<true, pg8::PlainOrderOffF8, pg8::PlainOrderOff>::type; constexpr int ldw2 = 512; constexpr float psc2 = 1.0f / 64.0f;
                pg8::Gemm g2{ldw2, ldw2, ldw2}; POF2 S2; S2.A = layer == 1 ? (const char*)HN8L1 : (const char*)H; S2.B = (const char*)WIN + (size_t)4864 * 2048 - (size_t)4864 * 1024; S2.nM = 64; S2.nN = 16; S2.lda = ldw2; S2.ldb = ldw2; S2.G = G; S2.c = vcu; S2.pn0 = 19; S2.L0 = (layer == 0 ? MK_GW0 : MK_GW1); S2.L1 = 1024;
                pg8::EpiProj E2{PROJB, GATE, b_gate + layer * 4096, psc2};
                pg8::gemm_phase<pg8::EpiProj, POF2, true, true>(lds, g2, S2, E2, wave_s);
            }
            GRID_BARC(4);
        }
        if (IN(pb + 4)) { PH_VARS
#ifdef MK_EXP_A
            pg8::Gemm g{2048, 2048, 2048}; pg8::PlainOrder S; S.A = (const char*)BR; S.B = (const char*)WB; S.nM = 64; S.nN = 4; S.lda = 2048; S.ldb = 2048; S.G = G; S.c = bx;
            pg8::EpiStore E{MERGED, 1024};
            pg8::gemm_phase<pg8::EpiStore, pg8::PlainOrder, true, true>(lds, g, S, E, wave_s);
#else
            pg8::Gemm g{2048, 2048, 512}; pg8::MergeOrder S; S.br_ = (const char*)BR; S.wb_ = (const char*)WB; S.G = G; S.c = bx;
            pg8::EpiMerge E{GATE, MERGED};
            pg8::gemm_phase<pg8::EpiMerge, pg8::MergeOrder, true, true>(lds, g, S, E, wave_s);
#endif
            GRID_BARC(5);
        }
        if (IN(pb + 5)) { PH_VARS
            pg8::Gemm g{1024, 1024, 1024}; pg8::PlainOrder S; S.A = (const char*)MERGED; S.B = (const char*)WOUT; S.nM = 64; S.nN = 4; S.lda = 1024; S.ldb = 1024; S.G = G; S.c = bx;
            pg8::EpiRes E{layer == 0 ? x_ : (const float*)H, H};
            pg8::gemm_phase<pg8::EpiRes, pg8::PlainOrder, true, true>(lds, g, S, E, wave_s);
            GRID_BARC(6);
        }
        if (IN(pb + 6)) { PH_VARS
            {
                const int voff = G >= 256 ? G - 128 : 0;
                pg8::Gemm gv{1024, 1024, 256}; pg8::VWOOrder Sv; Sv.wo_ = (const char*)WO; Sv.v_ = (const char*)VT; Sv.G = G - voff; Sv.c = bx - voff;
                pg8::EpiStore Ev{VWO, 1024};
                pg8::gemm_phase<pg8::EpiStore, pg8::VWOOrder, false, false>(lds, gv, Sv, Ev, wave_s);
            }
            norm_rows(H, HN, T, gw, NGW, lane, NoPost{});
            GRID_BARC(7);
        }
        if (IN(pb + 8)) { PH_VARS
            pg8::Gemm g{1024, 1024, 1024}; pg8::ScoreOrder S; S.hn_ = (const char*)HN; S.qkw_ = (const char*)QKW; S.G = G; S.c = bx;
            pg8::EpiSoftmax E{PB, (PG8_LAS float*)xch};
            for (int sb = 0; sb < 256; sb += G) { S.base = sb; pg8::gemm_phase<pg8::EpiSoftmax, pg8::ScoreOrder, false, false>(lds, g, S, E, wave_s); }
            GRID_BARC(9);
        }
        if (IN(pb + 10)) { PH_VARS
            pg8::Gemm g{1024, 1024, 1024}; pg8::PVWOrder S; S.p_ = (const char*)PB; S.vwo_ = (const char*)VWO; S.G = G; S.c = bx;
            pg8::EpiRes E{H, H};
            pg8::gemm_phase<pg8::EpiRes, pg8::PVWOrder, true, true>(lds, g, S, E, wave_s);
            GRID_BARC(11);
        }
        if (layer == 0) {
            if (IN(pb + 11)) { PH_VARS
                norm_rows(H, HN, T, gw, NGW, lane, NoPost{});
                GRID_BARC(7);
            }
            if (IN(pb + 12)) { PH_VARS
                pg8::Gemm g{1024, 1024, 1024}; pg8::PlainOrder S; S.A = (const char*)HN; S.B = (const char*)W13; S.nM = 64; S.nN = 22; S.lda = 1024; S.ldb = 1024; S.G = G; S.c = bx;
                pg8::EpiSwiglu E{ACT, DFF, 1.0f};
                pg8::gemm_phase<pg8::EpiSwiglu, pg8::PlainOrder, true, true>(lds, g, S, E, wave_s);
                GRID_BARC(12);
            }
            if (IN(pb + 13)) { PH_VARS
                pg8::Gemm g{DFF, DFF, DFF}; pg8::PlainOrder S; S.A = (const char*)ACT; S.B = (const char*)W2T; S.nM = 64; S.nN = 4; S.lda = DFF; S.ldb = DFF; S.G = G; S.c = bx;
                pg8::EpiRes E{H, H};
                pg8::gemm_phase<pg8::EpiRes, pg8::PlainOrder, true, true>(lds, g, S, E, wave_s);
                GRID_BARC(13);
            }
            if (IN(pb + 14)) { PH_VARS
                for (int i = tid; i < 8192; i += 512) w8[i] = norm_mix[D + (i >> 3)] * w_in[(size_t)D * IN_TOTAL + (size_t)(i >> 3) * IN_TOTAL + O_DT + (i & 7)];
                __syncthreads();
                norm_rows(H, HN, T, gw, NGW, lane, [&](const int row, const float r, const f32x4 (&v)[4]) { float lg[8]; row_dot8(v, w8, lane, lg);
                    float mine = 0.f;
#pragma unroll
                    for (int e = 0; e < 8; ++e) if (lane == e) mine = lg[e];
                    if (lane < 8) DT[(size_t)row * 8 + lane] = softplusf_(r * mine + opqp(p.in[17])[8 + lane]);
                    { unsigned* h8 = (unsigned*)(HN8L1 + (size_t)row * 1024) + lane;
#pragma unroll
                      for (int j = 0; j < 4; ++j) { int p8 = 0; p8 = __builtin_amdgcn_cvt_pk_fp8_f32(v[j].x * r, v[j].y * r, p8, false); p8 = __builtin_amdgcn_cvt_pk_fp8_f32(v[j].z * r, v[j].w * r, p8, true); h8[64 * j] = (unsigned)p8; } } });
                __syncthreads();
                GRID_BARC(7);
            }
        } else {
            if (IN(pb + 11)) { PH_VARS
                for (int i = tid; i < 8192; i += 512) w8[i] = norm_ffn[D + (i >> 3)] * moe_router[i];
                LAS int* lcnt = (LAS int*)(lds + 40960); LAS int* lbase = lcnt + 8; LAS i32x4* lti = (LAS i32x4*)(lds + 41984);
                if (tid < 8) lcnt[tid] = 0;
                __syncthreads();
                { int it = 0;
                norm_rows(H, HN, T, gw, NGW, lane, [&](const int row, const float r, const f32x4 (&v)[4]) { float lg[8]; row_dot8(v, w8, lane, lg);
                    { unsigned* h8 = (unsigned*)(HN8 + (size_t)row * 1024) + lane;
#pragma unroll
                      for (int j = 0; j < 4; ++j) { int p8 = 0; p8 = __builtin_amdgcn_cvt_pk_fp8_f32(v[j].x * r, v[j].y * r, p8, false); p8 = __builtin_amdgcn_cvt_pk_fp8_f32(v[j].z * r, v[j].w * r, p8, true); h8[64 * j] = (unsigned)p8; } }
                    if (lane == 0) {
                        int i1 = 0; float v1 = lg[0];
#pragma unroll
                        for (int e = 1; e < 8; ++e) if (lg[e] > v1) { v1 = lg[e]; i1 = e; }
                        int i2 = 0; float v2 = -3.0e38f;
#pragma unroll
                        for (int e = 0; e < 8; ++e) if (e != i1 && lg[e] > v2) { v2 = lg[e]; i2 = e; }
                        const float w1 = 1.0f / (1.0f + expf(r * (v2 - v1))), w2 = 1.0f - w1;
                        const int r1 = __hip_atomic_fetch_add(lcnt + i1, 1, __ATOMIC_RELAXED, __HIP_MEMORY_SCOPE_WORKGROUP), r2 = __hip_atomic_fetch_add(lcnt + i2, 1, __ATOMIC_RELAXED, __HIP_MEMORY_SCOPE_WORKGROUP);
                        lti[wave * 32 + (it & 31)] = (i32x4){i1, i2, r1, r2}; TOPW[row] = (f32x2){w1, w2};
                    } ++it; }); }
                __syncthreads();
                if (tid < 8) lbase[tid] = atomicAdd(&CNT[tid], lcnt[tid]);
                __syncthreads();
                { int it = 0;
                for (int row = gw; row < T; row += NGW, ++it) if (lane == 0) { i32x4 ti = lti[wave * 32 + (it & 31)]; ti.z += lbase[ti.x]; ti.w += lbase[ti.y]; TOPI[row] = ti; } }
                __syncthreads();
                {
                    int rot = 0;
                    for (int e = 0; e < NE; ++e) {
                        CVT_LOOP8(16 * 112, 64.0f, 1024, MapW13 m{moe_w1 + (size_t)e * D * DFE, moe_w3 + (size_t)e * D * DFE, norm_ffn + D, (bf16*)((unsigned char*)W13E + (size_t)e * 2 * DFE * D), DFE, 2 * DFE});
                        CVT_LOOP8(56 * 16, 64.0f, DFE, MapPlain m{moe_w2 + (size_t)e * DFE * D, DFE, D, nullptr, 1.f, (bf16*)((unsigned char*)W2E + (size_t)e * D * DFE), DFE});
                    }
                }
                GRID_BARC(14);
            }
            int t1 = 0, t2 = 0, t3 = 0, t4 = 0, t5 = 0, t6 = 0, t7 = 0, ntiles = 0;
            if (lo <= pb + 14 && hi > pb + 12) {
                int acc = 0;
#pragma unroll
                for (int e = 0; e < 8; ++e) { const int c = __hip_atomic_load(&CNT[e], RLX_AGENT); acc += (c + 255) >> 8;
                    if (e == 0) t1 = acc; if (e == 1) t2 = acc; if (e == 2) t3 = acc; if (e == 3) t4 = acc; if (e == 4) t5 = acc; if (e == 5) t6 = acc; if (e == 6) t7 = acc; if (e == 7) ntiles = acc; }
            }
            if (IN(pb + 12)) { PH_VARS
                for (int row = gw; row < T; row += NGW) {
                    const i32x4 ti = TOPI[row];
                    const int e1 = ti.x, e2 = ti.y;
                    const int s1 = (e1 == 0 ? 0 : e1 == 1 ? t1 : e1 == 2 ? t2 : e1 == 3 ? t3 : e1 == 4 ? t4 : e1 == 5 ? t5 : e1 == 6 ? t6 : t7) * 256 + ti.z;
                    const int s2 = (e2 == 0 ? 0 : e2 == 1 ? t1 : e2 == 2 ? t2 : e2 == 3 ? t3 : e2 == 4 ? t4 : e2 == 5 ? t5 : e2 == 6 ? t6 : t7) * 256 + ti.w;
                    { const v4u a8 = *((const v4u*)(HN8 + (size_t)row * 1024) + lane); *((v4u*)(XS8 + (size_t)s1 * 1024) + lane) = a8; *((v4u*)(XS8 + (size_t)s2 * 1024) + lane) = a8; }
                    if (lane == 0) SLOT[row] = (i32x2){s1, s2};
                }
                GRID_BARC(15);
            }
            if (IN(pb + 13)) { PH_VARS
                pg8::Gemm g{512, 512, 512}; pg8::MoeUpF8 S; S.A = (const char*)XS8; S.B = (const char*)W13E; S.estride = (size_t)2 * DFE * D; S.lda = 512; S.ldb = 512; S.ntiles = ntiles; S.nN = 28; S.G = G; S.c = bx;
                S.t1 = t1; S.t2 = t2; S.t3 = t3; S.t4 = t4; S.t5 = t5; S.t6 = t6; S.t7 = t7;
                pg8::EpiSwigluF8 E{(unsigned char*)ACTE, DFE, 1.0f / 64.0f, 2.0f};
                pg8::gemm_phase<pg8::EpiSwigluF8, pg8::MoeUpF8, false, true>(lds, g, S, E, wave_s);
                GRID_BARC(16);
            }
            if (IN(pb + 14)) { PH_VARS
                { pg8::Gemm g{DFE / 2, DFE / 2, DFE / 2}; pg8::MoeDownOrderF8 S; S.A = (const char*)ACTE; S.B = (const char*)W2E; S.estride = (size_t)D * DFE; S.lda = DFE / 2; S.ldb = DFE / 2; S.G = G; S.c = vcu;
                  S.t1 = t1; S.t2 = t2; S.t3 = t3; S.t4 = t4; S.t5 = t5; S.t6 = t6; S.t7 = t7;
                  pg8::EpiStoreS E{XS, 1024, 1.0f / 128.0f};
                  pg8::gemm_phase<pg8::EpiStoreS, pg8::MoeDownOrderF8, true, true>(lds, g, S, E, wave_s); }
                { pg8::Gemm g{DFE / 2, DFE / 2, 256}; pg8::MoeDownTailF8 S; S.A = (const char*)ACTE; S.B = (const char*)W2E; S.estride = (size_t)D * DFE; S.lda = DFE / 2; S.ldb = DFE / 2; S.ntiles = ntiles; S.G = G; S.c = vcu;
                  S.t1 = t1; S.t2 = t2; S.t3 = t3; S.t4 = t4; S.t5 = t5; S.t6 = t6; S.t7 = t7;
                  pg8::EpiPartF32S E{YPART, 1.0f / 128.0f};
                  pg8::gemm_phase<pg8::EpiPartF32S, pg8::MoeDownTailF8, true, true>(lds, g, S, E, wave_s); }
                GRID_BARC(17);
            }
            if (IN(pb + 15)) { PH_VARS
                const unsigned bad = __hip_atomic_load(ctl + CW_BAR + XB_TMO, RLX_AGENT);
                for (int row = gw; row < T; row += NGW) {
                    const i32x2 sl = SLOT[row]; const f32x2 tw = TOPW[row];
                    const f32x4* hr = (const f32x4*)(H + (size_t)row * D) + lane;
                    f32x4 v[4]; float ss = 0.f;
#pragma unroll
                    for (int j = 0; j < 4; ++j) v[j] = hr[64 * j];
#pragma unroll
                    for (int k = 0; k < 2; ++k) { const int s_ = k ? sl.y : sl.x; const float w_ = k ? tw.y : tw.x;
                        if (s_ < 32768) { const v2u* y = (const v2u*)(XS + (size_t)s_ * D) + lane;
#pragma unroll
                            for (int j = 0; j < 4; ++j) { const v2u a = y[64 * j]; v[j].x += w_ * bflo(a.x); v[j].y += w_ * bfhi(a.x); v[j].z += w_ * bflo(a.y); v[j].w += w_ * bfhi(a.y); } }
                        else { const f32x4* yp = (const f32x4*)(YPART + ((size_t)((s_ >> 8) - 128) * 7 * 256 + (s_ & 255)) * 1024) + lane;
                            for (int p7 = 0; p7 < 7; ++p7)
#pragma unroll
                                for (int j = 0; j < 4; ++j) v[j] += yp[(size_t)p7 * 256 * 256 + 64 * j] * w_; } }
#pragma unroll
                    for (int j = 0; j < 4; ++j) ss += (v[j].x * v[j].x + v[j].y * v[j].y) + (v[j].z * v[j].z + v[j].w * v[j].w);
                    float r = 1.0f / sqrtf(wave_sum(ss) * (1.0f / 1024.0f) + 1e-6f);
                    if (bad) r = __builtin_nanf("");
                    f32x4* orow = (f32x4*)(H + (size_t)row * D) + lane;
#pragma unroll
                    for (int j = 0; j < 4; ++j) { const f32x4 g4 = *((const f32x4*)norm_final + lane + 64 * j); orow[64 * j] = v[j] * r * g4; }
                }
            }
        }
        }
    { constexpr int layer = 1;
        const int pb = 1 + layer * 20;
#define WLP (ws + WS_W + (size_t)layer * WL_STRIDE)
#define WIN ((const bf16*)(WLP + WL_WIN))
#define WGLU ((const bf16*)(WLP + WL_GLU))
#define WB ((const bf16*)(WLP + WL_WB))
#define WOUT ((const bf16*)(WLP + WL_WOUT))
#define WQ ((const bf16*)(WLP + WL_WQ))
#define WO ((const bf16*)(WLP + WL_WO))
#define KX (KVB + (size_t)layer * 4194304)
#define VT (KX + 2097152)
        if (IN(pb + 0)) { PH_VARS
            pg8::Gemm g{1024, 1024, 1024}; pg8::PlainOrder S; S.A = (const char*)HN; S.B = (const char*)WIN; S.nM = 64; S.nN = 19; S.lda = 1024; S.ldb = 1024; S.G = G; S.c = bx;
            pg8::EpiProj E{PROJB, GATE, b_gate + layer * 4096, 1.0f};
            pg8::gemm_phase<pg8::EpiProj, pg8::PlainOrder, true, true>(lds, g, S, E, wave_s);
            GRID_BARC(1);
        }
        if (IN(pb + 1)) { PH_VARS
            const float* cw = opqp(p.in[15]) + layer * 4 * 768; const float* cb = opqp(p.in[16]) + layer * 768; const float* lw = opqp(p.in[22]) + layer * 4 * 512; const float* lb = opqp(p.in[23]) + layer * 512;
            for (int it = gt; it < T * 224; it += NGT) {
                const int row = it / 224, j = it % 224, t = row & (L - 1);
                if (j < 160) {
                    const bool isx = j < 96; const int c0 = isx ? j * 8 : (j - 96) * 8, C = isx ? 768 : 512; const float* w = isx ? cw : lw; const float* bb = isx ? cb : lb;
                    const bf16* src = PROJB + (size_t)row * PJ + (isx ? C_XBC : C_XL) + c0;
                    float acc[8];
#pragma unroll
                    for (int q = 0; q < 8; ++q) acc[q] = bb[c0 + q];
#pragma unroll
                    for (int tap = 0; tap < 4; ++tap) { if (t - 3 + tap >= 0) { const v4u xv = *(const v4u*)(src - (ptrdiff_t)(3 - tap) * PJ); const float* wt = w + tap * C + c0;
                        acc[0] += wt[0] * bflo(xv.x); acc[1] += wt[1] * bfhi(xv.x); acc[2] += wt[2] * bflo(xv.y); acc[3] += wt[3] * bfhi(xv.y);
                        acc[4] += wt[4] * bflo(xv.z); acc[5] += wt[5] * bfhi(xv.z); acc[6] += wt[6] * bflo(xv.w); acc[7] += wt[7] * bfhi(xv.w); } }
                    if (isx) {
#pragma unroll
                        for (int q = 0; q < 8; ++q) acc[q] = siluf_(acc[q]); }
                    v4u o; o.x = pk2(acc[0], acc[1]); o.y = pk2(acc[2], acc[3]); o.z = pk2(acc[4], acc[5]); o.w = pk2(acc[6], acc[7]);
                    *(v4u*)((isx ? XBCC + (size_t)row * 768 : XLC + (size_t)row * 512) + c0) = o;
                } else {
                    const bool isk = j >= 192; const int jj = isk ? j - 192 : j - 160, h = jj >> 2, i0 = (jj & 3) * 8; const float sc = isk ? 0.125f : 1.0f;
                    bf16* q1 = PROJB + (size_t)row * PJ + (isk ? C_K : C_Q) + h * 64 + i0; bf16* q2 = q1 + 32;
                    const v4u a = *(const v4u*)q1, b = *(const v4u*)q2;
                    const f32x4 c0v = *(const f32x4*)(COS + (size_t)row * 32 + i0), c1v = *(const f32x4*)(COS + (size_t)row * 32 + i0 + 4), s0v = *(const f32x4*)(SIN + (size_t)row * 32 + i0), s1v = *(const f32x4*)(SIN + (size_t)row * 32 + i0 + 4);
                    const float x1[8] = {bflo(a.x), bfhi(a.x), bflo(a.y), bfhi(a.y), bflo(a.z), bfhi(a.z), bflo(a.w), bfhi(a.w)};
                    const float x2[8] = {bflo(b.x), bfhi(b.x), bflo(b.y), bfhi(b.y), bflo(b.z), bfhi(b.z), bflo(b.w), bfhi(b.w)};
                    const float cc[8] = {c0v.x, c0v.y, c0v.z, c0v.w, c1v.x, c1v.y, c1v.z, c1v.w}, ss[8] = {s0v.x, s0v.y, s0v.z, s0v.w, s1v.x, s1v.y, s1v.z, s1v.w};
                    float o1[8], o2[8];
#pragma unroll
                    for (int q = 0; q < 8; ++q) { o1[q] = (x1[q] * cc[q] - x2[q] * ss[q]) * sc; o2[q] = (x2[q] * cc[q] + x1[q] * ss[q]) * sc; }
                    v4u w1; w1.x = pk2(o1[0], o1[1]); w1.y = pk2(o1[2], o1[3]); w1.z = pk2(o1[4], o1[5]); w1.w = pk2(o1[6], o1[7]);
                    v4u w2; w2.x = pk2(o2[0], o2[1]); w2.y = pk2(o2[2], o2[3]); w2.z = pk2(o2[4], o2[5]); w2.w = pk2(o2[6], o2[7]);
                    *(v4u*)q1 = w1; *(v4u*)q2 = w2;
                }
            }
            GRID_BARC(2);
        }
        if (IN(pb + 2)) { PH_VARS
            bf16* YS = YSB;
#ifdef MK_NAIVE_MIX
            for (int wu = gw; wu < 832; wu += NGW) {
                if (wu < 256) {
                    const int un = wu >> 2, sub = wu & 3, b = un >> 3, hh = un & 7, g = hh >> 2, pp = sub * 16 + (lane >> 2), nq = lane & 3;
                    const float Aa = -__expf(opqp(p.in[18])[layer * 8 + hh]), Dk = opqp(p.in[19])[layer * 8 + hh];
                    float S[16];
#pragma unroll
                    for (int j = 0; j < 16; ++j) S[j] = 0.f;
                    for (int t = 0; t < L; ++t) {
                        const size_t row = (size_t)b * L + t; const bf16* xr = XBCC + row * 768;
                        const float dtv = DT[row * 8 + hh], xv = bf1(xr[hh * 64 + pp]);
                        const v4u b0 = *(const v4u*)(xr + 512 + g * 64 + nq * 16), b1 = *(const v4u*)(xr + 512 + g * 64 + nq * 16 + 8), c0 = *(const v4u*)(xr + 640 + g * 64 + nq * 16), c1 = *(const v4u*)(xr + 640 + g * 64 + nq * 16 + 8);
                        const float Bv[16] = {bflo(b0.x), bfhi(b0.x), bflo(b0.y), bfhi(b0.y), bflo(b0.z), bfhi(b0.z), bflo(b0.w), bfhi(b0.w), bflo(b1.x), bfhi(b1.x), bflo(b1.y), bfhi(b1.y), bflo(b1.z), bfhi(b1.z), bflo(b1.w), bfhi(b1.w)};
                        const float Cv[16] = {bflo(c0.x), bfhi(c0.x), bflo(c0.y), bfhi(c0.y), bflo(c0.z), bfhi(c0.z), bflo(c0.w), bfhi(c0.w), bflo(c1.x), bfhi(c1.x), bflo(c1.y), bfhi(c1.y), bflo(c1.z), bfhi(c1.z), bflo(c1.w), bfhi(c1.w)};
                        const float da = __expf(dtv * Aa), xdt = xv * dtv; float acc = 0.f;
#pragma unroll
                        for (int j = 0; j < 16; ++j) { S[j] = da * S[j] + xdt * Bv[j]; acc += Cv[j] * S[j]; }
                        acc += __shfl_xor(acc, 1); acc += __shfl_xor(acc, 2);
                        if (nq == 0) BR[row * 2048 + 512 + hh * 64 + pp] = (bf16)f2bf(acc + Dk * xv);
                    }
                } else if (wu < 512) {
                    const int un = (wu - 256) >> 2, sub = wu & 3, b = un >> 3, hh = un & 7, e = sub * 16 + (lane >> 2), dq = lane & 3;
                    const float gamma = 1.0f - exp2f(-5.0f - (float)hh);
                    float S[16];
#pragma unroll
                    for (int j = 0; j < 16; ++j) S[j] = 0.f;
                    for (int t = 0; t < L; ++t) {
                        const size_t row = (size_t)b * L + t; const bf16* pr = PROJB + row * PJ;
                        const float vv = bf1(pr[C_V + hh * 64 + e]);
                        const v4u k0 = *(const v4u*)(pr + C_K + hh * 64 + dq * 16), k1 = *(const v4u*)(pr + C_K + hh * 64 + dq * 16 + 8), q0 = *(const v4u*)(pr + C_Q + hh * 64 + dq * 16), q1 = *(const v4u*)(pr + C_Q + hh * 64 + dq * 16 + 8);
                        const float Kv[16] = {bflo(k0.x), bfhi(k0.x), bflo(k0.y), bfhi(k0.y), bflo(k0.z), bfhi(k0.z), bflo(k0.w), bfhi(k0.w), bflo(k1.x), bfhi(k1.x), bflo(k1.y), bfhi(k1.y), bflo(k1.z), bfhi(k1.z), bflo(k1.w), bfhi(k1.w)};
                        const float Qv[16] = {bflo(q0.x), bfhi(q0.x), bflo(q0.y), bfhi(q0.y), bflo(q0.z), bfhi(q0.z), bflo(q0.w), bfhi(q0.w), bflo(q1.x), bfhi(q1.x), bflo(q1.y), bfhi(q1.y), bflo(q1.z), bfhi(q1.z), bflo(q1.w), bfhi(q1.w)};
                        float acc = 0.f;
#pragma unroll
                        for (int j = 0; j < 16; ++j) { S[j] = gamma * S[j] + Kv[j] * vv; acc += Qv[j] * S[j]; }
                        acc += __shfl_xor(acc, 1); acc += __shfl_xor(acc, 2);
                        if (dq == 0) BR[row * 2048 + 1024 + hh * 64 + e] = (bf16)f2bf(acc);
                    }
                } else if (wu < 768) {
                    const int un = wu - 512, b = un >> 5, g = un & 31, n = lane;
                    const float* lam_re = opqp(p.in[6]) + layer * 2048; const float* lam_im = opqp(p.in[7]) + layer * 2048; const float* b_re = opqp(p.in[8]) + layer * 32768; const float* b_im = opqp(p.in[9]) + layer * 32768;
                    const float* c_re = opqp(p.in[10]) + layer * 32768; const float* c_im = opqp(p.in[11]) + layer * 32768; const float* dsk = opqp(p.in[12]) + layer * 512;
                    const float lr = lam_re[g * 64 + n], li = lam_im[g * 64 + n], step = expf(opqp(p.in[13])[layer * 32 + g]);
                    const float mag = expf(lr * step), ar = mag * cosf(li * step), ai = mag * sinf(li * step);
                    const float inv = 1.0f / (lr * lr + li * li);
                    const float cr = ((ar - 1.0f) * lr + ai * li) * inv, ci = (ai * lr - (ar - 1.0f) * li) * inv;
                    float bbr[16], bbi[16], cre[16], cim[16];
#pragma unroll
                    for (int h = 0; h < 16; ++h) { const float br_ = b_re[(g * 64 + n) * 16 + h], bi_ = b_im[(g * 64 + n) * 16 + h];
                        bbr[h] = cr * br_ - ci * bi_; bbi[h] = cr * bi_ + ci * br_; cre[h] = c_re[(g * 16 + h) * 64 + n]; cim[h] = c_im[(g * 16 + h) * 64 + n]; }
                    const float dmine = dsk[g * 16 + (n & 15)];
                    float sr = 0.f, si = 0.f;
                    for (int t = 0; t < L; ++t) {
                        const size_t row = (size_t)b * L + t; const bf16* up = PROJB + row * PJ + C_U + g * 16;
                        const v4u u0 = *(const v4u*)up, u1 = *(const v4u*)(up + 8);
                        const float u[16] = {bflo(u0.x), bfhi(u0.x), bflo(u0.y), bfhi(u0.y), bflo(u0.z), bfhi(u0.z), bflo(u0.w), bfhi(u0.w), bflo(u1.x), bfhi(u1.x), bflo(u1.y), bfhi(u1.y), bflo(u1.z), bfhi(u1.z), bflo(u1.w), bfhi(u1.w)};
                        float bur = 0.f, bui = 0.f;
#pragma unroll
                        for (int h = 0; h < 16; ++h) { bur += u[h] * bbr[h]; bui += u[h] * bbi[h]; }
                        const float nr = ar * sr - ai * si + bur, ni = ar * si + ai * sr + bui; sr = nr; si = ni;
                        float mine = 0.f, umine = 0.f;
#pragma unroll
                        for (int h = 0; h < 16; ++h) { const float y = wave_sum(sr * cre[h] - si * cim[h]); if (n == h) { mine = y; umine = u[h]; } }
                        if (n < 16) YS[row * 512 + g * 16 + n] = (bf16)f2bf(gelu_tanh(mine + dmine * umine));
                    }
                } else {
                    const int un = wu - 768, b = un >> 3, blk = un & 7, j = lane;
                    LAS bf16* wA = (LAS bf16*)scr; LAS bf16* wX = wA + 4096;
                    for (int i = 0; i < 64; ++i) { wA[i * 64 + j] = (bf16)f2bf(opqp(p.in[24])[layer * 32768 + (blk * 64 + i) * 64 + j]); wX[i * 64 + j] = (bf16)f2bf(opqp(p.in[26])[layer * 32768 + (blk * 64 + i) * 64 + j]); }
                    LDS_WAIT();
                    const float bA = opqp(p.in[25])[layer * 512 + blk * 64 + j], bX = opqp(p.in[27])[layer * 512 + blk * 64 + j], sp = softplusf_(-opqp(p.in[28])[layer * 512 + blk * 64 + j]);
                    float hs = 0.f;
                    for (int t = 0; t < L; ++t) {
                        const size_t row = (size_t)b * L + t;
                        const float xc = bf1(XLC[row * 512 + blk * 64 + j]);
                        float ra = bA, ri = bX;
#pragma unroll
                        for (int i = 0; i < 64; ++i) { const float xi = __shfl(xc, i); ra += xi * bf1(wA[i * 64 + j]); ri += xi * bf1(wX[i * 64 + j]); }
                        const float r = sigmoidf_(ra), ig = sigmoidf_(ri);
                        const float log_a = -8.0f * r * sp, a = __expf(log_a);
                        const float mult = sqrtf(fmaxf(-expm1f(2.0f * log_a), 0.f));
                        hs = a * hs + mult * ig * xc;
                        BR[row * 2048 + 1536 + blk * 64 + j] = (bf16)f2bf(hs * gelu_tanh(bf1(PROJB[row * PJ + C_GL + blk * 64 + j])));
                    }
                }
            }
#else
            const int NMIXB = G >= 192 ? MK_NMIXB : G / 2;
            if (vcu >= NMIXB) {
                if (layer == 0) {
                    { const int gw = (vcu - NMIXB) * NWAVES + wave, NGW = (G - NMIXB) * NWAVES; int rot = 0;
                      CVT_LOOP(16 * 16, MapPlain m{xa_wo, D, D, nullptr, 1.f, (bf16*)(ws + WS_W + WL_WO), D});
                      CVT_LOOP(16 * 88, MapW13 m{ffn_w1, ffn_w3, norm_ffn, W13, DFF, 2 * DFF});
                      CVT_LOOP(44 * 16, MapPlain m{ffn_w2, DFF, D, nullptr, 1.f, W2T, DFF});
                      { unsigned char* wl = ws + WS_W + WL_STRIDE;
                        { for (int it = (gw + NGW - rot % NGW) % NGW; it < 16 * 140; it += NGW) { if (it % 140 < 76) { MapWin m{w_in + (size_t)D * IN_TOTAL, norm_mix + D, (bf16*)(wl + WL_WIN), 8960}; cvt_item(m, it, scr, lane); }
                            else { MapWin m{w_in + (size_t)D * IN_TOTAL, norm_mix + D, (bf16*)(wl + WL_WIN + (size_t)4864 * 2048 - (size_t)4864 * 1024), 8960}; cvt_item8(m, it, scr, lane, 64.0f, 1024); } } rot += 16 * 140; }
                        CVT_LOOP(8 * 8, MapPlain m{opqp(p.in[14]) + (size_t)512 * 512, 512, 512, nullptr, 1.f, (bf16*)(wl + WL_GLU), 512});
                        for (int k = 0; k < 4; ++k) CVT_LOOP(8 * 16, MapPlain m{w_branch + ((size_t)4 + k) * 512 * 1024, 512, 1024, nullptr, 1.f, (bf16*)(wl + WL_WB) + k * 512, 2048});
                        CVT_LOOP(16 * 16, MapPlain m{w_out + (size_t)D * D, D, D, nullptr, 1.f, (bf16*)(wl + WL_WOUT), D});
                        CVT_LOOP(16 * 16, MapPlain m{xa_wo + (size_t)D * D, D, D, nullptr, 1.f, (bf16*)(wl + WL_WO), D}); } }
                    for (int ll = 0; ll < 2; ++ll) {
                        const float* wq = xa_wq + (size_t)ll * D * D; const float* nx = norm_xa + ll * D; bf16* dq = (bf16*)(ws + WS_W + (size_t)ll * WL_STRIDE + WL_WQ);
                        for (int i8 = ((vcu - NMIXB) * NWAVES + wave) * 64 + lane; i8 < D * D / 8; i8 += (G - NMIXB) * NWAVES * 64) { const float sc = nx[i8 >> 7] * 0.0625f;
                            const f32x4 v0 = *(const f32x4*)(wq + (size_t)i8 * 8), v1 = *(const f32x4*)(wq + (size_t)i8 * 8 + 4);
                            v4u o; o.x = pg8::cvt_pk_bf16(v0[0] * sc, v0[1] * sc); o.y = pg8::cvt_pk_bf16(v0[2] * sc, v0[3] * sc); o.z = pg8::cvt_pk_bf16(v1[0] * sc, v1[1] * sc); o.w = pg8::cvt_pk_bf16(v1[2] * sc, v1[3] * sc);
                            *(v4u*)(dq + (size_t)i8 * 8) = o; } }
                    __syncthreads();
                    pg8::Gemm g{1024, 1024, 1024}; pg8::KVOrder S; S.mnr_ = (const char*)MNR; S.WKV0 = (const char*)(ws + WS_W + WL_WKV); S.WKV1 = (const char*)(ws + WS_W + WL_STRIDE + WL_WKV); S.G = G - NMIXB; S.c = vcu - NMIXB;
                    pg8::EpiKV E{KVB};
                    pg8::gemm_phase<pg8::EpiKV, pg8::KVOrder, true, true>(lds, g, S, E, wave_s);
                }
                using POF = std::conditional<true, pg8::PlainOrderOffF8, pg8::PlainOrderOff>::type; constexpr int ldw = 512; constexpr float psc = 1.0f / 64.0f;
                pg8::Gemm g{ldw, ldw, ldw}; POF S; S.A = layer == 1 ? (const char*)HN8L1 : (const char*)H; S.B = (const char*)WIN + (size_t)4864 * 2048 - (size_t)4864 * 1024;     S.nM = 64; S.nN = 16; S.lda = ldw; S.ldb = ldw; S.G = G - NMIXB; S.c = vcu - NMIXB; S.pn0 = 19; S.L0 = 0; S.L1 = (layer == 0 ? MK_GW0 : MK_GW1) - (layer == 0 ? MK_TAIL0 : MK_TAIL1);
                pg8::EpiProj E{PROJB, GATE, b_gate + layer * 4096, psc};
                pg8::gemm_phase<pg8::EpiProj, POF, true, true>(lds, g, S, E, wave_s);
            } else
            for (int wu = wave * NMIXB + vcu; wu < 768; wu += NMIXB * NWAVES) {
#ifdef MK_MIXONLY
                if ((wu < 256 ? 0 : wu < 512 ? 1 : 2) != MK_MIXONLY) continue;
#endif
                LAS unsigned char* sl = (LAS unsigned char*)scr; const int ln_ = lane_id_fresh();
                if (wu < 256) {
                    const int ty = wu >> 7, uu = wu & 127, b = uu >> 4, hh = (uu >> 1) & 7, eh = uu & 1; const size_t r0 = (size_t)b * L;
                    if (ty == 0) { const int g = hh >> 2; const float Aa = -__expf(opqp(p.in[18])[layer * 8 + hh]);
                        linattn_unit(XBCC + r0 * 768 + 640 + g * 64, 768, XBCC + r0 * 768 + 512 + g * 64, 768, XBCC + r0 * 768 + hh * 64 + eh * 32, 768, DT + r0 * 8 + hh, Aa * 1.4426950408889634f, opqp(p.in[19])[layer * 8 + hh],
                                     BR + r0 * 2048 + 512 + hh * 64 + eh * 32, 2048, sl, ln_); }
                    else { const float lg = log2f(1.0f - exp2f(-5.0f - (float)hh));
                        linattn_unit(PROJB + r0 * PJ + C_Q + hh * 64, PJ, PROJB + r0 * PJ + C_K + hh * 64, PJ, PROJB + r0 * PJ + C_V + hh * 64 + eh * 32, PJ, nullptr, lg, 0.f,
                                     BR + r0 * 2048 + 1024 + hh * 64 + eh * 32, 2048, sl, ln_); }
                } else if (wu < 512) {
                    const int un = wu - 256, b = un >> 5, g = un & 31; const size_t r0 = (size_t)b * L;
                    s5_unit(PROJB + r0 * PJ + C_U + g * 16, YS + r0 * 512 + g * 16, opqp(p.in[6]) + layer * 2048 + g * 64, opqp(p.in[7]) + layer * 2048 + g * 64, opqp(p.in[8]) + layer * 32768 + g * 1024, opqp(p.in[9]) + layer * 32768 + g * 1024,
                            opqp(p.in[10]) + layer * 32768 + g * 1024, opqp(p.in[11]) + layer * 32768 + g * 1024, opqp(p.in[12]) + layer * 512 + g * 16, expf(opqp(p.in[13])[layer * 32 + g]), sl, ln_);
                } else {
                    const int un = wu - 512, b = un >> 5, blk = (un >> 2) & 7, jq = un & 3, ch = blk * 64 + jq * 16 + (ln_ & 15); const size_t r0 = (size_t)b * L;
                    lru_unit(XLC + r0 * 512 + blk * 64, PROJB + r0 * PJ + C_GL + blk * 64, BR + r0 * 2048 + 1536 + blk * 64 + jq * 16, opqp(p.in[24]) + layer * 32768 + blk * 4096, opqp(p.in[26]) + layer * 32768 + blk * 4096,
                             opqp(p.in[25])[layer * 512 + ch], opqp(p.in[27])[layer * 512 + ch], softplusf_(-opqp(p.in[28])[layer * 512 + ch]), jq, ln_);
                }
            }
            if (vcu < NMIXB && (layer == 0 ? MK_TAIL0 : MK_TAIL1) > 0) {
                __syncthreads();
                pg8::Gemm g{1024, 1024, 1024}; pg8::PlainOrderOff S; S.A = (const char*)HN; S.B = (const char*)WIN; S.nM = 64; S.nN = 16; S.lda = 1024; S.ldb = 1024; S.G = NMIXB; S.c = vcu; S.pn0 = 19; S.L0 = (layer == 0 ? MK_GW0 : MK_GW1) - (layer == 0 ? MK_TAIL0 : MK_TAIL1); S.L1 = (layer == 0 ? MK_GW0 : MK_GW1);
                pg8::EpiProj E{PROJB, GATE, b_gate + layer * 4096, 1.0f};
                pg8::gemm_phase<pg8::EpiProj, pg8::PlainOrderOff, true, true>(lds, g, S, E, wave_s);
            }
#endif
            GRID_BARC(3);
        }
        if (IN(pb + 3)) { PH_VARS
            const float* snw = opqp(p.in[20]) + layer * 512; const float* rnw = opqp(p.in[21]) + layer * 512;
            for (int row = gw; row < T; row += NGW) {
                bf16* y = BR + (size_t)row * 2048; const bf16* pr = PROJB + (size_t)row * PJ;
                {
                    const v4u yw = *(const v4u*)(y + 512 + 8 * lane), zw = *(const v4u*)(pr + C_Z + 8 * lane);
                    float v[8] = {bflo(yw.x), bfhi(yw.x), bflo(yw.y), bfhi(yw.y), bflo(yw.z), bfhi(yw.z), bflo(yw.w), bfhi(yw.w)};
                    const float z[8] = {bflo(zw.x), bfhi(zw.x), bflo(zw.y), bfhi(zw.y), bflo(zw.z), bfhi(zw.z), bflo(zw.w), bfhi(zw.w)};
                    float ss = 0.f;
#pragma unroll
                    for (int q = 0; q < 8; ++q) { v[q] *= siluf_(z[q]); ss += v[q] * v[q]; }
                    const float r = 1.0f / sqrtf(wave_sum(ss) * (1.0f / 512.0f) + 1e-6f);
#pragma unroll
                    for (int q = 0; q < 8; ++q) v[q] *= r * snw[8 * lane + q];
                    v4u o; o.x = pk2(v[0], v[1]); o.y = pk2(v[2], v[3]); o.z = pk2(v[4], v[5]); o.w = pk2(v[6], v[7]);
                    *(v4u*)(y + 512 + 8 * lane) = o;
                }
                {
                    const v4u yw = *(const v4u*)(y + 1024 + 8 * lane), gw_ = *(const v4u*)(pr + C_G + 8 * lane);
                    float v[8] = {bflo(yw.x), bfhi(yw.x), bflo(yw.y), bfhi(yw.y), bflo(yw.z), bfhi(yw.z), bflo(yw.w), bfhi(yw.w)};
                    const float gg[8] = {bflo(gw_.x), bfhi(gw_.x), bflo(gw_.y), bfhi(gw_.y), bflo(gw_.z), bfhi(gw_.z), bflo(gw_.w), bfhi(gw_.w)};
                    float s = 0.f;
#pragma unroll
                    for (int q = 0; q < 8; ++q) s += v[q];
                    s = sum8(s);
                    const float mu = s * (1.0f / 64.0f); float q2 = 0.f;
#pragma unroll
                    for (int q = 0; q < 8; ++q) { v[q] -= mu; q2 += v[q] * v[q]; }
                    q2 = sum8(q2);
                    const float rs = 1.0f / sqrtf(q2 * (1.0f / 64.0f) + 1e-6f);
#pragma unroll
                    for (int q = 0; q < 8; ++q) v[q] = siluf_(gg[q]) * (v[q] * rs * rnw[8 * lane + q]);
                    v4u o; o.x = pk2(v[0], v[1]); o.y = pk2(v[2], v[3]); o.z = pk2(v[4], v[5]); o.w = pk2(v[6], v[7]);
                    *(v4u*)(y + 1024 + 8 * lane) = o;
                }
            }
            pg8::Gemm g{512, 512, 512}; pg8::PlainOrder S; S.A = (const char*)YSB; S.B = (const char*)WGLU; S.nM = 64; S.nN = 2; S.lda = 512; S.ldb = 512; S.G = G; S.c = bx;
            pg8::EpiGlu E{YSB, BR};
            pg8::gemm_phase<pg8::EpiGlu, pg8::PlainOrder, true, true>(lds, g, S, E, wave_s);
            {
                const int qoff = G >= 256 ? 128 : 0;
                pg8::Gemm gq{1024, 1024, 256}; pg8::QKWOrder Sq; Sq.kx_ = (const char*)KX; Sq.wqn_ = (const char*)WQ; Sq.G = G - qoff; Sq.c = bx - qoff;
                pg8::EpiStore Eq{QKW, 1024};
                pg8::gemm_phase<pg8::EpiStore, pg8::QKWOrder, false, false>(lds, gq, Sq, Eq, wave_s);
            }
            if ((layer == 0 ? MK_GW0 : MK_GW1) < 1024) {
                using POF2 = std::conditional<true, pg8::PlainOrderOffF8, pg8::PlainOrderOff>::type; constexpr int ldw2 = 512; constexpr float psc2 = 1.0f / 64.0f;
                pg8::Gemm g2{ldw2, ldw2, ldw2}; POF2 S2; S2.A = layer == 1 ? (const char*)HN8L1 : (const char*)H; S2.B = (const char*)WIN + (size_t)4864 * 2048 - (size_t)4864 * 1024; S2.nM = 64; S2.nN = 16; S2.lda = ldw2; S2.ldb = ldw2; S2.G = G; S2.c = vcu; S2.pn0 = 19; S2.L0 = (layer == 0 ? MK_GW0 : MK_GW1); S2.L1 = 1024;
                pg8::EpiProj E2{PROJB, GATE, b_gate + layer * 4096, psc2};
                pg8::gemm_phase<pg8::EpiProj, POF2, true, true>(lds, g2, S2, E2, wave_s);
            }
            GRID_BARC(4);
        }
        if (IN(pb + 4)) { PH_VARS
#ifdef MK_EXP_A
            pg8::Gemm g{2048, 2048, 2048}; pg8::PlainOrder S; S.A = (const char*)BR; S.B = (const char*)WB; S.nM = 64; S.nN = 4; S.lda = 2048; S.ldb = 2048; S.G = G; S.c = bx;
            pg8::EpiStore E{MERGED, 1024};
            pg8::gemm_phase<pg8::EpiStore, pg8::PlainOrder, true, true>(lds, g, S, E, wave_s);
#else
            pg8::Gemm g{2048, 2048, 512}; pg8::MergeOrder S; S.br_ = (const char*)BR; S.wb_ = (const char*)WB; S.G = G; S.c = bx;
            pg8::EpiMerge E{GATE, MERGED};
            pg8::gemm_phase<pg8::EpiMerge, pg8::MergeOrder, true, true>(lds, g, S, E, wave_s);
#endif
            GRID_BARC(5);
        }
        if (IN(pb + 5)) { PH_VARS
            pg8::Gemm g{1024, 1024, 1024}; pg8::PlainOrder S; S.A = (const char*)MERGED; S.B = (const char*)WOUT; S.nM = 64; S.nN = 4; S.lda = 1024; S.ldb = 1024; S.G = G; S.c = bx;
            pg8::EpiRes E{layer == 0 ? x_ : (const float*)H, H};
            pg8::gemm_phase<pg8::EpiRes, pg8::PlainOrder, true, true>(lds, g, S, E, wave_s);
            GRID_BARC(6);
        }
        if (IN(pb + 6)) { PH_VARS
            {
                const int voff = G >= 256 ? G - 128 : 0;
                pg8::Gemm gv{1024, 1024, 256}; pg8::VWOOrder Sv; Sv.wo_ = (const char*)WO; Sv.v_ = (const char*)VT; Sv.G = G - voff; Sv.c = bx - voff;
                pg8::EpiStore Ev{VWO, 1024};
                pg8::gemm_phase<pg8::EpiStore, pg8::VWOOrder, false, false>(lds, gv, Sv, Ev, wave_s);
            }
            norm_rows(H, HN, T, gw, NGW, lane, NoPost{});
            GRID_BARC(7);
        }
        if (IN(pb + 8)) { PH_VARS
            pg8::Gemm g{1024, 1024, 1024}; pg8::ScoreOrder S; S.hn_ = (const char*)HN; S.qkw_ = (const char*)QKW; S.G = G; S.c = bx;
            pg8::EpiSoftmax E{PB, (PG8_LAS float*)xch};
            for (int sb = 0; sb < 256; sb += G) { S.base = sb; pg8::gemm_phase<pg8::EpiSoftmax, pg8::ScoreOrder, false, false>(lds, g, S, E, wave_s); }
            GRID_BARC(9);
        }
        if (IN(pb + 10)) { PH_VARS
            pg8::Gemm g{1024, 1024, 1024}; pg8::PVWOrder S; S.p_ = (const char*)PB; S.vwo_ = (const char*)VWO; S.G = G; S.c = bx;
            pg8::EpiRes E{H, H};
            pg8::gemm_phase<pg8::EpiRes, pg8::PVWOrder, true, true>(lds, g, S, E, wave_s);
            GRID_BARC(11);
        }
        if (layer == 0) {
            if (IN(pb + 11)) { PH_VARS
                norm_rows(H, HN, T, gw, NGW, lane, NoPost{});
                GRID_BARC(7);
            }
            if (IN(pb + 12)) { PH_VARS
                pg8::Gemm g{1024, 1024, 1024}; pg8::PlainOrder S; S.A = (const char*)HN; S.B = (const char*)W13; S.nM = 64; S.nN = 22; S.lda = 1024; S.ldb = 1024; S.G = G; S.c = bx;
                pg8::EpiSwiglu E{ACT, DFF, 1.0f};
                pg8::gemm_phase<pg8::EpiSwiglu, pg8::PlainOrder, true, true>(lds, g, S, E, wave_s);
                GRID_BARC(12);
            }
            if (IN(pb + 13)) { PH_VARS
                pg8::Gemm g{DFF, DFF, DFF}; pg8::PlainOrder S; S.A = (const char*)ACT; S.B = (const char*)W2T; S.nM = 64; S.nN = 4; S.lda = DFF; S.ldb = DFF; S.G = G; S.c = bx;
                pg8::EpiRes E{H, H};
                pg8::gemm_phase<pg8::EpiRes, pg8::PlainOrder, true, true>(lds, g, S, E, wave_s);
                GRID_BARC(13);
            }
            if (IN(pb + 14)) { PH_VARS
                for (int i = tid; i < 8192; i += 512) w8[i] = norm_mix[D + (i >> 3)] * w_in[(size_t)D * IN_TOTAL + (size_t)(i >> 3) * IN_TOTAL + O_DT + (i & 7)];
                __syncthreads();
                norm_rows(H, HN, T, gw, NGW, lane, [&](const int row, const float r, const f32x4 (&v)[4]) { float lg[8]; row_dot8(v, w8, lane, lg);
                    float mine = 0.f;
#pragma unroll
                    for (int e = 0; e < 8; ++e) if (lane == e) mine = lg[e];
                    if (lane < 8) DT[(size_t)row * 8 + lane] = softplusf_(r * mine + opqp(p.in[17])[8 + lane]);
                    { unsigned* h8 = (unsigned*)(HN8L1 + (size_t)row * 1024) + lane;
#pragma unroll
                      for (int j = 0; j < 4; ++j) { int p8 = 0; p8 = __builtin_amdgcn_cvt_pk_fp8_f32(v[j].x * r, v[j].y * r, p8, false); p8 = __builtin_amdgcn_cvt_pk_fp8_f32(v[j].z * r, v[j].w * r, p8, true); h8[64 * j] = (unsigned)p8; } } });
                __syncthreads();
                GRID_BARC(7);
            }
        } else {
            if (IN(pb + 11)) { PH_VARS
                for (int i = tid; i < 8192; i += 512) w8[i] = norm_ffn[D + (i >> 3)] * moe_router[i];
                LAS int* lcnt = (LAS int*)(lds + 40960); LAS int* lbase = lcnt + 8; LAS i32x4* lti = (LAS i32x4*)(lds + 41984);
                if (tid < 8) lcnt[tid] = 0;
                __syncthreads();
                { int it = 0;
                norm_rows(H, HN, T, gw, NGW, lane, [&](const int row, const float r, const f32x4 (&v)[4]) { float lg[8]; row_dot8(v, w8, lane, lg);
                    { unsigned* h8 = (unsigned*)(HN8 + (size_t)row * 1024) + lane;
#pragma unroll
                      for (int j = 0; j < 4; ++j) { int p8 = 0; p8 = __builtin_amdgcn_cvt_pk_fp8_f32(v[j].x * r, v[j].y * r, p8, false); p8 = __builtin_amdgcn_cvt_pk_fp8_f32(v[j].z * r, v[j].w * r, p8, true); h8[64 * j] = (unsigned)p8; } }
                    if (lane == 0) {
                        int i1 = 0; float v1 = lg[0];
#pragma unroll
                        for (int e = 1; e < 8; ++e) if (lg[e] > v1) { v1 = lg[e]; i1 = e; }
                        int i2 = 0; float v2 = -3.0e38f;
#pragma unroll
                        for (int e = 0; e < 8; ++e) if (e != i1 && lg[e] > v2) { v2 = lg[e]; i2 = e; }
                        const float w1 = 1.0f / (1.0f + expf(r * (v2 - v1))), w2 = 1.0f - w1;
                        const int r1 = __hip_atomic_fetch_add(lcnt + i1, 1, __ATOMIC_RELAXED, __HIP_MEMORY_SCOPE_WORKGROUP), r2 = __hip_atomic_fetch_add(lcnt + i2, 1, __ATOMIC_RELAXED, __HIP_MEMORY_SCOPE_WORKGROUP);
                        lti[wave * 32 + (it & 31)] = (i32x4){i1, i2, r1, r2}; TOPW[row] = (f32x2){w1, w2};
                    } ++it; }); }
                __syncthreads();
                if (tid < 8) lbase[tid] = atomicAdd(&CNT[tid], lcnt[tid]);
                __syncthreads();
                { int it = 0;
                for (int row = gw; row < T; row += NGW, ++it) if (lane == 0) { i32x4 ti = lti[wave * 32 + (it & 31)]; ti.z += lbase[ti.x]; ti.w += lbase[ti.y]; TOPI[row] = ti; } }
                __syncthreads();
                {
                    int rot = 0;
                    for (int e = 0; e < NE; ++e) {
                        CVT_LOOP8(16 * 112, 64.0f, 1024, MapW13 m{moe_w1 + (size_t)e * D * DFE, moe_w3 + (size_t)e * D * DFE, norm_ffn + D, (bf16*)((unsigned char*)W13E + (size_t)e * 2 * DFE * D), DFE, 2 * DFE});
                        CVT_LOOP8(56 * 16, 64.0f, DFE, MapPlain m{moe_w2 + (size_t)e * DFE * D, DFE, D, nullptr, 1.f, (bf16*)((unsigned char*)W2E + (size_t)e * D * DFE), DFE});
                    }
                }
                GRID_BARC(14);
            }
            int t1 = 0, t2 = 0, t3 = 0, t4 = 0, t5 = 0, t6 = 0, t7 = 0, ntiles = 0;
            if (lo <= pb + 14 && hi > pb + 12) {
                int acc = 0;
#pragma unroll
                for (int e = 0; e < 8; ++e) { const int c = __hip_atomic_load(&CNT[e], RLX_AGENT); acc += (c + 255) >> 8;
                    if (e == 0) t1 = acc; if (e == 1) t2 = acc; if (e == 2) t3 = acc; if (e == 3) t4 = acc; if (e == 4) t5 = acc; if (e == 5) t6 = acc; if (e == 6) t7 = acc; if (e == 7) ntiles = acc; }
            }
            if (IN(pb + 12)) { PH_VARS
                for (int row = gw; row < T; row += NGW) {
                    const i32x4 ti = TOPI[row];
                    const int e1 = ti.x, e2 = ti.y;
                    const int s1 = (e1 == 0 ? 0 : e1 == 1 ? t1 : e1 == 2 ? t2 : e1 == 3 ? t3 : e1 == 4 ? t4 : e1 == 5 ? t5 : e1 == 6 ? t6 : t7) * 256 + ti.z;
                    const int s2 = (e2 == 0 ? 0 : e2 == 1 ? t1 : e2 == 2 ? t2 : e2 == 3 ? t3 : e2 == 4 ? t4 : e2 == 5 ? t5 : e2 == 6 ? t6 : t7) * 256 + ti.w;
                    { const v4u a8 = *((const v4u*)(HN8 + (size_t)row * 1024) + lane); *((v4u*)(XS8 + (size_t)s1 * 1024) + lane) = a8; *((v4u*)(XS8 + (size_t)s2 * 1024) + lane) = a8; }
                    if (lane == 0) SLOT[row] = (i32x2){s1, s2};
                }
                GRID_BARC(15);
            }
            if (IN(pb + 13)) { PH_VARS
                pg8::Gemm g{512, 512, 512}; pg8::MoeUpF8 S; S.A = (const char*)XS8; S.B = (const char*)W13E; S.estride = (size_t)2 * DFE * D; S.lda = 512; S.ldb = 512; S.ntiles = ntiles; S.nN = 28; S.G = G; S.c = bx;
                S.t1 = t1; S.t2 = t2; S.t3 = t3; S.t4 = t4; S.t5 = t5; S.t6 = t6; S.t7 = t7;
                pg8::EpiSwigluF8 E{(unsigned char*)ACTE, DFE, 1.0f / 64.0f, 2.0f};
                pg8::gemm_phase<pg8::EpiSwigluF8, pg8::MoeUpF8, false, true>(lds, g, S, E, wave_s);
                GRID_BARC(16);
            }
            if (IN(pb + 14)) { PH_VARS
                { pg8::Gemm g{DFE / 2, DFE / 2, DFE / 2}; pg8::MoeDownOrderF8 S; S.A = (const char*)ACTE; S.B = (const char*)W2E; S.estride = (size_t)D * DFE; S.lda = DFE / 2; S.ldb = DFE / 2; S.G = G; S.c = vcu;
                  S.t1 = t1; S.t2 = t2; S.t3 = t3; S.t4 = t4; S.t5 = t5; S.t6 = t6; S.t7 = t7;
                  pg8::EpiStoreS E{XS, 1024, 1.0f / 128.0f};
                  pg8::gemm_phase<pg8::EpiStoreS, pg8::MoeDownOrderF8, true, true>(lds, g, S, E, wave_s); }
                { pg8::Gemm g{DFE / 2, DFE / 2, 256}; pg8::MoeDownTailF8 S; S.A = (const char*)ACTE; S.B = (const char*)W2E; S.estride = (size_t)D * DFE; S.lda = DFE / 2; S.ldb = DFE / 2; S.ntiles = ntiles; S.G = G; S.c = vcu;
                  S.t1 = t1; S.t2 = t2; S.t3 = t3; S.t4 = t4; S.t5 = t5; S.t6 = t6; S.t7 = t7;
                  pg8::EpiPartF32S E{YPART, 1.0f / 128.0f};
                  pg8::gemm_phase<pg8::EpiPartF32S, pg8::MoeDownTailF8, true, true>(lds, g, S, E, wave_s); }
                GRID_BARC(17);
            }
            if (IN(pb + 15)) { PH_VARS
                const unsigned bad = __hip_atomic_load(ctl + CW_BAR + XB_TMO, RLX_AGENT);
                for (int row = gw; row < T; row += NGW) {
                    const i32x2 sl = SLOT[row]; const f32x2 tw = TOPW[row];
                    const f32x4* hr = (const f32x4*)(H + (size_t)row * D) + lane;
                    f32x4 v[4]; float ss = 0.f;
#pragma unroll
                    for (int j = 0; j < 4; ++j) v[j] = hr[64 * j];
#pragma unroll
                    for (int k = 0; k < 2; ++k) { const int s_ = k ? sl.y : sl.x; const float w_ = k ? tw.y : tw.x;
                        if (s_ < 32768) { const v2u* y = (const v2u*)(XS + (size_t)s_ * D) + lane;
#pragma unroll
                            for (int j = 0; j < 4; ++j) { const v2u a = y[64 * j]; v[j].x += w_ * bflo(a.x); v[j].y += w_ * bfhi(a.x); v[j].z += w_ * bflo(a.y); v[j].w += w_ * bfhi(a.y); } }
                        else { const f32x4* yp = (const f32x4*)(YPART + ((size_t)((s_ >> 8) - 128) * 7 * 256 + (s_ & 255)) * 1024) + lane;
                            for (int p7 = 0; p7 < 7; ++p7)
#pragma unroll
                                for (int j = 0; j < 4; ++j) v[j] += yp[(size_t)p7 * 256 * 256 + 64 * j] * w_; } }
#pragma unroll
                    for (int j = 0; j < 4; ++j) ss += (v[j].x * v[j].x + v[j].y * v[j].y) + (v[j].z * v[j].z + v[j].w * v[j].w);
                    float r = 1.0f / sqrtf(wave_sum(ss) * (1.0f / 1024.0f) + 1e-6f);
                    if (bad) r = __builtin_nanf("");
                    f32x4* orow = (f32x4*)(H + (size_t)row * D) + lane;
#pragma unroll
                    for (int j = 0; j < 4; ++j) { const f32x4 g4 = *((const f32x4*)norm_final + lane + 64 * j); orow[64 * j] = v[j] * r * g4; }
                }
            }
        }
        }
#ifdef MK_TPROBE
    if (IN(98)) { GRID_BAR(); PH_VARS
        const float tus = fmaxf((float)__hip_atomic_load(ctl + 20100, RLX_AGENT) * 0.01f, 1.0f);
        const float tp_v = __builtin_amdgcn_sqrtf(0.1f * __builtin_amdgcn_exp2f((1.0f / MK_TQ) * __builtin_rintf((float)MK_TQ * __builtin_amdgcn_logf(tus))));
        for (int i = gt; i < cf::T * cf::D / 4; i += NGT) ((f32x4*)H)[i] = (f32x4){tp_v, tp_v, tp_v, tp_v};
    }
#endif
#ifdef MK_DUMP
    if (IN(99)) { PH_VARS
        for (int row = gw; row < cf::T; row += NGW) {
#pragma unroll
            for (int j = 0; j < 16; ++j) { const int cc = lane + 64 * j; float v;
#if MK_DUMP == 1
                v = (cc < 512 ? bf1(HN[(size_t)row * 512 + cc]) : bf1(BR[(size_t)row * 2048 + cc])) + bf1(BR[(size_t)row * 2048 + cc + 1024]);
#elif MK_DUMP == 2
                v = bf1(PROJB[(size_t)row * cf::PJ + cc]) + bf1(PROJB[(size_t)row * cf::PJ + cc + 1024]) + bf1(PROJB[(size_t)row * cf::PJ + cc + 2048]) + bf1(PROJB[(size_t)row * cf::PJ + cc + 3072]) + bf1(GATE[(size_t)row * 4096 + cc]) + bf1(GATE[(size_t)row * 4096 + 3072 + cc]) + (cc < 768 ? bf1(PROJB[(size_t)row * cf::PJ + cc + 4096]) : 0.f);
#elif MK_DUMP == 5
                v = bf1(GATE[(size_t)row * 4096 + cc]) + bf1(GATE[(size_t)row * 4096 + 1024 + cc]) + bf1(GATE[(size_t)row * 4096 + 2048 + cc]) + bf1(GATE[(size_t)row * 4096 + 3072 + cc]);
#elif MK_DUMP == 7
                v = bf1(GATE[(size_t)row * 4096 + MK_GB * 1024 + cc]);
#elif MK_DUMP == 3
                v = bf1(BR[(size_t)row * 2048 + cc]) + bf1(BR[(size_t)row * 2048 + cc + 1024]);
#elif MK_DUMP == 4
                v = bf1(MERGED[(size_t)row * 1024 + cc]);
#endif
                H[(size_t)row * 1024 + cc] = v; }
        }
    }
#endif
#undef IN
#undef GRID_BAR
#undef ws
#undef ctl
#undef H
}

#undef PH_VARS
#undef ws
#undef ctl
#undef GRID_BAR
#undef IN
#undef x_
#undef mem_
#undef positions_
#undef norm_mix
#undef w_in
#undef b_gate
#undef w_branch
#undef w_out
#undef norm_xa
#undef norm_mem
#undef xa_wq
#undef xa_wk
#undef xa_wv
#undef xa_wo
#undef norm_ffn
#undef ffn_w1
#undef ffn_w3
#undef ffn_w2
#undef moe_router
#undef moe_w1
#undef moe_w3
#undef moe_w2
#undef norm_final
#undef H
#undef HN
#undef KVB
#undef COS
#undef SIN
#undef DT
#undef MNR
#undef PROJB
#undef GATE
#undef BR
#undef XBCC
#undef XLC
#undef MP
#undef MERGED
#undef XQ
#undef PB
#undef XO
#undef ACT
#undef W13E
#undef W2E
#undef XS
#undef ACTE
#undef YPART
#undef ROWOF
#undef HN8
#undef XS8
#undef HN8L1
#undef TOPI
#undef TOPW
#undef SLOT
#undef CNT
#undef W13
#undef W2T
#undef CVT_LOOP
#undef WLP
#undef WIN
#undef WGLU
#undef WB
#undef WOUT
#undef WQ
#undef WO
#undef KX
#undef VT
extern "C" void kernel_launch(void* const* d_in, const int* in_sizes, int n_in, void* d_out, int out_size, void* d_ws, size_t ws_size, hipStream_t stream) {
    static int grid = 0;
    if (grid == 0) {
        if (n_in != 46 || in_sizes[0] != cf::T * cf::D || out_size != cf::T * cf::D || ws_size < WS_NEED) { fprintf(stderr, "kernel_launch: unexpected shapes / workspace (n_in %d, in0 %d, out %d, ws %zu < %zu)\n", n_in, n_in > 0 ? in_sizes[0] : -1, out_size, ws_size, (size_t)WS_NEED); grid = -1; return; }
        int dev = 0, cus = 0, per_cu = 0;
        if (hipGetDevice(&dev) != hipSuccess || hipDeviceGetAttribute(&cus, hipDeviceAttributeMultiprocessorCount, dev) != hipSuccess) { grid = -1; return; }
        if (hipFuncSetAttribute((const void*)mega, hipFuncAttributeMaxDynamicSharedMemorySize, LDS_BYTES) != hipSuccess) { fprintf(stderr, "kernel_launch: hipFuncSetAttribute failed\n"); grid = -1; return; }
        if (hipOccupancyMaxActiveBlocksPerMultiprocessor(&per_cu, (const void*)mega, NWAVES * 64, LDS_BYTES) != hipSuccess || per_cu < 1) fprintf(stderr, "kernel_launch: occupancy query reports %d\n", per_cu);
        (void)hipGetLastError();
        grid = cus;
    }
    if (grid < 0) return;
    if (hipMemsetAsync((char*)d_ws + WS_CTL, 0, CTL_ZERO_BYTES, stream) != hipSuccess) return;
    Params a{};
    for (int i = 0; i < 46; ++i) a.in[i] = (const float*)d_in[i];
    a.out = (float*)d_out; a.ws = (unsigned char*)d_ws;
#ifdef MK_PER_PHASE
    for (int ph = 0; ph < MK_PER_PHASE; ++ph) { if (ph >= 16 && ph <= 20) continue; a.ph_lo = ph; a.ph_hi = ph + 1; hipLaunchKernelGGL(mega, dim3(grid), dim3(NWAVES * 64), LDS_BYTES, stream, a); }
#ifdef MK_DUMP
    a.ph_lo = 99; a.ph_hi = 100; hipLaunchKernelGGL(mega, dim3(grid), dim3(NWAVES * 64), LDS_BYTES, stream, a);
#endif
#elif defined(MK_SELFCHK)
    {
        using namespace nv;
        const float* x = (const float*)d_in[0]; char* wsb = (char*)d_ws;
        float* hn = (float*)wsb; float* PROJ = hn + (size_t)2048 * 1024; float* BRn = PROJ + (size_t)2048 * PW; float* TMP = BRn + (size_t)2048 * 2048; float* GLG = TMP + (size_t)2048 * 1024; float* MER = GLG + (size_t)2048 * 1024;
        float* ct = MER + (size_t)2048 * 1024; float* st = ct + (size_t)T * 32; float* hh = st + (size_t)T * 32;
        char* safe = wsb + (size_t)524 * 1048576; float* sBR = (float*)safe; float* sMER = sBR + (size_t)2048 * 2048; float* sH = sMER + (size_t)2048 * 1024; float* sPROJ = sH + (size_t)2048 * 1024; float* sGATE = sPROJ + (size_t)256 * PW; float* acc = sGATE + (size_t)256 * 4096;
        const float* Win = (const float*)d_in[4];
        hipLaunchKernelGGL(k_rope_tab, dim3((T * 32 + 255) / 256), dim3(256), 0, stream, (const int*)d_in[2], ct, st);
        hipLaunchKernelGGL(k_rmsnorm, dim3(2048 / 4), dim3(256), 0, stream, x, (const float*)d_in[3], hn, 2048);
        sgemm(stream, false, hn, D, Win, IN_TOTAL, PROJ, PW, 2048, PW, D);
        hipMemcpyAsync(sPROJ, PROJ, (size_t)256 * PW * 4, hipMemcpyDeviceToDevice, stream);
        hipLaunchKernelGGL(k_s5_scan, dim3(32), dim3(64), 0, stream, PROJ, BRn, (const float*)d_in[6], (const float*)d_in[7], (const float*)d_in[8], (const float*)d_in[9], (const float*)d_in[10], (const float*)d_in[11], (const float*)d_in[12], (const float*)d_in[13]);
        sgemm(stream, false, BRn, 2048, (const float*)d_in[14], 512, TMP, 512, 2048, 512, 512);
        hipLaunchKernelGGL(k_s5_gate, dim3((2048 * 512 + 255) / 256), dim3(256), 0, stream, BRn, TMP, 2048);
        hipLaunchKernelGGL(k_conv_inplace, dim3((768 + 255) / 256), dim3(256), 0, stream, PROJ, PW, OFF_XBC, 768, (const float*)d_in[15], (const float*)d_in[16], 1, 1);
        hipLaunchKernelGGL(k_ssd_scan, dim3(8), dim3(256), 0, stream, PROJ, BRn, (const float*)d_in[17], (const float*)d_in[18], (const float*)d_in[19]);
        hipLaunchKernelGGL(k_ssd_post, dim3(2048 / 4), dim3(256), 0, stream, BRn, PROJ, (const float*)d_in[20], 2048);
        hipLaunchKernelGGL(k_rope, dim3((2048 * 256 + 255) / 256), dim3(256), 0, stream, PROJ, ct, st, 0, 2048);
        hipLaunchKernelGGL(k_ret_scan, dim3(8), dim3(256), 0, stream, PROJ, BRn);
        hipLaunchKernelGGL(k_ret_post, dim3(2048 / 4), dim3(256), 0, stream, BRn, PROJ, (const float*)d_in[21], 2048);
        hipLaunchKernelGGL(k_conv_inplace, dim3((512 + 255) / 256), dim3(256), 0, stream, PROJ, PW, OFF_XL, 512, (const float*)d_in[22], (const float*)d_in[23], 0, 1);
        hipLaunchKernelGGL(k_lru_scan, dim3(8), dim3(64), 0, stream, PROJ, BRn, (const float*)d_in[24], (const float*)d_in[25], (const float*)d_in[26], (const float*)d_in[27], (const float*)d_in[28]);
        for (int k = 0; k < 4; ++k) {
            sgemm(stream, false, BRn + k * 512, 2048, (const float*)d_in[29] + (size_t)k * 512 * 1024, 1024, TMP, 1024, 2048, 1024, 512);
            sgemm(stream, false, hn, D, Win + OFF_GATE + k * 1024, IN_TOTAL, GLG, 1024, 2048, 1024, D);
            hipLaunchKernelGGL(k_dbg_gate, dim3((256 * 1024 + 255) / 256), dim3(256), 0, stream, sGATE + k * 1024, GLG, (const float*)d_in[5] + k * 1024);
            hipLaunchKernelGGL(k_gate_acc, dim3((2048 * 1024 + 255) / 256), dim3(256), 0, stream, MER, TMP, GLG, (const float*)d_in[5] + k * 1024, k == 0 ? 1 : 0, 2048);
        }
        hipMemcpyAsync(hh, x, (size_t)2048 * 1024 * 4, hipMemcpyDeviceToDevice, stream);
        sgemm(stream, true, MER, 1024, (const float*)d_in[30], D, hh, D, 2048, D, D);
        hipMemcpyAsync(sBR, BRn, (size_t)2048 * 2048 * 4, hipMemcpyDeviceToDevice, stream);
        hipMemcpyAsync(sMER, MER, (size_t)2048 * 1024 * 4, hipMemcpyDeviceToDevice, stream);
        hipMemcpyAsync(sH, hh, (size_t)2048 * 1024 * 4, hipMemcpyDeviceToDevice, stream);
        hipMemsetAsync((char*)d_ws + WS_CTL, 0, CTL_ZERO_BYTES, stream);
        a.ph_lo = 0; a.ph_hi = MK_SELFCHK;
        hipLaunchKernelGGL(mega, dim3(grid), dim3(NWAVES * 64), LDS_BYTES, stream, a);
        hipMemsetAsync(acc, 0, 256, stream);
        const unsigned short* PROJBp = (const unsigned short*)((char*)d_ws + R_PROJB); const unsigned short* GATEp = (const unsigned short*)((char*)d_ws + R_GATE); const unsigned short* BRp = (const unsigned short*)((char*)d_ws + R_BR); const unsigned short* MERp = (const unsigned short*)((char*)d_ws + R_MERGED);
        hipLaunchKernelGGL(k_dbg_cmp, dim3(256), dim3(256), 0, stream, sPROJ, PW, 0, (const void*)PROJBp, 4864, 0, 1, 256, 1792, acc + 0);
        hipLaunchKernelGGL(k_dbg_cmp, dim3(256), dim3(256), 0, stream, sPROJ, PW, 2824, (const void*)PROJBp, 4864, 2816, 1, 256, 1024, acc + 2);
        hipLaunchKernelGGL(k_dbg_cmp, dim3(256), dim3(256), 0, stream, sPROJ, PW, 3848, (const void*)PROJBp, 4864, 3840, 1, 256, 1024, acc + 4);
        for (int kk = 0; kk < 4; ++kk) hipLaunchKernelGGL(k_dbg_cmp, dim3(256), dim3(256), 0, stream, sGATE, 4096, kk * 1024, (const void*)GATEp, 4096, kk * 1024, 1, 256, 1024, acc + 6 + 2 * kk);
        if (MK_SELFCHK >= 5) for (int s = 0; s < 4; ++s) hipLaunchKernelGGL(k_dbg_cmp, dim3(256), dim3(256), 0, stream, sBR, 2048, s * 512, (const void*)BRp, 2048, s * 512, 1, 2048, 512, acc + 14 + 2 * s);
        if (MK_SELFCHK >= 6) hipLaunchKernelGGL(k_dbg_cmp, dim3(256), dim3(256), 0, stream, sMER, 1024, 0, (const void*)MERp, 1024, 0, 1, 2048, 1024, acc + 22);
        if (MK_SELFCHK >= 7) hipLaunchKernelGGL(k_dbg_cmp, dim3(256), dim3(256), 0, stream, sH, 1024, 0, (const void*)d_out, 1024, 0, 0, 2048, 1024, acc + 24);
        hipLaunchKernelGGL(k_dbg_report, dim3(1), dim3(1), 0, stream, acc, acc + 64);
        hipLaunchKernelGGL(k_dbg_fill, dim3(4096), dim3(256), 0, stream, (float*)d_out, acc + 64, (size_t)T * D);
        return;
    }
#elif defined(MK_HYBRID)
    a.ph_lo = 0; a.ph_hi = MK_HYBRID;
    hipLaunchKernelGGL(mega, dim3(grid), dim3(NWAVES * 64), LDS_BYTES, stream, a);
    nv::naive_from(MK_HYB_L, MK_HYB_S, d_in, d_out, d_ws, stream);
    return;
#else
    a.ph_lo = 0; a.ph_hi = 1000;
    hipLaunchKernelGGL(mega, dim3(grid), dim3(NWAVES * 64), LDS_BYTES, stream, a);
#endif
    const hipError_t le = hipPeekAtLastError();
    if (le != hipSuccess) fprintf(stderr, "kernel_launch: launch failed: %s\n", hipGetErrorName(le));
}
```
